# Optimizing an MI355X kernel written in HIP

```python
import jax, jax.numpy as jnp
from jax import lax
import numpy as np

D_MODEL = 1024
BATCH = 4
SEQ = 8192
DEPTH = 2

D_MIX = D_MODEL
NORM_EPS = 1e-6
ATT_HEADS = 4
QK_NOPE_DIM = 128
QK_ROPE_DIM = 64
V_HEAD_DIM = 128
ATT_WIDTH = ATT_HEADS * V_HEAD_DIM
Q_LORA_RANK = D_MODEL // 4
KV_LORA_RANK = D_MODEL // 8
ROPE_THETA = 10000.0
Q_BLOCK = 128
CONV_WIDTH = D_MIX // 4
CONV_KERNEL = 31
SGU_WIDTH = D_MIX // 4
SGU_GROUPS = 4
SGU_GROUP_DIM = SGU_WIDTH // SGU_GROUPS
SGU_CHUNK = 128
IN_SPLITS = (Q_LORA_RANK, KV_LORA_RANK, QK_ROPE_DIM, ATT_WIDTH,
             CONV_WIDTH, CONV_WIDTH, CONV_WIDTH,
             SGU_WIDTH, SGU_WIDTH, SGU_WIDTH)
D_IN = Q_LORA_RANK + KV_LORA_RANK + QK_ROPE_DIM + ATT_WIDTH + 3 * CONV_WIDTH + 3 * SGU_WIDTH

kernel_name = "hymba_style_mla_conformer_sgu_hybrid"


def rms_norm(x, g):
    xf = x.astype(jnp.float32)
    y = xf * lax.rsqrt(jnp.mean(xf * xf, axis=-1, keepdims=True) + NORM_EPS)
    return (y * g.astype(jnp.float32)).astype(x.dtype)


def layer_norm(x, g, b):
    xf = x.astype(jnp.float32)
    mu = jnp.mean(xf, axis=-1, keepdims=True)
    var = jnp.mean(jnp.square(xf - mu), axis=-1, keepdims=True)
    y = (xf - mu) * lax.rsqrt(var + NORM_EPS)
    return (y * g.astype(jnp.float32) + b.astype(jnp.float32)).astype(x.dtype)


def apply_rope(x, cos, sin):
    half = x.shape[-1] // 2
    x1, x2 = x[..., :half], x[..., half:]
    return jnp.concatenate([x1 * cos - x2 * sin, x2 * cos + x1 * sin], axis=-1)


def mla_mixer(q_lat, kv_lat, k_rope, positions, q_norm_g, w_uq, kv_norm_g, w_ukv):
    B, S, _ = q_lat.shape
    q = (rms_norm(q_lat, q_norm_g) @ w_uq).reshape(B, S, ATT_HEADS, QK_NOPE_DIM + QK_ROPE_DIM)
    q_nope, q_rope = q[..., :QK_NOPE_DIM], q[..., QK_NOPE_DIM:]
    kv = (rms_norm(kv_lat, kv_norm_g) @ w_ukv).reshape(B, S, ATT_HEADS, QK_NOPE_DIM + V_HEAD_DIM)
    k_nope, v = kv[..., :QK_NOPE_DIM], kv[..., QK_NOPE_DIM:]
    inv_freq = ROPE_THETA ** (-jnp.arange(0, QK_ROPE_DIM, 2, dtype=jnp.float32) / QK_ROPE_DIM)
    ang = positions.astype(jnp.float32)[..., None] * inv_freq
    cos, sin = jnp.cos(ang).astype(q.dtype), jnp.sin(ang).astype(q.dtype)
    q_rope = apply_rope(q_rope, cos[:, :, None, :], sin[:, :, None, :])
    k_rope = apply_rope(k_rope, cos, sin)
    scale = (QK_NOPE_DIM + QK_ROPE_DIM) ** -0.5
    nb = S // Q_BLOCK
    qn_blocks = q_nope.reshape(B, nb, Q_BLOCK, ATT_HEADS, QK_NOPE_DIM).transpose(1, 0, 2, 3, 4)
    qr_blocks = q_rope.reshape(B, nb, Q_BLOCK, ATT_HEADS, QK_ROPE_DIM).transpose(1, 0, 2, 3, 4)
    k_pos = jnp.arange(S)

    def one_block(args):
        qn, qr, blk = args
        s = (jnp.einsum('bqhd,bkhd->bhqk', qn, k_nope)
             + jnp.einsum('bqhr,bkr->bhqk', qr, k_rope)).astype(jnp.float32) * scale
        q_pos = blk * Q_BLOCK + jnp.arange(Q_BLOCK)
        s = jnp.where(k_pos[None, :] <= q_pos[:, None], s, -jnp.inf)
        p = jax.nn.softmax(s, axis=-1).astype(v.dtype)
        return jnp.einsum('bhqk,bkhd->bqhd', p, v)

    out = lax.map(one_block, (qn_blocks, qr_blocks, jnp.arange(nb)))
    return out.transpose(1, 0, 2, 3, 4).reshape(B, S, ATT_WIDTH)


def conv_mixer(a, b, conv_w, conv_b, ln_g, ln_b, w_pw2):
    h = a * jax.nn.sigmoid(b)
    h = lax.conv_general_dilated(
        h, conv_w[:, None, :].astype(h.dtype), window_strides=(1,),
        padding=[(CONV_KERNEL - 1, 0)],
        dimension_numbers=('NWC', 'WIO', 'NWC'),
        feature_group_count=CONV_WIDTH) + conv_b
    h = jax.nn.silu(layer_norm(h, ln_g, ln_b))
    return h @ w_pw2


def sgu_mixer(u, v, ln_g, ln_b, w_s, b_s):
    u = jax.nn.gelu(u, approximate=False)
    v = layer_norm(jax.nn.gelu(v, approximate=False), ln_g, ln_b)
    B, S, _ = v.shape
    nc = S // SGU_CHUNK
    v = v.reshape(B, nc, SGU_CHUNK, SGU_GROUPS, SGU_GROUP_DIM)
    causal = jnp.tril(jnp.ones((SGU_CHUNK, SGU_CHUNK), dtype=bool))
    w = jnp.where(causal[None], w_s, jnp.zeros_like(w_s))
    sv = jnp.einsum('gts,bnsgc->bntgc', w, v) + b_s.T[None, None, :, :, None]
    return u * sv.reshape(B, S, SGU_WIDTH)


def hybrid_layer(x, c, positions, w_ada, b_ada, g_pre, g_post, w_in, q_norm_g, w_uq,
                 kv_norm_g, w_ukv, conv_w, conv_b, conv_ln_g, conv_ln_b, w_pw2,
                 sgu_ln_g, sgu_ln_b, w_s, b_s, w_out):
    mod = jax.nn.silu(c) @ w_ada + b_ada
    shift, scale, gate = jnp.split(mod, 3, axis=-1)
    h = rms_norm(x, g_pre) * (1 + scale[:, None, :]) + shift[:, None, :]
    z = h @ w_in
    (q_lat, kv_lat, k_rope, g_att, conv_a, conv_b_in, g_conv,
     sgu_u, sgu_v, g_sgu) = jnp.split(z, np.cumsum(IN_SPLITS)[:-1].tolist(), axis=-1)
    y_att = mla_mixer(q_lat, kv_lat, k_rope, positions, q_norm_g, w_uq, kv_norm_g, w_ukv)
    y_conv = conv_mixer(conv_a, conv_b_in, conv_w, conv_b, conv_ln_g, conv_ln_b, w_pw2)
    y_sgu = sgu_mixer(sgu_u, sgu_v, sgu_ln_g, sgu_ln_b, w_s, b_s)
    y = jnp.concatenate([y_att * jax.nn.silu(g_att),
                         y_conv * jax.nn.silu(g_conv),
                         y_sgu * jax.nn.silu(g_sgu)], axis=-1) @ w_out
    return x + gate[:, None, :] * rms_norm(y, g_post)


def setup_inputs(seed: int = 0) -> dict:
    key = jax.random.key(seed)
    ks = jax.random.split(key, 32)
    f32 = jnp.float32
    L = DEPTH

    def nrm(k, shape, s):
        return jax.random.normal(k, shape, f32) * s

    def gain(k, shape):
        return 1.0 + 0.02 * jax.random.normal(k, shape, f32)

    b_ada = jnp.concatenate([nrm(ks[3], (L, D_MODEL), 0.02),
                             nrm(ks[4], (L, D_MODEL), 0.02),
                             gain(ks[5], (L, D_MODEL))], axis=-1)
    return {
        "x": jax.random.normal(ks[0], (BATCH, SEQ, D_MODEL), f32),
        "c": jax.random.normal(ks[1], (BATCH, D_MODEL), f32),
        "positions": jnp.tile(jnp.arange(SEQ, dtype=jnp.int32)[None, :], (BATCH, 1)),
        "w_ada": nrm(ks[2], (L, D_MODEL, 3 * D_MODEL), 0.1 * D_MODEL ** -0.5),
        "b_ada": b_ada,
        "g_pre": gain(ks[6], (L, D_MODEL)),
        "g_post": gain(ks[7], (L, D_MODEL)),
        "w_in": nrm(ks[8], (L, D_MODEL, D_IN), D_MODEL ** -0.5),
        "q_norm_g": gain(ks[9], (L, Q_LORA_RANK)),
        "w_uq": nrm(ks[10], (L, Q_LORA_RANK, ATT_HEADS * (QK_NOPE_DIM + QK_ROPE_DIM)), Q_LORA_RANK ** -0.5),
        "kv_norm_g": gain(ks[11], (L, KV_LORA_RANK)),
        "w_ukv": nrm(ks[12], (L, KV_LORA_RANK, ATT_HEADS * (QK_NOPE_DIM + V_HEAD_DIM)), KV_LORA_RANK ** -0.5),
        "conv_w": nrm(ks[13], (L, CONV_KERNEL, CONV_WIDTH), CONV_KERNEL ** -0.5),
        "conv_b": nrm(ks[14], (L, CONV_WIDTH), 0.02),
        "conv_ln_g": gain(ks[15], (L, CONV_WIDTH)),
        "conv_ln_b": nrm(ks[16], (L, CONV_WIDTH), 0.02),
        "w_pw2": nrm(ks[17], (L, CONV_WIDTH, CONV_WIDTH), CONV_WIDTH ** -0.5),
        "sgu_ln_g": gain(ks[18], (L, SGU_WIDTH)),
        "sgu_ln_b": nrm(ks[19], (L, SGU_WIDTH), 0.02),
        "w_s": nrm(ks[20], (L, SGU_GROUPS, SGU_CHUNK, SGU_CHUNK), SGU_CHUNK ** -0.5),
        "b_s": gain(ks[21], (L, SGU_GROUPS, SGU_CHUNK)),
        "w_out": nrm(ks[22], (L, D_MIX, D_MODEL), D_MIX ** -0.5),
    }


def reference(x, c, positions, w_ada, b_ada, g_pre, g_post, w_in, q_norm_g, w_uq,
              kv_norm_g, w_ukv, conv_w, conv_b, conv_ln_g, conv_ln_b, w_pw2,
              sgu_ln_g, sgu_ln_b, w_s, b_s, w_out):
    for l in range(DEPTH):
        x = hybrid_layer(x, c, positions, w_ada[l], b_ada[l], g_pre[l], g_post[l], w_in[l],
                         q_norm_g[l], w_uq[l], kv_norm_g[l], w_ukv[l], conv_w[l], conv_b[l],
                         conv_ln_g[l], conv_ln_b[l], w_pw2[l], sgu_ln_g[l], sgu_ln_b[l],
                         w_s[l], b_s[l], w_out[l])
    return x
```

```cpp
#include <hip/hip_runtime.h>
#include <hip/hip_cooperative_groups.h>
#include <cstdio>
#include <cstdint>
namespace cg = cooperative_groups;

#ifndef MK_N_LAUNCHES
#define MK_N_LAUNCHES 1
#endif

#define LAS __attribute__((address_space(3)))
#ifndef PROBE_MASK
#define PROBE_MASK 0
#endif
#ifndef PHMASK
#define PHMASK 0xff
#endif
#define PHEN(k) (((PHMASK) >> (k)) & 1)
typedef unsigned short bf16_t;
typedef short bf16x8 __attribute__((ext_vector_type(8)));
typedef short s16x4 __attribute__((ext_vector_type(4)));
typedef float f32x2 __attribute__((ext_vector_type(2)));
typedef float f32x4 __attribute__((ext_vector_type(4)));
typedef float f32x16 __attribute__((ext_vector_type(16)));
typedef unsigned u32x2 __attribute__((ext_vector_type(2)));
typedef unsigned u32x4 __attribute__((ext_vector_type(4)));

constexpr int DM = 1024, NB = 4, SEQ = 8192, MTOK = NB * SEQ, NLAYER = 2;
constexpr int NH = 4, DNOPE = 128, DROPE = 64, DQK = 192, DV = 128;
constexpr int QLR = 256, KVLR = 128, DIN = 2496, DINP = 2560;
constexpr int CW = 256, CK = 31, SW = 256, SG = 4, SCH = 128;
constexpr float EPS = 1e-6f;
constexpr int ZC_Q = 0, ZC_KV = 256, ZC_KR = 384, ZC_GATT = 512, ZC_CA = 1024, ZC_CB = 1280, ZC_GC = 1536, ZC_SU = 1792, ZC_SV = 2048, ZC_GS = 2304;
constexpr float QSCALE = 0.07216878364870323f * 1.4426950408889634f;

constexpr size_t MiB = 1u << 20;
constexpr size_t WS_CTL = 0, CTL_BYTES = 1 * MiB;
constexpr size_t CTL_BARW = 1024;
constexpr size_t CTL_ADACNT = 8192;
constexpr size_t CTL_MOD = 65536;
constexpr size_t WS_COS = 1 * MiB, WS_SIN = 5 * MiB;
constexpr size_t WS_WIN = 9 * MiB;
constexpr size_t WS_WOUT = 19 * MiB;
constexpr size_t WS_WUQ = 23 * MiB;
constexpr size_t WS_WUKV = 24 * MiB;
constexpr size_t WS_WPW2 = 25 * MiB;
constexpr size_t WS_WSM = 26 * MiB;
constexpr size_t WS_ADAP = 27 * MiB;
constexpr size_t WS_H = 32 * MiB;
constexpr size_t WS_Z = 96 * MiB;
constexpr size_t WS_Y = WS_Z;
constexpr size_t WS_QLN = 256 * MiB;
constexpr size_t WS_KVLN = 272 * MiB;
constexpr size_t WS_CONVH = 288 * MiB;
constexpr size_t WS_SGVT = 304 * MiB;
constexpr size_t WS_Q = 320 * MiB;
constexpr size_t WS_KN = 368 * MiB;
constexpr size_t WS_KR = 400 * MiB;
constexpr size_t WS_V = 408 * MiB;
constexpr size_t WS_YCAT = 440 * MiB;
constexpr size_t WS_END = 504 * MiB;

constexpr int LDS_BYTES = 147456;
constexpr int NTHREADS = 512, NWAVES = 8;

__device__ __forceinline__ float bf2f(unsigned short u) { return __uint_as_float(((unsigned)u) << 16); }
__device__ __forceinline__ unsigned cvtpk(float lo, float hi) { unsigned r; asm("v_cvt_pk_bf16_f32 %0, %1, %2" : "=v"(r) : "v"(lo), "v"(hi)); return r; }
__device__ __forceinline__ float lo_bf(unsigned w) { return __uint_as_float(w << 16); }
__device__ __forceinline__ float hi_bf(unsigned w) { return __uint_as_float(w & 0xffff0000u); }
#define dpp_f(v, ctrl) __int_as_float(__builtin_amdgcn_update_dpp(0, __float_as_int(v), (ctrl), 0xf, 0xf, true))
#define DPP_XOR1 0xB1
#define DPP_XOR2 0x4E
#define DPP_HMIRROR 0x141
#define DPP_MIRROR 0x140
__device__ __forceinline__ float xor1_f(float v) { return dpp_f(v, DPP_XOR1); }
__device__ __forceinline__ float wave_sum(float v) {
    v += dpp_f(v, DPP_XOR1); v += dpp_f(v, DPP_XOR2); v += dpp_f(v, DPP_HMIRROR); v += dpp_f(v, DPP_MIRROR);
    const int iv = __float_as_int(v);
    return (__int_as_float(__builtin_amdgcn_readlane(iv, 0)) + __int_as_float(__builtin_amdgcn_readlane(iv, 16))) +
           (__int_as_float(__builtin_amdgcn_readlane(iv, 32)) + __int_as_float(__builtin_amdgcn_readlane(iv, 48)));
}
__device__ __forceinline__ float sigmoidf_(float x) { return __builtin_amdgcn_rcpf(1.f + __builtin_amdgcn_exp2f(-1.4426950408889634f * x)); }
__device__ __forceinline__ float siluf_(float x) { return x * __builtin_amdgcn_rcpf(1.f + __builtin_amdgcn_exp2f(-1.4426950408889634f * x)); }
__device__ __forceinline__ float geluf_(float v) {
    const float av = __builtin_fabsf(v), t = __builtin_amdgcn_rcpf(av * 0.2316418882f + 1.0f);
    float q = t * 0.5307027145f + (-0.7265760135f); q = q * t + 0.7107068705f; q = q * t + (-0.142248368f); q = q * t + 0.127414796f; q = q * t;
    const float e = __builtin_amdgcn_exp2f((v * v) * (-0.72134752044f));
    const float m = v * (q * e);
    return v < 0.f ? m : v - m;
}

namespace pg8 {
constexpr int BM = 256, BK = 64, HALF = 128, HTB = HALF * BK * 2, STAGE_BYTES = 8 * HTB, NXCD = 8, WGM = 8;
__host__ __device__ __forceinline__ int lds_byte(int r, int c) { const int st = (r >> 4) * 2 + (c >> 5), rr = r & 15, cc = c & 31, ob = rr * 64 + cc * 2; return st * 1024 + (ob ^ (((ob >> 9) & 1) << 5)); }
__host__ __device__ __forceinline__ void stage_rc(int b, int& R, int& C) { const int st = b / 1024, sb = b % 1024, swz = sb ^ (((sb >> 9) & 1) << 5); R = (st >> 1) * 16 + swz / 64; C = (st & 1) * 32 + (swz % 64) / 2; }
__host__ __device__ __forceinline__ int perm32(int rho) { const int n = rho >> 4, i = rho & 15; return 8 * (i >> 2) + 4 * n + (i & 3); }

struct Unit { int pm, pn; };
struct Gemm { const bf16_t* A; const bf16_t* Bt; int M, N, K, lda, ldb; };

struct StaticOrder {
    int nM, nN, nwg, G, c;
    __host__ __device__ void init(int M, int N, int G_, int c_) { nM = M / BM; nN = N / BM; nwg = nM * nN; G = G_; c = c_; }
    __host__ __device__ bool next(int i, Unit& u) const {
        const long L = (long)i * G + c; if (L >= nwg) return false;
        int wgid = (int)L; { const int q = nwg / NXCD, r = nwg % NXCD, xcd = wgid % NXCD, off = wgid / NXCD; wgid = (xcd < r ? xcd * (q + 1) : r * (q + 1) + (xcd - r) * q) + off; }
        const int nig = WGM * nN, gid = wgid / nig, fm = gid * WGM, gsz = (nM - fm) < WGM ? (nM - fm) : WGM;
        u.pm = fm + ((wgid % nig) % gsz); u.pn = (wgid % nig) / gsz; return true;
    }
};

template <class Epi>
__device__ __forceinline__ void gemm_phase(LAS unsigned char* lds, const Gemm g, const StaticOrder& S, const Epi& E, const int tid) {
    const int wid = __builtin_amdgcn_readfirstlane(tid >> 6), lane = tid & 63, wr = wid >> 2, wc = wid & 3, fr = lane & 15, fq = lane >> 4;
    const int K = g.K, nt = K / BK;
    unsigned voffA[2], voffB[2];
#pragma unroll
    for (int i = 0; i < 2; ++i) { int R, C; stage_rc(tid * 16 + i * 8192, R, C); const int Rb = Epi::PERM ? ((R & ~31) + perm32(R & 31)) : R;
        voffA[i] = (unsigned)(R * g.lda + C) * 2u; voffB[i] = (unsigned)(Rb * g.ldb + C) * 2u; }
    const size_t kstep = (size_t)(BK * 2);
    const size_t hstepA = (size_t)HALF * g.lda * 2, hstepB = (size_t)HALF * g.ldb * 2;
    const size_t tstepA = 2 * hstepA, tstepB = 2 * hstepB;
    const unsigned ldsw = (unsigned)wid * 1024u;
    const int aoff = lds_byte(wr * 64 + fr, fq * 8), boff = lds_byte(wc * 32 + fr, fq * 8);
#define PG8_SA(b, h) (((b) * 2 + (h)) * HTB)
#define PG8_SB(b, h) ((4 + (b) * 2 + (h)) * HTB)
#define PG8_STAGE(bufoff, gbase, voff) do { _Pragma("unroll") for (int _i = 0; _i < 2; ++_i) \
        __builtin_amdgcn_global_load_lds((const unsigned*)((const char*)(gbase) + (voff)[_i]), (LAS unsigned*)(lds + (bufoff) + ldsw + _i * 8192), 16, 0, 0); } while (0)
#define PG8_LDA(dst, b, h) do { _Pragma("unroll") for (int m = 0; m < 4; ++m) _Pragma("unroll") for (int k = 0; k < 2; ++k) dst[m][k] = *(const LAS bf16x8*)(lds + PG8_SA(b, h) + aoff + m * 2048 + k * 1024); } while (0)
#define PG8_LDB(dst, b, h) do { _Pragma("unroll") for (int n = 0; n < 2; ++n) _Pragma("unroll") for (int k = 0; k < 2; ++k) dst[n][k] = *(const LAS bf16x8*)(lds + PG8_SB(b, h) + boff + n * 2048 + k * 1024); } while (0)
#define PG8_MMA(ai, bj, At, Bt) do { __builtin_amdgcn_s_setprio(1); _Pragma("unroll") for (int m = 0; m < 4; ++m) _Pragma("unroll") for (int n = 0; n < 2; ++n) _Pragma("unroll") for (int k = 0; k < 2; ++k) \
        acc[ai][bj][m][n] = __builtin_amdgcn_mfma_f32_16x16x32_bf16(Bt[n][k], At[m][k], acc[ai][bj][m][n], 0, 0, 0); __builtin_amdgcn_s_setprio(0); } while (0)
#define PG8_WAIT_V(n) asm volatile("s_waitcnt vmcnt(" #n ")" ::: "memory")
#define PG8_WAIT_L(n) asm volatile("s_waitcnt lgkmcnt(" #n ")" ::: "memory")
#define PG8_BAR __builtin_amdgcn_s_barrier()
#define PG8_SCHED __builtin_amdgcn_sched_barrier(0)
    Unit cur, nxt; int ui = 0;
    if (!S.next(0, cur)) return;
    f32x4 acc[2][2][4][2];
#pragma unroll
    for (int a = 0; a < 2; ++a)
#pragma unroll
        for (int b = 0; b < 2; ++b)
#pragma unroll
            for (int m = 0; m < 4; ++m)
#pragma unroll
                for (int n = 0; n < 2; ++n) acc[a][b][m][n] = (f32x4){0.f, 0.f, 0.f, 0.f};
    bf16x8 At[4][2], B0[2][2], B1[2][2];
    const char* cA = (const char*)g.A + (size_t)cur.pm * tstepA; const char* cB = (const char*)g.Bt + (size_t)cur.pn * tstepB;
    PG8_STAGE(PG8_SB(0, 0), cB, voffB); PG8_STAGE(PG8_SB(0, 1), cB + hstepB, voffB); PG8_STAGE(PG8_SA(0, 0), cA, voffA); PG8_STAGE(PG8_SA(0, 1), cA + hstepA, voffA);
    if (wr == 1) PG8_BAR;
    PG8_WAIT_V(2); PG8_BAR;
    PG8_STAGE(PG8_SB(1, 0), cB + kstep, voffB); PG8_STAGE(PG8_SA(1, 0), cA + kstep, voffA); PG8_STAGE(PG8_SB(1, 1), cB + hstepB + kstep, voffB);
    PG8_WAIT_V(6); PG8_BAR;
    for (;;) {
        const bool has_next = S.next(ui + 1, nxt);
        const char* nA = has_next ? (const char*)g.A + (size_t)nxt.pm * tstepA : cA; const char* nB = has_next ? (const char*)g.Bt + (size_t)nxt.pn * tstepB : cB;
        for (int t = 0; t < nt; t += 2) {
            const bool last = (t == nt - 2);
            const char* a1 = cA + (size_t)(t + 1) * kstep;
            const char* a2 = last ? nA : cA + (size_t)(t + 2) * kstep; const char* b2 = last ? nB : cB + (size_t)(t + 2) * kstep;
            const char* a3 = a2 + kstep; const char* b3 = b2 + kstep;
            PG8_LDB(B0, 0, 0); PG8_LDB(B1, 0, 1); PG8_SCHED; PG8_LDA(At, 0, 0); PG8_STAGE(PG8_SA(1, 1), a1 + hstepA, voffA);
            PG8_WAIT_V(8); PG8_WAIT_L(0); PG8_BAR; PG8_MMA(0, 0, At, B0); PG8_MMA(0, 1, At, B1); PG8_BAR; PG8_SCHED;
            PG8_LDA(At, 0, 1); PG8_STAGE(PG8_SB(0, 0), b2, voffB); PG8_STAGE(PG8_SB(0, 1), b2 + hstepB, voffB); PG8_STAGE(PG8_SA(0, 0), a2, voffA);
            PG8_WAIT_V(8); PG8_WAIT_L(0); PG8_BAR; PG8_MMA(1, 0, At, B0); PG8_MMA(1, 1, At, B1); PG8_BAR; PG8_SCHED;
            PG8_LDB(B0, 1, 0); PG8_LDB(B1, 1, 1); PG8_SCHED; PG8_LDA(At, 1, 0); PG8_STAGE(PG8_SA(0, 1), a2 + hstepA, voffA);
            PG8_WAIT_V(8); PG8_WAIT_L(0); PG8_BAR; PG8_MMA(0, 0, At, B0); PG8_MMA(0, 1, At, B1); PG8_BAR; PG8_SCHED;
            PG8_LDA(At, 1, 1); PG8_STAGE(PG8_SB(1, 0), b3, voffB); PG8_STAGE(PG8_SB(1, 1), b3 + hstepB, voffB); PG8_STAGE(PG8_SA(1, 0), a3, voffA);
            PG8_WAIT_V(8); PG8_WAIT_L(0); PG8_BAR; PG8_MMA(1, 0, At, B0); PG8_MMA(1, 1, At, B1); PG8_BAR; PG8_SCHED;
        }
        if (wr == 0) PG8_BAR;
        { Unit uu = cur; asm volatile("" : "+s"(uu.pm), "+s"(uu.pn)); int t2 = tid; asm volatile("" : "+v"(t2));
          E(acc, uu, wr, wc, t2 & 15, (t2 & 63) >> 4); }
        if (!has_next) break;
#pragma unroll
        for (int a = 0; a < 2; ++a)
#pragma unroll
            for (int b = 0; b < 2; ++b)
#pragma unroll
                for (int m = 0; m < 4; ++m)
#pragma unroll
                    for (int n = 0; n < 2; ++n) acc[a][b][m][n] = (f32x4){0.f, 0.f, 0.f, 0.f};
        cur = nxt; cA = nA; cB = nB; ++ui;
        if (wr == 1) PG8_BAR;
    }
    PG8_WAIT_V(0);
    PG8_BAR;
#undef PG8_SA
#undef PG8_SB
#undef PG8_STAGE
#undef PG8_LDA
#undef PG8_LDB
#undef PG8_MMA
#undef PG8_WAIT_V
#undef PG8_WAIT_L
#undef PG8_BAR
#undef PG8_SCHED
}
}

__host__ __device__ __forceinline__ int v_st(int k, int c) { const int kk = (k & ~0xC) | ((k & 4) << 1) | ((k & 8) >> 1); return ((kk >> 3) * 4 + (c >> 5)) * 512 + ((kk & 7) * 32 + (c & 31)) * 2; }
__device__ __forceinline__ int v_rd_base(int lane) { return ((lane & 3) << 3) | (((lane >> 2) & 3) << 6) | (((lane >> 4) & 1) << 5) | (((lane >> 5) & 1) << 8); }
constexpr int v_rd_off(int d0, int ks, int half) { return d0 * 512 + ks * 4096 + half * 2048; }
__device__ __forceinline__ int crow(int r, int hi) { return (r & 3) + 8 * (r >> 2) + 4 * hi; }

enum { EM_Z = 0, EM_F32 = 1, EM_Q = 2, EM_KV = 3, EM_PW2 = 4 };
struct EpiAll {
    static constexpr bool PERM = true;
    int mode; int ldc; void* p0; const void* p1; const void* p2;
    __device__ __forceinline__ void operator()(const f32x4 (&acc)[2][2][4][2], const pg8::Unit& u, int wr, int wc, int fr, int fq) const {
        const int row0 = u.pm * 256 + wr * 64 + fr, col0 = u.pn * 256 + wc * 32 + 8 * fq;
        if (mode == EM_Z) {
            bf16_t* O = (bf16_t*)p0;
#pragma unroll
            for (int ai = 0; ai < 2; ++ai)
#pragma unroll
                for (int m = 0; m < 4; ++m) { bf16_t* rowp = O + (size_t)(row0 + ai * 128 + m * 16) * ldc + col0;
#pragma unroll
                    for (int bj = 0; bj < 2; ++bj) { const f32x4 v0 = acc[ai][bj][m][0], v1 = acc[ai][bj][m][1];
                        u32x4 w; w.x = cvtpk(v0[0], v0[1]); w.y = cvtpk(v0[2], v0[3]); w.z = cvtpk(v1[0], v1[1]); w.w = cvtpk(v1[2], v1[3]);
                        *(u32x4*)(rowp + bj * 128) = w; } }
        } else if (mode == EM_F32) {
            float* C = (float*)p0;
#pragma unroll
            for (int ai = 0; ai < 2; ++ai)
#pragma unroll
                for (int m = 0; m < 4; ++m) { float* rowp = C + (size_t)(row0 + ai * 128 + m * 16) * ldc + col0;
#pragma unroll
                    for (int bj = 0; bj < 2; ++bj)
#pragma unroll
                        for (int n = 0; n < 2; ++n) *(f32x4*)(rowp + bj * 128 + n * 4) = acc[ai][bj][m][n]; }
        } else if (mode == EM_Q) {
            bf16_t* Q = (bf16_t*)p0; const float* cs = (const float*)p1; const float* sn = (const float*)p2;
#pragma unroll
            for (int ai = 0; ai < 2; ++ai)
#pragma unroll
                for (int m = 0; m < 4; ++m) { const int tok = row0 + ai * 128 + m * 16, b = tok >> 13, s = tok & 8191;
#pragma unroll
                    for (int bj = 0; bj < 2; ++bj) { f32x4 v0 = acc[ai][bj][m][0], v1 = acc[ai][bj][m][1]; const int n = col0 + bj * 128;
                        bf16_t* dst;
                        if (u.pn < 2) { const int h = n >> 7, d = n & 127; dst = Q + ((size_t)((b * NH + h) * SEQ + s)) * DQK + d; }
                        else { const int n2 = n - 512, h = n2 >> 6, w = n2 & 63, i0 = w >> 1;
                            const f32x4 c4 = *(const f32x4*)(cs + (size_t)tok * 32 + i0), s4 = *(const f32x4*)(sn + (size_t)tok * 32 + i0);
                            f32x4 a0, a1;
                            a0[0] = v0[0] * c4[0] - v0[1] * s4[0]; a0[1] = v0[1] * c4[0] + v0[0] * s4[0];
                            a0[2] = v0[2] * c4[1] - v0[3] * s4[1]; a0[3] = v0[3] * c4[1] + v0[2] * s4[1];
                            a1[0] = v1[0] * c4[2] - v1[1] * s4[2]; a1[1] = v1[1] * c4[2] + v1[0] * s4[2];
                            a1[2] = v1[2] * c4[3] - v1[3] * s4[3]; a1[3] = v1[3] * c4[3] + v1[2] * s4[3];
                            v0 = a0; v1 = a1; dst = Q + ((size_t)((b * NH + h) * SEQ + s)) * DQK + DNOPE + w; }
                        v0 = v0 * QSCALE; v1 = v1 * QSCALE;
                        u32x4 wv; wv.x = cvtpk(v0[0], v0[1]); wv.y = cvtpk(v0[2], v0[3]); wv.z = cvtpk(v1[0], v1[1]); wv.w = cvtpk(v1[2], v1[3]);
                        *(u32x4*)dst = wv; } }
        } else if (mode == EM_KV) {
            unsigned char* KN = (unsigned char*)p0; unsigned char* VI = (unsigned char*)p1;
#pragma unroll
            for (int ai = 0; ai < 2; ++ai)
#pragma unroll
                for (int m = 0; m < 4; ++m) { const int tok = row0 + ai * 128 + m * 16, b = tok >> 13, s = tok & 8191;
#pragma unroll
                    for (int bj = 0; bj < 2; ++bj) { const f32x4 v0 = acc[ai][bj][m][0], v1 = acc[ai][bj][m][1]; const int n = (col0 + bj * 128) & 511;
                        const int h = n >> 7, d = n & 127;
                        const size_t tbase = ((size_t)((b * NH + h) * (SEQ / 64) + (s >> 6))) * 16384;
                        unsigned char* dst = (u.pn < 2) ? KN + tbase + (d >> 3) * 1024 + (s & 63) * 16 : VI + tbase + v_st(s & 63, d);
                        u32x4 wv; wv.x = cvtpk(v0[0], v0[1]); wv.y = cvtpk(v0[2], v0[3]); wv.z = cvtpk(v1[0], v1[1]); wv.w = cvtpk(v1[2], v1[3]);
                        *(u32x4*)dst = wv; } }
        } else {
            bf16_t* YCAT = (bf16_t*)p0; const bf16_t* Z = (const bf16_t*)p1;
#pragma unroll
            for (int ai = 0; ai < 2; ++ai)
#pragma unroll
                for (int m = 0; m < 4; ++m) { const int tok = row0 + ai * 128 + m * 16;
#pragma unroll
                    for (int bj = 0; bj < 2; ++bj) { const f32x4 v0 = acc[ai][bj][m][0], v1 = acc[ai][bj][m][1]; const int c = col0 + bj * 128;
                        const u32x4 g = *(const u32x4*)(Z + (size_t)tok * DINP + ZC_GC + c);
                        u32x4 wv;
                        wv.x = cvtpk(v0[0] * siluf_(lo_bf(g.x)), v0[1] * siluf_(hi_bf(g.x))); wv.y = cvtpk(v0[2] * siluf_(lo_bf(g.y)), v0[3] * siluf_(hi_bf(g.y)));
                        wv.z = cvtpk(v1[0] * siluf_(lo_bf(g.z)), v1[1] * siluf_(hi_bf(g.z))); wv.w = cvtpk(v1[2] * siluf_(lo_bf(g.w)), v1[3] * siluf_(hi_bf(g.w)));
                        *(u32x4*)(YCAT + (size_t)tok * DM + 512 + c) = wv; } }
        }
    }
};

namespace att {
constexpr int SLOT = 40960, NSLOT = 3, VOFF = 24576, LDS_WS = NSLOT * SLOT;
constexpr float THR = 8.f;
#define SBAR() __builtin_amdgcn_sched_barrier(0)
__device__ __forceinline__ void glds16(const void* gsrc, unsigned lds_dst) { unsigned keep;
    asm volatile("s_mov_b32 %0, m0\n\ts_mov_b32 m0, %2\n\ts_nop 0\n\tglobal_load_lds_dwordx4 %1, off\n\ts_mov_b32 m0, %0" : "=&s"(keep) : "v"(gsrc), "s"(lds_dst) : "memory"); }

__device__ __forceinline__ void pv_tile(f32x16* o, int vb, bf16x8 pa0, bf16x8 pa1, bf16x8 pa2, bf16x8 pa3) {
#define TRRD(dst, off) asm volatile("ds_read_b64_tr_b16 %0, %1 offset:%2" : "=&v"(dst) : "v"(vb), "i"(off) : "memory")
#define PV_D0(d0) do { s16x4 l0, l1, l2, l3, h0, h1, h2, h3; constexpr int b_ = v_rd_off(d0, 0, 0); \
        TRRD(l0, b_); TRRD(h0, b_ + 2048); TRRD(l1, b_ + 4096); TRRD(h1, b_ + 6144); TRRD(l2, b_ + 8192); TRRD(h2, b_ + 10240); TRRD(l3, b_ + 12288); TRRD(h3, b_ + 14336); \
        asm volatile("s_waitcnt lgkmcnt(0)" ::: "memory"); SBAR(); \
        o[d0] = __builtin_amdgcn_mfma_f32_32x32x16_bf16(pa0, (bf16x8){l0[0], l0[1], l0[2], l0[3], h0[0], h0[1], h0[2], h0[3]}, o[d0], 0, 0, 0); \
        o[d0] = __builtin_amdgcn_mfma_f32_32x32x16_bf16(pa1, (bf16x8){l1[0], l1[1], l1[2], l1[3], h1[0], h1[1], h1[2], h1[3]}, o[d0], 0, 0, 0); \
        o[d0] = __builtin_amdgcn_mfma_f32_32x32x16_bf16(pa2, (bf16x8){l2[0], l2[1], l2[2], l2[3], h2[0], h2[1], h2[2], h2[3]}, o[d0], 0, 0, 0); \
        o[d0] = __builtin_amdgcn_mfma_f32_32x32x16_bf16(pa3, (bf16x8){l3[0], l3[1], l3[2], l3[3], h3[0], h3[1], h3[2], h3[3]}, o[d0], 0, 0, 0); } while (0)
    PV_D0(0); PV_D0(1); PV_D0(2); PV_D0(3);
#undef PV_D0
#undef TRRD
}

__device__ __forceinline__ void attn_unit(int b, int h, int qb, const bf16_t* Q, const unsigned char* KN, const unsigned char* KR, const unsigned char* VI,
                                          const bf16_t* Z, bf16_t* YCAT, char* shm, const int tid) {
    const int lane = tid & 63, r32 = lane & 31, hi = lane >> 5; const int wid = __builtin_amdgcn_readfirstlane(tid >> 6);
    const int q0 = qb * 256, NT = 4 * (qb + 1);
    const int bh = b * NH + h;
    const unsigned lds0 = (unsigned)(uintptr_t)shm;
    float* wsf = (float*)(shm + LDS_WS) + wid * 64;
    const unsigned char* knsrc = KN + (size_t)bh * (SEQ / 64) * 16384 + wid * 1024 + lane * 16;
    const unsigned char* krsrc = KR + (size_t)b * (SEQ / 64) * 8192 + wid * 1024 + lane * 16;
    const unsigned char* vsrc = VI + (size_t)bh * (SEQ / 64) * 16384 + wid * 1024 + lane * 16;
#define DMA_TILE(t, slot) do { const unsigned d_ = (unsigned)__builtin_amdgcn_readfirstlane(lds0 + (slot) + wid * 1024); \
        glds16(knsrc + (size_t)(t) * 16384, d_); glds16(knsrc + (size_t)(t) * 16384 + 8192, d_ + 8192); glds16(krsrc + (size_t)(t) * 8192, d_ + 16384); \
        glds16(vsrc + (size_t)(t) * 16384, d_ + VOFF); glds16(vsrc + (size_t)(t) * 16384 + 8192, d_ + VOFF + 8192); } while (0)
    const bf16_t* Qw = Q + ((size_t)(bh * SEQ + q0 + wid * 32 + r32)) * DQK;
    bf16x8 qr[12];
#pragma unroll
    for (int d0 = 0; d0 < 12; ++d0) qr[d0] = *(const bf16x8*)(Qw + d0 * 16 + hi * 8);
#pragma unroll
    for (int d0 = 0; d0 < 12; ++d0) asm volatile("" : "+v"(qr[d0]));
    asm volatile("s_waitcnt vmcnt(0)" ::: "memory");
    DMA_TILE(0, 0); DMA_TILE(1, SLOT);
    float m_run = -1e30f, l_run = 0.f; f32x16 o[4];
#pragma unroll
    for (int d = 0; d < 4; ++d) o[d] = f32x16{};
    const LAS char* shm3 = (const LAS char*)shm;
    const int vb0 = (int)lds0 + VOFF + v_rd_base(lane);
    const int qabs = q0 + wid * 32 + r32;
    int sl_cur = 0, sl_n1 = SLOT, sl_n2 = 2 * SLOT;
    for (int t = 0; t < NT; ++t) {
        if (t + 1 < NT) asm volatile("s_waitcnt vmcnt(5) lgkmcnt(0)\n\ts_barrier" ::: "memory");
        else asm volatile("s_waitcnt vmcnt(0) lgkmcnt(0)\n\ts_barrier" ::: "memory");
        if (t + 2 < NT) DMA_TILE(t + 2, sl_n2);
        f32x16 p0 = f32x16{}, p1 = f32x16{};
        const LAS char* kp = shm3 + sl_cur + hi * 1024 + r32 * 16;
        {
            bf16x8 ka[4], kb[4];
#define KLD(buf, g) do { buf[0] = *(const LAS bf16x8*)(kp + (2 * (g)) * 2048); buf[1] = *(const LAS bf16x8*)(kp + (2 * (g)) * 2048 + 512); \
                         buf[2] = *(const LAS bf16x8*)(kp + (2 * (g) + 1) * 2048); buf[3] = *(const LAS bf16x8*)(kp + (2 * (g) + 1) * 2048 + 512); } while (0)
#define KMM(buf, g) do { p0 = __builtin_amdgcn_mfma_f32_32x32x16_bf16(buf[0], qr[2 * (g)], p0, 0, 0, 0); p1 = __builtin_amdgcn_mfma_f32_32x32x16_bf16(buf[1], qr[2 * (g)], p1, 0, 0, 0); \
                         p0 = __builtin_amdgcn_mfma_f32_32x32x16_bf16(buf[2], qr[2 * (g) + 1], p0, 0, 0, 0); p1 = __builtin_amdgcn_mfma_f32_32x32x16_bf16(buf[3], qr[2 * (g) + 1], p1, 0, 0, 0); } while (0)
            KLD(ka, 0); KLD(kb, 1); SBAR();
            KMM(ka, 0); SBAR(); KLD(ka, 2); SBAR();
            KMM(kb, 1); SBAR(); KLD(kb, 3); SBAR();
            KMM(ka, 2); SBAR(); KLD(ka, 4); SBAR();
            KMM(kb, 3); SBAR(); KLD(kb, 5); SBAR();
            KMM(ka, 4); SBAR();
            KMM(kb, 5); SBAR();
#undef KLD
#undef KMM
        }
        if (t >= NT - 4) {
            const float NEG = -__builtin_inff(); const int kb = 64 * t + 4 * hi;
#pragma unroll
            for (int r = 0; r < 16; ++r) { const int kv = kb + (r & 3) + 8 * (r >> 2); if (kv > qabs) p0[r] = NEG; if (kv + 32 > qabs) p1[r] = NEG; }
        }
        float pmax = p0[0];
#pragma unroll
        for (int r = 1; r < 16; ++r) pmax = fmaxf(pmax, p0[r]);
#pragma unroll
        for (int r = 0; r < 16; ++r) pmax = fmaxf(pmax, p1[r]);
        { auto rr = __builtin_amdgcn_permlane32_swap(__float_as_uint(pmax), __float_as_uint(pmax), false, false);
          pmax = fmaxf(__uint_as_float(rr[0]), __uint_as_float(rr[1])); }
        float alpha = 1.f;
        if (!__all(pmax - m_run <= THR)) {
            const float mn = fmaxf(m_run, pmax); alpha = __builtin_amdgcn_exp2f(m_run - mn); m_run = mn;
            if (hi == 0) wsf[r32] = alpha;
            asm volatile("s_waitcnt lgkmcnt(0)" ::: "memory");
#pragma unroll
            for (int d = 0; d < 4; ++d)
#pragma unroll
                for (int r = 0; r < 16; ++r) o[d][r] *= wsf[crow(r, hi)];
            asm volatile("s_waitcnt lgkmcnt(0)" ::: "memory");
        }
#pragma unroll
        for (int r = 0; r < 16; ++r) { p0[r] = __builtin_amdgcn_exp2f(p0[r] - m_run); p1[r] = __builtin_amdgcn_exp2f(p1[r] - m_run); }
        float ps = 0.f;
#pragma unroll
        for (int r = 0; r < 16; ++r) ps += p0[r];
#pragma unroll
        for (int r = 0; r < 16; ++r) ps += p1[r];
        { auto rr = __builtin_amdgcn_permlane32_swap(__float_as_uint(ps), __float_as_uint(ps), false, false);
          ps = __uint_as_float(rr[0]) + __uint_as_float(rr[1]); }
        l_run = l_run * alpha + ps;
        bf16x8 pa0, pa1, pa2, pa3;
#define PK4(P, B_, OUT) do { unsigned a0 = cvtpk(P[B_ + 0], P[B_ + 1]), a1 = cvtpk(P[B_ + 2], P[B_ + 3]); \
        unsigned b0 = cvtpk(P[B_ + 4], P[B_ + 5]), b1 = cvtpk(P[B_ + 6], P[B_ + 7]); \
        auto r0 = __builtin_amdgcn_permlane32_swap(a0, b0, false, false); auto r1 = __builtin_amdgcn_permlane32_swap(a1, b1, false, false); \
        u32x4 w = {r0[0], r1[0], r0[1], r1[1]}; OUT = *reinterpret_cast<bf16x8*>(&w); } while (0)
        PK4(p0, 0, pa0); PK4(p0, 8, pa1); PK4(p1, 0, pa2); PK4(p1, 8, pa3);
#undef PK4
        SBAR();
        pv_tile(o, vb0 + sl_cur, pa0, pa1, pa2, pa3);
        { const int tmp = sl_cur; sl_cur = sl_n1; sl_n1 = sl_n2; sl_n2 = tmp; }
    }
    if (hi == 0) wsf[32 + r32] = l_run;
    asm volatile("s_waitcnt lgkmcnt(0)" ::: "memory");
    const size_t mrow0 = (size_t)b * SEQ + q0 + wid * 32;
#pragma unroll
    for (int r = 0; r < 16; ++r) { const int orow = crow(r, hi); const float rl = 1.f / wsf[32 + orow]; const size_t m = mrow0 + orow;
#pragma unroll
        for (int d0 = 0; d0 < 4; ++d0) { const int col = h * DV + d0 * 32 + r32;
            const float g = bf2f(Z[m * DINP + ZC_GATT + col]);
            const float v = o[d0][r] * rl * siluf_(g);
            const float vn = xor1_f(v);
            if ((r32 & 1) == 0) *(unsigned*)(YCAT + m * DM + col) = cvtpk(v, vn); } }
    asm volatile("s_waitcnt vmcnt(0) lgkmcnt(0)\n\ts_barrier" ::: "memory");
#undef DMA_TILE
}

__device__ __forceinline__ void attn_unit3(int b, int h, int qb, const bf16_t* Q, const unsigned char* KN, const unsigned char* KR, const unsigned char* VI,
                                           const bf16_t* Z, bf16_t* YCAT, char* shm, const int tid) {
    const int lane = tid & 63, r32 = lane & 31, hi = lane >> 5; const int wid = __builtin_amdgcn_readfirstlane(tid >> 6);
    const int q0 = qb * 256, NT = 4 * (qb + 1);
    const int bh = b * NH + h;
    const unsigned lds0 = (unsigned)(uintptr_t)shm;
    LAS float* wsf = (LAS float*)((LAS char*)shm + LDS_WS) + wid * 64;
    LAS float* wsh = wsf + 4 * hi;
    const unsigned char* knsrc = KN + (size_t)bh * (SEQ / 64) * 16384 + wid * 1024 + lane * 16;
    const unsigned char* krsrc = KR + (size_t)b * (SEQ / 64) * 8192 + wid * 1024 + lane * 16;
    const unsigned char* vsrc = VI + (size_t)bh * (SEQ / 64) * 16384 + wid * 1024 + lane * 16;
#define DMA_TILE(t, slot) do { const unsigned d_ = (unsigned)__builtin_amdgcn_readfirstlane(lds0 + (slot) + wid * 1024); \
        glds16(knsrc + (size_t)(t) * 16384, d_); glds16(knsrc + (size_t)(t) * 16384 + 8192, d_ + 8192); glds16(krsrc + (size_t)(t) * 8192, d_ + 16384); \
        glds16(vsrc + (size_t)(t) * 16384, d_ + VOFF); glds16(vsrc + (size_t)(t) * 16384 + 8192, d_ + VOFF + 8192); } while (0)
    const bf16_t* Qw = Q + ((size_t)(bh * SEQ + q0 + wid * 32 + r32)) * DQK;
    bf16x8 qr[12];
#pragma unroll
    for (int d0 = 0; d0 < 12; ++d0) qr[d0] = *(const bf16x8*)(Qw + d0 * 16 + hi * 8);
#pragma unroll
    for (int d0 = 0; d0 < 12; ++d0) asm volatile("" : "+v"(qr[d0]));
    asm volatile("s_waitcnt vmcnt(0)" ::: "memory");
    DMA_TILE(0, 0);
    float m_run = -1e30f, l_run = 0.f; f32x16 o[4];
#pragma unroll
    for (int d = 0; d < 4; ++d) o[d] = f32x16{};
    const LAS char* shm3 = (const LAS char*)shm;
    const int vb0 = (int)lds0 + VOFF + v_rd_base(lane);
    const int qabs = q0 + wid * 32 + r32;
    f32x16 sA, sB; bf16x8 pa0, pa1; float pmaxN = 0.f;

#define MF(acc, a_, b_) acc = __builtin_amdgcn_mfma_f32_32x32x16_bf16(a_, b_, acc, 0, 0, 0)
#define DMAP(on_, i_, t_, slot_) do { if (on_) { const unsigned d_ = (unsigned)__builtin_amdgcn_readfirstlane(lds0 + (slot_) + wid * 1024); \
        if ((i_) == 0) glds16(knsrc + (size_t)(t_) * 16384, d_); else if ((i_) == 1) glds16(knsrc + (size_t)(t_) * 16384 + 8192, d_ + 8192); \
        else if ((i_) == 2) glds16(krsrc + (size_t)(t_) * 8192, d_ + 16384); else if ((i_) == 3) glds16(vsrc + (size_t)(t_) * 16384, d_ + VOFF); \
        else glds16(vsrc + (size_t)(t_) * 16384 + 8192, d_ + VOFF + 8192); } } while (0)
#define KLD1(dst, kp_, d0) dst = *(const LAS bf16x8*)(kp_ + (d0) * 2048)
#define MASKH(S, T_, hf_) do { if ((T_) >= NT - 4) { const float NEG = -__builtin_inff(); const int kb_ = 64 * (T_) + 32 * (hf_) + 4 * hi; \
        _Pragma("unroll") for (int r = 0; r < 16; ++r) { const int kv = kb_ + (r & 3) + 8 * (r >> 2); if (kv > qabs) S[r] = NEG; } } } while (0)
#define ROWMAX_FIN(mx0, mx1, out) do { float m_ = fmaxf(mx0, mx1); auto rr_ = __builtin_amdgcn_permlane32_swap(__float_as_uint(m_), __float_as_uint(m_), false, false); \
        out = fmaxf(__uint_as_float(rr_[0]), __uint_as_float(rr_[1])); } while (0)
#define DECIDE(pmax_) do { if (!__all((pmax_) - m_run <= THR)) { const float mn_ = fmaxf(m_run, (pmax_)); const float al_ = __builtin_amdgcn_exp2f(m_run - mn_); m_run = mn_; l_run *= al_; \
        if (hi == 0) wsf[r32] = al_; asm volatile("s_waitcnt lgkmcnt(0)" ::: "memory"); \
        _Pragma("unroll") for (int d_ = 0; d_ < 4; ++d_) _Pragma("unroll") for (int r = 0; r < 16; ++r) o[d_][r] *= wsh[(r & 3) + 8 * (r >> 2)]; \
        asm volatile("s_waitcnt lgkmcnt(0)" ::: "memory"); } } while (0)
#define PK4(P, B_, OUT) do { unsigned a0_ = cvtpk(P[B_ + 0], P[B_ + 1]), a1_ = cvtpk(P[B_ + 2], P[B_ + 3]); \
        unsigned b0_ = cvtpk(P[B_ + 4], P[B_ + 5]), b1_ = cvtpk(P[B_ + 6], P[B_ + 7]); \
        auto r0_ = __builtin_amdgcn_permlane32_swap(a0_, b0_, false, false); auto r1_ = __builtin_amdgcn_permlane32_swap(a1_, b1_, false, false); \
        u32x4 w_ = {r0_[0], r1_[0], r0_[1], r1_[1]}; OUT = *reinterpret_cast<bf16x8*>(&w_); } while (0)
#define SMC2(S, i) do { const float e0_ = __builtin_amdgcn_exp2f(S[i] - m_run), e1_ = __builtin_amdgcn_exp2f(S[(i) + 1] - m_run); S[i] = e0_; S[(i) + 1] = e1_; ps0 += e0_; ps1 += e1_; } while (0)
#define SMFIN() do { float ps_ = ps0 + ps1; auto rr_ = __builtin_amdgcn_permlane32_swap(__float_as_uint(ps_), __float_as_uint(ps_), false, false); \
        l_run += __uint_as_float(rr_[0]) + __uint_as_float(rr_[1]); } while (0)
#define TRRD(dst, off) asm volatile("ds_read_b64_tr_b16 %0, %1 offset:%2" : "=&v"(dst) : "v"(vb_), "i"(off) : "memory")
#define TRRD4(P_, d0, hf_) do { constexpr int b_ = v_rd_off(d0, 2 * (hf_), 0); TRRD(P_##l0, b_); TRRD(P_##h0, b_ + 2048); TRRD(P_##l1, b_ + 4096); TRRD(P_##h1, b_ + 6144); } while (0)
#define VF(P_, k) (bf16x8){P_##l##k[0], P_##l##k[1], P_##l##k[2], P_##l##k[3], P_##h##k[0], P_##h##k[1], P_##h##k[2], P_##h##k[3]}
#define LGK(n) asm volatile("s_waitcnt lgkmcnt(" #n ")" ::: "memory")
#define RMC2(S, j) do { mx0 = __builtin_fmaxf(__builtin_fmaxf(mx0, S[j]), S[(j) + 1]); } while (0)
#define RMC4(S, j) do { RMC2(S, j); RMC2(S, (j) + 2); } while (0)

#define HSTEP(SX, SY, T_, HF, TN, HFN, has_next_, dma_on_) do { \
        float ps0 = 0.f, ps1 = 0.f; \
        if (has_next_) { \
            const LAS char* kp_ = shm3 + ((HFN) == 0 ? sl_n1 : sl_cur) + hi * 1024 + r32 * 16 + (HFN) * 512; bf16x8 k0, k1, k2, k3; \
            SY = f32x16{}; \
            KLD1(k0, kp_, 0); KLD1(k1, kp_, 1); KLD1(k2, kp_, 2); KLD1(k3, kp_, 3); SBAR(); \
            MF(SY, k0, qr[0]); SMC2(SX, 0); SBAR(); KLD1(k0, kp_, 4); DMAP(dma_on_, 0, (T_) + 2, sl_n2); SBAR(); \
            MF(SY, k1, qr[1]); SMC2(SX, 2); SBAR(); KLD1(k1, kp_, 5); DMAP(dma_on_, 1, (T_) + 2, sl_n2); SBAR(); \
            MF(SY, k2, qr[2]); SMC2(SX, 4); SBAR(); KLD1(k2, kp_, 6); DMAP(dma_on_, 2, (T_) + 2, sl_n2); SBAR(); \
            MF(SY, k3, qr[3]); SMC2(SX, 6); SBAR(); KLD1(k3, kp_, 7); DMAP(dma_on_, 3, (T_) + 2, sl_n2); SBAR(); \
            MF(SY, k0, qr[4]); SMC2(SX, 8); SBAR(); KLD1(k0, kp_, 8); DMAP(dma_on_, 4, (T_) + 2, sl_n2); SBAR(); \
            MF(SY, k1, qr[5]); SMC2(SX, 10); SBAR(); KLD1(k1, kp_, 9); SBAR(); \
            MF(SY, k2, qr[6]); SMC2(SX, 12); SBAR(); KLD1(k2, kp_, 10); SBAR(); \
            MF(SY, k3, qr[7]); SMC2(SX, 14); SBAR(); KLD1(k3, kp_, 11); SBAR(); \
            MF(SY, k0, qr[8]); PK4(SX, 0, pa0); SBAR(); \
            MF(SY, k1, qr[9]); PK4(SX, 8, pa1); SBAR(); \
            MF(SY, k2, qr[10]); SMFIN(); SBAR(); \
            MF(SY, k3, qr[11]); SBAR(); \
        } else { \
            _Pragma("unroll") for (int i_ = 0; i_ < 16; i_ += 2) SMC2(SX, i_); \
            PK4(SX, 0, pa0); PK4(SX, 8, pa1); SMFIN(); SBAR(); \
        } \
        { const int vb_ = vb0 + sl_cur; s16x4 Al0, Al1, Ah0, Ah1, Bl0, Bl1, Bh0, Bh1, Cl0, Cl1, Ch0, Ch1; \
          float mx0 = -__builtin_inff(); \
          TRRD4(A, 0, HF); TRRD4(B, 1, HF); TRRD4(C, 2, HF); SBAR(); \
          if (has_next_) MASKH(SY, TN, HFN); \
          SBAR(); LGK(8); SBAR(); \
          MF(o[0], pa0, VF(A, 0)); if (has_next_) { RMC4(SY, 0); } SBAR(); MF(o[0], pa1, VF(A, 1)); if (has_next_) { RMC4(SY, 4); } SBAR(); \
          TRRD4(A, 3, HF); LGK(8); SBAR(); \
          MF(o[1], pa0, VF(B, 0)); if (has_next_) { RMC4(SY, 8); } SBAR(); MF(o[1], pa1, VF(B, 1)); if (has_next_) { RMC4(SY, 12); } SBAR(); \
          LGK(4); SBAR(); \
          MF(o[2], pa0, VF(C, 0)); MF(o[2], pa1, VF(C, 1)); SBAR(); \
          LGK(0); SBAR(); \
          MF(o[3], pa0, VF(A, 0)); MF(o[3], pa1, VF(A, 1)); SBAR(); \
          const float mx1 = mx0; \
          if (has_next_) { ROWMAX_FIN(mx0, mx1, pmaxN); DECIDE(pmaxN); } } \
    } while (0)

    int sl_cur = 0, sl_n1 = SLOT, sl_n2 = 2 * SLOT;
    asm volatile("s_waitcnt vmcnt(0) lgkmcnt(0)\n\ts_barrier" ::: "memory");
    DMA_TILE(1, SLOT);
    { const LAS char* kp_ = shm3 + hi * 1024 + r32 * 16; bf16x8 ka, kb;
      sA = f32x16{};
      KLD1(ka, kp_, 0); KLD1(kb, kp_, 1); SBAR();
#pragma unroll
      for (int d2 = 0; d2 < 12; d2 += 2) {
          MF(sA, ka, qr[d2]); SBAR(); if (d2 + 2 < 12) KLD1(ka, kp_, d2 + 2); SBAR();
          MF(sA, kb, qr[d2 + 1]); SBAR(); if (d2 + 3 < 12) KLD1(kb, kp_, d2 + 3); SBAR(); } }
    MASKH(sA, 0, 0);
    { float mx0 = -__builtin_inff();
#pragma unroll
      for (int j = 0; j < 16; j += 2) RMC2(sA, j);
      ROWMAX_FIN(mx0, mx0, pmaxN); DECIDE(pmaxN); }
    for (int T = 0; T < NT; ++T) {
        HSTEP(sA, sB, T, 0, T, 1, true, false);
        const bool more = T + 1 < NT;
        if (more) {
            asm volatile("s_waitcnt vmcnt(0) lgkmcnt(0)\n\ts_barrier" ::: "memory");
        }
        HSTEP(sB, sA, T, 1, T + 1, 0, more, (T + 2 < NT));
        { const int tmp_ = sl_cur; sl_cur = sl_n1; sl_n1 = sl_n2; sl_n2 = tmp_; }
    }
    if (hi == 0) wsf[32 + r32] = l_run;
    asm volatile("s_waitcnt lgkmcnt(0)" ::: "memory");
    { int r32e = r32, hie = hi; asm volatile("" : "+v"(r32e), "+v"(hie));
      const LAS float* wse = wsf + 32 + 4 * hie;
      const size_t mrow0 = (size_t)b * SEQ + q0 + wid * 32 + 4 * hie;
      const bf16_t* zp = Z + mrow0 * DINP + ZC_GATT + h * DV + r32e; bf16_t* yp = YCAT + mrow0 * DM + h * DV + r32e;
#pragma unroll
      for (int r = 0; r < 16; ++r) { const int cr = (r & 3) + 8 * (r >> 2); const float rl = __builtin_amdgcn_rcpf(wse[cr]);
#pragma unroll
          for (int d0 = 0; d0 < 4; ++d0) {
              const float g = bf2f(zp[(size_t)cr * DINP + d0 * 32]);
              const float v = o[d0][r] * rl * siluf_(g);
              const float vn = xor1_f(v);
              if ((r32e & 1) == 0) *(unsigned*)(yp + (size_t)cr * DM + d0 * 32) = cvtpk(v, vn); } } }
    asm volatile("s_waitcnt vmcnt(0) lgkmcnt(0)\n\ts_barrier" ::: "memory");
#undef DMA_TILE
#undef DMAP
#undef MF
#undef KLD1
#undef MASKH
#undef ROWMAX_FIN
#undef DECIDE
#undef PK4
#undef SMC2
#undef SMFIN
#undef TRRD
#undef TRRD4
#undef VF
#undef LGK
#undef RMC2
#undef RMC4
#undef HSTEP
}
#undef SBAR
}

#define XB_TMO      128
#define XB_XCNT(j)  (256  + 64 * (j))
#define XB_XSUB(j)  (1280 + 64 * (j))
#define XB_XGEN(j)  (2304 + 64 * (j))
#define XB_TOP      3328
#define XB_TOPGEN   3392
#define XCD_BAR_WORDS 3456
#define XB_SPIN_CAP (1u << 18)
__device__ __forceinline__ unsigned xb_ld(unsigned* p)              { return __hip_atomic_load(p, __ATOMIC_RELAXED, __HIP_MEMORY_SCOPE_AGENT); }
__device__ __forceinline__ unsigned xb_add(unsigned* p, unsigned v) { return __hip_atomic_fetch_add(p, v, __ATOMIC_RELAXED, __HIP_MEMORY_SCOPE_AGENT); }
__device__ __forceinline__ unsigned xb_xcc_id() { return (unsigned)__builtin_amdgcn_s_getreg((3 << 11) | 20) & 0xFu; }
#define XB_SPIN(cond, bar) do { unsigned _sp = 0; while (cond) { __builtin_amdgcn_s_sleep(1); \
    if ((++_sp & 255u) == 0u) { if (xb_ld(&(bar)[XB_TMO])) break; if (_sp > XB_SPIN_CAP) { atomicAdd(&(bar)[XB_TMO], 1u); break; } } } } while (0)
struct XcdBarrier { unsigned* bar; unsigned x; volatile LAS unsigned* st; };
__device__ __forceinline__ XcdBarrier xcd_barrier_post(unsigned* bar, volatile LAS unsigned* st) {
    XcdBarrier b; b.bar = bar; b.x = xb_xcc_id(); b.st = st;
    if (threadIdx.x == 0) (void)xb_add(&bar[XB_XCNT(b.x)], 1u);
    return b;
}
__device__ __forceinline__ void xcd_barrier_complete(unsigned* bar, unsigned x, unsigned& nloc, unsigned& nx) {
    const unsigned G = gridDim.x * gridDim.y * gridDim.z;
    unsigned sum, cnt, mine, sp = 0u;
    for (;;) {
        sum = 0u; cnt = 0u; mine = 0u;
#pragma unroll
        for (unsigned j = 0; j < 16; ++j) { const unsigned c = xb_ld(&bar[XB_XCNT(j)]); sum += c; cnt += (c > 0u) ? 1u : 0u; mine = (j == x) ? c : mine; }
        if (sum == G) break;
        __builtin_amdgcn_s_sleep(1);
        if ((++sp & 255u) == 0u) { if (xb_ld(&bar[XB_TMO])) break; if (sp > XB_SPIN_CAP) { atomicAdd(&bar[XB_TMO], 1u); break; } }
    }
    nloc = mine > 0u ? mine : 1u; nx = cnt > 0u ? cnt : 1u;
}
__device__ __forceinline__ void xcd_barrier(const XcdBarrier& b) {
    asm volatile("s_waitcnt vmcnt(0)" ::: "memory");
    __syncthreads();
    if (threadIdx.x == 0) {
        unsigned* bar = b.bar;
        __builtin_amdgcn_s_waitcnt(0);
        unsigned nloc = b.st[0], nx = b.st[1];
        if (nloc == 0u) { xcd_barrier_complete(bar, b.x, nloc, nx); b.st[0] = nloc; b.st[1] = nx; }
        const unsigned old = xb_add(&bar[XB_XSUB(b.x)], 1u);
        const unsigned gen = old / nloc;
        if (old + 1u == (gen + 1u) * nloc) {
            __builtin_amdgcn_fence(__ATOMIC_RELEASE, "agent");
            asm volatile("s_waitcnt vmcnt(0)" ::: "memory");
            const unsigned og = xb_add(&bar[XB_TOP], 1u);
            const unsigned tg = og / nx;
            if (og + 1u == (tg + 1u) * nx) xb_add(&bar[XB_TOPGEN], 1u);
            else XB_SPIN(xb_ld(&bar[XB_TOPGEN]) == tg, bar);
            __builtin_amdgcn_fence(__ATOMIC_ACQUIRE, "agent");
            xb_add(&bar[XB_XGEN(b.x)], 1u);
            asm volatile("s_waitcnt vmcnt(0)" ::: "memory");
        } else {
            XB_SPIN(xb_ld(&bar[XB_XGEN(b.x)]) == gen, bar);
            __builtin_amdgcn_fence(__ATOMIC_ACQUIRE, "agent");
            asm volatile("s_waitcnt vmcnt(0)" ::: "memory");
        }
    }
    __syncthreads();
}

__device__ __forceinline__ float ada_val(const float* adap, const float* bada_l, int l, int b, int e) {
    float s = 0.f;
#pragma unroll
    for (int kc = 0; kc < 16; ++kc) s += adap[((size_t)(kc * 2 + l) * 4 + b) * 3072 + e];
    return s + bada_l[e];
}
struct Args { const void* in[22]; float* out; unsigned char* ws; int ph_lo, ph_hi; };
enum { I_X = 0, I_C, I_POS, I_WADA, I_BADA, I_GPRE, I_GPOST, I_WIN, I_QNG, I_WUQ, I_KVNG, I_WUKV, I_CONVW, I_CONVB, I_CLNG, I_CLNB, I_WPW2, I_SLNG, I_SLNB, I_WS, I_BS, I_WOUT };
constexpr int N_PHASES = 2 + 6 * NLAYER;

__device__ __forceinline__ int wmap(int mat, int n) {
    if (mat == 0) return n < 448 ? n : (n < 512 ? -1 : n - 64);
    if (mat == 2) { if (n < 512) return (n >> 7) * DQK + (n & 127); const int n2 = n - 512, h = n2 >> 6, w = n2 & 63; return h * DQK + DNOPE + 32 * (w & 1) + (w >> 1); }
    if (mat == 3) { const int h = (n & 511) >> 7, d = n & 127; return h * 256 + (n >= 512 ? 128 : 0) + d; }
    return n;
}
__device__ __forceinline__ void transpose_item(const float* W, int Nsrc, bf16_t* WT, int Kd, int mat, LAS float* scr, int kb, int nb, int lane) {
    const int k0 = 64 * kb, n0 = 32 * nb; const int src = wmap(mat, n0 + (lane & 31));
#pragma unroll 8
    for (int i = 0; i < 32; ++i) { const int kk = 2 * i + (lane >> 5); scr[kk * 33 + (lane & 31)] = src >= 0 ? W[(size_t)(k0 + kk) * Nsrc + src] : 0.f; }
    asm volatile("s_waitcnt lgkmcnt(0)" ::: "memory");
    const int c = lane & 7;
#pragma unroll
    for (int j = 0; j < 4; ++j) { const int n = (lane >> 3) + 8 * j; const LAS float* s = scr + (8 * c) * 33 + n;
        u32x4 o; o.x = cvtpk(s[0 * 33], s[1 * 33]); o.y = cvtpk(s[2 * 33], s[3 * 33]); o.z = cvtpk(s[4 * 33], s[5 * 33]); o.w = cvtpk(s[6 * 33], s[7 * 33]);
        *(u32x4*)(WT + (size_t)(n0 + n) * Kd + k0 + 8 * c) = o; }
    asm volatile("s_waitcnt lgkmcnt(0)" ::: "memory");
}

__global__ void __launch_bounds__(NTHREADS, 2) hymba_fwd(Args args) {
    extern __shared__ __attribute__((aligned(16))) unsigned char lds[];
    typedef const __attribute__((address_space(4))) Args* KArgP;
    cg::grid_group grid = cg::this_grid();
    const int ph_lo = args.ph_lo, ph_hi = args.ph_hi;
    const int wave_s = __builtin_amdgcn_readfirstlane(threadIdx.x >> 6);
    volatile LAS unsigned* xbst = (volatile LAS unsigned*)((LAS unsigned char*)lds + LDS_BYTES - 64);
    if (threadIdx.x < 4) xbst[threadIdx.x] = 0u;
    __syncthreads();
    const XcdBarrier xbar = xcd_barrier_post((unsigned*)(args.ws + WS_CTL) + CTL_BARW, xbst);

    int ph = ph_lo, rep = 0;
    while (ph < ph_hi) {
        KArgP ap0 = (KArgP)__builtin_amdgcn_kernarg_segment_ptr();
#define ARG(k) (ap->in[k])
#define TID_HERE() int lane; asm volatile("v_mbcnt_lo_u32_b32 %0, -1, 0\n\tv_mbcnt_hi_u32_b32 %0, -1, %0" : "=v"(lane)); const int tid = wave_s * 64 + lane; (void)tid
        const int wave = wave_s;
#define PHASE_ROOTS() \
        KArgP ap = ap0; asm volatile("" : "+s"(ap)); \
        int G = gridDim.x, bx = blockIdx.x; asm volatile("" : "+s"(G), "+s"(bx)); \
        const int vcu = (G % 8 == 0) ? (bx % 8) * (G / 8) + bx / 8 : bx; \
        const int gw = vcu * NWAVES + wave, NGW = G * NWAVES; (void)gw; (void)NGW; \
        unsigned char* ws = ap->ws; float* outp = ap->out; (void)outp; \
        const float* x_in = (const float*)ARG(I_X); (void)x_in; \
        float* adap = (float*)(ws + WS_ADAP); (void)adap; float* mod = (float*)(ws + WS_CTL + CTL_MOD); (void)mod; \
        float* cs_t = (float*)(ws + WS_COS); float* sn_t = (float*)(ws + WS_SIN); (void)cs_t; (void)sn_t; \
        bf16_t* Hb = (bf16_t*)(ws + WS_H); bf16_t* Zb = (bf16_t*)(ws + WS_Z); bf16_t* Y16 = (bf16_t*)(ws + WS_Y); (void)Hb; (void)Zb; (void)Y16; \
        bf16_t* QLN = (bf16_t*)(ws + WS_QLN); bf16_t* KVLN = (bf16_t*)(ws + WS_KVLN); bf16_t* CONVH = (bf16_t*)(ws + WS_CONVH); bf16_t* SGVT = (bf16_t*)(ws + WS_SGVT); (void)QLN; (void)KVLN; (void)CONVH; (void)SGVT; \
        bf16_t* Qb = (bf16_t*)(ws + WS_Q); unsigned char* KNb = ws + WS_KN; unsigned char* KRb = ws + WS_KR; unsigned char* VIb = ws + WS_V; (void)Qb; (void)KNb; (void)KRb; (void)VIb; \
        bf16_t* YCAT = (bf16_t*)(ws + WS_YCAT); (void)YCAT
        if (ph == 0 && PHEN(0)) {
            TID_HERE(); PHASE_ROOTS();
            LAS float* scr = (LAS float*)(lds + wave * 16384);
            {
                constexpr int I0 = 16 * 80, I1 = 16 * 32, I2 = 4 * 24, I3 = 2 * 32, I4 = 4 * 8, IL = I0 + I1 + I2 + I3 + I4;
                for (int it = gw; it < NLAYER * IL; it += NGW) {
                    const int l = it / IL; int r = it % IL;
                    if (r < I0) { transpose_item((const float*)ARG(I_WIN) + (size_t)l * DM * DIN, DIN, (bf16_t*)(ws + WS_WIN) + (size_t)l * DINP * DM, DM, 0, scr, r / 80, r % 80, lane); continue; } r -= I0;
                    if (r < I1) { transpose_item((const float*)ARG(I_WOUT) + (size_t)l * DM * DM, DM, (bf16_t*)(ws + WS_WOUT) + (size_t)l * DM * DM, DM, 1, scr, r / 32, r % 32, lane); continue; } r -= I1;
                    if (r < I2) { transpose_item((const float*)ARG(I_WUQ) + (size_t)l * QLR * 768, 768, (bf16_t*)(ws + WS_WUQ) + (size_t)l * 768 * 256, 256, 2, scr, r / 24, r % 24, lane); continue; } r -= I2;
                    if (r < I3) { transpose_item((const float*)ARG(I_WUKV) + (size_t)l * KVLR * 1024, 1024, (bf16_t*)(ws + WS_WUKV) + (size_t)l * 1024 * 256, 256, 3, scr, r / 32, r % 32, lane); continue; } r -= I3;
                    transpose_item((const float*)ARG(I_WPW2) + (size_t)l * CW * CW, CW, (bf16_t*)(ws + WS_WPW2) + (size_t)l * CW * CW, CW, 4, scr, r / 8, r % 8, lane);
                }
            }
            const int gt = vcu * NTHREADS + tid, NGT = G * NTHREADS;
            for (int i = gt; i < NLAYER * 1024 * 16; i += NGT) { const int row = i >> 4, c8 = (i & 15) * 8;
                *(u32x4*)((bf16_t*)(ws + WS_WUKV) + (size_t)row * 256 + 128 + c8) = (u32x4){0u, 0u, 0u, 0u}; }
            for (int i = gt; i < NLAYER * SG * SCH * SCH; i += NGT) { const int s = i & 127, t = (i >> 7) & 127;
                const float v = s <= t ? ((const float*)ARG(I_WS))[i] : 0.f; ((bf16_t*)(ws + WS_WSM))[i] = (bf16_t)(cvtpk(v, 0.f) & 0xffffu); }
            for (int i = gt; i < MTOK * 32; i += NGT) { const int tok = i >> 5, fi = i & 31;
                const float inv_freq = powf(10000.0f, -(float)(2 * fi) / 64.0f);
                const float ang = (float)((const int*)ARG(I_POS))[tok] * inv_freq;
                cs_t[i] = cosf(ang); sn_t[i] = sinf(ang); }
            for (int it = gw; it < NLAYER * 16 * 48; it += NGW) { const int l = it / 768, r = it % 768, kc = r / 48, nc = r % 48;
                const float* W = (const float*)ARG(I_WADA) + (size_t)l * DM * 3072 + (size_t)(kc * 64) * 3072 + nc * 64 + lane;
                const float* c = (const float*)ARG(I_C) + kc * 64;
                float a0 = 0.f, a1 = 0.f, a2 = 0.f, a3 = 0.f;
#pragma unroll 8
                for (int k = 0; k < 64; ++k) { const float w = W[(size_t)k * 3072];
                    a0 += siluf_(c[k]) * w; a1 += siluf_(c[DM + k]) * w; a2 += siluf_(c[2 * DM + k]) * w; a3 += siluf_(c[3 * DM + k]) * w; }
                float* dst = adap + ((size_t)(kc * 2 + l) * 4) * 3072 + nc * 64 + lane;
                __hip_atomic_store(dst, a0, __ATOMIC_RELAXED, __HIP_MEMORY_SCOPE_AGENT); __hip_atomic_store(dst + 3072, a1, __ATOMIC_RELAXED, __HIP_MEMORY_SCOPE_AGENT);
                __hip_atomic_store(dst + 2 * 3072, a2, __ATOMIC_RELAXED, __HIP_MEMORY_SCOPE_AGENT); __hip_atomic_store(dst + 3 * 3072, a3, __ATOMIC_RELAXED, __HIP_MEMORY_SCOPE_AGENT);
                asm volatile("s_waitcnt vmcnt(0)" ::: "memory");
                unsigned tk = 0;
                if (lane == 0) tk = __hip_atomic_fetch_add((unsigned*)(ws + WS_CTL) + CTL_ADACNT + (l * 48 + nc) * 16, 1u, __ATOMIC_RELAXED, __HIP_MEMORY_SCOPE_AGENT);
                tk = (unsigned)__builtin_amdgcn_readfirstlane((int)tk);
                if (tk == 15u) {
                    const float* bada = (const float*)ARG(I_BADA) + (size_t)l * 3072;
#pragma unroll
                    for (int b = 0; b < 4; ++b) { float s = 0.f;
#pragma unroll
                        for (int k2 = 0; k2 < 16; ++k2) s += __hip_atomic_load(adap + ((size_t)(k2 * 2 + l) * 4 + b) * 3072 + nc * 64 + lane, __ATOMIC_RELAXED, __HIP_MEMORY_SCOPE_AGENT);
                        mod[((size_t)l * 4 + b) * 3072 + nc * 64 + lane] = s + bada[nc * 64 + lane]; }
                } }
        } else if (ph == 1 && PHEN(1)) {
            TID_HERE(); PHASE_ROOTS();
            const float* gp = (const float*)ARG(I_GPRE);
            for (int grp = gw; grp < MTOK / 4; grp += NGW) { const int m0 = grp * 4, b = m0 >> 13;
                f32x4 v[4][4];
#pragma unroll
                for (int k = 0; k < 4; ++k) { const f32x4* xr = (const f32x4*)(x_in + (size_t)(m0 + k) * DM) + lane;
#pragma unroll
                    for (int j = 0; j < 4; ++j) v[k][j] = xr[64 * j]; }
                f32x4 pa[4], pb[4];
#pragma unroll
                for (int j = 0; j < 4; ++j) { const int c = 4 * lane + 256 * j;
                    pb[j] = *(const f32x4*)(mod + (size_t)b * 3072 + c);
                    pa[j] = *(const f32x4*)(gp + c) * (*(const f32x4*)(mod + (size_t)b * 3072 + DM + c) + 1.f); }
#pragma unroll
                for (int k = 0; k < 4; ++k) { float ss = 0.f;
#pragma unroll
                    for (int j = 0; j < 4; ++j) ss += (v[k][j].x * v[k][j].x + v[k][j].y * v[k][j].y) + (v[k][j].z * v[k][j].z + v[k][j].w * v[k][j].w);
                    const float rstd = rsqrtf(wave_sum(ss) * (1.f / DM) + EPS);
                    u32x2* o8 = (u32x2*)(Hb + (size_t)(m0 + k) * DM) + lane;
#pragma unroll
                    for (int j = 0; j < 4; ++j) { const f32x4 hv = (v[k][j] * rstd) * pa[j] + pb[j];
                        u32x2 w; w.x = cvtpk(hv.x, hv.y); w.y = cvtpk(hv.z, hv.w); o8[64 * j] = w; } }
            }
        } else {
            const int l = (ph - 2) / 6, sub = (ph - 2) % 6;
            const int ngemm = (sub == 0 || sub == 4) ? 1 : (sub == 2 ? 3 : 0);
#pragma nounroll
            for (int gi_ = 0; gi_ < ngemm * (1 + ((PROBE_MASK >> 8) & 1)) && PHEN(2); ++gi_) {
                const int gi = gi_ % ngemm;
                TID_HERE(); PHASE_ROOTS();
                pg8::Gemm g; EpiAll E; int Nn, cc = bx;
                if (sub == 0) { g = pg8::Gemm{Hb, (const bf16_t*)(ws + WS_WIN) + (size_t)l * DINP * DM, MTOK, DINP, DM, DM, DM}; Nn = DINP; E = EpiAll{EM_Z, DINP, Zb, nullptr, nullptr}; }
                else if (sub == 4) { g = pg8::Gemm{YCAT, (const bf16_t*)(ws + WS_WOUT) + (size_t)l * DM * DM, MTOK, DM, DM, DM, DM}; Nn = DM; E = EpiAll{EM_Z, DM, Y16, nullptr, nullptr}; }
                else if (gi == 0) { g = pg8::Gemm{QLN, (const bf16_t*)(ws + WS_WUQ) + (size_t)l * 768 * 256, MTOK, 768, 256, 256, 256}; Nn = 768; E = EpiAll{EM_Q, 0, Qb, cs_t, sn_t}; }
                else if (gi == 1) { g = pg8::Gemm{CONVH, (const bf16_t*)(ws + WS_WPW2) + (size_t)l * CW * CW, MTOK, CW, CW, CW, CW}; Nn = CW; cc = (bx + G / 2) % G; E = EpiAll{EM_PW2, 0, YCAT, Zb, nullptr}; }
                else { g = pg8::Gemm{KVLN, (const bf16_t*)(ws + WS_WUKV) + (size_t)l * 1024 * 256, MTOK, 1024, 256, 256, 256}; Nn = 1024; E = EpiAll{EM_KV, 0, KNb, VIb, nullptr}; }
                pg8::StaticOrder S; S.init(MTOK, Nn, G, cc);
                pg8::gemm_phase<EpiAll>((LAS unsigned char*)lds, g, S, E, tid);
            }
            if (sub == 0) {
            } else if (sub == 1 && PHEN(3)) {
                TID_HERE(); PHASE_ROOTS();
                const float* qng = (const float*)ARG(I_QNG) + l * QLR; const float* kvng = (const float*)ARG(I_KVNG) + l * KVLR;
                const float* cw = (const float*)ARG(I_CONVW) + (size_t)l * CK * CW; const float* cb = (const float*)ARG(I_CONVB) + l * CW;
                const float* clg = (const float*)ARG(I_CLNG) + l * CW; const float* clb = (const float*)ARG(I_CLNB) + l * CW;
                const float* slg = (const float*)ARG(I_SLNG) + l * SW; const float* slb = (const float*)ARG(I_SLNB) + l * SW;
                LAS float* glu = (LAS float*)lds;
                LAS float* cvo = (LAS float*)(lds + 63488);
                LAS bf16_t* sgv = (LAS bf16_t*)(lds + 63488 + 32768);
                for (int tt = vcu; tt < MTOK / 32; tt += G) {
                    const int b = tt >> 8, s0 = (tt & 255) * 32; const size_t m0 = (size_t)b * SEQ + s0;
#pragma unroll
                    for (int pass = 0; pass < 4; ++pass) { const int r = pass * 16 + (tid >> 5), c8 = (tid & 31) * 8;
                        if (r < 62) { const int s = s0 - 30 + r; f32x4 g0 = {0.f, 0.f, 0.f, 0.f}, g1 = {0.f, 0.f, 0.f, 0.f};
                            if (s >= 0) { const bf16_t* zr = Zb + ((size_t)b * SEQ + s) * DINP;
                                const u32x4 a = *(const u32x4*)(zr + ZC_CA + c8), g = *(const u32x4*)(zr + ZC_CB + c8);
                                g0[0] = lo_bf(a.x) * sigmoidf_(lo_bf(g.x)); g0[1] = hi_bf(a.x) * sigmoidf_(hi_bf(g.x)); g0[2] = lo_bf(a.y) * sigmoidf_(lo_bf(g.y)); g0[3] = hi_bf(a.y) * sigmoidf_(hi_bf(g.y));
                                g1[0] = lo_bf(a.z) * sigmoidf_(lo_bf(g.z)); g1[1] = hi_bf(a.z) * sigmoidf_(hi_bf(g.z)); g1[2] = lo_bf(a.w) * sigmoidf_(lo_bf(g.w)); g1[3] = hi_bf(a.w) * sigmoidf_(hi_bf(g.w)); }
                            *(LAS f32x4*)(glu + r * 256 + c8) = g0; *(LAS f32x4*)(glu + r * 256 + c8 + 4) = g1; } }
                    for (int i = 0; i < 4; ++i) { const int tl = 4 * wave + i; const size_t m = m0 + tl; const int s = s0 + tl; const bf16_t* zr = Zb + m * DINP;
                        {
                            const u32x2 z = *(const u32x2*)(zr + ZC_Q + 4 * lane); const float x0 = lo_bf(z.x), x1 = hi_bf(z.x), x2 = lo_bf(z.y), x3 = hi_bf(z.y);
                            const float rstd = rsqrtf(wave_sum((x0 * x0 + x1 * x1) + (x2 * x2 + x3 * x3)) * (1.f / QLR) + EPS);
                            const f32x4 g = *(const f32x4*)(qng + 4 * lane);
                            u32x2 w; w.x = cvtpk(x0 * rstd * g.x, x1 * rstd * g.y); w.y = cvtpk(x2 * rstd * g.z, x3 * rstd * g.w);
                            *(u32x2*)(QLN + m * 256 + 4 * lane) = w; }
                        {
                            float x0 = 0.f, x1 = 0.f, x2 = 0.f, x3 = 0.f;
                            if (lane < 32) { const u32x2 z = *(const u32x2*)(zr + ZC_KV + 4 * lane); x0 = lo_bf(z.x); x1 = hi_bf(z.x); x2 = lo_bf(z.y); x3 = hi_bf(z.y); }
                            const float rstd = rsqrtf(wave_sum((x0 * x0 + x1 * x1) + (x2 * x2 + x3 * x3)) * (1.f / KVLR) + EPS);
                            const f32x4 g = *(const f32x4*)(kvng + 4 * (lane & 31));
                            u32x2 w; w.x = cvtpk(x0 * rstd * g.x, x1 * rstd * g.y); w.y = cvtpk(x2 * rstd * g.z, x3 * rstd * g.w);
                            *(u32x2*)(KVLN + m * 256 + 4 * lane) = w; }
                        if (lane < 32) {
                            const float x1 = bf2f(zr[ZC_KR + lane]), x2 = bf2f(zr[ZC_KR + 32 + lane]);
                            const float c = cs_t[m * 32 + lane], sn = sn_t[m * 32 + lane];
                            const size_t off = ((size_t)(b * (SEQ / 64) + (s >> 6))) * 8192 + (lane >> 2) * 1024 + (s & 63) * 16 + (lane & 3) * 4;
                            *(unsigned*)(KRb + off) = cvtpk(x1 * c - x2 * sn, x2 * c + x1 * sn); }
                        {
                            const u32x2 z = *(const u32x2*)(zr + ZC_SV + 4 * lane);
                            const float x0 = geluf_(lo_bf(z.x)), x1 = geluf_(hi_bf(z.x)), x2 = geluf_(lo_bf(z.y)), x3 = geluf_(hi_bf(z.y));
                            const float mean = wave_sum((x0 + x1) + (x2 + x3)) * (1.f / SW);
                            const float d0 = x0 - mean, d1 = x1 - mean, d2 = x2 - mean, d3 = x3 - mean;
                            const float rstd = rsqrtf(wave_sum((d0 * d0 + d1 * d1) + (d2 * d2 + d3 * d3)) * (1.f / SW) + EPS);
                            const f32x4 g = *(const f32x4*)(slg + 4 * lane), bb = *(const f32x4*)(slb + 4 * lane);
                            u32x2 w; w.x = cvtpk(d0 * rstd * g.x + bb.x, d1 * rstd * g.y + bb.y); w.y = cvtpk(d2 * rstd * g.z + bb.z, d3 * rstd * g.w + bb.w);
                            *(LAS u32x2*)(sgv + tl * 256 + 4 * lane) = w; }
                    }
                    __syncthreads();
                    { const int c = tid & 255, half = tid >> 8; float w[CK];
#pragma unroll
                      for (int j = 0; j < CK; ++j) w[j] = cw[j * CW + c];
                      const float bias = cb[c];
                      for (int g4 = 0; g4 < 4; ++g4) { const int tb = 16 * half + 4 * g4; float v[34];
#pragma unroll
                          for (int k = 0; k < 34; ++k) v[k] = glu[(tb + k) * 256 + c];
#pragma unroll
                          for (int i = 0; i < 4; ++i) { float a = bias;
#pragma unroll
                              for (int j = 0; j < CK; ++j) a += w[j] * v[i + j];
                              cvo[(tb + i) * 256 + c] = a; } } }
                    __syncthreads();
                    for (int i = 0; i < 4; ++i) { const int tl = 4 * wave + i; const size_t m = m0 + tl;
                        const f32x4 xv = *(const LAS f32x4*)(cvo + tl * 256 + 4 * lane);
                        const float mean = wave_sum((xv.x + xv.y) + (xv.z + xv.w)) * (1.f / CW);
                        const float d0 = xv.x - mean, d1 = xv.y - mean, d2 = xv.z - mean, d3 = xv.w - mean;
                        const float rstd = rsqrtf(wave_sum((d0 * d0 + d1 * d1) + (d2 * d2 + d3 * d3)) * (1.f / CW) + EPS);
                        const f32x4 g = *(const f32x4*)(clg + 4 * lane), bb = *(const f32x4*)(clb + 4 * lane);
                        u32x2 w; w.x = cvtpk(siluf_(d0 * rstd * g.x + bb.x), siluf_(d1 * rstd * g.y + bb.y)); w.y = cvtpk(siluf_(d2 * rstd * g.z + bb.z), siluf_(d3 * rstd * g.w + bb.w));
                        *(u32x2*)(CONVH + m * 256 + 4 * lane) = w; }
                    { const int c = tid & 255, half = tid >> 8; unsigned pk[8];
#pragma unroll
                      for (int k = 0; k < 8; ++k) { const unsigned lo = sgv[(16 * half + 2 * k) * 256 + c], hi2 = sgv[(16 * half + 2 * k + 1) * 256 + c]; pk[k] = lo | (hi2 << 16); }
                      bf16_t* dst = SGVT + ((size_t)(m0 >> 7) * 256 + c) * 128 + (s0 & 127) + 16 * half;
                      *(u32x4*)dst = (u32x4){pk[0], pk[1], pk[2], pk[3]}; *(u32x4*)(dst + 8) = (u32x4){pk[4], pk[5], pk[6], pk[7]}; }
                    __syncthreads();
                }
            } else if (sub == 2 && PHEN(4)) {
                TID_HERE(); PHASE_ROOTS();
                { const bf16_t* WsM = (const bf16_t*)(ws + WS_WSM) + (size_t)l * SG * SCH * SCH; const float* bs = (const float*)ARG(I_BS) + l * SG * SCH;
                  const int r32 = lane & 31, hi = lane >> 5, gq = wave >> 1, th = wave & 1;
                  for (int ck_ = vcu; ck_ < (MTOK / SCH) * (1 + ((PROBE_MASK >> 9) & 1)); ck_ += G) { const int ck = ck_ % (MTOK / SCH);
                      f32x16 acc[2][2];
#pragma unroll
                      for (int a = 0; a < 2; ++a)
#pragma unroll
                          for (int bq = 0; bq < 2; ++bq) acc[a][bq] = f32x16{};
                      const bf16_t* Ab = WsM + ((size_t)gq * SCH + 64 * th + r32) * SCH + 8 * hi;
                      const bf16_t* Bb = SGVT + ((size_t)ck * 256 + gq * 64 + r32) * SCH + 8 * hi;
#pragma unroll
                      for (int ks = 0; ks < 8; ++ks) {
                          const bf16x8 a0 = *(const bf16x8*)(Ab + 16 * ks), a1 = *(const bf16x8*)(Ab + 32 * SCH + 16 * ks);
                          const bf16x8 b0 = *(const bf16x8*)(Bb + 16 * ks), b1 = *(const bf16x8*)(Bb + 32 * SCH + 16 * ks);
                          acc[0][0] = __builtin_amdgcn_mfma_f32_32x32x16_bf16(a0, b0, acc[0][0], 0, 0, 0);
                          acc[0][1] = __builtin_amdgcn_mfma_f32_32x32x16_bf16(a0, b1, acc[0][1], 0, 0, 0);
                          acc[1][0] = __builtin_amdgcn_mfma_f32_32x32x16_bf16(a1, b0, acc[1][0], 0, 0, 0);
                          acc[1][1] = __builtin_amdgcn_mfma_f32_32x32x16_bf16(a1, b1, acc[1][1], 0, 0, 0);
                      }
#pragma unroll
                      for (int rb = 0; rb < 2; ++rb)
#pragma unroll
                          for (int r = 0; r < 16; ++r) { const int t = 64 * th + 32 * rb + crow(r, hi); const size_t m = (size_t)ck * SCH + t; const float bt = bs[gq * SCH + t];
#pragma unroll
                              for (int cbk = 0; cbk < 2; ++cbk) { const int col = gq * 64 + 32 * cbk + r32;
                                  const float uu = geluf_(bf2f(Zb[m * DINP + ZC_SU + col])), gs = siluf_(bf2f(Zb[m * DINP + ZC_GS + col]));
                                  const float v = (acc[rb][cbk][r] + bt) * uu * gs;
                                  const float vn = xor1_f(v);
                                  if ((r32 & 1) == 0) *(unsigned*)(YCAT + m * DM + 768 + col) = cvtpk(v, vn); } }
                  } }
            } else if (sub == 3 && PHEN(5)) {
                TID_HERE(); PHASE_ROOTS();
                const int nun = (NB * NH * 32 + G - 1) / G;
#pragma nounroll
                for (int i = 0; i < nun; ++i) {
                    const int u_ = vcu + i * G;
                    int bh = u_ >> 5, qb = 31 - (u_ & 31);
                    if (G == 256) { bh = vcu >> 4; qb = (i == 0) ? 31 - (vcu & 15) : (vcu & 15); }
                    if (bh < NB * NH) att::attn_unit3(bh >> 2, bh & 3, qb, Qb, KNb, KRb, VIb, Zb, YCAT, (char*)lds, tid);
                }
            } else if (sub == 5 && PHEN(7)) {
                TID_HERE(); PHASE_ROOTS();
                const float* xsrc = (l == 0) ? x_in : (const float*)outp;
                const float* gpost = (const float*)ARG(I_GPOST) + l * DM;
                const float* modl = mod + (size_t)l * 4 * 3072; const float* mod1 = mod + (size_t)4 * 3072; const float* gp1 = (const float*)ARG(I_GPRE) + DM;
                for (int grp = gw; grp < MTOK / 4; grp += NGW) { const int m0 = grp * 4, b = m0 >> 13;
                    u32x2 yv[4][4]; f32x4 xv[4][4];
#pragma unroll
                    for (int k = 0; k < 4; ++k) { const u32x2* yr = (const u32x2*)(Y16 + (size_t)(m0 + k) * DM) + lane; const f32x4* xr = (const f32x4*)(xsrc + (size_t)(m0 + k) * DM) + lane;
#pragma unroll
                        for (int j = 0; j < 4; ++j) { yv[k][j] = yr[64 * j]; xv[k][j] = xr[64 * j]; } }
                    f32x4 pg[4];
#pragma unroll
                    for (int j = 0; j < 4; ++j) { const int c = 4 * lane + 256 * j; pg[j] = *(const f32x4*)(modl + (size_t)b * 3072 + 2 * DM + c) * *(const f32x4*)(gpost + c); }
                    float rstd2[4];
#pragma unroll
                    for (int k = 0; k < 4; ++k) { float ss = 0.f; f32x4 y[4];
#pragma unroll
                        for (int j = 0; j < 4; ++j) { y[j] = (f32x4){lo_bf(yv[k][j].x), hi_bf(yv[k][j].x), lo_bf(yv[k][j].y), hi_bf(yv[k][j].y)};
                            ss += (y[j].x * y[j].x + y[j].y * y[j].y) + (y[j].z * y[j].z + y[j].w * y[j].w); }
                        const float rstd = rsqrtf(wave_sum(ss) * (1.f / DM) + EPS);
                        f32x4* orow = (f32x4*)(outp + (size_t)(m0 + k) * DM) + lane; float ss2 = 0.f;
#pragma unroll
                        for (int j = 0; j < 4; ++j) { xv[k][j] = xv[k][j] + (y[j] * rstd) * pg[j]; orow[64 * j] = xv[k][j];
                            ss2 += (xv[k][j].x * xv[k][j].x + xv[k][j].y * xv[k][j].y) + (xv[k][j].z * xv[k][j].z + xv[k][j].w * xv[k][j].w); }
                        rstd2[k] = rsqrtf(wave_sum(ss2) * (1.f / DM) + EPS); }
                    if (l == 0) {
                        f32x4 pa[4], pb[4];
#pragma unroll
                        for (int j = 0; j < 4; ++j) { const int c = 4 * lane + 256 * j;
                            pb[j] = *(const f32x4*)(mod1 + (size_t)b * 3072 + c);
                            pa[j] = *(const f32x4*)(gp1 + c) * (*(const f32x4*)(mod1 + (size_t)b * 3072 + DM + c) + 1.f); }
#pragma unroll
                        for (int k = 0; k < 4; ++k) { u32x2* o8 = (u32x2*)(Hb + (size_t)(m0 + k) * DM) + lane;
#pragma unroll
                            for (int j = 0; j < 4; ++j) { const f32x4 hv = (xv[k][j] * rstd2[k]) * pa[j] + pb[j];
                                u32x2 w; w.x = cvtpk(hv.x, hv.y); w.y = cvtpk(hv.z, hv.w); o8[64 * j] = w; } }
                    }
                }
            }
        }
        { bool again = false;
          if (rep == 0 && PROBE_MASK != 0) { if (ph == 1) again = (PROBE_MASK >> 6) & 1; else if (ph >= 2) { const int sub_ = (ph - 2) % 6, l_ = (ph - 2) / 6; again = ((PROBE_MASK >> sub_) & 1) && !(sub_ == 5 && l_ == 1); } }
          if (again) rep = 1; else { rep = 0; ++ph; } }
        if (ph < ph_hi) { if (ph_lo < 0) grid.sync(); else xcd_barrier(xbar); }
    }
}

extern "C" void kernel_launch(void* const* d_in, const int* in_sizes, int n_in, void* d_out, int out_size, void* d_ws, size_t ws_size, hipStream_t stream) {
    static int grid = 0;
    if (grid == 0) {
        if (n_in != 22 || in_sizes[0] != MTOK * DM || out_size != MTOK * DM || ws_size < WS_END) {
            fprintf(stderr, "kernel_launch: unexpected shapes (n_in %d, in0 %d, out %d, ws %zu); nothing launched\n", n_in, n_in > 0 ? in_sizes[0] : -1, out_size, ws_size); grid = -1; return; }
        int dev = 0, cus = 0, per_cu = 0;
        (void)hipGetDevice(&dev); (void)hipDeviceGetAttribute(&cus, hipDeviceAttributeMultiprocessorCount, dev);
        if (hipFuncSetAttribute((const void*)hymba_fwd, hipFuncAttributeMaxDynamicSharedMemorySize, LDS_BYTES) != hipSuccess) { fprintf(stderr, "kernel_launch: hipFuncSetAttribute failed\n"); grid = -1; return; }
        if (hipOccupancyMaxActiveBlocksPerMultiprocessor(&per_cu, (const void*)hymba_fwd, NTHREADS, LDS_BYTES) != hipSuccess || per_cu < 1) { fprintf(stderr, "kernel_launch: occupancy query says %d blocks per CU\n", per_cu); per_cu = 1; }
        (void)hipGetLastError();
        grid = cus > 0 ? cus : 256;
    }
    if (grid < 0) return;
    (void)hipMemsetAsync((char*)d_ws + WS_CTL, 0, CTL_BYTES, stream);
    Args a{};
    for (int i = 0; i < 22; ++i) a.in[i] = d_in[i];
    a.out = (float*)d_out; a.ws = (unsigned char*)d_ws;
#if MK_N_LAUNCHES == 1
    a.ph_lo = 0; a.ph_hi = N_PHASES;
    { void* kargs[] = {&a};
      hipError_t e = hipLaunchCooperativeKernel((const void*)hymba_fwd, dim3(grid), dim3(NTHREADS), kargs, LDS_BYTES, stream);
      if (e != hipSuccess) fprintf(stderr, "cooperative launch failed: %s (grid %d)\n", hipGetErrorString(e), grid); }
#else
    for (int ph = 0; ph < N_PHASES; ++ph) { a.ph_lo = ph; a.ph_hi = ph + 1; void* kargs[] = {&a};
        hipError_t e = hipLaunchCooperativeKernel((const void*)hymba_fwd, dim3(grid), dim3(NTHREADS), kargs, LDS_BYTES, stream);
        if (e != hipSuccess) { fprintf(stderr, "launch %d failed: %s (grid %d)\n", ph, hipGetErrorString(e), grid); break; } }
#endif
}
```

```cpp
#include <hip/hip_runtime.h>
#include <hip/hip_cooperative_groups.h>
#include <cstdio>
#include <cstdint>
namespace cg = cooperative_groups;

#ifndef MK_N_LAUNCHES
#define MK_N_LAUNCHES 1
#endif

#define LAS __attribute__((address_space(3)))
#ifndef PROBE_MASK
#define PROBE_MASK 0
#endif
#ifndef PHMASK
#define PHMASK 0xff
#endif
#define PHEN(k) (((PHMASK) >> (k)) & 1)
typedef unsigned short bf16_t;
typedef short bf16x8 __attribute__((ext_vector_type(8)));
typedef short s16x4 __attribute__((ext_vector_type(4)));
typedef float f32x2 __attribute__((ext_vector_type(2)));
typedef float f32x4 __attribute__((ext_vector_type(4)));
typedef float f32x16 __attribute__((ext_vector_type(16)));
typedef unsigned u32x2 __attribute__((ext_vector_type(2)));
typedef unsigned u32x4 __attribute__((ext_vector_type(4)));

constexpr int DM = 1024, NB = 4, SEQ = 8192, MTOK = NB * SEQ, NLAYER = 2;
constexpr int NH = 4, DNOPE = 128, DROPE = 64, DQK = 192, DV = 128;
constexpr int QLR = 256, KVLR = 128, DIN = 2496, DINP = 2560;
constexpr int CW = 256, CK = 31, SW = 256, SG = 4, SCH = 128;
constexpr float EPS = 1e-6f;
constexpr int ZC_Q = 0, ZC_KV = 256, ZC_KR = 384, ZC_GATT = 512, ZC_CA = 1024, ZC_CB = 1280, ZC_GC = 1536, ZC_SU = 1792, ZC_SV = 2048, ZC_GS = 2304;
constexpr float QSCALE = 0.07216878364870323f * 1.4426950408889634f;

constexpr size_t MiB = 1u << 20;
constexpr size_t WS_CTL = 0, CTL_BYTES = 1 * MiB;
constexpr size_t CTL_BARW = 1024;
constexpr size_t CTL_ADACNT = 8192;
constexpr size_t CTL_MOD = 65536;
constexpr size_t WS_COS = 1 * MiB, WS_SIN = 5 * MiB;
constexpr size_t WS_WIN = 9 * MiB;
constexpr size_t WS_WOUT = 19 * MiB;
constexpr size_t WS_WUQ = 23 * MiB;
constexpr size_t WS_WUKV = 24 * MiB;
constexpr size_t WS_WPW2 = 25 * MiB;
constexpr size_t WS_WSM = 26 * MiB;
constexpr size_t WS_ADAP = 27 * MiB;
constexpr size_t WS_H = 32 * MiB;
constexpr size_t WS_Z = 96 * MiB;
constexpr size_t WS_Y = WS_Z;
constexpr size_t WS_QLN = 256 * MiB;
constexpr size_t WS_KVLN = 272 * MiB;
constexpr size_t WS_CONVH = 288 * MiB;
constexpr size_t WS_SGVT = 304 * MiB;
constexpr size_t WS_Q = 320 * MiB;
constexpr size_t WS_KN = 368 * MiB;
constexpr size_t WS_KR = 400 * MiB;
constexpr size_t WS_V = 408 * MiB;
constexpr size_t WS_YCAT = 440 * MiB;
constexpr size_t WS_END = 504 * MiB;

constexpr int LDS_BYTES = 147456;
constexpr int NTHREADS = 512, NWAVES = 8;

__device__ __forceinline__ float bf2f(unsigned short u) { return __uint_as_float(((unsigned)u) << 16); }
__device__ __forceinline__ unsigned cvtpk(float lo, float hi) { unsigned r; asm("v_cvt_pk_bf16_f32 %0, %1, %2" : "=v"(r) : "v"(lo), "v"(hi)); return r; }
__device__ __forceinline__ float lo_bf(unsigned w) { return __uint_as_float(w << 16); }
__device__ __forceinline__ float hi_bf(unsigned w) { return __uint_as_float(w & 0xffff0000u); }
#define dpp_f(v, ctrl) __int_as_float(__builtin_amdgcn_update_dpp(0, __float_as_int(v), (ctrl), 0xf, 0xf, true))
#define DPP_XOR1 0xB1
#define DPP_XOR2 0x4E
#define DPP_HMIRROR 0x141
#define DPP_MIRROR 0x140
__device__ __forceinline__ float xor1_f(float v) { return dpp_f(v, DPP_XOR1); }
__device__ __forceinline__ float wave_sum(float v) {
    v += dpp_f(v, DPP_XOR1); v += dpp_f(v, DPP_XOR2); v += dpp_f(v, DPP_HMIRROR); v += dpp_f(v, DPP_MIRROR);
    const int iv = __float_as_int(v);
    return (__int_as_float(__builtin_amdgcn_readlane(iv, 0)) + __int_as_float(__builtin_amdgcn_readlane(iv, 16))) +
           (__int_as_float(__builtin_amdgcn_readlane(iv, 32)) + __int_as_float(__builtin_amdgcn_readlane(iv, 48)));
}
__device__ __forceinline__ float sigmoidf_(float x) { return __builtin_amdgcn_rcpf(1.f + __builtin_amdgcn_exp2f(-1.4426950408889634f * x)); }
__device__ __forceinline__ float siluf_(float x) { return x * __builtin_amdgcn_rcpf(1.f + __builtin_amdgcn_exp2f(-1.4426950408889634f * x)); }
__device__ __forceinline__ float geluf_(float v) {
    const float av = __builtin_fabsf(v), t = __builtin_amdgcn_rcpf(av * 0.2316418882f + 1.0f);
    float q = t * 0.5307027145f + (-0.7265760135f); q = q * t + 0.7107068705f; q = q * t + (-0.142248368f); q = q * t + 0.127414796f; q = q * t;
    const float e = __builtin_amdgcn_exp2f((v * v) * (-0.72134752044f));
    const float m = v * (q * e);
    return v < 0.f ? m : v - m;
}

namespace pg8 {
constexpr int BM = 256, BK = 64, HALF = 128, HTB = HALF * BK * 2, STAGE_BYTES = 8 * HTB, NXCD = 8, WGM = 8;
__host__ __device__ __forceinline__ int lds_byte(int r, int c) { const int st = (r >> 4) * 2 + (c >> 5), rr = r & 15, cc = c & 31, ob = rr * 64 + cc * 2; return st * 1024 + (ob ^ (((ob >> 9) & 1) << 5)); }
__host__ __device__ __forceinline__ void stage_rc(int b, int& R, int& C) { const int st = b / 1024, sb = b % 1024, swz = sb ^ (((sb >> 9) & 1) << 5); R = (st >> 1) * 16 + swz / 64; C = (st & 1) * 32 + (swz % 64) / 2; }
__host__ __device__ __forceinline__ int perm32(int rho) { const int n = rho >> 4, i = rho & 15; return 8 * (i >> 2) + 4 * n + (i & 3); }

struct Unit { int pm, pn; };
struct Gemm { const bf16_t* A; const bf16_t* Bt; int M, N, K, lda, ldb; };

struct StaticOrder {
    int nM, nN, nwg, G, c;
    __host__ __device__ void init(int M, int N, int G_, int c_) { nM = M / BM; nN = N / BM; nwg = nM * nN; G = G_; c = c_; }
    __host__ __device__ bool next(int i, Unit& u) const {
        const long L = (long)i * G + c; if (L >= nwg) return false;
        int wgid = (int)L; { const int q = nwg / NXCD, r = nwg % NXCD, xcd = wgid % NXCD, off = wgid / NXCD; wgid = (xcd < r ? xcd * (q + 1) : r * (q + 1) + (xcd - r) * q) + off; }
        const int nig = WGM * nN, gid = wgid / nig, fm = gid * WGM, gsz = (nM - fm) < WGM ? (nM - fm) : WGM;
        u.pm = fm + ((wgid % nig) % gsz); u.pn = (wgid % nig) / gsz; return true;
    }
};

template <class Epi>
__device__ __forceinline__ void gemm_phase(LAS unsigned char* lds, const Gemm g, const StaticOrder& S, const Epi& E, const int tid) {
    const int wid = __builtin_amdgcn_readfirstlane(tid >> 6), lane = tid & 63, wr = wid >> 2, wc = wid & 3, fr = lane & 15, fq = lane >> 4;
    const int K = g.K, nt = K / BK;
    unsigned voffA[2], voffB[2];
#pragma unroll
    for (int i = 0; i < 2; ++i) { int R, C; stage_rc(tid * 16 + i * 8192, R, C); const int Rb = Epi::PERM ? ((R & ~31) + perm32(R & 31)) : R;
        voffA[i] = (unsigned)(R * g.lda + C) * 2u; voffB[i] = (unsigned)(Rb * g.ldb + C) * 2u; }
    const size_t kstep = (size_t)(BK * 2);
    const size_t hstepA = (size_t)HALF * g.lda * 2, hstepB = (size_t)HALF * g.ldb * 2;
    const size_t tstepA = 2 * hstepA, tstepB = 2 * hstepB;
    const unsigned ldsw = (unsigned)wid * 1024u;
    const int aoff = lds_byte(wr * 64 + fr, fq * 8), boff = lds_byte(wc * 32 + fr, fq * 8);
#define PG8_SA(b, h) (((b) * 2 + (h)) * HTB)
#define PG8_SB(b, h) ((4 + (b) * 2 + (h)) * HTB)
#define PG8_STAGE(bufoff, gbase, voff) do { _Pragma("unroll") for (int _i = 0; _i < 2; ++_i) \
        __builtin_amdgcn_global_load_lds((const unsigned*)((const char*)(gbase) + (voff)[_i]), (LAS unsigned*)(lds + (bufoff) + ldsw + _i * 8192), 16, 0, 0); } while (0)
#define PG8_LDA(dst, b, h) do { _Pragma("unroll") for (int m = 0; m < 4; ++m) _Pragma("unroll") for (int k = 0; k < 2; ++k) dst[m][k] = *(const LAS bf16x8*)(lds + PG8_SA(b, h) + aoff + m * 2048 + k * 1024); } while (0)
#define PG8_LDB(dst, b, h) do { _Pragma("unroll") for (int n = 0; n < 2; ++n) _Pragma("unroll") for (int k = 0; k < 2; ++k) dst[n][k] = *(const LAS bf16x8*)(lds + PG8_SB(b, h) + boff + n * 2048 + k * 1024); } while (0)
#define PG8_MMA(ai, bj, At, Bt) do { __builtin_amdgcn_s_setprio(1); _Pragma("unroll") for (int m = 0; m < 4; ++m) _Pragma("unroll") for (int n = 0; n < 2; ++n) _Pragma("unroll") for (int k = 0; k < 2; ++k) \
        acc[ai][bj][m][n] = __builtin_amdgcn_mfma_f32_16x16x32_bf16(Bt[n][k], At[m][k], acc[ai][bj][m][n], 0, 0, 0); __builtin_amdgcn_s_setprio(0); } while (0)
#define PG8_WAIT_V(n) asm volatile("s_waitcnt vmcnt(" #n ")" ::: "memory")
#define PG8_WAIT_L(n) asm volatile("s_waitcnt lgkmcnt(" #n ")" ::: "memory")
#define PG8_BAR __builtin_amdgcn_s_barrier()
#define PG8_SCHED __builtin_amdgcn_sched_barrier(0)
    Unit cur, nxt; int ui = 0;
    if (!S.next(0, cur)) return;
    f32x4 acc[2][2][4][2];
#pragma unroll
    for (int a = 0; a < 2; ++a)
#pragma unroll
        for (int b = 0; b < 2; ++b)
#pragma unroll
            for (int m = 0; m < 4; ++m)
#pragma unroll
                for (int n = 0; n < 2; ++n) acc[a][b][m][n] = (f32x4){0.f, 0.f, 0.f, 0.f};
    bf16x8 At[4][2], B0[2][2], B1[2][2];
    const char* cA = (const char*)g.A + (size_t)cur.pm * tstepA; const char* cB = (const char*)g.Bt + (size_t)cur.pn * tstepB;
    PG8_STAGE(PG8_SB(0, 0), cB, voffB); PG8_STAGE(PG8_SB(0, 1), cB + hstepB, voffB); PG8_STAGE(PG8_SA(0, 0), cA, voffA); PG8_STAGE(PG8_SA(0, 1), cA + hstepA, voffA);
    if (wr == 1) PG8_BAR;
    PG8_WAIT_V(2); PG8_BAR;
    PG8_STAGE(PG8_SB(1, 0), cB + kstep, voffB); PG8_STAGE(PG8_SA(1, 0), cA + kstep, voffA); PG8_STAGE(PG8_SB(1, 1), cB + hstepB + kstep, voffB);
    PG8_WAIT_V(6); PG8_BAR;
    for (;;) {
        const bool has_next = S.next(ui + 1, nxt);
        const char* nA = has_next ? (const char*)g.A + (size_t)nxt.pm * tstepA : cA; const char* nB = has_next ? (const char*)g.Bt + (size_t)nxt.pn * tstepB : cB;
        for (int t = 0; t < nt; t += 2) {
            const bool last = (t == nt - 2);
            const char* a1 = cA + (size_t)(t + 1) * kstep;
            const char* a2 = last ? nA : cA + (size_t)(t + 2) * kstep; const char* b2 = last ? nB : cB + (size_t)(t + 2) * kstep;
            const char* a3 = a2 + kstep; const char* b3 = b2 + kstep;
            PG8_LDB(B0, 0, 0); PG8_LDB(B1, 0, 1); PG8_SCHED; PG8_LDA(At, 0, 0); PG8_STAGE(PG8_SA(1, 1), a1 + hstepA, voffA);
            PG8_WAIT_V(8); PG8_WAIT_L(0); PG8_BAR; PG8_MMA(0, 0, At, B0); PG8_MMA(0, 1, At, B1); PG8_BAR; PG8_SCHED;
            PG8_LDA(At, 0, 1); PG8_STAGE(PG8_SB(0, 0), b2, voffB); PG8_STAGE(PG8_SB(0, 1), b2 + hstepB, voffB); PG8_STAGE(PG8_SA(0, 0), a2, voffA);
            PG8_WAIT_V(8); PG8_WAIT_L(0); PG8_BAR; PG8_MMA(1, 0, At, B0); PG8_MMA(1, 1, At, B1); PG8_BAR; PG8_SCHED;
            PG8_LDB(B0, 1, 0); PG8_LDB(B1, 1, 1); PG8_SCHED; PG8_LDA(At, 1, 0); PG8_STAGE(PG8_SA(0, 1), a2 + hstepA, voffA);
            PG8_WAIT_V(8); PG8_WAIT_L(0); PG8_BAR; PG8_MMA(0, 0, At, B0); PG8_MMA(0, 1, At, B1); PG8_BAR; PG8_SCHED;
            PG8_LDA(At, 1, 1); PG8_STAGE(PG8_SB(1, 0), b3, voffB); PG8_STAGE(PG8_SB(1, 1), b3 + hstepB, voffB); PG8_STAGE(PG8_SA(1, 0), a3, voffA);
            PG8_WAIT_V(8); PG8_WAIT_L(0); PG8_BAR; PG8_MMA(1, 0, At, B0); PG8_MMA(1, 1, At, B1); PG8_BAR; PG8_SCHED;
        }
        if (wr == 0) PG8_BAR;
        { Unit uu = cur; asm volatile("" : "+s"(uu.pm), "+s"(uu.pn)); int t2 = tid; asm volatile("" : "+v"(t2));
          E(acc, uu, wr, wc, t2 & 15, (t2 & 63) >> 4); }
        if (!has_next) break;
#pragma unroll
        for (int a = 0; a < 2; ++a)
#pragma unroll
            for (int b = 0; b < 2; ++b)
#pragma unroll
                for (int m = 0; m < 4; ++m)
#pragma unroll
                    for (int n = 0; n < 2; ++n) acc[a][b][m][n] = (f32x4){0.f, 0.f, 0.f, 0.f};
        cur = nxt; cA = nA; cB = nB; ++ui;
        if (wr == 1) PG8_BAR;
    }
    PG8_WAIT_V(0);
    PG8_BAR;
#undef PG8_SA
#undef PG8_SB
#undef PG8_STAGE
#undef PG8_LDA
#undef PG8_LDB
#undef PG8_MMA
#undef PG8_WAIT_V
#undef PG8_WAIT_L
#undef PG8_BAR
#undef PG8_SCHED
}
}

__host__ __device__ __forceinline__ int v_st(int k, int c) { const int kk = (k & ~0xC) | ((k & 4) << 1) | ((k & 8) >> 1); return ((kk >> 3) * 4 + (c >> 5)) * 512 + ((kk & 7) * 32 + (c & 31)) * 2; }
__device__ __forceinline__ int v_rd_base(int lane) { return ((lane & 3) << 3) | (((lane >> 2) & 3) << 6) | (((lane >> 4) & 1) << 5) | (((lane >> 5) & 1) << 8); }
constexpr int v_rd_off(int d0, int ks, int half) { return d0 * 512 + ks * 4096 + half * 2048; }
__device__ __forceinline__ int crow(int r, int hi) { return (r & 3) + 8 * (r >> 2) + 4 * hi; }

enum { EM_Z = 0, EM_F32 = 1, EM_Q = 2, EM_KV = 3, EM_PW2 = 4 };
struct EpiAll {
    static constexpr bool PERM = true;
    int mode; int ldc; void* p0; const void* p1; const void* p2;
    __device__ __forceinline__ void operator()(const f32x4 (&acc)[2][2][4][2], const pg8::Unit& u, int wr, int wc, int fr, int fq) const {
        const int row0 = u.pm * 256 + wr * 64 + fr, col0 = u.pn * 256 + wc * 32 + 8 * fq;
        if (mode == EM_Z) {
            bf16_t* O = (bf16_t*)p0;
#pragma unroll
            for (int ai = 0; ai < 2; ++ai)
#pragma unroll
                for (int m = 0; m < 4; ++m) { bf16_t* rowp = O + (size_t)(row0 + ai * 128 + m * 16) * ldc + col0;
#pragma unroll
                    for (int bj = 0; bj < 2; ++bj) { const f32x4 v0 = acc[ai][bj][m][0], v1 = acc[ai][bj][m][1];
                        u32x4 w; w.x = cvtpk(v0[0], v0[1]); w.y = cvtpk(v0[2], v0[3]); w.z = cvtpk(v1[0], v1[1]); w.w = cvtpk(v1[2], v1[3]);
                        *(u32x4*)(rowp + bj * 128) = w; } }
        } else if (mode == EM_F32) {
            float* C = (float*)p0;
#pragma unroll
            for (int ai = 0; ai < 2; ++ai)
#pragma unroll
                for (int m = 0; m < 4; ++m) { float* rowp = C + (size_t)(row0 + ai * 128 + m * 16) * ldc + col0;
#pragma unroll
                    for (int bj = 0; bj < 2; ++bj)
#pragma unroll
                        for (int n = 0; n < 2; ++n) *(f32x4*)(rowp + bj * 128 + n * 4) = acc[ai][bj][m][n]; }
        } else if (mode == EM_Q) {
            bf16_t* Q = (bf16_t*)p0; const float* cs = (const float*)p1; const float* sn = (const float*)p2;
#pragma unroll
            for (int ai = 0; ai < 2; ++ai)
#pragma unroll
                for (int m = 0; m < 4; ++m) { const int tok = row0 + ai * 128 + m * 16, b = tok >> 13, s = tok & 8191;
#pragma unroll
                    for (int bj = 0; bj < 2; ++bj) { f32x4 v0 = acc[ai][bj][m][0], v1 = acc[ai][bj][m][1]; const int n = col0 + bj * 128;
                        bf16_t* dst;
                        if (u.pn < 2) { const int h = n >> 7, d = n & 127; dst = Q + ((size_t)((b * NH + h) * SEQ + s)) * DQK + d; }
                        else { const int n2 = n - 512, h = n2 >> 6, w = n2 & 63, i0 = w >> 1;
                            const f32x4 c4 = *(const f32x4*)(cs + (size_t)tok * 32 + i0), s4 = *(const f32x4*)(sn + (size_t)tok * 32 + i0);
                            f32x4 a0, a1;
                            a0[0] = v0[0] * c4[0] - v0[1] * s4[0]; a0[1] = v0[1] * c4[0] + v0[0] * s4[0];
                            a0[2] = v0[2] * c4[1] - v0[3] * s4[1]; a0[3] = v0[3] * c4[1] + v0[2] * s4[1];
                            a1[0] = v1[0] * c4[2] - v1[1] * s4[2]; a1[1] = v1[1] * c4[2] + v1[0] * s4[2];
                            a1[2] = v1[2] * c4[3] - v1[3] * s4[3]; a1[3] = v1[3] * c4[3] + v1[2] * s4[3];
                            v0 = a0; v1 = a1; dst = Q + ((size_t)((b * NH + h) * SEQ + s)) * DQK + DNOPE + w; }
                        v0 = v0 * QSCALE; v1 = v1 * QSCALE;
                        u32x4 wv; wv.x = cvtpk(v0[0], v0[1]); wv.y = cvtpk(v0[2], v0[3]); wv.z = cvtpk(v1[0], v1[1]); wv.w = cvtpk(v1[2], v1[3]);
                        *(u32x4*)dst = wv; } }
        } else if (mode == EM_KV) {
            unsigned char* KN = (unsigned char*)p0; unsigned char* VI = (unsigned char*)p1;
#pragma unroll
            for (int ai = 0; ai < 2; ++ai)
#pragma unroll
                for (int m = 0; m < 4; ++m) { const int tok = row0 + ai * 128 + m * 16, b = tok >> 13, s = tok & 8191;
#pragma unroll
                    for (int bj = 0; bj < 2; ++bj) { const f32x4 v0 = acc[ai][bj][m][0], v1 = acc[ai][bj][m][1]; const int n = (col0 + bj * 128) & 511;
                        const int h = n >> 7, d = n & 127;
                        const size_t tbase = ((size_t)((b * NH + h) * (SEQ / 64) + (s >> 6))) * 16384;
                        unsigned char* dst = (u.pn < 2) ? KN + tbase + (d >> 3) * 1024 + (s & 63) * 16 : VI + tbase + v_st(s & 63, d);
                        u32x4 wv; wv.x = cvtpk(v0[0], v0[1]); wv.y = cvtpk(v0[2], v0[3]); wv.z = cvtpk(v1[0], v1[1]); wv.w = cvtpk(v1[2], v1[3]);
                        *(u32x4*)dst = wv; } }
        } else {
            bf16_t* YCAT = (bf16_t*)p0; const bf16_t* Z = (const bf16_t*)p1;
#pragma unroll
            for (int ai = 0; ai < 2; ++ai)
#pragma unroll
                for (int m = 0; m < 4; ++m) { const int tok = row0 + ai * 128 + m * 16;
#pragma unroll
                    for (int bj = 0; bj < 2; ++bj) { const f32x4 v0 = acc[ai][bj][m][0], v1 = acc[ai][bj][m][1]; const int c = col0 + bj * 128;
                        const u32x4 g = *(const u32x4*)(Z + (size_t)tok * DINP + ZC_GC + c);
                        u32x4 wv;
                        wv.x = cvtpk(v0[0] * siluf_(lo_bf(g.x)), v0[1] * siluf_(hi_bf(g.x))); wv.y = cvtpk(v0[2] * siluf_(lo_bf(g.y)), v0[3] * siluf_(hi_bf(g.y)));
                        wv.z = cvtpk(v1[0] * siluf_(lo_bf(g.z)), v1[1] * siluf_(hi_bf(g.z))); wv.w = cvtpk(v1[2] * siluf_(lo_bf(g.w)), v1[3] * siluf_(hi_bf(g.w)));
                        *(u32x4*)(YCAT + (size_t)tok * DM + 512 + c) = wv; } }
        }
    }
};

namespace att {
constexpr int SLOT = 40960, NSLOT = 3, VOFF = 24576, LDS_WS = NSLOT * SLOT;
constexpr float THR = 8.f;
#define SBAR() __builtin_amdgcn_sched_barrier(0)
__device__ __forceinline__ void glds16(const void* gsrc, unsigned lds_dst) { unsigned keep;
    asm volatile("s_mov_b32 %0, m0\n\ts_mov_b32 m0, %2\n\ts_nop 0\n\tglobal_load_lds_dwordx4 %1, off\n\ts_mov_b32 m0, %0" : "=&s"(keep) : "v"(gsrc), "s"(lds_dst) : "memory"); }

__device__ __forceinline__ void pv_tile(f32x16* o, int vb, bf16x8 pa0, bf16x8 pa1, bf16x8 pa2, bf16x8 pa3) {
#define TRRD(dst, off) asm volatile("ds_read_b64_tr_b16 %0, %1 offset:%2" : "=&v"(dst) : "v"(vb), "i"(off) : "memory")
#define PV_D0(d0) do { s16x4 l0, l1, l2, l3, h0, h1, h2, h3; constexpr int b_ = v_rd_off(d0, 0, 0); \
        TRRD(l0, b_); TRRD(h0, b_ + 2048); TRRD(l1, b_ + 4096); TRRD(h1, b_ + 6144); TRRD(l2, b_ + 8192); TRRD(h2, b_ + 10240); TRRD(l3, b_ + 12288); TRRD(h3, b_ + 14336); \
        asm volatile("s_waitcnt lgkmcnt(0)" ::: "memory"); SBAR(); \
        o[d0] = __builtin_amdgcn_mfma_f32_32x32x16_bf16(pa0, (bf16x8){l0[0], l0[1], l0[2], l0[3], h0[0], h0[1], h0[2], h0[3]}, o[d0], 0, 0, 0); \
        o[d0] = __builtin_amdgcn_mfma_f32_32x32x16_bf16(pa1, (bf16x8){l1[0], l1[1], l1[2], l1[3], h1[0], h1[1], h1[2], h1[3]}, o[d0], 0, 0, 0); \
        o[d0] = __builtin_amdgcn_mfma_f32_32x32x16_bf16(pa2, (bf16x8){l2[0], l2[1], l2[2], l2[3], h2[0], h2[1], h2[2], h2[3]}, o[d0], 0, 0, 0); \
        o[d0] = __builtin_amdgcn_mfma_f32_32x32x16_bf16(pa3, (bf16x8){l3[0], l3[1], l3[2], l3[3], h3[0], h3[1], h3[2], h3[3]}, o[d0], 0, 0, 0); } while (0)
    PV_D0(0); PV_D0(1); PV_D0(2); PV_D0(3);
#undef PV_D0
#undef TRRD
}

__device__ __forceinline__ void attn_unit(int b, int h, int qb, const bf16_t* Q, const unsigned char* KN, const unsigned char* KR, const unsigned char* VI,
                                          const bf16_t* Z, bf16_t* YCAT, char* shm, const int tid) {
    const int lane = tid & 63, r32 = lane & 31, hi = lane >> 5; const int wid = __builtin_amdgcn_readfirstlane(tid >> 6);
    const int q0 = qb * 256, NT = 4 * (qb + 1);
    const int bh = b * NH + h;
    const unsigned lds0 = (unsigned)(uintptr_t)shm;
    float* wsf = (float*)(shm + LDS_WS) + wid * 64;
    const unsigned char* knsrc = KN + (size_t)bh * (SEQ / 64) * 16384 + wid * 1024 + lane * 16;
    const unsigned char* krsrc = KR + (size_t)b * (SEQ / 64) * 8192 + wid * 1024 + lane * 16;
    const unsigned char* vsrc = VI + (size_t)bh * (SEQ / 64) * 16384 + wid * 1024 + lane * 16;
#define DMA_TILE(t, slot) do { const unsigned d_ = (unsigned)__builtin_amdgcn_readfirstlane(lds0 + (slot) + wid * 1024); \
        glds16(knsrc + (size_t)(t) * 16384, d_); glds16(knsrc + (size_t)(t) * 16384 + 8192, d_ + 8192); glds16(krsrc + (size_t)(t) * 8192, d_ + 16384); \
        glds16(vsrc + (size_t)(t) * 16384, d_ + VOFF); glds16(vsrc + (size_t)(t) * 16384 + 8192, d_ + VOFF + 8192); } while (0)
    const bf16_t* Qw = Q + ((size_t)(bh * SEQ + q0 + wid * 32 + r32)) * DQK;
    bf16x8 qr[12];
#pragma unroll
    for (int d0 = 0; d0 < 12; ++d0) qr[d0] = *(const bf16x8*)(Qw + d0 * 16 + hi * 8);
#pragma unroll
    for (int d0 = 0; d0 < 12; ++d0) asm volatile("" : "+v"(qr[d0]));
    asm volatile("s_waitcnt vmcnt(0)" ::: "memory");
    DMA_TILE(0, 0); DMA_TILE(1, SLOT);
    float m_run = -1e30f, l_run = 0.f; f32x16 o[4];
#pragma unroll
    for (int d = 0; d < 4; ++d) o[d] = f32x16{};
    const LAS char* shm3 = (const LAS char*)shm;
    const int vb0 = (int)lds0 + VOFF + v_rd_base(lane);
    const int qabs = q0 + wid * 32 + r32;
    int sl_cur = 0, sl_n1 = SLOT, sl_n2 = 2 * SLOT;
    for (int t = 0; t < NT; ++t) {
        if (t + 1 < NT) asm volatile("s_waitcnt vmcnt(5) lgkmcnt(0)\n\ts_barrier" ::: "memory");
        else asm volatile("s_waitcnt vmcnt(0) lgkmcnt(0)\n\ts_barrier" ::: "memory");
        if (t + 2 < NT) DMA_TILE(t + 2, sl_n2);
        f32x16 p0 = f32x16{}, p1 = f32x16{};
        const LAS char* kp = shm3 + sl_cur + hi * 1024 + r32 * 16;
        {
            bf16x8 ka[4], kb[4];
#define KLD(buf, g) do { buf[0] = *(const LAS bf16x8*)(kp + (2 * (g)) * 2048); buf[1] = *(const LAS bf16x8*)(kp + (2 * (g)) * 2048 + 512); \
                         buf[2] = *(const LAS bf16x8*)(kp + (2 * (g) + 1) * 2048); buf[3] = *(const LAS bf16x8*)(kp + (2 * (g) + 1) * 2048 + 512); } while (0)
#define KMM(buf, g) do { p0 = __builtin_amdgcn_mfma_f32_32x32x16_bf16(buf[0], qr[2 * (g)], p0, 0, 0, 0); p1 = __builtin_amdgcn_mfma_f32_32x32x16_bf16(buf[1], qr[2 * (g)], p1, 0, 0, 0); \
                         p0 = __builtin_amdgcn_mfma_f32_32x32x16_bf16(buf[2], qr[2 * (g) + 1], p0, 0, 0, 0); p1 = __builtin_amdgcn_mfma_f32_32x32x16_bf16(buf[3], qr[2 * (g) + 1], p1, 0, 0, 0); } while (0)
            KLD(ka, 0); KLD(kb, 1); SBAR();
            KMM(ka, 0); SBAR(); KLD(ka, 2); SBAR();
            KMM(kb, 1); SBAR(); KLD(kb, 3); SBAR();
            KMM(ka, 2); SBAR(); KLD(ka, 4); SBAR();
            KMM(kb, 3); SBAR(); KLD(kb, 5); SBAR();
            KMM(ka, 4); SBAR();
            KMM(kb, 5); SBAR();
#undef KLD
#undef KMM
        }
        if (t >= NT - 4) {
            const float NEG = -__builtin_inff(); const int kb = 64 * t + 4 * hi;
#pragma unroll
            for (int r = 0; r < 16; ++r) { const int kv = kb + (r & 3) + 8 * (r >> 2); if (kv > qabs) p0[r] = NEG; if (kv + 32 > qabs) p1[r] = NEG; }
        }
        float pmax = p0[0];
#pragma unroll
        for (int r = 1; r < 16; ++r) pmax = fmaxf(pmax, p0[r]);
#pragma unroll
        for (int r = 0; r < 16; ++r) pmax = fmaxf(pmax, p1[r]);
        { auto rr = __builtin_amdgcn_permlane32_swap(__float_as_uint(pmax), __float_as_uint(pmax), false, false);
          pmax = fmaxf(__uint_as_float(rr[0]), __uint_as_float(rr[1])); }
        float alpha = 1.f;
        if (!__all(pmax - m_run <= THR)) {
            const float mn = fmaxf(m_run, pmax); alpha = __builtin_amdgcn_exp2f(m_run - mn); m_run = mn;
            if (hi == 0) wsf[r32] = alpha;
            asm volatile("s_waitcnt lgkmcnt(0)" ::: "memory");
#pragma unroll
            for (int d = 0; d < 4; ++d)
#pragma unroll
                for (int r = 0; r < 16; ++r) o[d][r] *= wsf[crow(r, hi)];
            asm volatile("s_waitcnt lgkmcnt(0)" ::: "memory");
        }
#pragma unroll
        for (int r = 0; r < 16; ++r) { p0[r] = __builtin_amdgcn_exp2f(p0[r] - m_run); p1[r] = __builtin_amdgcn_exp2f(p1[r] - m_run); }
        float ps = 0.f;
#pragma unroll
        for (int r = 0; r < 16; ++r) ps += p0[r];
#pragma unroll
        for (int r = 0; r < 16; ++r) ps += p1[r];
        { auto rr = __builtin_amdgcn_permlane32_swap(__float_as_uint(ps), __float_as_uint(ps), false, false);
          ps = __uint_as_float(rr[0]) + __uint_as_float(rr[1]); }
        l_run = l_run * alpha + ps;
        bf16x8 pa0, pa1, pa2, pa3;
#define PK4(P, B_, OUT) do { unsigned a0 = cvtpk(P[B_ + 0], P[B_ + 1]), a1 = cvtpk(P[B_ + 2], P[B_ + 3]); \
        unsigned b0 = cvtpk(P[B_ + 4], P[B_ + 5]), b1 = cvtpk(P[B_ + 6], P[B_ + 7]); \
        auto r0 = __builtin_amdgcn_permlane32_swap(a0, b0, false, false); auto r1 = __builtin_amdgcn_permlane32_swap(a1, b1, false, false); \
        u32x4 w = {r0[0], r1[0], r0[1], r1[1]}; OUT = *reinterpret_cast<bf16x8*>(&w); } while (0)
        PK4(p0, 0, pa0); PK4(p0, 8, pa1); PK4(p1, 0, pa2); PK4(p1, 8, pa3);
#undef PK4
        SBAR();
        pv_tile(o, vb0 + sl_cur, pa0, pa1, pa2, pa3);
        { const int tmp = sl_cur; sl_cur = sl_n1; sl_n1 = sl_n2; sl_n2 = tmp; }
    }
    if (hi == 0) wsf[32 + r32] = l_run;
    asm volatile("s_waitcnt lgkmcnt(0)" ::: "memory");
    const size_t mrow0 = (size_t)b * SEQ + q0 + wid * 32;
#pragma unroll
    for (int r = 0; r < 16; ++r) { const int orow = crow(r, hi); const float rl = 1.f / wsf[32 + orow]; const size_t m = mrow0 + orow;
#pragma unroll
        for (int d0 = 0; d0 < 4; ++d0) { const int col = h * DV + d0 * 32 + r32;
            const float g = bf2f(Z[m * DINP + ZC_GATT + col]);
            const float v = o[d0][r] * rl * siluf_(g);
            const float vn = xor1_f(v);
            if ((r32 & 1) == 0) *(unsigned*)(YCAT + m * DM + col) = cvtpk(v, vn); } }
    asm volatile("s_waitcnt vmcnt(0) lgkmcnt(0)\n\ts_barrier" ::: "memory");
#undef DMA_TILE
}

__device__ __forceinline__ void attn_unit3(int b, int h, int qb, const bf16_t* Q, const unsigned char* KN, const unsigned char* KR, const unsigned char* VI,
                                           const bf16_t* Z, bf16_t* YCAT, char* shm, const int tid) {
    const int lane = tid & 63, r32 = lane & 31, hi = lane >> 5; const int wid = __builtin_amdgcn_readfirstlane(tid >> 6);
    const int q0 = qb * 256, NT = 4 * (qb + 1);
    const int bh = b * NH + h;
    const unsigned lds0 = (unsigned)(uintptr_t)shm;
    LAS float* wsf = (LAS float*)((LAS char*)shm + LDS_WS) + wid * 64;
    LAS float* wsh = wsf + 4 * hi;
    const unsigned char* knsrc = KN + (size_t)bh * (SEQ / 64) * 16384 + wid * 1024 + lane * 16;
    const unsigned char* krsrc = KR + (size_t)b * (SEQ / 64) * 8192 + wid * 1024 + lane * 16;
    const unsigned char* vsrc = VI + (size_t)bh * (SEQ / 64) * 16384 + wid * 1024 + lane * 16;
#define DMA_TILE(t, slot) do { const unsigned d_ = (unsigned)__builtin_amdgcn_readfirstlane(lds0 + (slot) + wid * 1024); \
        glds16(knsrc + (size_t)(t) * 16384, d_); glds16(knsrc + (size_t)(t) * 16384 + 8192, d_ + 8192); glds16(krsrc + (size_t)(t) * 8192, d_ + 16384); \
        glds16(vsrc + (size_t)(t) * 16384, d_ + VOFF); glds16(vsrc + (size_t)(t) * 16384 + 8192, d_ + VOFF + 8192); } while (0)
    const bf16_t* Qw = Q + ((size_t)(bh * SEQ + q0 + wid * 32 + r32)) * DQK;
    bf16x8 qr[12];
#pragma unroll
    for (int d0 = 0; d0 < 12; ++d0) qr[d0] = *(const bf16x8*)(Qw + d0 * 16 + hi * 8);
#pragma unroll
    for (int d0 = 0; d0 < 12; ++d0) asm volatile("" : "+v"(qr[d0]));
    asm volatile("s_waitcnt vmcnt(0)" ::: "memory");
    DMA_TILE(0, 0);
    float m_run = -1e30f, l_run = 0.f; f32x16 o[4];
#pragma unroll
    for (int d = 0; d < 4; ++d) o[d] = f32x16{};
    const LAS char* shm3 = (const LAS char*)shm;
    const int vb0 = (int)lds0 + VOFF + v_rd_base(lane);
    const int qabs = q0 + wid * 32 + r32;
    f32x16 sA, sB; bf16x8 pa0, pa1; float pmaxN = 0.f;

#define MF(acc, a_, b_) acc = __builtin_amdgcn_mfma_f32_32x32x16_bf16(a_, b_, acc, 0, 0, 0)
#define DMAP(on_, i_, t_, slot_) do { if (on_) { const unsigned d_ = (unsigned)__builtin_amdgcn_readfirstlane(lds0 + (slot_) + wid * 1024); \
        if ((i_) == 0) glds16(knsrc + (size_t)(t_) * 16384, d_); else if ((i_) == 1) glds16(knsrc + (size_t)(t_) * 16384 + 8192, d_ + 8192); \
        else if ((i_) == 2) glds16(krsrc + (size_t)(t_) * 8192, d_ + 16384); else if ((i_) == 3) glds16(vsrc + (size_t)(t_) * 16384, d_ + VOFF); \
        else glds16(vsrc + (size_t)(t_) * 16384 + 8192, d_ + VOFF + 8192); } } while (0)
#ifndef ATT_EXP
#define ATT_EXP 0
#endif
#if ATT_EXP & 1
#define KLD1(dst, kp_, d0) do { dst = *(const LAS bf16x8*)(kp_ + (d0) * 2048); bf16x8 dmy_; asm volatile("ds_read_b128 %0, %1 offset:%2" : "=v"(dmy_) : "v"((int)(uintptr_t)(kp_)), "i"(((d0) * 2048) & 0xffff) : "memory"); asm volatile("" :: "v"(dmy_)); } while (0)
#else
#define KLD1(dst, kp_, d0) dst = *(const LAS bf16x8*)(kp_ + (d0) * 2048)
#endif
#define MASKH(S, T_, hf_) do { if ((T_) >= NT - 4) { const float NEG = -__builtin_inff(); const int kb_ = 64 * (T_) + 32 * (hf_) + 4 * hi; \
        _Pragma("unroll") for (int r = 0; r < 16; ++r) { const int kv = kb_ + (r & 3) + 8 * (r >> 2); if (kv > qabs) S[r] = NEG; } } } while (0)
#define ROWMAX_FIN(mx0, mx1, out) do { float m_ = fmaxf(mx0, mx1); auto rr_ = __builtin_amdgcn_permlane32_swap(__float_as_uint(m_), __float_as_uint(m_), false, false); \
        out = fmaxf(__uint_as_float(rr_[0]), __uint_as_float(rr_[1])); } while (0)
#define DECIDE(pmax_) do { if (!__all((pmax_) - m_run <= THR)) { const float mn_ = fmaxf(m_run, (pmax_)); const float al_ = __builtin_amdgcn_exp2f(m_run - mn_); m_run = mn_; l_run *= al_; \
        if (hi == 0) wsf[r32] = al_; asm volatile("s_waitcnt lgkmcnt(0)" ::: "memory"); \
        _Pragma("unroll") for (int d_ = 0; d_ < 4; ++d_) _Pragma("unroll") for (int r = 0; r < 16; ++r) o[d_][r] *= wsh[(r & 3) + 8 * (r >> 2)]; \
        asm volatile("s_waitcnt lgkmcnt(0)" ::: "memory"); } } while (0)
#define PK4(P, B_, OUT) do { unsigned a0_ = cvtpk(P[B_ + 0], P[B_ + 1]), a1_ = cvtpk(P[B_ + 2], P[B_ + 3]); \
        unsigned b0_ = cvtpk(P[B_ + 4], P[B_ + 5]), b1_ = cvtpk(P[B_ + 6], P[B_ + 7]); \
        auto r0_ = __builtin_amdgcn_permlane32_swap(a0_, b0_, false, false); auto r1_ = __builtin_amdgcn_permlane32_swap(a1_, b1_, false, false); \
        u32x4 w_ = {r0_[0], r1_[0], r0_[1], r1_[1]}; OUT = *reinterpret_cast<bf16x8*>(&w_); } while (0)
#if ATT_EXP & 2
#define SMC2(S, i) do { const float e0_ = __builtin_amdgcn_exp2f(S[i] - m_run), e1_ = __builtin_amdgcn_exp2f(S[(i) + 1] - m_run); \
        float x0_ = __builtin_amdgcn_exp2f(S[i] - l_run), x1_ = __builtin_amdgcn_exp2f(S[(i) + 1] - l_run); x0_ += x1_; asm volatile("" :: "v"(x0_)); \
        S[i] = e0_; S[(i) + 1] = e1_; ps0 += e0_; ps1 += e1_; } while (0)
#else
#define SMC2(S, i) do { const float e0_ = __builtin_amdgcn_exp2f(S[i] - m_run), e1_ = __builtin_amdgcn_exp2f(S[(i) + 1] - m_run); S[i] = e0_; S[(i) + 1] = e1_; ps0 += e0_; ps1 += e1_; } while (0)
#endif
#define SMFIN() do { float ps_ = ps0 + ps1; auto rr_ = __builtin_amdgcn_permlane32_swap(__float_as_uint(ps_), __float_as_uint(ps_), false, false); \
        l_run += __uint_as_float(rr_[0]) + __uint_as_float(rr_[1]); } while (0)
#define TRRD(dst, off) asm volatile("ds_read_b64_tr_b16 %0, %1 offset:%2" : "=&v"(dst) : "v"(vb_), "i"(off) : "memory")
#define TRRD4(P_, d0, hf_) do { constexpr int b_ = v_rd_off(d0, 2 * (hf_), 0); TRRD(P_##l0, b_); TRRD(P_##h0, b_ + 2048); TRRD(P_##l1, b_ + 4096); TRRD(P_##h1, b_ + 6144); } while (0)
#define VF(P_, k) (bf16x8){P_##l##k[0], P_##l##k[1], P_##l##k[2], P_##l##k[3], P_##h##k[0], P_##h##k[1], P_##h##k[2], P_##h##k[3]}
#define LGK(n) asm volatile("s_waitcnt lgkmcnt(" #n ")" ::: "memory")
#define RMC2(S, j) do { mx0 = __builtin_fmaxf(__builtin_fmaxf(mx0, S[j]), S[(j) + 1]); } while (0)
#define RMC4(S, j) do { RMC2(S, j); RMC2(S, (j) + 2); } while (0)

#define HSTEP(SX, SY, T_, HF, TN, HFN, has_next_, dma_on_) do { \
        float ps0 = 0.f, ps1 = 0.f; \
        if (has_next_) { \
            const LAS char* kp_ = shm3 + ((HFN) == 0 ? sl_n1 : sl_cur) + hi * 1024 + r32 * 16 + (HFN) * 512; bf16x8 k0, k1, k2, k3; \
            SY = f32x16{}; \
            KLD1(k0, kp_, 0); KLD1(k1, kp_, 1); KLD1(k2, kp_, 2); KLD1(k3, kp_, 3); SBAR(); \
            MF(SY, k0, qr[0]); SMC2(SX, 0); SBAR(); KLD1(k0, kp_, 4); DMAP(dma_on_, 0, (T_) + 2, sl_n2); SBAR(); \
            MF(SY, k1, qr[1]); SMC2(SX, 2); SBAR(); KLD1(k1, kp_, 5); DMAP(dma_on_, 1, (T_) + 2, sl_n2); SBAR(); \
            MF(SY, k2, qr[2]); SMC2(SX, 4); SBAR(); KLD1(k2, kp_, 6); DMAP(dma_on_, 2, (T_) + 2, sl_n2); SBAR(); \
            MF(SY, k3, qr[3]); SMC2(SX, 6); SBAR(); KLD1(k3, kp_, 7); DMAP(dma_on_, 3, (T_) + 2, sl_n2); SBAR(); \
            MF(SY, k0, qr[4]); SMC2(SX, 8); SBAR(); KLD1(k0, kp_, 8); DMAP(dma_on_, 4, (T_) + 2, sl_n2); SBAR(); \
            MF(SY, k1, qr[5]); SMC2(SX, 10); SBAR(); KLD1(k1, kp_, 9); SBAR(); \
            MF(SY, k2, qr[6]); SMC2(SX, 12); SBAR(); KLD1(k2, kp_, 10); SBAR(); \
            MF(SY, k3, qr[7]); SMC2(SX, 14); SBAR(); KLD1(k3, kp_, 11); SBAR(); \
            MF(SY, k0, qr[8]); PK4(SX, 0, pa0); SBAR(); \
            MF(SY, k1, qr[9]); PK4(SX, 8, pa1); SBAR(); \
            MF(SY, k2, qr[10]); SMFIN(); SBAR(); \
            MF(SY, k3, qr[11]); SBAR(); \
        } else { \
            _Pragma("unroll") for (int i_ = 0; i_ < 16; i_ += 2) SMC2(SX, i_); \
            PK4(SX, 0, pa0); PK4(SX, 8, pa1); SMFIN(); SBAR(); \
        } \
        { const int vb_ = vb0 + sl_cur; s16x4 Al0, Al1, Ah0, Ah1, Bl0, Bl1, Bh0, Bh1, Cl0, Cl1, Ch0, Ch1; \
          float mx0 = -__builtin_inff(); \
          TRRD4(A, 0, HF); TRRD4(B, 1, HF); TRRD4(C, 2, HF); SBAR(); \
          if (has_next_) MASKH(SY, TN, HFN); \
          SBAR(); LGK(8); SBAR(); \
          MF(o[0], pa0, VF(A, 0)); if (has_next_) { RMC4(SY, 0); } SBAR(); MF(o[0], pa1, VF(A, 1)); if (has_next_) { RMC4(SY, 4); } SBAR(); \
          TRRD4(A, 3, HF); LGK(8); SBAR(); \
          MF(o[1], pa0, VF(B, 0)); if (has_next_) { RMC4(SY, 8); } SBAR(); MF(o[1], pa1, VF(B, 1)); if (has_next_) { RMC4(SY, 12); } SBAR(); \
          LGK(4); SBAR(); \
          MF(o[2], pa0, VF(C, 0)); MF(o[2], pa1, VF(C, 1)); SBAR(); \
          LGK(0); SBAR(); \
          MF(o[3], pa0, VF(A, 0)); MF(o[3], pa1, VF(A, 1)); SBAR(); \
          const float mx1 = mx0; \
          if (has_next_) { ROWMAX_FIN(mx0, mx1, pmaxN); DECIDE(pmaxN); } } \
    } while (0)

    int sl_cur = 0, sl_n1 = SLOT, sl_n2 = 2 * SLOT;
    asm volatile("s_waitcnt vmcnt(0) lgkmcnt(0)\n\ts_barrier" ::: "memory");
    DMA_TILE(1, SLOT);
    { const LAS char* kp_ = shm3 + hi * 1024 + r32 * 16; bf16x8 ka, kb;
      sA = f32x16{};
      KLD1(ka, kp_, 0); KLD1(kb, kp_, 1); SBAR();
#pragma unroll
      for (int d2 = 0; d2 < 12; d2 += 2) {
          MF(sA, ka, qr[d2]); SBAR(); if (d2 + 2 < 12) KLD1(ka, kp_, d2 + 2); SBAR();
          MF(sA, kb, qr[d2 + 1]); SBAR(); if (d2 + 3 < 12) KLD1(kb, kp_, d2 + 3); SBAR(); } }
    MASKH(sA, 0, 0);
    { float mx0 = -__builtin_inff();
#pragma unroll
      for (int j = 0; j < 16; j += 2) RMC2(sA, j);
      ROWMAX_FIN(mx0, mx0, pmaxN); DECIDE(pmaxN); }
    for (int T = 0; T < NT; ++T) {
        HSTEP(sA, sB, T, 0, T, 1, true, false);
        const bool more = T + 1 < NT;
        if (more) {
            asm volatile("s_waitcnt vmcnt(0) lgkmcnt(0)\n\ts_barrier" ::: "memory");
        }
        HSTEP(sB, sA, T, 1, T + 1, 0, more, (T + 2 < NT));
        { const int tmp_ = sl_cur; sl_cur = sl_n1; sl_n1 = sl_n2; sl_n2 = tmp_; }
    }
    if (hi == 0) wsf[32 + r32] = l_run;
    asm volatile("s_waitcnt lgkmcnt(0)" ::: "memory");
    { int r32e = r32, hie = hi; asm volatile("" : "+v"(r32e), "+v"(hie));
      const LAS float* wse = wsf + 32 + 4 * hie;
      const size_t mrow0 = (size_t)b * SEQ + q0 + wid * 32 + 4 * hie;
      const bf16_t* zp = Z + mrow0 * DINP + ZC_GATT + h * DV + r32e; bf16_t* yp = YCAT + mrow0 * DM + h * DV + r32e;
#pragma unroll
      for (int r = 0; r < 16; ++r) { const int cr = (r & 3) + 8 * (r >> 2); const float rl = __builtin_amdgcn_rcpf(wse[cr]);
#pragma unroll
          for (int d0 = 0; d0 < 4; ++d0) {
              const float g = bf2f(zp[(size_t)cr * DINP + d0 * 32]);
              const float v = o[d0][r] * rl * siluf_(g);
              const float vn = xor1_f(v);
              if ((r32e & 1) == 0) *(unsigned*)(yp + (size_t)cr * DM + d0 * 32) = cvtpk(v, vn); } } }
    asm volatile("s_waitcnt vmcnt(0) lgkmcnt(0)\n\ts_barrier" ::: "memory");
#undef DMA_TILE
#undef DMAP
#undef MF
#undef KLD1
#undef MASKH
#undef ROWMAX_FIN
#undef DECIDE
#undef PK4
#undef SMC2
#undef SMFIN
#undef TRRD
#undef TRRD4
#undef VF
#undef LGK
#undef RMC2
#undef RMC4
#undef HSTEP
}
#undef SBAR
}

#define XB_TMO      128
#define XB_XCNT(j)  (256  + 64 * (j))
#define XB_XSUB(j)  (1280 + 64 * (j))
#define XB_XGEN(j)  (2304 + 64 * (j))
#define XB_TOP      3328
#define XB_TOPGEN   3392
#define XCD_BAR_WORDS 3456
#define XB_SPIN_CAP (1u << 18)
__device__ __forceinline__ unsigned xb_ld(unsigned* p)              { return __hip_atomic_load(p, __ATOMIC_RELAXED, __HIP_MEMORY_SCOPE_AGENT); }
__device__ __forceinline__ unsigned xb_add(unsigned* p, unsigned v) { return __hip_atomic_fetch_add(p, v, __ATOMIC_RELAXED, __HIP_MEMORY_SCOPE_AGENT); }
__device__ __forceinline__ unsigned xb_xcc_id() { return (unsigned)__builtin_amdgcn_s_getreg((3 << 11) | 20) & 0xFu; }
#define XB_SPIN(cond, bar) do { unsigned _sp = 0; while (cond) { __builtin_amdgcn_s_sleep(1); \
    if ((++_sp & 255u) == 0u) { if (xb_ld(&(bar)[XB_TMO])) break; if (_sp > XB_SPIN_CAP) { atomicAdd(&(bar)[XB_TMO], 1u); break; } } } } while (0)
struct XcdBarrier { unsigned* bar; unsigned x; volatile LAS unsigned* st; };
__device__ __forceinline__ XcdBarrier xcd_barrier_post(unsigned* bar, volatile LAS unsigned* st) {
    XcdBarrier b; b.bar = bar; b.x = xb_xcc_id(); b.st = st;
    if (threadIdx.x == 0) (void)xb_add(&bar[XB_XCNT(b.x)], 1u);
    return b;
}
__device__ __forceinline__ void xcd_barrier_complete(unsigned* bar, unsigned x, unsigned& nloc, unsigned& nx) {
    const unsigned G = gridDim.x * gridDim.y * gridDim.z;
    unsigned sum, cnt, mine, sp = 0u;
    for (;;) {
        sum = 0u; cnt = 0u; mine = 0u;
#pragma unroll
        for (unsigned j = 0; j < 16; ++j) { const unsigned c = xb_ld(&bar[XB_XCNT(j)]); sum += c; cnt += (c > 0u) ? 1u : 0u; mine = (j == x) ? c : mine; }
        if (sum == G) break;
        __builtin_amdgcn_s_sleep(1);
        if ((++sp & 255u) == 0u) { if (xb_ld(&bar[XB_TMO])) break; if (sp > XB_SPIN_CAP) { atomicAdd(&bar[XB_TMO], 1u); break; } }
    }
    nloc = mine > 0u ? mine : 1u; nx = cnt > 0u ? cnt : 1u;
}
__device__ __forceinline__ void xcd_barrier(const XcdBarrier& b) {
    asm volatile("s_waitcnt vmcnt(0)" ::: "memory");
    __syncthreads();
    if (threadIdx.x == 0) {
        unsigned* bar = b.bar;
        __builtin_amdgcn_s_waitcnt(0);
        unsigned nloc = b.st[0], nx = b.st[1];
        if (nloc == 0u) { xcd_barrier_complete(bar, b.x, nloc, nx); b.st[0] = nloc; b.st[1] = nx; }
        const unsigned old = xb_add(&bar[XB_XSUB(b.x)], 1u);
        const unsigned gen = old / nloc;
        if (old + 1u == (gen + 1u) * nloc) {
            __builtin_amdgcn_fence(__ATOMIC_RELEASE, "agent");
            asm volatile("s_waitcnt vmcnt(0)" ::: "memory");
            const unsigned og = xb_add(&bar[XB_TOP], 1u);
            const unsigned tg = og / nx;
            if (og + 1u == (tg + 1u) * nx) xb_add(&bar[XB_TOPGEN], 1u);
            else XB_SPIN(xb_ld(&bar[XB_TOPGEN]) == tg, bar);
            __builtin_amdgcn_fence(__ATOMIC_ACQUIRE, "agent");
            xb_add(&bar[XB_XGEN(b.x)], 1u);
            asm volatile("s_waitcnt vmcnt(0)" ::: "memory");
        } else {
            XB_SPIN(xb_ld(&bar[XB_XGEN(b.x)]) == gen, bar);
            __builtin_amdgcn_fence(__ATOMIC_ACQUIRE, "agent");
            asm volatile("s_waitcnt vmcnt(0)" ::: "memory");
        }
    }
    __syncthreads();
}

__device__ __forceinline__ float ada_val(const float* adap, const float* bada_l, int l, int b, int e) {
    float s = 0.f;
#pragma unroll
    for (int kc = 0; kc < 16; ++kc) s += adap[((size_t)(kc * 2 + l) * 4 + b) * 3072 + e];
    return s + bada_l[e];
}
struct Args { const void* in[22]; float* out; unsigned char* ws; int ph_lo, ph_hi; };
enum { I_X = 0, I_C, I_POS, I_WADA, I_BADA, I_GPRE, I_GPOST, I_WIN, I_QNG, I_WUQ, I_KVNG, I_WUKV, I_CONVW, I_CONVB, I_CLNG, I_CLNB, I_WPW2, I_SLNG, I_SLNB, I_WS, I_BS, I_WOUT };
constexpr int N_PHASES = 2 + 6 * NLAYER;

__device__ __forceinline__ int wmap(int mat, int n) {
    if (mat == 0) return n < 448 ? n : (n < 512 ? -1 : n - 64);
    if (mat == 2) { if (n < 512) return (n >> 7) * DQK + (n & 127); const int n2 = n - 512, h = n2 >> 6, w = n2 & 63; return h * DQK + DNOPE + 32 * (w & 1) + (w >> 1); }
    if (mat == 3) { const int h = (n & 511) >> 7, d = n & 127; return h * 256 + (n >= 512 ? 128 : 0) + d; }
    return n;
}
__device__ __forceinline__ void transpose_item(const float* W, int Nsrc, bf16_t* WT, int Kd, int mat, LAS float* scr, int kb, int nb, int lane) {
    const int k0 = 64 * kb, n0 = 32 * nb; const int src = wmap(mat, n0 + (lane & 31));
#pragma unroll 8
    for (int i = 0; i < 32; ++i) { const int kk = 2 * i + (lane >> 5); scr[kk * 33 + (lane & 31)] = src >= 0 ? W[(size_t)(k0 + kk) * Nsrc + src] : 0.f; }
    asm volatile("s_waitcnt lgkmcnt(0)" ::: "memory");
    const int c = lane & 7;
#pragma unroll
    for (int j = 0; j < 4; ++j) { const int n = (lane >> 3) + 8 * j; const LAS float* s = scr + (8 * c) * 33 + n;
        u32x4 o; o.x = cvtpk(s[0 * 33], s[1 * 33]); o.y = cvtpk(s[2 * 33], s[3 * 33]); o.z = cvtpk(s[4 * 33], s[5 * 33]); o.w = cvtpk(s[6 * 33], s[7 * 33]);
        *(u32x4*)(WT + (size_t)(n0 + n) * Kd + k0 + 8 * c) = o; }
    asm volatile("s_waitcnt lgkmcnt(0)" ::: "memory");
}

__global__ void __launch_bounds__(NTHREADS, 2) hymba_fwd(Args args) {
    extern __shared__ __attribute__((aligned(16))) unsigned char lds[];
    typedef const __attribute__((address_space(4))) Args* KArgP;
    cg::grid_group grid = cg::this_grid();
    const int ph_lo = args.ph_lo, ph_hi = args.ph_hi;
    const int wave_s = __builtin_amdgcn_readfirstlane(threadIdx.x >> 6);
    volatile LAS unsigned* xbst = (volatile LAS unsigned*)((LAS unsigned char*)lds + LDS_BYTES - 64);
    if (threadIdx.x < 4) xbst[threadIdx.x] = 0u;
    __syncthreads();
    const XcdBarrier xbar = xcd_barrier_post((unsigned*)(args.ws + WS_CTL) + CTL_BARW, xbst);

    int ph = ph_lo, rep = 0;
    while (ph < ph_hi) {
        KArgP ap0 = (KArgP)__builtin_amdgcn_kernarg_segment_ptr();
#define ARG(k) (ap->in[k])
#define TID_HERE() int lane; asm volatile("v_mbcnt_lo_u32_b32 %0, -1, 0\n\tv_mbcnt_hi_u32_b32 %0, -1, %0" : "=v"(lane)); const int tid = wave_s * 64 + lane; (void)tid
        const int wave = wave_s;
#define PHASE_ROOTS() \
        KArgP ap = ap0; asm volatile("" : "+s"(ap)); \
        int G = gridDim.x, bx = blockIdx.x; asm volatile("" : "+s"(G), "+s"(bx)); \
        const int vcu = (G % 8 == 0) ? (bx % 8) * (G / 8) + bx / 8 : bx; \
        const int gw = vcu * NWAVES + wave, NGW = G * NWAVES; (void)gw; (void)NGW; \
        unsigned char* ws = ap->ws; float* outp = ap->out; (void)outp; \
        const float* x_in = (const float*)ARG(I_X); (void)x_in; \
        float* adap = (float*)(ws + WS_ADAP); (void)adap; float* mod = (float*)(ws + WS_CTL + CTL_MOD); (void)mod; \
        float* cs_t = (float*)(ws + WS_COS); float* sn_t = (float*)(ws + WS_SIN); (void)cs_t; (void)sn_t; \
        bf16_t* Hb = (bf16_t*)(ws + WS_H); bf16_t* Zb = (bf16_t*)(ws + WS_Z); bf16_t* Y16 = (bf16_t*)(ws + WS_Y); (void)Hb; (void)Zb; (void)Y16; \
        bf16_t* QLN = (bf16_t*)(ws + WS_QLN); bf16_t* KVLN = (bf16_t*)(ws + WS_KVLN); bf16_t* CONVH = (bf16_t*)(ws + WS_CONVH); bf16_t* SGVT = (bf16_t*)(ws + WS_SGVT); (void)QLN; (void)KVLN; (void)CONVH; (void)SGVT; \
        bf16_t* Qb = (bf16_t*)(ws + WS_Q); unsigned char* KNb = ws + WS_KN; unsigned char* KRb = ws + WS_KR; unsigned char* VIb = ws + WS_V; (void)Qb; (void)KNb; (void)KRb; (void)VIb; \
        bf16_t* YCAT = (bf16_t*)(ws + WS_YCAT); (void)YCAT
        if (ph == 0 && PHEN(0)) {
            TID_HERE(); PHASE_ROOTS();
            LAS float* scr = (LAS float*)(lds + wave * 16384);
            {
                constexpr int I0 = 16 * 80, I1 = 16 * 32, I2 = 4 * 24, I3 = 2 * 32, I4 = 4 * 8, IL = I0 + I1 + I2 + I3 + I4;
                for (int it = gw; it < NLAYER * IL; it += NGW) {
                    const int l = it / IL; int r = it % IL;
                    if (r < I0) { transpose_item((const float*)ARG(I_WIN) + (size_t)l * DM * DIN, DIN, (bf16_t*)(ws + WS_WIN) + (size_t)l * DINP * DM, DM, 0, scr, r / 80, r % 80, lane); continue; } r -= I0;
                    if (r < I1) { transpose_item((const float*)ARG(I_WOUT) + (size_t)l * DM * DM, DM, (bf16_t*)(ws + WS_WOUT) + (size_t)l * DM * DM, DM, 1, scr, r / 32, r % 32, lane); continue; } r -= I1;
                    if (r < I2) { transpose_item((const float*)ARG(I_WUQ) + (size_t)l * QLR * 768, 768, (bf16_t*)(ws + WS_WUQ) + (size_t)l * 768 * 256, 256, 2, scr, r / 24, r % 24, lane); continue; } r -= I2;
                    if (r < I3) { transpose_item((const float*)ARG(I_WUKV) + (size_t)l * KVLR * 1024, 1024, (bf16_t*)(ws + WS_WUKV) + (size_t)l * 1024 * 256, 256, 3, scr, r / 32, r % 32, lane); continue; } r -= I3;
                    transpose_item((const float*)ARG(I_WPW2) + (size_t)l * CW * CW, CW, (bf16_t*)(ws + WS_WPW2) + (size_t)l * CW * CW, CW, 4, scr, r / 8, r % 8, lane);
                }
            }
            const int gt = vcu * NTHREADS + tid, NGT = G * NTHREADS;
            for (int i = gt; i < NLAYER * 1024 * 16; i += NGT) { const int row = i >> 4, c8 = (i & 15) * 8;
                *(u32x4*)((bf16_t*)(ws + WS_WUKV) + (size_t)row * 256 + 128 + c8) = (u32x4){0u, 0u, 0u, 0u}; }
            for (int i = gt; i < NLAYER * SG * SCH * SCH; i += NGT) { const int s = i & 127, t = (i >> 7) & 127;
                const float v = s <= t ? ((const float*)ARG(I_WS))[i] : 0.f; ((bf16_t*)(ws + WS_WSM))[i] = (bf16_t)(cvtpk(v, 0.f) & 0xffffu); }
            for (int i = gt; i < MTOK * 32; i += NGT) { const int tok = i >> 5, fi = i & 31;
                const float inv_freq = powf(10000.0f, -(float)(2 * fi) / 64.0f);
                const float ang = (float)((const int*)ARG(I_POS))[tok] * inv_freq;
                cs_t[i] = cosf(ang); sn_t[i] = sinf(ang); }
            for (int it = gw; it < NLAYER * 16 * 48; it += NGW) { const int l = it / 768, r = it % 768, kc = r / 48, nc = r % 48;
                const float* W = (const float*)ARG(I_WADA) + (size_t)l * DM * 3072 + (size_t)(kc * 64) * 3072 + nc * 64 + lane;
                const float* c = (const float*)ARG(I_C) + kc * 64;
                float a0 = 0.f, a1 = 0.f, a2 = 0.f, a3 = 0.f;
#pragma unroll 8
                for (int k = 0; k < 64; ++k) { const float w = W[(size_t)k * 3072];
                    a0 += siluf_(c[k]) * w; a1 += siluf_(c[DM + k]) * w; a2 += siluf_(c[2 * DM + k]) * w; a3 += siluf_(c[3 * DM + k]) * w; }
                float* dst = adap + ((size_t)(kc * 2 + l) * 4) * 3072 + nc * 64 + lane;
                __hip_atomic_store(dst, a0, __ATOMIC_RELAXED, __HIP_MEMORY_SCOPE_AGENT); __hip_atomic_store(dst + 3072, a1, __ATOMIC_RELAXED, __HIP_MEMORY_SCOPE_AGENT);
                __hip_atomic_store(dst + 2 * 3072, a2, __ATOMIC_RELAXED, __HIP_MEMORY_SCOPE_AGENT); __hip_atomic_store(dst + 3 * 3072, a3, __ATOMIC_RELAXED, __HIP_MEMORY_SCOPE_AGENT);
                asm volatile("s_waitcnt vmcnt(0)" ::: "memory");
                unsigned tk = 0;
                if (lane == 0) tk = __hip_atomic_fetch_add((unsigned*)(ws + WS_CTL) + CTL_ADACNT + (l * 48 + nc) * 16, 1u, __ATOMIC_RELAXED, __HIP_MEMORY_SCOPE_AGENT);
                tk = (unsigned)__builtin_amdgcn_readfirstlane((int)tk);
                if (tk == 15u) {
                    const float* bada = (const float*)ARG(I_BADA) + (size_t)l * 3072;
#pragma unroll
                    for (int b = 0; b < 4; ++b) { float s = 0.f;
#pragma unroll
                        for (int k2 = 0; k2 < 16; ++k2) s += __hip_atomic_load(adap + ((size_t)(k2 * 2 + l) * 4 + b) * 3072 + nc * 64 + lane, __ATOMIC_RELAXED, __HIP_MEMORY_SCOPE_AGENT);
                        mod[((size_t)l * 4 + b) * 3072 + nc * 64 + lane] = s + bada[nc * 64 + lane]; }
                } }
        } else if (ph == 1 && PHEN(1)) {
            TID_HERE(); PHASE_ROOTS();
            const float* gp = (const float*)ARG(I_GPRE);
            for (int grp = gw; grp < MTOK / 4; grp += NGW) { const int m0 = grp * 4, b = m0 >> 13;
                f32x4 v[4][4];
#pragma unroll
                for (int k = 0; k < 4; ++k) { const f32x4* xr = (const f32x4*)(x_in + (size_t)(m0 + k) * DM) + lane;
#pragma unroll
                    for (int j = 0; j < 4; ++j) v[k][j] = xr[64 * j]; }
                f32x4 pa[4], pb[4];
#pragma unroll
                for (int j = 0; j < 4; ++j) { const int c = 4 * lane + 256 * j;
                    pb[j] = *(const f32x4*)(mod + (size_t)b * 3072 + c);
                    pa[j] = *(const f32x4*)(gp + c) * (*(const f32x4*)(mod + (size_t)b * 3072 + DM + c) + 1.f); }
#pragma unroll
                for (int k = 0; k < 4; ++k) { float ss = 0.f;
#pragma unroll
                    for (int j = 0; j < 4; ++j) ss += (v[k][j].x * v[k][j].x + v[k][j].y * v[k][j].y) + (v[k][j].z * v[k][j].z + v[k][j].w * v[k][j].w);
                    const float rstd = rsqrtf(wave_sum(ss) * (1.f / DM) + EPS);
                    u32x2* o8 = (u32x2*)(Hb + (size_t)(m0 + k) * DM) + lane;
#pragma unroll
                    for (int j = 0; j < 4; ++j) { const f32x4 hv = (v[k][j] * rstd) * pa[j] + pb[j];
                        u32x2 w; w.x = cvtpk(hv.x, hv.y); w.y = cvtpk(hv.z, hv.w); o8[64 * j] = w; } }
            }
        } else {
            const int l = (ph - 2) / 6, sub = (ph - 2) % 6;
            const int ngemm = (sub == 0 || sub == 4) ? 1 : (sub == 2 ? 3 : 0);
#pragma nounroll
            for (int gi_ = 0; gi_ < ngemm * (1 + ((PROBE_MASK >> 8) & 1)) && PHEN(2); ++gi_) {
                const int gi = gi_ % ngemm;
                TID_HERE(); PHASE_ROOTS();
                pg8::Gemm g; EpiAll E; int Nn, cc = bx;
                if (sub == 0) { g = pg8::Gemm{Hb, (const bf16_t*)(ws + WS_WIN) + (size_t)l * DINP * DM, MTOK, DINP, DM, DM, DM}; Nn = DINP; E = EpiAll{EM_Z, DINP, Zb, nullptr, nullptr}; }
                else if (sub == 4) { g = pg8::Gemm{YCAT, (const bf16_t*)(ws + WS_WOUT) + (size_t)l * DM * DM, MTOK, DM, DM, DM, DM}; Nn = DM; E = EpiAll{EM_Z, DM, Y16, nullptr, nullptr}; }
                else if (gi == 0) { g = pg8::Gemm{QLN, (const bf16_t*)(ws + WS_WUQ) + (size_t)l * 768 * 256, MTOK, 768, 256, 256, 256}; Nn = 768; E = EpiAll{EM_Q, 0, Qb, cs_t, sn_t}; }
                else if (gi == 1) { g = pg8::Gemm{CONVH, (const bf16_t*)(ws + WS_WPW2) + (size_t)l * CW * CW, MTOK, CW, CW, CW, CW}; Nn = CW; cc = (bx + G / 2) % G; E = EpiAll{EM_PW2, 0, YCAT, Zb, nullptr}; }
                else { g = pg8::Gemm{KVLN, (const bf16_t*)(ws + WS_WUKV) + (size_t)l * 1024 * 256, MTOK, 1024, 256, 256, 256}; Nn = 1024; E = EpiAll{EM_KV, 0, KNb, VIb, nullptr}; }
                pg8::StaticOrder S; S.init(MTOK, Nn, G, cc);
                pg8::gemm_phase<EpiAll>((LAS unsigned char*)lds, g, S, E, tid);
            }
            if (sub == 0) {
            } else if (sub == 1 && PHEN(3)) {
                TID_HERE(); PHASE_ROOTS();
                const float* qng = (const float*)ARG(I_QNG) + l * QLR; const float* kvng = (const float*)ARG(I_KVNG) + l * KVLR;
                const float* cw = (const float*)ARG(I_CONVW) + (size_t)l * CK * CW; const float* cb = (const float*)ARG(I_CONVB) + l * CW;
                const float* clg = (const float*)ARG(I_CLNG) + l * CW; const float* clb = (const float*)ARG(I_CLNB) + l * CW;
                const float* slg = (const float*)ARG(I_SLNG) + l * SW; const float* slb = (const float*)ARG(I_SLNB) + l * SW;
                LAS float* glu = (LAS float*)lds;
                LAS float* cvo = (LAS float*)(lds + 63488);
                LAS bf16_t* sgv = (LAS bf16_t*)(lds + 63488 + 32768);
                for (int tt = vcu; tt < MTOK / 32; tt += G) {
                    const int b = tt >> 8, s0 = (tt & 255) * 32; const size_t m0 = (size_t)b * SEQ + s0;
#pragma unroll
                    for (int pass = 0; pass < 4; ++pass) { const int r = pass * 16 + (tid >> 5), c8 = (tid & 31) * 8;
                        if (r < 62) { const int s = s0 - 30 + r; f32x4 g0 = {0.f, 0.f, 0.f, 0.f}, g1 = {0.f, 0.f, 0.f, 0.f};
                            if (s >= 0) { const bf16_t* zr = Zb + ((size_t)b * SEQ + s) * DINP;
                                const u32x4 a = *(const u32x4*)(zr + ZC_CA + c8), g = *(const u32x4*)(zr + ZC_CB + c8);
                                g0[0] = lo_bf(a.x) * sigmoidf_(lo_bf(g.x)); g0[1] = hi_bf(a.x) * sigmoidf_(hi_bf(g.x)); g0[2] = lo_bf(a.y) * sigmoidf_(lo_bf(g.y)); g0[3] = hi_bf(a.y) * sigmoidf_(hi_bf(g.y));
                                g1[0] = lo_bf(a.z) * sigmoidf_(lo_bf(g.z)); g1[1] = hi_bf(a.z) * sigmoidf_(hi_bf(g.z)); g1[2] = lo_bf(a.w) * sigmoidf_(lo_bf(g.w)); g1[3] = hi_bf(a.w) * sigmoidf_(hi_bf(g.w)); }
                            *(LAS f32x4*)(glu + r * 256 + c8) = g0; *(LAS f32x4*)(glu + r * 256 + c8 + 4) = g1; } }
                    for (int i = 0; i < 4; ++i) { const int tl = 4 * wave + i; const size_t m = m0 + tl; const int s = s0 + tl; const bf16_t* zr = Zb + m * DINP;
                        {
                            const u32x2 z = *(const u32x2*)(zr + ZC_Q + 4 * lane); const float x0 = lo_bf(z.x), x1 = hi_bf(z.x), x2 = lo_bf(z.y), x3 = hi_bf(z.y);
                            const float rstd = rsqrtf(wave_sum((x0 * x0 + x1 * x1) + (x2 * x2 + x3 * x3)) * (1.f / QLR) + EPS);
                            const f32x4 g = *(const f32x4*)(qng + 4 * lane);
                            u32x2 w; w.x = cvtpk(x0 * rstd * g.x, x1 * rstd * g.y); w.y = cvtpk(x2 * rstd * g.z, x3 * rstd * g.w);
                            *(u32x2*)(QLN + m * 256 + 4 * lane) = w; }
                        {
                            float x0 = 0.f, x1 = 0.f, x2 = 0.f, x3 = 0.f;
                            if (lane < 32) { const u32x2 z = *(const u32x2*)(zr + ZC_KV + 4 * lane); x0 = lo_bf(z.x); x1 = hi_bf(z.x); x2 = lo_bf(z.y); x3 = hi_bf(z.y); }
                            const float rstd = rsqrtf(wave_sum((x0 * x0 + x1 * x1) + (x2 * x2 + x3 * x3)) * (1.f / KVLR) + EPS);
                            const f32x4 g = *(const f32x4*)(kvng + 4 * (lane & 31));
                            u32x2 w; w.x = cvtpk(x0 * rstd * g.x, x1 * rstd * g.y); w.y = cvtpk(x2 * rstd * g.z, x3 * rstd * g.w);
                            *(u32x2*)(KVLN + m * 256 + 4 * lane) = w; }
                        if (lane < 32) {
                            const float x1 = bf2f(zr[ZC_KR + lane]), x2 = bf2f(zr[ZC_KR + 32 + lane]);
                            const float c = cs_t[m * 32 + lane], sn = sn_t[m * 32 + lane];
                            const size_t off = ((size_t)(b * (SEQ / 64) + (s >> 6))) * 8192 + (lane >> 2) * 1024 + (s & 63) * 16 + (lane & 3) * 4;
                            *(unsigned*)(KRb + off) = cvtpk(x1 * c - x2 * sn, x2 * c + x1 * sn); }
                        {
                            const u32x2 z = *(const u32x2*)(zr + ZC_SV + 4 * lane);
                            const float x0 = geluf_(lo_bf(z.x)), x1 = geluf_(hi_bf(z.x)), x2 = geluf_(lo_bf(z.y)), x3 = geluf_(hi_bf(z.y));
                            const float mean = wave_sum((x0 + x1) + (x2 + x3)) * (1.f / SW);
                            const float d0 = x0 - mean, d1 = x1 - mean, d2 = x2 - mean, d3 = x3 - mean;
                            const float rstd = rsqrtf(wave_sum((d0 * d0 + d1 * d1) + (d2 * d2 + d3 * d3)) * (1.f / SW) + EPS);
                            const f32x4 g = *(const f32x4*)(slg + 4 * lane), bb = *(const f32x4*)(slb + 4 * lane);
                            u32x2 w; w.x = cvtpk(d0 * rstd * g.x + bb.x, d1 * rstd * g.y + bb.y); w.y = cvtpk(d2 * rstd * g.z + bb.z, d3 * rstd * g.w + bb.w);
                            *(LAS u32x2*)(sgv + tl * 256 + 4 * lane) = w; }
                    }
                    __syncthreads();
                    { const int c = tid & 255, half = tid >> 8; float w[CK];
#pragma unroll
                      for (int j = 0; j < CK; ++j) w[j] = cw[j * CW + c];
                      const float bias = cb[c];
                      for (int g4 = 0; g4 < 4; ++g4) { const int tb = 16 * half + 4 * g4; float v[34];
#pragma unroll
                          for (int k = 0; k < 34; ++k) v[k] = glu[(tb + k) * 256 + c];
#pragma unroll
                          for (int i = 0; i < 4; ++i) { float a = bias;
#pragma unroll
                              for (int j = 0; j < CK; ++j) a += w[j] * v[i + j];
                              cvo[(tb + i) * 256 + c] = a; } } }
                    __syncthreads();
                    for (int i = 0; i < 4; ++i) { const int tl = 4 * wave + i; const size_t m = m0 + tl;
                        const f32x4 xv = *(const LAS f32x4*)(cvo + tl * 256 + 4 * lane);
                        const float mean = wave_sum((xv.x + xv.y) + (xv.z + xv.w)) * (1.f / CW);
                        const float d0 = xv.x - mean, d1 = xv.y - mean, d2 = xv.z - mean, d3 = xv.w - mean;
                        const float rstd = rsqrtf(wave_sum((d0 * d0 + d1 * d1) + (d2 * d2 + d3 * d3)) * (1.f / CW) + EPS);
                        const f32x4 g = *(const f32x4*)(clg + 4 * lane), bb = *(const f32x4*)(clb + 4 * lane);
                        u32x2 w; w.x = cvtpk(siluf_(d0 * rstd * g.x + bb.x), siluf_(d1 * rstd * g.y + bb.y)); w.y = cvtpk(siluf_(d2 * rstd * g.z + bb.z), siluf_(d3 * rstd * g.w + bb.w));
                        *(u32x2*)(CONVH + m * 256 + 4 * lane) = w; }
                    { const int c = tid & 255, half = tid >> 8; unsigned pk[8];
#pragma unroll
                      for (int k = 0; k < 8; ++k) { const unsigned lo = sgv[(16 * half + 2 * k) * 256 + c], hi2 = sgv[(16 * half + 2 * k + 1) * 256 + c]; pk[k] = lo | (hi2 << 16); }
                      bf16_t* dst = SGVT + ((size_t)(m0 >> 7) * 256 + c) * 128 + (s0 & 127) + 16 * half;
                      *(u32x4*)dst = (u32x4){pk[0], pk[1], pk[2], pk[3]}; *(u32x4*)(dst + 8) = (u32x4){pk[4], pk[5], pk[6], pk[7]}; }
                    __syncthreads();
                }
            } else if (sub == 2 && PHEN(4)) {
                TID_HERE(); PHASE_ROOTS();
                { const bf16_t* WsM = (const bf16_t*)(ws + WS_WSM) + (size_t)l * SG * SCH * SCH; const float* bs = (const float*)ARG(I_BS) + l * SG * SCH;
                  const int r32 = lane & 31, hi = lane >> 5, gq = wave >> 1, th = wave & 1;
                  constexpr int UP = 528;
                  LAS unsigned char* ub = (LAS unsigned char*)lds;
                  for (int ck_ = vcu; ck_ < (MTOK / SCH) * (1 + ((PROBE_MASK >> 9) & 1)); ck_ += G) { const int ck = ck_ % (MTOK / SCH);
                      const size_t mc = (size_t)ck * SCH;
                      const bf16_t* Wb = WsM + ((size_t)gq * SCH + 64 * th + r32) * SCH + 8 * hi;
                      const bf16_t* Vb = SGVT + ((size_t)ck * 256 + gq * 64 + r32) * SCH + 8 * hi;
                      bf16x8 wf[2][4], vf[2][4];
#pragma unroll
                      for (int ks = 0; ks < 4; ++ks) { wf[0][ks] = *(const bf16x8*)(Wb + 16 * ks); wf[1][ks] = *(const bf16x8*)(Wb + 32 * SCH + 16 * ks);
                                                       vf[0][ks] = *(const bf16x8*)(Vb + 16 * ks); vf[1][ks] = *(const bf16x8*)(Vb + 32 * SCH + 16 * ks); }
#pragma unroll
                      for (int p = 0; p < 8; ++p) { const int idx = p * NTHREADS + tid, t = idx >> 5, c8 = (idx & 31) * 8;
                          const u32x4 uu = *(const u32x4*)(Zb + (mc + t) * DINP + ZC_SU + c8), gg = *(const u32x4*)(Zb + (mc + t) * DINP + ZC_GS + c8);
                          u32x4 o;
                          o.x = cvtpk(geluf_(lo_bf(uu.x)) * siluf_(lo_bf(gg.x)), geluf_(hi_bf(uu.x)) * siluf_(hi_bf(gg.x)));
                          o.y = cvtpk(geluf_(lo_bf(uu.y)) * siluf_(lo_bf(gg.y)), geluf_(hi_bf(uu.y)) * siluf_(hi_bf(gg.y)));
                          o.z = cvtpk(geluf_(lo_bf(uu.z)) * siluf_(lo_bf(gg.z)), geluf_(hi_bf(uu.z)) * siluf_(hi_bf(gg.z)));
                          o.w = cvtpk(geluf_(lo_bf(uu.w)) * siluf_(lo_bf(gg.w)), geluf_(hi_bf(uu.w)) * siluf_(hi_bf(gg.w)));
                          *(LAS u32x4*)(ub + t * UP + c8 * 2) = o; }
                      f32x16 acc[2][2];
#pragma unroll
                      for (int a = 0; a < 2; ++a)
#pragma unroll
                          for (int bq = 0; bq < 2; ++bq) acc[a][bq] = f32x16{};
#pragma unroll
                      for (int kh = 0; kh < 2; ++kh) {
#pragma unroll
                          for (int ks = 0; ks < 4; ++ks) {
                              acc[0][0] = __builtin_amdgcn_mfma_f32_32x32x16_bf16(vf[0][ks], wf[0][ks], acc[0][0], 0, 0, 0);
                              acc[0][1] = __builtin_amdgcn_mfma_f32_32x32x16_bf16(vf[0][ks], wf[1][ks], acc[0][1], 0, 0, 0);
                              acc[1][0] = __builtin_amdgcn_mfma_f32_32x32x16_bf16(vf[1][ks], wf[0][ks], acc[1][0], 0, 0, 0);
                              acc[1][1] = __builtin_amdgcn_mfma_f32_32x32x16_bf16(vf[1][ks], wf[1][ks], acc[1][1], 0, 0, 0);
                          }
                          if (kh == 0) {
#pragma unroll
                              for (int ks = 0; ks < 4; ++ks) { wf[0][ks] = *(const bf16x8*)(Wb + 64 + 16 * ks); wf[1][ks] = *(const bf16x8*)(Wb + 32 * SCH + 64 + 16 * ks);
                                                               vf[0][ks] = *(const bf16x8*)(Vb + 64 + 16 * ks); vf[1][ks] = *(const bf16x8*)(Vb + 32 * SCH + 64 + 16 * ks); }
                          }
                      }
                      __syncthreads();
#pragma unroll
                      for (int rb = 0; rb < 2; ++rb) { const int t = 64 * th + 32 * rb + r32; const float bt = bs[gq * SCH + t];
#pragma unroll
                          for (int cb = 0; cb < 2; ++cb)
#pragma unroll
                              for (int q4 = 0; q4 < 4; ++q4) { LAS u32x2* p = (LAS u32x2*)(ub + t * UP + (gq * 64 + 32 * cb + 8 * q4 + 4 * hi) * 2);
                                  const u32x2 up = *p; u32x2 w;
                                  w.x = cvtpk((acc[cb][rb][4 * q4 + 0] + bt) * lo_bf(up.x), (acc[cb][rb][4 * q4 + 1] + bt) * hi_bf(up.x));
                                  w.y = cvtpk((acc[cb][rb][4 * q4 + 2] + bt) * lo_bf(up.y), (acc[cb][rb][4 * q4 + 3] + bt) * hi_bf(up.y));
                                  *p = w; } }
                      __syncthreads();
#pragma unroll
                      for (int p = 0; p < 8; ++p) { const int idx = p * NTHREADS + tid, t = idx >> 5, c8 = (idx & 31) * 8;
                          *(u32x4*)(YCAT + (mc + t) * DM + 768 + c8) = *(const LAS u32x4*)(ub + t * UP + c8 * 2); }
                      __syncthreads();
                  } }
            } else if (sub == 3 && PHEN(5)) {
                TID_HERE(); PHASE_ROOTS();
                const int nun = (NB * NH * 32 + G - 1) / G;
#pragma nounroll
                for (int i = 0; i < nun; ++i) {
                    const int u_ = vcu + i * G;
                    int bh = u_ >> 5, qb = 31 - (u_ & 31);
                    if (G == 256) { bh = vcu >> 4; qb = (i == 0) ? 31 - (vcu & 15) : (vcu & 15); }
                    if (bh < NB * NH) att::attn_unit3(bh >> 2, bh & 3, qb, Qb, KNb, KRb, VIb, Zb, YCAT, (char*)lds, tid);
                }
            } else if (sub == 5 && PHEN(7)) {
                TID_HERE(); PHASE_ROOTS();
                const float* xsrc = (l == 0) ? x_in : (const float*)outp;
                const float* gpost = (const float*)ARG(I_GPOST) + l * DM;
                const float* modl = mod + (size_t)l * 4 * 3072; const float* mod1 = mod + (size_t)4 * 3072; const float* gp1 = (const float*)ARG(I_GPRE) + DM;
                for (int grp = gw; grp < MTOK / 4; grp += NGW) { const int m0 = grp * 4, b = m0 >> 13;
                    u32x2 yv[4][4]; f32x4 xv[4][4];
#pragma unroll
                    for (int k = 0; k < 4; ++k) { const u32x2* yr = (const u32x2*)(Y16 + (size_t)(m0 + k) * DM) + lane; const f32x4* xr = (const f32x4*)(xsrc + (size_t)(m0 + k) * DM) + lane;
#pragma unroll
                        for (int j = 0; j < 4; ++j) { yv[k][j] = yr[64 * j]; xv[k][j] = xr[64 * j]; } }
                    f32x4 pg[4];
#pragma unroll
                    for (int j = 0; j < 4; ++j) { const int c = 4 * lane + 256 * j; pg[j] = *(const f32x4*)(modl + (size_t)b * 3072 + 2 * DM + c) * *(const f32x4*)(gpost + c); }
                    float rstd2[4];
#pragma unroll
                    for (int k = 0; k < 4; ++k) { float ss = 0.f; f32x4 y[4];
#pragma unroll
                        for (int j = 0; j < 4; ++j) { y[j] = (f32x4){lo_bf(yv[k][j].x), hi_bf(yv[k][j].x), lo_bf(yv[k][j].y), hi_bf(yv[k][j].y)};
                            ss += (y[j].x * y[j].x + y[j].y * y[j].y) + (y[j].z * y[j].z + y[j].w * y[j].w); }
                        const float rstd = rsqrtf(wave_sum(ss) * (1.f / DM) + EPS);
                        f32x4* orow = (f32x4*)(outp + (size_t)(m0 + k) * DM) + lane; float ss2 = 0.f;
#pragma unroll
                        for (int j = 0; j < 4; ++j) { xv[k][j] = xv[k][j] + (y[j] * rstd) * pg[j]; orow[64 * j] = xv[k][j];
                            ss2 += (xv[k][j].x * xv[k][j].x + xv[k][j].y * xv[k][j].y) + (xv[k][j].z * xv[k][j].z + xv[k][j].w * xv[k][j].w); }
                        rstd2[k] = rsqrtf(wave_sum(ss2) * (1.f / DM) + EPS); }
                    if (l == 0) {
                        f32x4 pa[4], pb[4];
#pragma unroll
                        for (int j = 0; j < 4; ++j) { const int c = 4 * lane + 256 * j;
                            pb[j] = *(const f32x4*)(mod1 + (size_t)b * 3072 + c);
                            pa[j] = *(const f32x4*)(gp1 + c) * (*(const f32x4*)(mod1 + (size_t)b * 3072 + DM + c) + 1.f); }
#pragma unroll
                        for (int k = 0; k < 4; ++k) { u32x2* o8 = (u32x2*)(Hb + (size_t)(m0 + k) * DM) + lane;
#pragma unroll
                            for (int j = 0; j < 4; ++j) { const f32x4 hv = (xv[k][j] * rstd2[k]) * pa[j] + pb[j];
                                u32x2 w; w.x = cvtpk(hv.x, hv.y); w.y = cvtpk(hv.z, hv.w); o8[64 * j] = w; } }
                    }
                }
            }
        }
        { bool again = false;
          if (rep == 0 && PROBE_MASK != 0) { if (ph == 0) again = (PROBE_MASK >> 7) & 1; else if (ph == 1) again = (PROBE_MASK >> 6) & 1; else if (ph >= 2) { const int sub_ = (ph - 2) % 6, l_ = (ph - 2) / 6; again = ((PROBE_MASK >> sub_) & 1) && !(sub_ == 5 && l_ == 1); } }
          if (again) rep = 1; else { rep = 0; ++ph; } }
        if (ph < ph_hi) { if (ph_lo < 0) grid.sync(); else xcd_barrier(xbar); }
    }
}

extern "C" void kernel_launch(void* const* d_in, const int* in_sizes, int n_in, void* d_out, int out_size, void* d_ws, size_t ws_size, hipStream_t stream) {
    static int grid = 0;
    if (grid == 0) {
        if (n_in != 22 || in_sizes[0] != MTOK * DM || out_size != MTOK * DM || ws_size < WS_END) {
            fprintf(stderr, "kernel_launch: unexpected shapes (n_in %d, in0 %d, out %d, ws %zu); nothing launched\n", n_in, n_in > 0 ? in_sizes[0] : -1, out_size, ws_size); grid = -1; return; }
        int dev = 0, cus = 0, per_cu = 0;
        (void)hipGetDevice(&dev); (void)hipDeviceGetAttribute(&cus, hipDeviceAttributeMultiprocessorCount, dev);
        if (hipFuncSetAttribute((const void*)hymba_fwd, hipFuncAttributeMaxDynamicSharedMemorySize, LDS_BYTES) != hipSuccess) { fprintf(stderr, "kernel_launch: hipFuncSetAttribute failed\n"); grid = -1; return; }
        if (hipOccupancyMaxActiveBlocksPerMultiprocessor(&per_cu, (const void*)hymba_fwd, NTHREADS, LDS_BYTES) != hipSuccess || per_cu < 1) { fprintf(stderr, "kernel_launch: occupancy query says %d blocks per CU\n", per_cu); per_cu = 1; }
        (void)hipGetLastError();
        grid = cus > 0 ? cus : 256;
    }
    if (grid < 0) return;
    (void)hipMemsetAsync((char*)d_ws + WS_CTL, 0, CTL_BYTES, stream);
    Args a{};
    for (int i = 0; i < 22; ++i) a.in[i] = d_in[i];
    a.out = (float*)d_out; a.ws = (unsigned char*)d_ws;
#if MK_N_LAUNCHES == 1
    a.ph_lo = 0; a.ph_hi = N_PHASES;
    { void* kargs[] = {&a};
      hipError_t e = hipLaunchCooperativeKernel((const void*)hymba_fwd, dim3(grid), dim3(NTHREADS), kargs, LDS_BYTES, stream);
      if (e != hipSuccess) fprintf(stderr, "cooperative launch failed: %s (grid %d)\n", hipGetErrorString(e), grid); }
#else
    for (int ph = 0; ph < N_PHASES; ++ph) { a.ph_lo = ph; a.ph_hi = ph + 1; void* kargs[] = {&a};
        hipError_t e = hipLaunchCooperativeKernel((const void*)hymba_fwd, dim3(grid), dim3(NTHREADS), kargs, LDS_BYTES, stream);
        if (e != hipSuccess) { fprintf(stderr, "launch %d failed: %s (grid %d)\n", ph, hipGetErrorString(e), grid); break; } }
#endif
}
```

```cpp
#include <hip/hip_runtime.h>
#include <hip/hip_cooperative_groups.h>
#include <cstdio>
#include <cstdint>
namespace cg = cooperative_groups;

#ifndef MK_N_LAUNCHES
#define MK_N_LAUNCHES 1
#endif

#define LAS __attribute__((address_space(3)))
#ifndef PROBE_MASK
#define PROBE_MASK 0
#endif
#ifndef PHMASK
#define PHMASK 0xff
#endif
#define PHEN(k) (((PHMASK) >> (k)) & 1)
typedef unsigned short bf16_t;
typedef short bf16x8 __attribute__((ext_vector_type(8)));
typedef short s16x4 __attribute__((ext_vector_type(4)));
typedef float f32x2 __attribute__((ext_vector_type(2)));
typedef float f32x4 __attribute__((ext_vector_type(4)));
typedef float f32x16 __attribute__((ext_vector_type(16)));
typedef unsigned u32x2 __attribute__((ext_vector_type(2)));
typedef unsigned u32x4 __attribute__((ext_vector_type(4)));

constexpr int DM = 1024, NB = 4, SEQ = 8192, MTOK = NB * SEQ, NLAYER = 2;
constexpr int NH = 4, DNOPE = 128, DROPE = 64, DQK = 192, DV = 128;
constexpr int QLR = 256, KVLR = 128, DIN = 2496, DINP = 2560;
constexpr int CW = 256, CK = 31, SW = 256, SG = 4, SCH = 128;
constexpr float EPS = 1e-6f;
constexpr int ZC_Q = 0, ZC_KV = 256, ZC_KR = 384, ZC_GATT = 512, ZC_CA = 1024, ZC_CB = 1280, ZC_GC = 1536, ZC_SU = 1792, ZC_SV = 2048, ZC_GS = 2304;
constexpr float QSCALE = 0.07216878364870323f * 1.4426950408889634f;

constexpr size_t MiB = 1u << 20;
constexpr size_t WS_CTL = 0, CTL_BYTES = 1 * MiB;
constexpr size_t CTL_BARW = 1024;
constexpr size_t CTL_ADACNT = 8192;
constexpr size_t CTL_MOD = 65536;
constexpr size_t WS_COS = 1 * MiB, WS_SIN = 5 * MiB;
constexpr size_t WS_WIN = 9 * MiB;
constexpr size_t WS_WOUT = 19 * MiB;
constexpr size_t WS_WUQ = 23 * MiB;
constexpr size_t WS_WUKV = 24 * MiB;
constexpr size_t WS_WPW2 = 25 * MiB;
constexpr size_t WS_WSM = 26 * MiB;
constexpr size_t WS_ADAP = 27 * MiB;
constexpr size_t WS_H = 32 * MiB;
constexpr size_t WS_Z = 96 * MiB;
constexpr size_t WS_Y = WS_Z;
constexpr size_t WS_QLN = 256 * MiB;
constexpr size_t WS_KVLN = 272 * MiB;
constexpr size_t WS_CONVH = 288 * MiB;
constexpr size_t WS_SGVT = 304 * MiB;
constexpr size_t WS_Q = 320 * MiB;
constexpr size_t WS_KN = 368 * MiB;
constexpr size_t WS_KR = 400 * MiB;
constexpr size_t WS_V = 408 * MiB;
constexpr size_t WS_YCAT = 440 * MiB;
constexpr size_t WS_END = 504 * MiB;

constexpr int LDS_BYTES = 147456;
constexpr int NTHREADS = 512, NWAVES = 8;

__device__ __forceinline__ float bf2f(unsigned short u) { return __uint_as_float(((unsigned)u) << 16); }
__device__ __forceinline__ unsigned cvtpk(float lo, float hi) { unsigned r; asm("v_cvt_pk_bf16_f32 %0, %1, %2" : "=v"(r) : "v"(lo), "v"(hi)); return r; }
__device__ __forceinline__ float lo_bf(unsigned w) { return __uint_as_float(w << 16); }
__device__ __forceinline__ float hi_bf(unsigned w) { return __uint_as_float(w & 0xffff0000u); }
#define dpp_f(v, ctrl) __int_as_float(__builtin_amdgcn_update_dpp(0, __float_as_int(v), (ctrl), 0xf, 0xf, true))
#define DPP_XOR1 0xB1
#define DPP_XOR2 0x4E
#define DPP_HMIRROR 0x141
#define DPP_MIRROR 0x140
__device__ __forceinline__ float xor1_f(float v) { return dpp_f(v, DPP_XOR1); }
__device__ __forceinline__ float wave_sum(float v) {
    v += dpp_f(v, DPP_XOR1); v += dpp_f(v, DPP_XOR2); v += dpp_f(v, DPP_HMIRROR); v += dpp_f(v, DPP_MIRROR);
    const int iv = __float_as_int(v);
    return (__int_as_float(__builtin_amdgcn_readlane(iv, 0)) + __int_as_float(__builtin_amdgcn_readlane(iv, 16))) +
           (__int_as_float(__builtin_amdgcn_readlane(iv, 32)) + __int_as_float(__builtin_amdgcn_readlane(iv, 48)));
}
__device__ __forceinline__ float sigmoidf_(float x) { return __builtin_amdgcn_rcpf(1.f + __builtin_amdgcn_exp2f(-1.4426950408889634f * x)); }
__device__ __forceinline__ float siluf_(float x) { return x * __builtin_amdgcn_rcpf(1.f + __builtin_amdgcn_exp2f(-1.4426950408889634f * x)); }
__device__ __forceinline__ float geluf_(float v) {
    const float av = __builtin_fabsf(v), t = __builtin_amdgcn_rcpf(av * 0.2316418882f + 1.0f);
    float q = t * 0.5307027145f + (-0.7265760135f); q = q * t + 0.7107068705f; q = q * t + (-0.142248368f); q = q * t + 0.127414796f; q = q * t;
    const float e = __builtin_amdgcn_exp2f((v * v) * (-0.72134752044f));
    const float m = v * (q * e);
    return v < 0.f ? m : v - m;
}

namespace pg8 {
constexpr int BM = 256, BK = 64, HALF = 128, HTB = HALF * BK * 2, STAGE_BYTES = 8 * HTB, NXCD = 8, WGM = 8;
__host__ __device__ __forceinline__ int lds_byte(int r, int c) { const int st = (r >> 4) * 2 + (c >> 5), rr = r & 15, cc = c & 31, ob = rr * 64 + cc * 2; return st * 1024 + (ob ^ (((ob >> 9) & 1) << 5)); }
__host__ __device__ __forceinline__ void stage_rc(int b, int& R, int& C) { const int st = b / 1024, sb = b % 1024, swz = sb ^ (((sb >> 9) & 1) << 5); R = (st >> 1) * 16 + swz / 64; C = (st & 1) * 32 + (swz % 64) / 2; }
__host__ __device__ __forceinline__ int perm32(int rho) { const int n = rho >> 4, i = rho & 15; return 8 * (i >> 2) + 4 * n + (i & 3); }

struct Unit { int pm, pn; };
struct Gemm { const bf16_t* A; const bf16_t* Bt; int M, N, K, lda, ldb; };

struct StaticOrder {
    int nM, nN, nwg, G, c;
    __host__ __device__ void init(int M, int N, int G_, int c_) { nM = M / BM; nN = N / BM; nwg = nM * nN; G = G_; c = c_; }
    __host__ __device__ bool next(int i, Unit& u) const {
        const long L = (long)i * G + c; if (L >= nwg) return false;
        int wgid = (int)L; { const int q = nwg / NXCD, r = nwg % NXCD, xcd = wgid % NXCD, off = wgid / NXCD; wgid = (xcd < r ? xcd * (q + 1) : r * (q + 1) + (xcd - r) * q) + off; }
        const int nig = WGM * nN, gid = wgid / nig, fm = gid * WGM, gsz = (nM - fm) < WGM ? (nM - fm) : WGM;
        u.pm = fm + ((wgid % nig) % gsz); u.pn = (wgid % nig) / gsz; return true;
    }
};

template <class Epi>
__device__ __forceinline__ void gemm_phase(LAS unsigned char* lds, const Gemm g, const StaticOrder& S, const Epi& E, const int tid) {
    const int wid = __builtin_amdgcn_readfirstlane(tid >> 6), lane = tid & 63, wr = wid >> 2, wc = wid & 3, fr = lane & 15, fq = lane >> 4;
    const int K = g.K, nt = K / BK;
    unsigned voffA[2], voffB[2];
#pragma unroll
    for (int i = 0; i < 2; ++i) { int R, C; stage_rc(tid * 16 + i * 8192, R, C); const int Rb = Epi::PERM ? ((R & ~31) + perm32(R & 31)) : R;
        voffA[i] = (unsigned)(R * g.lda + C) * 2u; voffB[i] = (unsigned)(Rb * g.ldb + C) * 2u; }
    const size_t kstep = (size_t)(BK * 2);
    const size_t hstepA = (size_t)HALF * g.lda * 2, hstepB = (size_t)HALF * g.ldb * 2;
    const size_t tstepA = 2 * hstepA, tstepB = 2 * hstepB;
    const unsigned ldsw = (unsigned)wid * 1024u;
    const int aoff = lds_byte(wr * 64 + fr, fq * 8), boff = lds_byte(wc * 32 + fr, fq * 8);
#define PG8_SA(b, h) (((b) * 2 + (h)) * HTB)
#define PG8_SB(b, h) ((4 + (b) * 2 + (h)) * HTB)
#define PG8_STAGE(bufoff, gbase, voff) do { _Pragma("unroll") for (int _i = 0; _i < 2; ++_i) \
        __builtin_amdgcn_global_load_lds((const unsigned*)((const char*)(gbase) + (voff)[_i]), (LAS unsigned*)(lds + (bufoff) + ldsw + _i * 8192), 16, 0, 0); } while (0)
#define PG8_LDA(dst, b, h) do { _Pragma("unroll") for (int m = 0; m < 4; ++m) _Pragma("unroll") for (int k = 0; k < 2; ++k) dst[m][k] = *(const LAS bf16x8*)(lds + PG8_SA(b, h) + aoff + m * 2048 + k * 1024); } while (0)
#define PG8_LDB(dst, b, h) do { _Pragma("unroll") for (int n = 0; n < 2; ++n) _Pragma("unroll") for (int k = 0; k < 2; ++k) dst[n][k] = *(const LAS bf16x8*)(lds + PG8_SB(b, h) + boff + n * 2048 + k * 1024); } while (0)
#define PG8_MMA(ai, bj, At, Bt) do { __builtin_amdgcn_s_setprio(1); _Pragma("unroll") for (int m = 0; m < 4; ++m) _Pragma("unroll") for (int n = 0; n < 2; ++n) _Pragma("unroll") for (int k = 0; k < 2; ++k) \
        acc[ai][bj][m][n] = __builtin_amdgcn_mfma_f32_16x16x32_bf16(Bt[n][k], At[m][k], acc[ai][bj][m][n], 0, 0, 0); __builtin_amdgcn_s_setprio(0); } while (0)
#define PG8_WAIT_V(n) asm volatile("s_waitcnt vmcnt(" #n ")" ::: "memory")
#define PG8_WAIT_L(n) asm volatile("s_waitcnt lgkmcnt(" #n ")" ::: "memory")
#define PG8_BAR __builtin_amdgcn_s_barrier()
#define PG8_SCHED __builtin_amdgcn_sched_barrier(0)
    Unit cur, nxt; int ui = 0;
    if (!S.next(0, cur)) return;
    f32x4 acc[2][2][4][2];
#pragma unroll
    for (int a = 0; a < 2; ++a)
#pragma unroll
        for (int b = 0; b < 2; ++b)
#pragma unroll
            for (int m = 0; m < 4; ++m)
#pragma unroll
                for (int n = 0; n < 2; ++n) acc[a][b][m][n] = (f32x4){0.f, 0.f, 0.f, 0.f};
    bf16x8 At[4][2], B0[2][2], B1[2][2];
    const char* cA = (const char*)g.A + (size_t)cur.pm * tstepA; const char* cB = (const char*)g.Bt + (size_t)cur.pn * tstepB;
    PG8_STAGE(PG8_SB(0, 0), cB, voffB); PG8_STAGE(PG8_SB(0, 1), cB + hstepB, voffB); PG8_STAGE(PG8_SA(0, 0), cA, voffA); PG8_STAGE(PG8_SA(0, 1), cA + hstepA, voffA);
    if (wr == 1) PG8_BAR;
    PG8_WAIT_V(2); PG8_BAR;
    PG8_STAGE(PG8_SB(1, 0), cB + kstep, voffB); PG8_STAGE(PG8_SA(1, 0), cA + kstep, voffA); PG8_STAGE(PG8_SB(1, 1), cB + hstepB + kstep, voffB);
    PG8_WAIT_V(6); PG8_BAR;
    for (;;) {
        const bool has_next = S.next(ui + 1, nxt);
        const char* nA = has_next ? (const char*)g.A + (size_t)nxt.pm * tstepA : cA; const char* nB = has_next ? (const char*)g.Bt + (size_t)nxt.pn * tstepB : cB;
        for (int t = 0; t < nt; t += 2) {
            const bool last = (t == nt - 2);
            const char* a1 = cA + (size_t)(t + 1) * kstep;
            const char* a2 = last ? nA : cA + (size_t)(t + 2) * kstep; const char* b2 = last ? nB : cB + (size_t)(t + 2) * kstep;
            const char* a3 = a2 + kstep; const char* b3 = b2 + kstep;
            PG8_LDB(B0, 0, 0); PG8_LDB(B1, 0, 1); PG8_SCHED; PG8_LDA(At, 0, 0); PG8_STAGE(PG8_SA(1, 1), a1 + hstepA, voffA);
            PG8_WAIT_V(8); PG8_WAIT_L(0); PG8_BAR; PG8_MMA(0, 0, At, B0); PG8_MMA(0, 1, At, B1); PG8_BAR; PG8_SCHED;
            PG8_LDA(At, 0, 1); PG8_STAGE(PG8_SB(0, 0), b2, voffB); PG8_STAGE(PG8_SB(0, 1), b2 + hstepB, voffB); PG8_STAGE(PG8_SA(0, 0), a2, voffA);
            PG8_WAIT_V(8); PG8_WAIT_L(0); PG8_BAR; PG8_MMA(1, 0, At, B0); PG8_MMA(1, 1, At, B1); PG8_BAR; PG8_SCHED;
            PG8_LDB(B0, 1, 0); PG8_LDB(B1, 1, 1); PG8_SCHED; PG8_LDA(At, 1, 0); PG8_STAGE(PG8_SA(0, 1), a2 + hstepA, voffA);
            PG8_WAIT_V(8); PG8_WAIT_L(0); PG8_BAR; PG8_MMA(0, 0, At, B0); PG8_MMA(0, 1, At, B1); PG8_BAR; PG8_SCHED;
            PG8_LDA(At, 1, 1); PG8_STAGE(PG8_SB(1, 0), b3, voffB); PG8_STAGE(PG8_SB(1, 1), b3 + hstepB, voffB); PG8_STAGE(PG8_SA(1, 0), a3, voffA);
            PG8_WAIT_V(8); PG8_WAIT_L(0); PG8_BAR; PG8_MMA(1, 0, At, B0); PG8_MMA(1, 1, At, B1); PG8_BAR; PG8_SCHED;
        }
        if (wr == 0) PG8_BAR;
        { Unit uu = cur; asm volatile("" : "+s"(uu.pm), "+s"(uu.pn)); int t2 = tid; asm volatile("" : "+v"(t2));
          E(acc, uu, wr, wc, t2 & 15, (t2 & 63) >> 4); }
        if (!has_next) break;
#pragma unroll
        for (int a = 0; a < 2; ++a)
#pragma unroll
            for (int b = 0; b < 2; ++b)
#pragma unroll
                for (int m = 0; m < 4; ++m)
#pragma unroll
                    for (int n = 0; n < 2; ++n) acc[a][b][m][n] = (f32x4){0.f, 0.f, 0.f, 0.f};
        cur = nxt; cA = nA; cB = nB; ++ui;
        if (wr == 1) PG8_BAR;
    }
    PG8_WAIT_V(0);
    PG8_BAR;
#undef PG8_SA
#undef PG8_SB
#undef PG8_STAGE
#undef PG8_LDA
#undef PG8_LDB
#undef PG8_MMA
#undef PG8_WAIT_V
#undef PG8_WAIT_L
#undef PG8_BAR
#undef PG8_SCHED
}
}

__host__ __device__ __forceinline__ int v_st(int k, int c) { const int kk = (k & ~0xC) | ((k & 4) << 1) | ((k & 8) >> 1); return ((kk >> 3) * 4 + (c >> 5)) * 512 + ((kk & 7) * 32 + (c & 31)) * 2; }
__device__ __forceinline__ int v_rd_base(int lane) { return ((lane & 3) << 3) | (((lane >> 2) & 3) << 6) | (((lane >> 4) & 1) << 5) | (((lane >> 5) & 1) << 8); }
constexpr int v_rd_off(int d0, int ks, int half) { return d0 * 512 + ks * 4096 + half * 2048; }
__device__ __forceinline__ int crow(int r, int hi) { return (r & 3) + 8 * (r >> 2) + 4 * hi; }

enum { EM_Z = 0, EM_F32 = 1, EM_Q = 2, EM_KV = 3, EM_PW2 = 4, EM_Z1 = 5 };
struct EpiAll {
    static constexpr bool PERM = true;
    int mode; int ldc; void* p0; const void* p1; const void* p2;
    __device__ __forceinline__ void operator()(const f32x4 (&acc)[2][2][4][2], const pg8::Unit& u, int wr, int wc, int fr, int fq) const {
        const int row0 = u.pm * 256 + wr * 64 + fr, col0 = u.pn * 256 + wc * 32 + 8 * fq;
        if (mode == EM_Z) {
            bf16_t* O = (bf16_t*)p0;
#pragma unroll
            for (int ai = 0; ai < 2; ++ai)
#pragma unroll
                for (int m = 0; m < 4; ++m) { bf16_t* rowp = O + (size_t)(row0 + ai * 128 + m * 16) * ldc + col0;
#pragma unroll
                    for (int bj = 0; bj < 2; ++bj) { const f32x4 v0 = acc[ai][bj][m][0], v1 = acc[ai][bj][m][1];
                        u32x4 w; w.x = cvtpk(v0[0], v0[1]); w.y = cvtpk(v0[2], v0[3]); w.z = cvtpk(v1[0], v1[1]); w.w = cvtpk(v1[2], v1[3]);
                        *(u32x4*)(rowp + bj * 128) = w; } }
        } else if (mode == EM_Z1) {
            bf16_t* O = (bf16_t*)p0; const int pn = u.pn;
            const bool paired = (pn == 4) | (pn == 5) | (pn == 7) | (pn == 9), gate = (pn == 2) | (pn == 3) | (pn == 6);
            const int pcol = (pn == 4 ? 1024 : pn == 5 ? 1152 : pn == 7 ? 1792 : 1920) + wc * 32 + 8 * fq;
#pragma unroll
            for (int ai = 0; ai < 2; ++ai)
#pragma unroll
                for (int m = 0; m < 4; ++m) { bf16_t* rowb = O + (size_t)(row0 + ai * 128 + m * 16) * ldc;
                    if (paired) { const f32x4 a0 = acc[ai][0][m][0], a1 = acc[ai][0][m][1], b0 = acc[ai][1][m][0], b1 = acc[ai][1][m][1]; f32x4 r0, r1;
                        if (pn < 6) {
#pragma unroll
                            for (int e = 0; e < 4; ++e) { r0[e] = a0[e] * sigmoidf_(b0[e]); r1[e] = a1[e] * sigmoidf_(b1[e]); } }
                        else {
#pragma unroll
                            for (int e = 0; e < 4; ++e) { r0[e] = geluf_(a0[e]) * siluf_(b0[e]); r1[e] = geluf_(a1[e]) * siluf_(b1[e]); } }
                        u32x4 w; w.x = cvtpk(r0[0], r0[1]); w.y = cvtpk(r0[2], r0[3]); w.z = cvtpk(r1[0], r1[1]); w.w = cvtpk(r1[2], r1[3]);
                        *(u32x4*)(rowb + pcol) = w; }
                    else {
#pragma unroll
                        for (int bj = 0; bj < 2; ++bj) { f32x4 v0 = acc[ai][bj][m][0], v1 = acc[ai][bj][m][1];
                            if (gate) {
#pragma unroll
                                for (int e = 0; e < 4; ++e) { v0[e] = siluf_(v0[e]); v1[e] = siluf_(v1[e]); } }
                            u32x4 w; w.x = cvtpk(v0[0], v0[1]); w.y = cvtpk(v0[2], v0[3]); w.z = cvtpk(v1[0], v1[1]); w.w = cvtpk(v1[2], v1[3]);
                            *(u32x4*)(rowb + col0 + bj * 128) = w; } } }
        } else if (mode == EM_F32) {
            float* C = (float*)p0;
#pragma unroll
            for (int ai = 0; ai < 2; ++ai)
#pragma unroll
                for (int m = 0; m < 4; ++m) { float* rowp = C + (size_t)(row0 + ai * 128 + m * 16) * ldc + col0;
#pragma unroll
                    for (int bj = 0; bj < 2; ++bj)
#pragma unroll
                        for (int n = 0; n < 2; ++n) *(f32x4*)(rowp + bj * 128 + n * 4) = acc[ai][bj][m][n]; }
        } else if (mode == EM_Q) {
            bf16_t* Q = (bf16_t*)p0; const float* cs = (const float*)p1; const float* sn = (const float*)p2;
#pragma unroll
            for (int ai = 0; ai < 2; ++ai)
#pragma unroll
                for (int m = 0; m < 4; ++m) { const int tok = row0 + ai * 128 + m * 16, b = tok >> 13, s = tok & 8191;
#pragma unroll
                    for (int bj = 0; bj < 2; ++bj) { f32x4 v0 = acc[ai][bj][m][0], v1 = acc[ai][bj][m][1]; const int n = col0 + bj * 128;
                        bf16_t* dst;
                        if (u.pn < 2) { const int h = n >> 7, d = n & 127; dst = Q + ((size_t)((b * NH + h) * SEQ + s)) * DQK + d; }
                        else { const int n2 = n - 512, h = n2 >> 6, w = n2 & 63, i0 = w >> 1;
                            const f32x4 c4 = *(const f32x4*)(cs + (size_t)tok * 32 + i0), s4 = *(const f32x4*)(sn + (size_t)tok * 32 + i0);
                            f32x4 a0, a1;
                            a0[0] = v0[0] * c4[0] - v0[1] * s4[0]; a0[1] = v0[1] * c4[0] + v0[0] * s4[0];
                            a0[2] = v0[2] * c4[1] - v0[3] * s4[1]; a0[3] = v0[3] * c4[1] + v0[2] * s4[1];
                            a1[0] = v1[0] * c4[2] - v1[1] * s4[2]; a1[1] = v1[1] * c4[2] + v1[0] * s4[2];
                            a1[2] = v1[2] * c4[3] - v1[3] * s4[3]; a1[3] = v1[3] * c4[3] + v1[2] * s4[3];
                            v0 = a0; v1 = a1; dst = Q + ((size_t)((b * NH + h) * SEQ + s)) * DQK + DNOPE + w; }
                        v0 = v0 * QSCALE; v1 = v1 * QSCALE;
                        u32x4 wv; wv.x = cvtpk(v0[0], v0[1]); wv.y = cvtpk(v0[2], v0[3]); wv.z = cvtpk(v1[0], v1[1]); wv.w = cvtpk(v1[2], v1[3]);
                        *(u32x4*)dst = wv; } }
        } else if (mode == EM_KV) {
            unsigned char* KN = (unsigned char*)p0; unsigned char* VI = (unsigned char*)p1;
#pragma unroll
            for (int ai = 0; ai < 2; ++ai)
#pragma unroll
                for (int m = 0; m < 4; ++m) { const int tok = row0 + ai * 128 + m * 16, b = tok >> 13, s = tok & 8191;
#pragma unroll
                    for (int bj = 0; bj < 2; ++bj) { const f32x4 v0 = acc[ai][bj][m][0], v1 = acc[ai][bj][m][1]; const int n = (col0 + bj * 128) & 511;
                        const int h = n >> 7, d = n & 127;
                        const size_t tbase = ((size_t)((b * NH + h) * (SEQ / 64) + (s >> 6))) * 16384;
                        unsigned char* dst = (u.pn < 2) ? KN + tbase + (d >> 3) * 1024 + (s & 63) * 16 : VI + tbase + v_st(s & 63, d);
                        u32x4 wv; wv.x = cvtpk(v0[0], v0[1]); wv.y = cvtpk(v0[2], v0[3]); wv.z = cvtpk(v1[0], v1[1]); wv.w = cvtpk(v1[2], v1[3]);
                        *(u32x4*)dst = wv; } }
        } else {
            bf16_t* YCAT = (bf16_t*)p0; const bf16_t* Z = (const bf16_t*)p1;
#pragma unroll
            for (int ai = 0; ai < 2; ++ai)
#pragma unroll
                for (int m = 0; m < 4; ++m) { const int tok = row0 + ai * 128 + m * 16;
#pragma unroll
                    for (int bj = 0; bj < 2; ++bj) { const f32x4 v0 = acc[ai][bj][m][0], v1 = acc[ai][bj][m][1]; const int c = col0 + bj * 128;
                        const u32x4 g = *(const u32x4*)(Z + (size_t)tok * DINP + ZC_GC + c);
                        u32x4 wv;
                        wv.x = cvtpk(v0[0] * lo_bf(g.x), v0[1] * hi_bf(g.x)); wv.y = cvtpk(v0[2] * lo_bf(g.y), v0[3] * hi_bf(g.y));
                        wv.z = cvtpk(v1[0] * lo_bf(g.z), v1[1] * hi_bf(g.z)); wv.w = cvtpk(v1[2] * lo_bf(g.w), v1[3] * hi_bf(g.w));
                        *(u32x4*)(YCAT + (size_t)tok * DM + 512 + c) = wv; } }
        }
    }
};

namespace att {
constexpr int SLOT = 40960, NSLOT = 3, VOFF = 24576, LDS_WS = NSLOT * SLOT;
constexpr float THR = 8.f;
#define SBAR() __builtin_amdgcn_sched_barrier(0)
__device__ __forceinline__ void glds16(const void* gsrc, unsigned lds_dst) { unsigned keep;
    asm volatile("s_mov_b32 %0, m0\n\ts_mov_b32 m0, %2\n\ts_nop 0\n\tglobal_load_lds_dwordx4 %1, off\n\ts_mov_b32 m0, %0" : "=&s"(keep) : "v"(gsrc), "s"(lds_dst) : "memory"); }

__device__ __forceinline__ void pv_tile(f32x16* o, int vb, bf16x8 pa0, bf16x8 pa1, bf16x8 pa2, bf16x8 pa3) {
#define TRRD(dst, off) asm volatile("ds_read_b64_tr_b16 %0, %1 offset:%2" : "=&v"(dst) : "v"(vb), "i"(off) : "memory")
#define PV_D0(d0) do { s16x4 l0, l1, l2, l3, h0, h1, h2, h3; constexpr int b_ = v_rd_off(d0, 0, 0); \
        TRRD(l0, b_); TRRD(h0, b_ + 2048); TRRD(l1, b_ + 4096); TRRD(h1, b_ + 6144); TRRD(l2, b_ + 8192); TRRD(h2, b_ + 10240); TRRD(l3, b_ + 12288); TRRD(h3, b_ + 14336); \
        asm volatile("s_waitcnt lgkmcnt(0)" ::: "memory"); SBAR(); \
        o[d0] = __builtin_amdgcn_mfma_f32_32x32x16_bf16(pa0, (bf16x8){l0[0], l0[1], l0[2], l0[3], h0[0], h0[1], h0[2], h0[3]}, o[d0], 0, 0, 0); \
        o[d0] = __builtin_amdgcn_mfma_f32_32x32x16_bf16(pa1, (bf16x8){l1[0], l1[1], l1[2], l1[3], h1[0], h1[1], h1[2], h1[3]}, o[d0], 0, 0, 0); \
        o[d0] = __builtin_amdgcn_mfma_f32_32x32x16_bf16(pa2, (bf16x8){l2[0], l2[1], l2[2], l2[3], h2[0], h2[1], h2[2], h2[3]}, o[d0], 0, 0, 0); \
        o[d0] = __builtin_amdgcn_mfma_f32_32x32x16_bf16(pa3, (bf16x8){l3[0], l3[1], l3[2], l3[3], h3[0], h3[1], h3[2], h3[3]}, o[d0], 0, 0, 0); } while (0)
    PV_D0(0); PV_D0(1); PV_D0(2); PV_D0(3);
#undef PV_D0
#undef TRRD
}

__device__ __forceinline__ void attn_unit(int b, int h, int qb, const bf16_t* Q, const unsigned char* KN, const unsigned char* KR, const unsigned char* VI,
                                          const bf16_t* Z, bf16_t* YCAT, char* shm, const int tid) {
    const int lane = tid & 63, r32 = lane & 31, hi = lane >> 5; const int wid = __builtin_amdgcn_readfirstlane(tid >> 6);
    const int q0 = qb * 256, NT = 4 * (qb + 1);
    const int bh = b * NH + h;
    const unsigned lds0 = (unsigned)(uintptr_t)shm;
    float* wsf = (float*)(shm + LDS_WS) + wid * 64;
    const unsigned char* knsrc = KN + (size_t)bh * (SEQ / 64) * 16384 + wid * 1024 + lane * 16;
    const unsigned char* krsrc = KR + (size_t)b * (SEQ / 64) * 8192 + wid * 1024 + lane * 16;
    const unsigned char* vsrc = VI + (size_t)bh * (SEQ / 64) * 16384 + wid * 1024 + lane * 16;
#define DMA_TILE(t, slot) do { const unsigned d_ = (unsigned)__builtin_amdgcn_readfirstlane(lds0 + (slot) + wid * 1024); \
        glds16(knsrc + (size_t)(t) * 16384, d_); glds16(knsrc + (size_t)(t) * 16384 + 8192, d_ + 8192); glds16(krsrc + (size_t)(t) * 8192, d_ + 16384); \
        glds16(vsrc + (size_t)(t) * 16384, d_ + VOFF); glds16(vsrc + (size_t)(t) * 16384 + 8192, d_ + VOFF + 8192); } while (0)
    const bf16_t* Qw = Q + ((size_t)(bh * SEQ + q0 + wid * 32 + r32)) * DQK;
    bf16x8 qr[12];
#pragma unroll
    for (int d0 = 0; d0 < 12; ++d0) qr[d0] = *(const bf16x8*)(Qw + d0 * 16 + hi * 8);
#pragma unroll
    for (int d0 = 0; d0 < 12; ++d0) asm volatile("" : "+v"(qr[d0]));
    asm volatile("s_waitcnt vmcnt(0)" ::: "memory");
    DMA_TILE(0, 0); DMA_TILE(1, SLOT);
    float m_run = -1e30f, l_run = 0.f; f32x16 o[4];
#pragma unroll
    for (int d = 0; d < 4; ++d) o[d] = f32x16{};
    const LAS char* shm3 = (const LAS char*)shm;
    const int vb0 = (int)lds0 + VOFF + v_rd_base(lane);
    const int qabs = q0 + wid * 32 + r32;
    int sl_cur = 0, sl_n1 = SLOT, sl_n2 = 2 * SLOT;
    for (int t = 0; t < NT; ++t) {
        if (t + 1 < NT) asm volatile("s_waitcnt vmcnt(5) lgkmcnt(0)\n\ts_barrier" ::: "memory");
        else asm volatile("s_waitcnt vmcnt(0) lgkmcnt(0)\n\ts_barrier" ::: "memory");
        if (t + 2 < NT) DMA_TILE(t + 2, sl_n2);
        f32x16 p0 = f32x16{}, p1 = f32x16{};
        const LAS char* kp = shm3 + sl_cur + hi * 1024 + r32 * 16;
        {
            bf16x8 ka[4], kb[4];
#define KLD(buf, g) do { buf[0] = *(const LAS bf16x8*)(kp + (2 * (g)) * 2048); buf[1] = *(const LAS bf16x8*)(kp + (2 * (g)) * 2048 + 512); \
                         buf[2] = *(const LAS bf16x8*)(kp + (2 * (g) + 1) * 2048); buf[3] = *(const LAS bf16x8*)(kp + (2 * (g) + 1) * 2048 + 512); } while (0)
#define KMM(buf, g) do { p0 = __builtin_amdgcn_mfma_f32_32x32x16_bf16(buf[0], qr[2 * (g)], p0, 0, 0, 0); p1 = __builtin_amdgcn_mfma_f32_32x32x16_bf16(buf[1], qr[2 * (g)], p1, 0, 0, 0); \
                         p0 = __builtin_amdgcn_mfma_f32_32x32x16_bf16(buf[2], qr[2 * (g) + 1], p0, 0, 0, 0); p1 = __builtin_amdgcn_mfma_f32_32x32x16_bf16(buf[3], qr[2 * (g) + 1], p1, 0, 0, 0); } while (0)
            KLD(ka, 0); KLD(kb, 1); SBAR();
            KMM(ka, 0); SBAR(); KLD(ka, 2); SBAR();
            KMM(kb, 1); SBAR(); KLD(kb, 3); SBAR();
            KMM(ka, 2); SBAR(); KLD(ka, 4); SBAR();
            KMM(kb, 3); SBAR(); KLD(kb, 5); SBAR();
            KMM(ka, 4); SBAR();
            KMM(kb, 5); SBAR();
#undef KLD
#undef KMM
        }
        if (t >= NT - 4) {
            const float NEG = -__builtin_inff(); const int kb = 64 * t + 4 * hi;
#pragma unroll
            for (int r = 0; r < 16; ++r) { const int kv = kb + (r & 3) + 8 * (r >> 2); if (kv > qabs) p0[r] = NEG; if (kv + 32 > qabs) p1[r] = NEG; }
        }
        float pmax = p0[0];
#pragma unroll
        for (int r = 1; r < 16; ++r) pmax = fmaxf(pmax, p0[r]);
#pragma unroll
        for (int r = 0; r < 16; ++r) pmax = fmaxf(pmax, p1[r]);
        { auto rr = __builtin_amdgcn_permlane32_swap(__float_as_uint(pmax), __float_as_uint(pmax), false, false);
          pmax = fmaxf(__uint_as_float(rr[0]), __uint_as_float(rr[1])); }
        float alpha = 1.f;
        if (!__all(pmax - m_run <= THR)) {
            const float mn = fmaxf(m_run, pmax); alpha = __builtin_amdgcn_exp2f(m_run - mn); m_run = mn;
            if (hi == 0) wsf[r32] = alpha;
            asm volatile("s_waitcnt lgkmcnt(0)" ::: "memory");
#pragma unroll
            for (int d = 0; d < 4; ++d)
#pragma unroll
                for (int r = 0; r < 16; ++r) o[d][r] *= wsf[crow(r, hi)];
            asm volatile("s_waitcnt lgkmcnt(0)" ::: "memory");
        }
#pragma unroll
        for (int r = 0; r < 16; ++r) { p0[r] = __builtin_amdgcn_exp2f(p0[r] - m_run); p1[r] = __builtin_amdgcn_exp2f(p1[r] - m_run); }
        float ps = 0.f;
#pragma unroll
        for (int r = 0; r < 16; ++r) ps += p0[r];
#pragma unroll
        for (int r = 0; r < 16; ++r) ps += p1[r];
        { auto rr = __builtin_amdgcn_permlane32_swap(__float_as_uint(ps), __float_as_uint(ps), false, false);
          ps = __uint_as_float(rr[0]) + __uint_as_float(rr[1]); }
        l_run = l_run * alpha + ps;
        bf16x8 pa0, pa1, pa2, pa3;
#define PK4(P, B_, OUT) do { unsigned a0 = cvtpk(P[B_ + 0], P[B_ + 1]), a1 = cvtpk(P[B_ + 2], P[B_ + 3]); \
        unsigned b0 = cvtpk(P[B_ + 4], P[B_ + 5]), b1 = cvtpk(P[B_ + 6], P[B_ + 7]); \
        auto r0 = __builtin_amdgcn_permlane32_swap(a0, b0, false, false); auto r1 = __builtin_amdgcn_permlane32_swap(a1, b1, false, false); \
        u32x4 w = {r0[0], r1[0], r0[1], r1[1]}; OUT = *reinterpret_cast<bf16x8*>(&w); } while (0)
        PK4(p0, 0, pa0); PK4(p0, 8, pa1); PK4(p1, 0, pa2); PK4(p1, 8, pa3);
#undef PK4
        SBAR();
        pv_tile(o, vb0 + sl_cur, pa0, pa1, pa2, pa3);
        { const int tmp = sl_cur; sl_cur = sl_n1; sl_n1 = sl_n2; sl_n2 = tmp; }
    }
    if (hi == 0) wsf[32 + r32] = l_run;
    asm volatile("s_waitcnt lgkmcnt(0)" ::: "memory");
    const size_t mrow0 = (size_t)b * SEQ + q0 + wid * 32;
#pragma unroll
    for (int r = 0; r < 16; ++r) { const int orow = crow(r, hi); const float rl = 1.f / wsf[32 + orow]; const size_t m = mrow0 + orow;
#pragma unroll
        for (int d0 = 0; d0 < 4; ++d0) { const int col = h * DV + d0 * 32 + r32;
            const float g = bf2f(Z[m * DINP + ZC_GATT + col]);
            const float v = o[d0][r] * rl * g;
            const float vn = xor1_f(v);
            if ((r32 & 1) == 0) *(unsigned*)(YCAT + m * DM + col) = cvtpk(v, vn); } }
    asm volatile("s_waitcnt vmcnt(0) lgkmcnt(0)\n\ts_barrier" ::: "memory");
#undef DMA_TILE
}

__device__ __forceinline__ void attn_unit3(int b, int h, int qb, const bf16_t* Q, const unsigned char* KN, const unsigned char* KR, const unsigned char* VI,
                                           const bf16_t* Z, bf16_t* YCAT, char* shm, const int tid) {
    const int lane = tid & 63, r32 = lane & 31, hi = lane >> 5; const int wid = __builtin_amdgcn_readfirstlane(tid >> 6);
    const int q0 = qb * 256, NT = 4 * (qb + 1);
    const int bh = b * NH + h;
    const unsigned lds0 = (unsigned)(uintptr_t)shm;
    LAS float* wsf = (LAS float*)((LAS char*)shm + LDS_WS) + wid * 64;
    LAS float* wsh = wsf + 4 * hi;
    const unsigned char* knsrc = KN + (size_t)bh * (SEQ / 64) * 16384 + wid * 1024 + lane * 16;
    const unsigned char* krsrc = KR + (size_t)b * (SEQ / 64) * 8192 + wid * 1024 + lane * 16;
    const unsigned char* vsrc = VI + (size_t)bh * (SEQ / 64) * 16384 + wid * 1024 + lane * 16;
#define DMA_TILE(t, slot) do { const unsigned d_ = (unsigned)__builtin_amdgcn_readfirstlane(lds0 + (slot) + wid * 1024); \
        glds16(knsrc + (size_t)(t) * 16384, d_); glds16(knsrc + (size_t)(t) * 16384 + 8192, d_ + 8192); glds16(krsrc + (size_t)(t) * 8192, d_ + 16384); \
        glds16(vsrc + (size_t)(t) * 16384, d_ + VOFF); glds16(vsrc + (size_t)(t) * 16384 + 8192, d_ + VOFF + 8192); } while (0)
    const bf16_t* Qw = Q + ((size_t)(bh * SEQ + q0 + wid * 32 + r32)) * DQK;
    bf16x8 qr[12];
#pragma unroll
    for (int d0 = 0; d0 < 12; ++d0) qr[d0] = *(const bf16x8*)(Qw + d0 * 16 + hi * 8);
#pragma unroll
    for (int d0 = 0; d0 < 12; ++d0) asm volatile("" : "+v"(qr[d0]));
    asm volatile("s_waitcnt vmcnt(0)" ::: "memory");
    DMA_TILE(0, 0);
    float m_run = -1e30f, l_run = 0.f; f32x16 o[4];
#pragma unroll
    for (int d = 0; d < 4; ++d) o[d] = f32x16{};
    const LAS char* shm3 = (const LAS char*)shm;
    const int vb0 = (int)lds0 + VOFF + v_rd_base(lane);
    const int qabs = q0 + wid * 32 + r32;
    f32x16 sA, sB; bf16x8 pa0, pa1; float pmaxN = 0.f;

#define MF(acc, a_, b_) acc = __builtin_amdgcn_mfma_f32_32x32x16_bf16(a_, b_, acc, 0, 0, 0)
#define DMAP(on_, i_, t_, slot_) do { if (on_) { const unsigned d_ = (unsigned)__builtin_amdgcn_readfirstlane(lds0 + (slot_) + wid * 1024); \
        if ((i_) == 0) glds16(knsrc + (size_t)(t_) * 16384, d_); else if ((i_) == 1) glds16(knsrc + (size_t)(t_) * 16384 + 8192, d_ + 8192); \
        else if ((i_) == 2) glds16(krsrc + (size_t)(t_) * 8192, d_ + 16384); else if ((i_) == 3) glds16(vsrc + (size_t)(t_) * 16384, d_ + VOFF); \
        else glds16(vsrc + (size_t)(t_) * 16384 + 8192, d_ + VOFF + 8192); } } while (0)
#ifndef ATT_EXP
#define ATT_EXP 0
#endif
#if ATT_EXP & 1
#define KLD1(dst, kp_, d0) do { dst = *(const LAS bf16x8*)(kp_ + (d0) * 2048); bf16x8 dmy_; asm volatile("ds_read_b128 %0, %1 offset:%2" : "=v"(dmy_) : "v"((int)(uintptr_t)(kp_)), "i"(((d0) * 2048) & 0xffff) : "memory"); asm volatile("" :: "v"(dmy_)); } while (0)
#else
#define KLD1(dst, kp_, d0) dst = *(const LAS bf16x8*)(kp_ + (d0) * 2048)
#endif
#define MASKH(S, T_, hf_) do { if ((T_) >= NT - 4) { const float NEG = -__builtin_inff(); const int kb_ = 64 * (T_) + 32 * (hf_) + 4 * hi; \
        _Pragma("unroll") for (int r = 0; r < 16; ++r) { const int kv = kb_ + (r & 3) + 8 * (r >> 2); if (kv > qabs) S[r] = NEG; } } } while (0)
#define ROWMAX_FIN(mx0, mx1, out) do { float m_ = fmaxf(mx0, mx1); auto rr_ = __builtin_amdgcn_permlane32_swap(__float_as_uint(m_), __float_as_uint(m_), false, false); \
        out = fmaxf(__uint_as_float(rr_[0]), __uint_as_float(rr_[1])); } while (0)
#define DECIDE(pmax_) do { if (!__all((pmax_) - m_run <= THR)) { const float mn_ = fmaxf(m_run, (pmax_)); const float al_ = __builtin_amdgcn_exp2f(m_run - mn_); m_run = mn_; l_run *= al_; \
        if (hi == 0) wsf[r32] = al_; asm volatile("s_waitcnt lgkmcnt(0)" ::: "memory"); \
        _Pragma("unroll") for (int d_ = 0; d_ < 4; ++d_) _Pragma("unroll") for (int r = 0; r < 16; ++r) o[d_][r] *= wsh[(r & 3) + 8 * (r >> 2)]; \
        asm volatile("s_waitcnt lgkmcnt(0)" ::: "memory"); } } while (0)
#define PK4(P, B_, OUT) do { unsigned a0_ = cvtpk(P[B_ + 0], P[B_ + 1]), a1_ = cvtpk(P[B_ + 2], P[B_ + 3]); \
        unsigned b0_ = cvtpk(P[B_ + 4], P[B_ + 5]), b1_ = cvtpk(P[B_ + 6], P[B_ + 7]); \
        auto r0_ = __builtin_amdgcn_permlane32_swap(a0_, b0_, false, false); auto r1_ = __builtin_amdgcn_permlane32_swap(a1_, b1_, false, false); \
        u32x4 w_ = {r0_[0], r1_[0], r0_[1], r1_[1]}; OUT = *reinterpret_cast<bf16x8*>(&w_); } while (0)
#if ATT_EXP & 2
#define SMC2(S, i) do { const float e0_ = __builtin_amdgcn_exp2f(S[i] - m_run), e1_ = __builtin_amdgcn_exp2f(S[(i) + 1] - m_run); \
        float x0_ = __builtin_amdgcn_exp2f(S[i] - l_run), x1_ = __builtin_amdgcn_exp2f(S[(i) + 1] - l_run); x0_ += x1_; asm volatile("" :: "v"(x0_)); \
        S[i] = e0_; S[(i) + 1] = e1_; ps0 += e0_; ps1 += e1_; } while (0)
#else
#define SMC2(S, i) do { const float e0_ = __builtin_amdgcn_exp2f(S[i] - m_run), e1_ = __builtin_amdgcn_exp2f(S[(i) + 1] - m_run); S[i] = e0_; S[(i) + 1] = e1_; ps0 += e0_; ps1 += e1_; } while (0)
#endif
#define SMFIN() do { float ps_ = ps0 + ps1; auto rr_ = __builtin_amdgcn_permlane32_swap(__float_as_uint(ps_), __float_as_uint(ps_), false, false); \
        l_run += __uint_as_float(rr_[0]) + __uint_as_float(rr_[1]); } while (0)
#define TRRD(dst, off) asm volatile("ds_read_b64_tr_b16 %0, %1 offset:%2" : "=&v"(dst) : "v"(vb_), "i"(off) : "memory")
#define TRRD4(P_, d0, hf_) do { constexpr int b_ = v_rd_off(d0, 2 * (hf_), 0); TRRD(P_##l0, b_); TRRD(P_##h0, b_ + 2048); TRRD(P_##l1, b_ + 4096); TRRD(P_##h1, b_ + 6144); } while (0)
#define VF(P_, k) (bf16x8){P_##l##k[0], P_##l##k[1], P_##l##k[2], P_##l##k[3], P_##h##k[0], P_##h##k[1], P_##h##k[2], P_##h##k[3]}
#define LGK(n) asm volatile("s_waitcnt lgkmcnt(" #n ")" ::: "memory")
#define RMC2(S, j) do { mx0 = __builtin_fmaxf(__builtin_fmaxf(mx0, S[j]), S[(j) + 1]); } while (0)
#define RMC4(S, j) do { RMC2(S, j); RMC2(S, (j) + 2); } while (0)

#define HSTEP(SX, SY, T_, HF, TN, HFN, has_next_, dma_on_) do { \
        float ps0 = 0.f, ps1 = 0.f; \
        if (has_next_) { \
            const LAS char* kp_ = shm3 + ((HFN) == 0 ? sl_n1 : sl_cur) + hi * 1024 + r32 * 16 + (HFN) * 512; bf16x8 k0, k1, k2, k3; \
            SY = f32x16{}; \
            KLD1(k0, kp_, 0); KLD1(k1, kp_, 1); KLD1(k2, kp_, 2); KLD1(k3, kp_, 3); SBAR(); \
            MF(SY, k0, qr[0]); SMC2(SX, 0); SBAR(); KLD1(k0, kp_, 4); DMAP(dma_on_, 0, (T_) + 2, sl_n2); SBAR(); \
            MF(SY, k1, qr[1]); SMC2(SX, 2); SBAR(); KLD1(k1, kp_, 5); DMAP(dma_on_, 1, (T_) + 2, sl_n2); SBAR(); \
            MF(SY, k2, qr[2]); SMC2(SX, 4); SBAR(); KLD1(k2, kp_, 6); DMAP(dma_on_, 2, (T_) + 2, sl_n2); SBAR(); \
            MF(SY, k3, qr[3]); SMC2(SX, 6); SBAR(); KLD1(k3, kp_, 7); DMAP(dma_on_, 3, (T_) + 2, sl_n2); SBAR(); \
            MF(SY, k0, qr[4]); SMC2(SX, 8); SBAR(); KLD1(k0, kp_, 8); DMAP(dma_on_, 4, (T_) + 2, sl_n2); SBAR(); \
            MF(SY, k1, qr[5]); SMC2(SX, 10); SBAR(); KLD1(k1, kp_, 9); SBAR(); \
            MF(SY, k2, qr[6]); SMC2(SX, 12); SBAR(); KLD1(k2, kp_, 10); SBAR(); \
            MF(SY, k3, qr[7]); SMC2(SX, 14); SBAR(); KLD1(k3, kp_, 11); SBAR(); \
            MF(SY, k0, qr[8]); PK4(SX, 0, pa0); SBAR(); \
            MF(SY, k1, qr[9]); PK4(SX, 8, pa1); SBAR(); \
            MF(SY, k2, qr[10]); SMFIN(); SBAR(); \
            MF(SY, k3, qr[11]); SBAR(); \
        } else { \
            _Pragma("unroll") for (int i_ = 0; i_ < 16; i_ += 2) SMC2(SX, i_); \
            PK4(SX, 0, pa0); PK4(SX, 8, pa1); SMFIN(); SBAR(); \
        } \
        { const int vb_ = vb0 + sl_cur; s16x4 Al0, Al1, Ah0, Ah1, Bl0, Bl1, Bh0, Bh1, Cl0, Cl1, Ch0, Ch1; \
          float mx0 = -__builtin_inff(); \
          TRRD4(A, 0, HF); TRRD4(B, 1, HF); TRRD4(C, 2, HF); SBAR(); \
          if (has_next_) MASKH(SY, TN, HFN); \
          SBAR(); LGK(8); SBAR(); \
          MF(o[0], pa0, VF(A, 0)); if (has_next_) { RMC4(SY, 0); } SBAR(); MF(o[0], pa1, VF(A, 1)); if (has_next_) { RMC4(SY, 4); } SBAR(); \
          TRRD4(A, 3, HF); LGK(8); SBAR(); \
          MF(o[1], pa0, VF(B, 0)); if (has_next_) { RMC4(SY, 8); } SBAR(); MF(o[1], pa1, VF(B, 1)); if (has_next_) { RMC4(SY, 12); } SBAR(); \
          LGK(4); SBAR(); \
          MF(o[2], pa0, VF(C, 0)); MF(o[2], pa1, VF(C, 1)); SBAR(); \
          LGK(0); SBAR(); \
          MF(o[3], pa0, VF(A, 0)); MF(o[3], pa1, VF(A, 1)); SBAR(); \
          const float mx1 = mx0; \
          if (has_next_) { ROWMAX_FIN(mx0, mx1, pmaxN); DECIDE(pmaxN); } } \
    } while (0)

    int sl_cur = 0, sl_n1 = SLOT, sl_n2 = 2 * SLOT;
    asm volatile("s_waitcnt vmcnt(0) lgkmcnt(0)\n\ts_barrier" ::: "memory");
    DMA_TILE(1, SLOT);
    { const LAS char* kp_ = shm3 + hi * 1024 + r32 * 16; bf16x8 ka, kb;
      sA = f32x16{};
      KLD1(ka, kp_, 0); KLD1(kb, kp_, 1); SBAR();
#pragma unroll
      for (int d2 = 0; d2 < 12; d2 += 2) {
          MF(sA, ka, qr[d2]); SBAR(); if (d2 + 2 < 12) KLD1(ka, kp_, d2 + 2); SBAR();
          MF(sA, kb, qr[d2 + 1]); SBAR(); if (d2 + 3 < 12) KLD1(kb, kp_, d2 + 3); SBAR(); } }
    MASKH(sA, 0, 0);
    { float mx0 = -__builtin_inff();
#pragma unroll
      for (int j = 0; j < 16; j += 2) RMC2(sA, j);
      ROWMAX_FIN(mx0, mx0, pmaxN); DECIDE(pmaxN); }
    for (int T = 0; T < NT; ++T) {
        HSTEP(sA, sB, T, 0, T, 1, true, false);
        const bool more = T + 1 < NT;
        if (more) {
            asm volatile("s_waitcnt vmcnt(0) lgkmcnt(0)\n\ts_barrier" ::: "memory");
        }
        HSTEP(sB, sA, T, 1, T + 1, 0, more, (T + 2 < NT));
        { const int tmp_ = sl_cur; sl_cur = sl_n1; sl_n1 = sl_n2; sl_n2 = tmp_; }
    }
    if (hi == 0) wsf[32 + r32] = l_run;
    asm volatile("s_waitcnt lgkmcnt(0)" ::: "memory");
    { int r32e = r32, hie = hi; asm volatile("" : "+v"(r32e), "+v"(hie));
      const LAS float* wse = wsf + 32 + 4 * hie;
      const size_t mrow0 = (size_t)b * SEQ + q0 + wid * 32 + 4 * hie;
      const bf16_t* zp = Z + mrow0 * DINP + ZC_GATT + h * DV + r32e; bf16_t* yp = YCAT + mrow0 * DM + h * DV + r32e;
#pragma unroll
      for (int r = 0; r < 16; ++r) { const int cr = (r & 3) + 8 * (r >> 2); const float rl = __builtin_amdgcn_rcpf(wse[cr]);
#pragma unroll
          for (int d0 = 0; d0 < 4; ++d0) {
              const float g = bf2f(zp[(size_t)cr * DINP + d0 * 32]);
              const float v = o[d0][r] * rl * g;
              const float vn = xor1_f(v);
              if ((r32e & 1) == 0) *(unsigned*)(yp + (size_t)cr * DM + d0 * 32) = cvtpk(v, vn); } } }
    asm volatile("s_waitcnt vmcnt(0) lgkmcnt(0)\n\ts_barrier" ::: "memory");
#undef DMA_TILE
#undef DMAP
#undef MF
#undef KLD1
#undef MASKH
#undef ROWMAX_FIN
#undef DECIDE
#undef PK4
#undef SMC2
#undef SMFIN
#undef TRRD
#undef TRRD4
#undef VF
#undef LGK
#undef RMC2
#undef RMC4
#undef HSTEP
}
#undef SBAR
}

#define XB_TMO      128
#define XB_XCNT(j)  (256  + 64 * (j))
#define XB_XSUB(j)  (1280 + 64 * (j))
#define XB_XGEN(j)  (2304 + 64 * (j))
#define XB_TOP      3328
#define XB_TOPGEN   3392
#define XCD_BAR_WORDS 3456
#define XB_SPIN_CAP (1u << 18)
__device__ __forceinline__ unsigned xb_ld(unsigned* p)              { return __hip_atomic_load(p, __ATOMIC_RELAXED, __HIP_MEMORY_SCOPE_AGENT); }
__device__ __forceinline__ unsigned xb_add(unsigned* p, unsigned v) { return __hip_atomic_fetch_add(p, v, __ATOMIC_RELAXED, __HIP_MEMORY_SCOPE_AGENT); }
__device__ __forceinline__ unsigned xb_xcc_id() { return (unsigned)__builtin_amdgcn_s_getreg((3 << 11) | 20) & 0xFu; }
#define XB_SPIN(cond, bar) do { unsigned _sp = 0; while (cond) { __builtin_amdgcn_s_sleep(1); \
    if ((++_sp & 255u) == 0u) { if (xb_ld(&(bar)[XB_TMO])) break; if (_sp > XB_SPIN_CAP) { atomicAdd(&(bar)[XB_TMO], 1u); break; } } } } while (0)
struct XcdBarrier { unsigned* bar; unsigned x; volatile LAS unsigned* st; };
__device__ __forceinline__ XcdBarrier xcd_barrier_post(unsigned* bar, volatile LAS unsigned* st) {
    XcdBarrier b; b.bar = bar; b.x = xb_xcc_id(); b.st = st;
    if (threadIdx.x == 0) (void)xb_add(&bar[XB_XCNT(b.x)], 1u);
    return b;
}
__device__ __forceinline__ void xcd_barrier_complete(unsigned* bar, unsigned x, unsigned& nloc, unsigned& nx) {
    const unsigned G = gridDim.x * gridDim.y * gridDim.z;
    unsigned sum, cnt, mine, sp = 0u;
    for (;;) {
        sum = 0u; cnt = 0u; mine = 0u;
#pragma unroll
        for (unsigned j = 0; j < 16; ++j) { const unsigned c = xb_ld(&bar[XB_XCNT(j)]); sum += c; cnt += (c > 0u) ? 1u : 0u; mine = (j == x) ? c : mine; }
        if (sum == G) break;
        __builtin_amdgcn_s_sleep(1);
        if ((++sp & 255u) == 0u) { if (xb_ld(&bar[XB_TMO])) break; if (sp > XB_SPIN_CAP) { atomicAdd(&bar[XB_TMO], 1u); break; } }
    }
    nloc = mine > 0u ? mine : 1u; nx = cnt > 0u ? cnt : 1u;
}
__device__ __forceinline__ void xcd_barrier(const XcdBarrier& b) {
    asm volatile("s_waitcnt vmcnt(0)" ::: "memory");
    __syncthreads();
    if (threadIdx.x == 0) {
        unsigned* bar = b.bar;
        __builtin_amdgcn_s_waitcnt(0);
        unsigned nloc = b.st[0], nx = b.st[1];
        if (nloc == 0u) { xcd_barrier_complete(bar, b.x, nloc, nx); b.st[0] = nloc; b.st[1] = nx; }
        const unsigned old = xb_add(&bar[XB_XSUB(b.x)], 1u);
        const unsigned gen = old / nloc;
        if (old + 1u == (gen + 1u) * nloc) {
            __builtin_amdgcn_fence(__ATOMIC_RELEASE, "agent");
            asm volatile("s_waitcnt vmcnt(0)" ::: "memory");
            const unsigned og = xb_add(&bar[XB_TOP], 1u);
            const unsigned tg = og / nx;
            if (og + 1u == (tg + 1u) * nx) xb_add(&bar[XB_TOPGEN], 1u);
            else XB_SPIN(xb_ld(&bar[XB_TOPGEN]) == tg, bar);
            __builtin_amdgcn_fence(__ATOMIC_ACQUIRE, "agent");
            xb_add(&bar[XB_XGEN(b.x)], 1u);
            asm volatile("s_waitcnt vmcnt(0)" ::: "memory");
        } else {
            XB_SPIN(xb_ld(&bar[XB_XGEN(b.x)]) == gen, bar);
            __builtin_amdgcn_fence(__ATOMIC_ACQUIRE, "agent");
            asm volatile("s_waitcnt vmcnt(0)" ::: "memory");
        }
    }
    __syncthreads();
}

__device__ __forceinline__ float ada_val(const float* adap, const float* bada_l, int l, int b, int e) {
    float s = 0.f;
#pragma unroll
    for (int kc = 0; kc < 16; ++kc) s += adap[((size_t)(kc * 2 + l) * 4 + b) * 3072 + e];
    return s + bada_l[e];
}
struct Args { const void* in[22]; float* out; unsigned char* ws; int ph_lo, ph_hi; };
enum { I_X = 0, I_C, I_POS, I_WADA, I_BADA, I_GPRE, I_GPOST, I_WIN, I_QNG, I_WUQ, I_KVNG, I_WUKV, I_CONVW, I_CONVB, I_CLNG, I_CLNB, I_WPW2, I_SLNG, I_SLNB, I_WS, I_BS, I_WOUT };
constexpr int N_PHASES = 2 + 6 * NLAYER;

__device__ __forceinline__ int wmap(int mat, int n) {
    if (mat == 0) {
        if (n < 448) return n; if (n < 512) return -1;
        const int t = n >> 8, j = n & 127, second = (n >> 7) & 1;
        if (t == 4 || t == 5) return (second ? 1216 : 960) + (t - 4) * 128 + j;
        if (t == 7 || t == 9) return (second ? 2240 : 1728) + (t == 9 ? 128 : 0) + j;
        return n - 64; }
    if (mat == 2) { if (n < 512) return (n >> 7) * DQK + (n & 127); const int n2 = n - 512, h = n2 >> 6, w = n2 & 63; return h * DQK + DNOPE + 32 * (w & 1) + (w >> 1); }
    if (mat == 3) { const int h = (n & 511) >> 7, d = n & 127; return h * 256 + (n >= 512 ? 128 : 0) + d; }
    return n;
}
__device__ __forceinline__ void transpose_item(const float* W, int Nsrc, bf16_t* WT, int Kd, int mat, LAS float* scr, int kb, int nb, int lane) {
    const int k0 = 64 * kb, n0 = 32 * nb; const int src = wmap(mat, n0 + (lane & 31));
#pragma unroll 8
    for (int i = 0; i < 32; ++i) { const int kk = 2 * i + (lane >> 5); scr[kk * 33 + (lane & 31)] = src >= 0 ? W[(size_t)(k0 + kk) * Nsrc + src] : 0.f; }
    asm volatile("s_waitcnt lgkmcnt(0)" ::: "memory");
    const int c = lane & 7;
#pragma unroll
    for (int j = 0; j < 4; ++j) { const int n = (lane >> 3) + 8 * j; const LAS float* s = scr + (8 * c) * 33 + n;
        u32x4 o; o.x = cvtpk(s[0 * 33], s[1 * 33]); o.y = cvtpk(s[2 * 33], s[3 * 33]); o.z = cvtpk(s[4 * 33], s[5 * 33]); o.w = cvtpk(s[6 * 33], s[7 * 33]);
        *(u32x4*)(WT + (size_t)(n0 + n) * Kd + k0 + 8 * c) = o; }
    asm volatile("s_waitcnt lgkmcnt(0)" ::: "memory");
}

__global__ void __launch_bounds__(NTHREADS, 2) hymba_fwd(Args args) {
    extern __shared__ __attribute__((aligned(16))) unsigned char lds[];
    typedef const __attribute__((address_space(4))) Args* KArgP;
    cg::grid_group grid = cg::this_grid();
    const int ph_lo = args.ph_lo, ph_hi = args.ph_hi;
    const int wave_s = __builtin_amdgcn_readfirstlane(threadIdx.x >> 6);
    volatile LAS unsigned* xbst = (volatile LAS unsigned*)((LAS unsigned char*)lds + LDS_BYTES - 64);
    if (threadIdx.x < 4) xbst[threadIdx.x] = 0u;
    __syncthreads();
    const XcdBarrier xbar = xcd_barrier_post((unsigned*)(args.ws + WS_CTL) + CTL_BARW, xbst);

    int ph = ph_lo, rep = 0;
    while (ph < ph_hi) {
        KArgP ap0 = (KArgP)__builtin_amdgcn_kernarg_segment_ptr();
#define ARG(k) (ap->in[k])
#define TID_HERE() int lane; asm volatile("v_mbcnt_lo_u32_b32 %0, -1, 0\n\tv_mbcnt_hi_u32_b32 %0, -1, %0" : "=v"(lane)); const int tid = wave_s * 64 + lane; (void)tid
        const int wave = wave_s;
#define PHASE_ROOTS() \
        KArgP ap = ap0; asm volatile("" : "+s"(ap)); \
        int G = gridDim.x, bx = blockIdx.x; asm volatile("" : "+s"(G), "+s"(bx)); \
        const int vcu = (G % 8 == 0) ? (bx % 8) * (G / 8) + bx / 8 : bx; \
        const int gw = vcu * NWAVES + wave, NGW = G * NWAVES; (void)gw; (void)NGW; \
        unsigned char* ws = ap->ws; float* outp = ap->out; (void)outp; \
        const float* x_in = (const float*)ARG(I_X); (void)x_in; \
        float* adap = (float*)(ws + WS_ADAP); (void)adap; float* mod = (float*)(ws + WS_CTL + CTL_MOD); (void)mod; \
        float* cs_t = (float*)(ws + WS_COS); float* sn_t = (float*)(ws + WS_SIN); (void)cs_t; (void)sn_t; \
        bf16_t* Hb = (bf16_t*)(ws + WS_H); bf16_t* Zb = (bf16_t*)(ws + WS_Z); bf16_t* Y16 = (bf16_t*)(ws + WS_Y); (void)Hb; (void)Zb; (void)Y16; \
        bf16_t* QLN = (bf16_t*)(ws + WS_QLN); bf16_t* KVLN = (bf16_t*)(ws + WS_KVLN); bf16_t* CONVH = (bf16_t*)(ws + WS_CONVH); bf16_t* SGVT = (bf16_t*)(ws + WS_SGVT); (void)QLN; (void)KVLN; (void)CONVH; (void)SGVT; \
        bf16_t* Qb = (bf16_t*)(ws + WS_Q); unsigned char* KNb = ws + WS_KN; unsigned char* KRb = ws + WS_KR; unsigned char* VIb = ws + WS_V; (void)Qb; (void)KNb; (void)KRb; (void)VIb; \
        bf16_t* YCAT = (bf16_t*)(ws + WS_YCAT); (void)YCAT
        if (ph == 0 && PHEN(0)) {
            TID_HERE(); PHASE_ROOTS();
            LAS float* scr = (LAS float*)(lds + wave * 16384);
            {
                constexpr int I0 = 16 * 80, I1 = 16 * 32, I2 = 4 * 24, I3 = 2 * 32, I4 = 4 * 8, IL = I0 + I1 + I2 + I3 + I4;
                for (int it = gw; it < NLAYER * IL; it += NGW) {
                    const int l = it / IL; int r = it % IL;
                    if (r < I0) { transpose_item((const float*)ARG(I_WIN) + (size_t)l * DM * DIN, DIN, (bf16_t*)(ws + WS_WIN) + (size_t)l * DINP * DM, DM, 0, scr, r / 80, r % 80, lane); continue; } r -= I0;
                    if (r < I1) { transpose_item((const float*)ARG(I_WOUT) + (size_t)l * DM * DM, DM, (bf16_t*)(ws + WS_WOUT) + (size_t)l * DM * DM, DM, 1, scr, r / 32, r % 32, lane); continue; } r -= I1;
                    if (r < I2) { transpose_item((const float*)ARG(I_WUQ) + (size_t)l * QLR * 768, 768, (bf16_t*)(ws + WS_WUQ) + (size_t)l * 768 * 256, 256, 2, scr, r / 24, r % 24, lane); continue; } r -= I2;
                    if (r < I3) { transpose_item((const float*)ARG(I_WUKV) + (size_t)l * KVLR * 1024, 1024, (bf16_t*)(ws + WS_WUKV) + (size_t)l * 1024 * 256, 256, 3, scr, r / 32, r % 32, lane); continue; } r -= I3;
                    transpose_item((const float*)ARG(I_WPW2) + (size_t)l * CW * CW, CW, (bf16_t*)(ws + WS_WPW2) + (size_t)l * CW * CW, CW, 4, scr, r / 8, r % 8, lane);
                }
            }
            const int gt = vcu * NTHREADS + tid, NGT = G * NTHREADS;
            for (int i = gt; i < NLAYER * 1024 * 16; i += NGT) { const int row = i >> 4, c8 = (i & 15) * 8;
                *(u32x4*)((bf16_t*)(ws + WS_WUKV) + (size_t)row * 256 + 128 + c8) = (u32x4){0u, 0u, 0u, 0u}; }
            for (int i = gt; i < NLAYER * SG * SCH * SCH; i += NGT) { const int s = i & 127, t = (i >> 7) & 127;
                const float v = s <= t ? ((const float*)ARG(I_WS))[i] : 0.f; ((bf16_t*)(ws + WS_WSM))[i] = (bf16_t)(cvtpk(v, 0.f) & 0xffffu); }
            for (int i = gt; i < MTOK * 32; i += NGT) { const int tok = i >> 5, fi = i & 31;
                const float inv_freq = powf(10000.0f, -(float)(2 * fi) / 64.0f);
                const float ang = (float)((const int*)ARG(I_POS))[tok] * inv_freq;
                cs_t[i] = cosf(ang); sn_t[i] = sinf(ang); }
            for (int it = gw; it < NLAYER * 16 * 48; it += NGW) { const int l = it / 768, r = it % 768, kc = r / 48, nc = r % 48;
                const float* W = (const float*)ARG(I_WADA) + (size_t)l * DM * 3072 + (size_t)(kc * 64) * 3072 + nc * 64 + lane;
                const float* c = (const float*)ARG(I_C) + kc * 64;
                float a0 = 0.f, a1 = 0.f, a2 = 0.f, a3 = 0.f;
#pragma unroll 8
                for (int k = 0; k < 64; ++k) { const float w = W[(size_t)k * 3072];
                    a0 += siluf_(c[k]) * w; a1 += siluf_(c[DM + k]) * w; a2 += siluf_(c[2 * DM + k]) * w; a3 += siluf_(c[3 * DM + k]) * w; }
                float* dst = adap + ((size_t)(kc * 2 + l) * 4) * 3072 + nc * 64 + lane;
                __hip_atomic_store(dst, a0, __ATOMIC_RELAXED, __HIP_MEMORY_SCOPE_AGENT); __hip_atomic_store(dst + 3072, a1, __ATOMIC_RELAXED, __HIP_MEMORY_SCOPE_AGENT);
                __hip_atomic_store(dst + 2 * 3072, a2, __ATOMIC_RELAXED, __HIP_MEMORY_SCOPE_AGENT); __hip_atomic_store(dst + 3 * 3072, a3, __ATOMIC_RELAXED, __HIP_MEMORY_SCOPE_AGENT);
                asm volatile("s_waitcnt vmcnt(0)" ::: "memory");
                unsigned tk = 0;
                if (lane == 0) tk = __hip_atomic_fetch_add((unsigned*)(ws + WS_CTL) + CTL_ADACNT + (l * 48 + nc) * 16, 1u, __ATOMIC_RELAXED, __HIP_MEMORY_SCOPE_AGENT);
                tk = (unsigned)__builtin_amdgcn_readfirstlane((int)tk);
                if (tk == 15u) {
                    const float* bada = (const float*)ARG(I_BADA) + (size_t)l * 3072;
#pragma unroll
                    for (int b = 0; b < 4; ++b) { float s = 0.f;
#pragma unroll
                        for (int k2 = 0; k2 < 16; ++k2) s += __hip_atomic_load(adap + ((size_t)(k2 * 2 + l) * 4 + b) * 3072 + nc * 64 + lane, __ATOMIC_RELAXED, __HIP_MEMORY_SCOPE_AGENT);
                        mod[((size_t)l * 4 + b) * 3072 + nc * 64 + lane] = s + bada[nc * 64 + lane]; }
                } }
        } else if (ph == 1 && PHEN(1)) {
            TID_HERE(); PHASE_ROOTS();
            const float* gp = (const float*)ARG(I_GPRE);
            for (int grp = gw; grp < MTOK / 4; grp += NGW) { const int m0 = grp * 4, b = m0 >> 13;
                f32x4 v[4][4];
#pragma unroll
                for (int k = 0; k < 4; ++k) { const f32x4* xr = (const f32x4*)(x_in + (size_t)(m0 + k) * DM) + lane;
#pragma unroll
                    for (int j = 0; j < 4; ++j) v[k][j] = xr[64 * j]; }
                f32x4 pa[4], pb[4];
#pragma unroll
                for (int j = 0; j < 4; ++j) { const int c = 4 * lane + 256 * j;
                    pb[j] = *(const f32x4*)(mod + (size_t)b * 3072 + c);
                    pa[j] = *(const f32x4*)(gp + c) * (*(const f32x4*)(mod + (size_t)b * 3072 + DM + c) + 1.f); }
#pragma unroll
                for (int k = 0; k < 4; ++k) { float ss = 0.f;
#pragma unroll
                    for (int j = 0; j < 4; ++j) ss += (v[k][j].x * v[k][j].x + v[k][j].y * v[k][j].y) + (v[k][j].z * v[k][j].z + v[k][j].w * v[k][j].w);
                    const float rstd = rsqrtf(wave_sum(ss) * (1.f / DM) + EPS);
                    u32x2* o8 = (u32x2*)(Hb + (size_t)(m0 + k) * DM) + lane;
#pragma unroll
                    for (int j = 0; j < 4; ++j) { const f32x4 hv = (v[k][j] * rstd) * pa[j] + pb[j];
                        u32x2 w; w.x = cvtpk(hv.x, hv.y); w.y = cvtpk(hv.z, hv.w); o8[64 * j] = w; } }
            }
        } else {
            const int l = (ph - 2) / 6, sub = (ph - 2) % 6;
            const int ngemm = (sub == 0 || sub == 4) ? 1 : (sub == 2 ? 3 : 0);
#pragma nounroll
            for (int gi_ = 0; gi_ < ngemm * (1 + ((PROBE_MASK >> 8) & 1)) && PHEN(2); ++gi_) {
                const int gi = gi_ % ngemm;
                TID_HERE(); PHASE_ROOTS();
                pg8::Gemm g; EpiAll E; int Nn, cc = bx;
                if (sub == 0) { g = pg8::Gemm{Hb, (const bf16_t*)(ws + WS_WIN) + (size_t)l * DINP * DM, MTOK, DINP, DM, DM, DM}; Nn = DINP; E = EpiAll{EM_Z1, DINP, Zb, nullptr, nullptr}; }
                else if (sub == 4) { g = pg8::Gemm{YCAT, (const bf16_t*)(ws + WS_WOUT) + (size_t)l * DM * DM, MTOK, DM, DM, DM, DM}; Nn = DM; E = EpiAll{EM_Z, DM, Y16, nullptr, nullptr}; }
                else if (gi == 0) { g = pg8::Gemm{QLN, (const bf16_t*)(ws + WS_WUQ) + (size_t)l * 768 * 256, MTOK, 768, 256, 256, 256}; Nn = 768; E = EpiAll{EM_Q, 0, Qb, cs_t, sn_t}; }
                else if (gi == 1) { g = pg8::Gemm{CONVH, (const bf16_t*)(ws + WS_WPW2) + (size_t)l * CW * CW, MTOK, CW, CW, CW, CW}; Nn = CW; cc = (bx + G / 2) % G; E = EpiAll{EM_PW2, 0, YCAT, Zb, nullptr}; }
                else { g = pg8::Gemm{KVLN, (const bf16_t*)(ws + WS_WUKV) + (size_t)l * 1024 * 256, MTOK, 1024, 256, 256, 256}; Nn = 1024; E = EpiAll{EM_KV, 0, KNb, VIb, nullptr}; }
                pg8::StaticOrder S; S.init(MTOK, Nn, G, cc);
                pg8::gemm_phase<EpiAll>((LAS unsigned char*)lds, g, S, E, tid);
            }
            if (sub == 0) {
            } else if (sub == 1 && PHEN(3)) {
                TID_HERE(); PHASE_ROOTS();
                const float* qng = (const float*)ARG(I_QNG) + l * QLR; const float* kvng = (const float*)ARG(I_KVNG) + l * KVLR;
                const float* cw = (const float*)ARG(I_CONVW) + (size_t)l * CK * CW; const float* cb = (const float*)ARG(I_CONVB) + l * CW;
                const float* clg = (const float*)ARG(I_CLNG) + l * CW; const float* clb = (const float*)ARG(I_CLNB) + l * CW;
                const float* slg = (const float*)ARG(I_SLNG) + l * SW; const float* slb = (const float*)ARG(I_SLNB) + l * SW;
                LAS float* glu = (LAS float*)lds;
                LAS float* cvo = (LAS float*)(lds + 63488);
                LAS bf16_t* sgv = (LAS bf16_t*)(lds + 63488 + 32768);
                float cwv[CK];
#pragma unroll
                for (int j = 0; j < CK; ++j) cwv[j] = cw[j * CW + (tid & 255)];
                const float cbias = cb[tid & 255];
                const f32x4 clg4 = *(const f32x4*)(clg + 4 * lane), clb4 = *(const f32x4*)(clb + 4 * lane);
                u32x4 ga[4]; u32x2 zq[4], zkv[4], zsv[4]; unsigned short zk1[4], zk2[4]; float rc[4], rs[4];
#define P2A_LOAD(tt_) do { const int b_ = (tt_) >> 8, s0_ = ((tt_) & 255) * 32; const size_t m0_ = (size_t)b_ * SEQ + s0_; \
                    _Pragma("unroll") for (int pass = 0; pass < 4; ++pass) { const int r = pass * 16 + (tid >> 5), c8 = (tid & 31) * 8; const int s = s0_ - 30 + r; \
                        ga[pass] = *(const u32x4*)(Zb + ((size_t)b_ * SEQ + (s >= 0 ? (r < 62 ? s : s0_) : 0)) * DINP + ZC_CA + c8); \
                        if (r >= 62 || s < 0) ga[pass] = (u32x4){0u, 0u, 0u, 0u}; } \
                    _Pragma("unroll") for (int i = 0; i < 4; ++i) { const size_t m = m0_ + 4 * wave + i; const bf16_t* zr = Zb + m * DINP; \
                        zq[i] = *(const u32x2*)(zr + ZC_Q + 4 * lane); zkv[i] = *(const u32x2*)(zr + ZC_KV + 4 * (lane & 31)); zsv[i] = *(const u32x2*)(zr + ZC_SV + 4 * lane); \
                        zk1[i] = zr[ZC_KR + (lane & 31)]; zk2[i] = zr[ZC_KR + 32 + (lane & 31)]; rc[i] = cs_t[m * 32 + (lane & 31)]; rs[i] = sn_t[m * 32 + (lane & 31)]; } } while (0)
                P2A_LOAD(vcu < MTOK / 32 ? vcu : 0);
                for (int tt = vcu; tt < MTOK / 32; tt += G) {
                    const int b = tt >> 8, s0 = (tt & 255) * 32; const size_t m0 = (size_t)b * SEQ + s0;
                    const f32x4 gq4 = *(const f32x4*)(qng + 4 * lane), gkv4 = *(const f32x4*)(kvng + 4 * (lane & 31)), gs4 = *(const f32x4*)(slg + 4 * lane), bs4 = *(const f32x4*)(slb + 4 * lane);
#pragma unroll
                    for (int pass = 0; pass < 4; ++pass) { const int r = pass * 16 + (tid >> 5), c8 = (tid & 31) * 8;
                        if (r < 62) { const u32x4 a = ga[pass];
                            *(LAS f32x4*)(glu + r * 256 + c8) = (f32x4){lo_bf(a.x), hi_bf(a.x), lo_bf(a.y), hi_bf(a.y)}; *(LAS f32x4*)(glu + r * 256 + c8 + 4) = (f32x4){lo_bf(a.z), hi_bf(a.z), lo_bf(a.w), hi_bf(a.w)}; } }
#pragma unroll
                    for (int i = 0; i < 4; ++i) { const int tl = 4 * wave + i; const size_t m = m0 + tl; const int s = s0 + tl;
                        {
                            const u32x2 z = zq[i]; const float x0 = lo_bf(z.x), x1 = hi_bf(z.x), x2 = lo_bf(z.y), x3 = hi_bf(z.y);
                            const float rstd = rsqrtf(wave_sum((x0 * x0 + x1 * x1) + (x2 * x2 + x3 * x3)) * (1.f / QLR) + EPS);
                            u32x2 w; w.x = cvtpk(x0 * rstd * gq4.x, x1 * rstd * gq4.y); w.y = cvtpk(x2 * rstd * gq4.z, x3 * rstd * gq4.w);
                            *(u32x2*)(QLN + m * 256 + 4 * lane) = w; }
                        {
                            const u32x2 z = zkv[i]; const bool lo32 = lane < 32;
                            const float x0 = lo32 ? lo_bf(z.x) : 0.f, x1 = lo32 ? hi_bf(z.x) : 0.f, x2 = lo32 ? lo_bf(z.y) : 0.f, x3 = lo32 ? hi_bf(z.y) : 0.f;
                            const float rstd = rsqrtf(wave_sum((x0 * x0 + x1 * x1) + (x2 * x2 + x3 * x3)) * (1.f / KVLR) + EPS);
                            u32x2 w; w.x = cvtpk(x0 * rstd * gkv4.x, x1 * rstd * gkv4.y); w.y = cvtpk(x2 * rstd * gkv4.z, x3 * rstd * gkv4.w);
                            *(u32x2*)(KVLN + m * 256 + 4 * lane) = w; }
                        if (lane < 32) {
                            const float x1 = bf2f(zk1[i]), x2 = bf2f(zk2[i]); const float c = rc[i], sn = rs[i];
                            const size_t off = ((size_t)(b * (SEQ / 64) + (s >> 6))) * 8192 + (lane >> 2) * 1024 + (s & 63) * 16 + (lane & 3) * 4;
                            *(unsigned*)(KRb + off) = cvtpk(x1 * c - x2 * sn, x2 * c + x1 * sn); }
                        {
                            const u32x2 z = zsv[i];
                            const float x0 = geluf_(lo_bf(z.x)), x1 = geluf_(hi_bf(z.x)), x2 = geluf_(lo_bf(z.y)), x3 = geluf_(hi_bf(z.y));
                            const float mean = wave_sum((x0 + x1) + (x2 + x3)) * (1.f / SW);
                            const float d0 = x0 - mean, d1 = x1 - mean, d2 = x2 - mean, d3 = x3 - mean;
                            const float rstd = rsqrtf(wave_sum((d0 * d0 + d1 * d1) + (d2 * d2 + d3 * d3)) * (1.f / SW) + EPS);
                            u32x2 w; w.x = cvtpk(d0 * rstd * gs4.x + bs4.x, d1 * rstd * gs4.y + bs4.y); w.y = cvtpk(d2 * rstd * gs4.z + bs4.z, d3 * rstd * gs4.w + bs4.w);
                            *(LAS u32x2*)(sgv + tl * 256 + 4 * lane) = w; }
                    }
                    __syncthreads();
                    { const int tn = tt + G; P2A_LOAD(tn < MTOK / 32 ? tn : tt); }
                    { const int c = tid & 255, half = tid >> 8;
                      for (int g4 = 0; g4 < 4; ++g4) { const int tb = 16 * half + 4 * g4; float v[34];
#pragma unroll
                          for (int k = 0; k < 34; ++k) v[k] = glu[(tb + k) * 256 + c];
#pragma unroll
                          for (int i = 0; i < 4; ++i) { float a = cbias;
#pragma unroll
                              for (int j = 0; j < CK; ++j) a += cwv[j] * v[i + j];
                              cvo[(tb + i) * 256 + c] = a; } } }
                    __syncthreads();
                    for (int i = 0; i < 4; ++i) { const int tl = 4 * wave + i; const size_t m = m0 + tl;
                        const f32x4 xv = *(const LAS f32x4*)(cvo + tl * 256 + 4 * lane);
                        const float mean = wave_sum((xv.x + xv.y) + (xv.z + xv.w)) * (1.f / CW);
                        const float d0 = xv.x - mean, d1 = xv.y - mean, d2 = xv.z - mean, d3 = xv.w - mean;
                        const float rstd = rsqrtf(wave_sum((d0 * d0 + d1 * d1) + (d2 * d2 + d3 * d3)) * (1.f / CW) + EPS);
                        const f32x4 g = clg4, bb = clb4;
                        u32x2 w; w.x = cvtpk(siluf_(d0 * rstd * g.x + bb.x), siluf_(d1 * rstd * g.y + bb.y)); w.y = cvtpk(siluf_(d2 * rstd * g.z + bb.z), siluf_(d3 * rstd * g.w + bb.w));
                        *(u32x2*)(CONVH + m * 256 + 4 * lane) = w; }
                    { const int c = tid & 255, half = tid >> 8; unsigned pk[8];
#pragma unroll
                      for (int k = 0; k < 8; ++k) { const unsigned lo = sgv[(16 * half + 2 * k) * 256 + c], hi2 = sgv[(16 * half + 2 * k + 1) * 256 + c]; pk[k] = lo | (hi2 << 16); }
                      bf16_t* dst = SGVT + ((size_t)(m0 >> 7) * 256 + c) * 128 + (s0 & 127) + 16 * half;
                      *(u32x4*)dst = (u32x4){pk[0], pk[1], pk[2], pk[3]}; *(u32x4*)(dst + 8) = (u32x4){pk[4], pk[5], pk[6], pk[7]}; }
                    __syncthreads();
                }
#undef P2A_LOAD
            } else if (sub == 2 && PHEN(4)) {
                TID_HERE(); PHASE_ROOTS();
                { const bf16_t* WsM = (const bf16_t*)(ws + WS_WSM) + (size_t)l * SG * SCH * SCH; const float* bs = (const float*)ARG(I_BS) + l * SG * SCH;
                  const int r32 = lane & 31, hi = lane >> 5, gq = wave >> 1, th = wave & 1;
                  constexpr int UP = 528;
                  LAS unsigned char* ub = (LAS unsigned char*)lds;
                  for (int ck_ = vcu; ck_ < (MTOK / SCH) * (1 + ((PROBE_MASK >> 9) & 1)); ck_ += G) { const int ck = ck_ % (MTOK / SCH);
                      const size_t mc = (size_t)ck * SCH;
                      const bf16_t* Wb = WsM + ((size_t)gq * SCH + 64 * th + r32) * SCH + 8 * hi;
                      const bf16_t* Vb = SGVT + ((size_t)ck * 256 + gq * 64 + r32) * SCH + 8 * hi;
                      bf16x8 wf[2][4], vf[2][4];
#pragma unroll
                      for (int ks = 0; ks < 4; ++ks) { wf[0][ks] = *(const bf16x8*)(Wb + 16 * ks); wf[1][ks] = *(const bf16x8*)(Wb + 32 * SCH + 16 * ks);
                                                       vf[0][ks] = *(const bf16x8*)(Vb + 16 * ks); vf[1][ks] = *(const bf16x8*)(Vb + 32 * SCH + 16 * ks); }
#pragma unroll
                      for (int p = 0; p < 8; ++p) { const int idx = p * NTHREADS + tid, t = idx >> 5, c8 = (idx & 31) * 8;
                          const u32x4 o = *(const u32x4*)(Zb + (mc + t) * DINP + ZC_SU + c8);
                          *(LAS u32x4*)(ub + t * UP + c8 * 2) = o; }
                      f32x16 acc[2][2];
#pragma unroll
                      for (int a = 0; a < 2; ++a)
#pragma unroll
                          for (int bq = 0; bq < 2; ++bq) acc[a][bq] = f32x16{};
#pragma unroll
                      for (int kh = 0; kh < 2; ++kh) {
#pragma unroll
                          for (int ks = 0; ks < 4; ++ks) {
                              acc[0][0] = __builtin_amdgcn_mfma_f32_32x32x16_bf16(vf[0][ks], wf[0][ks], acc[0][0], 0, 0, 0);
                              acc[0][1] = __builtin_amdgcn_mfma_f32_32x32x16_bf16(vf[0][ks], wf[1][ks], acc[0][1], 0, 0, 0);
                              acc[1][0] = __builtin_amdgcn_mfma_f32_32x32x16_bf16(vf[1][ks], wf[0][ks], acc[1][0], 0, 0, 0);
                              acc[1][1] = __builtin_amdgcn_mfma_f32_32x32x16_bf16(vf[1][ks], wf[1][ks], acc[1][1], 0, 0, 0);
                          }
                          if (kh == 0) {
#pragma unroll
                              for (int ks = 0; ks < 4; ++ks) { wf[0][ks] = *(const bf16x8*)(Wb + 64 + 16 * ks); wf[1][ks] = *(const bf16x8*)(Wb + 32 * SCH + 64 + 16 * ks);
                                                               vf[0][ks] = *(const bf16x8*)(Vb + 64 + 16 * ks); vf[1][ks] = *(const bf16x8*)(Vb + 32 * SCH + 64 + 16 * ks); }
                          }
                      }
                      __syncthreads();
#pragma unroll
                      for (int rb = 0; rb < 2; ++rb) { const int t = 64 * th + 32 * rb + r32; const float bt = bs[gq * SCH + t];
#pragma unroll
                          for (int cb = 0; cb < 2; ++cb)
#pragma unroll
                              for (int q4 = 0; q4 < 4; ++q4) { LAS u32x2* p = (LAS u32x2*)(ub + t * UP + (gq * 64 + 32 * cb + 8 * q4 + 4 * hi) * 2);
                                  const u32x2 up = *p; u32x2 w;
                                  w.x = cvtpk((acc[cb][rb][4 * q4 + 0] + bt) * lo_bf(up.x), (acc[cb][rb][4 * q4 + 1] + bt) * hi_bf(up.x));
                                  w.y = cvtpk((acc[cb][rb][4 * q4 + 2] + bt) * lo_bf(up.y), (acc[cb][rb][4 * q4 + 3] + bt) * hi_bf(up.y));
                                  *p = w; } }
                      __syncthreads();
#pragma unroll
                      for (int p = 0; p < 8; ++p) { const int idx = p * NTHREADS + tid, t = idx >> 5, c8 = (idx & 31) * 8;
                          *(u32x4*)(YCAT + (mc + t) * DM + 768 + c8) = *(const LAS u32x4*)(ub + t * UP + c8 * 2); }
                      __syncthreads();
                  } }
            } else if (sub == 3 && PHEN(5)) {
                TID_HERE(); PHASE_ROOTS();
                const int nun = (NB * NH * 32 + G - 1) / G;
#pragma nounroll
                for (int i = 0; i < nun; ++i) {
                    const int u_ = vcu + i * G;
                    int bh = u_ >> 5, qb = 31 - (u_ & 31);
                    if (G == 256) { bh = vcu >> 4; qb = (i == 0) ? 31 - (vcu & 15) : (vcu & 15); }
                    if (bh < NB * NH) att::attn_unit3(bh >> 2, bh & 3, qb, Qb, KNb, KRb, VIb, Zb, YCAT, (char*)lds, tid);
                }
            } else if (sub == 5 && PHEN(7)) {
                TID_HERE(); PHASE_ROOTS();
                const float* xsrc = (l == 0) ? x_in : (const float*)outp;
                const float* gpost = (const float*)ARG(I_GPOST) + l * DM;
                const float* modl = mod + (size_t)l * 4 * 3072; const float* mod1 = mod + (size_t)4 * 3072; const float* gp1 = (const float*)ARG(I_GPRE) + DM;
                for (int grp = gw; grp < MTOK / 4; grp += NGW) { const int m0 = grp * 4, b = m0 >> 13;
                    u32x2 yv[4][4]; f32x4 xv[4][4];
#pragma unroll
                    for (int k = 0; k < 4; ++k) { const u32x2* yr = (const u32x2*)(Y16 + (size_t)(m0 + k) * DM) + lane; const f32x4* xr = (const f32x4*)(xsrc + (size_t)(m0 + k) * DM) + lane;
#pragma unroll
                        for (int j = 0; j < 4; ++j) { yv[k][j] = yr[64 * j]; xv[k][j] = xr[64 * j]; } }
                    f32x4 pg[4];
#pragma unroll
                    for (int j = 0; j < 4; ++j) { const int c = 4 * lane + 256 * j; pg[j] = *(const f32x4*)(modl + (size_t)b * 3072 + 2 * DM + c) * *(const f32x4*)(gpost + c); }
                    float rstd2[4];
#pragma unroll
                    for (int k = 0; k < 4; ++k) { float ss = 0.f; f32x4 y[4];
#pragma unroll
                        for (int j = 0; j < 4; ++j) { y[j] = (f32x4){lo_bf(yv[k][j].x), hi_bf(yv[k][j].x), lo_bf(yv[k][j].y), hi_bf(yv[k][j].y)};
                            ss += (y[j].x * y[j].x + y[j].y * y[j].y) + (y[j].z * y[j].z + y[j].w * y[j].w); }
                        const float rstd = rsqrtf(wave_sum(ss) * (1.f / DM) + EPS);
                        f32x4* orow = (f32x4*)(outp + (size_t)(m0 + k) * DM) + lane; float ss2 = 0.f;
#pragma unroll
                        for (int j = 0; j < 4; ++j) { xv[k][j] = xv[k][j] + (y[j] * rstd) * pg[j]; orow[64 * j] = xv[k][j];
                            ss2 += (xv[k][j].x * xv[k][j].x + xv[k][j].y * xv[k][j].y) + (xv[k][j].z * xv[k][j].z + xv[k][j].w * xv[k][j].w); }
                        rstd2[k] = rsqrtf(wave_sum(ss2) * (1.f / DM) + EPS); }
                    if (l == 0) {
                        f32x4 pa[4], pb[4];
#pragma unroll
                        for (int j = 0; j < 4; ++j) { const int c = 4 * lane + 256 * j;
                            pb[j] = *(const f32x4*)(mod1 + (size_t)b * 3072 + c);
                            pa[j] = *(const f32x4*)(gp1 + c) * (*(const f32x4*)(mod1 + (size_t)b * 3072 + DM + c) + 1.f); }
#pragma unroll
                        for (int k = 0; k < 4; ++k) { u32x2* o8 = (u32x2*)(Hb + (size_t)(m0 + k) * DM) + lane;
#pragma unroll
                            for (int j = 0; j < 4; ++j) { const f32x4 hv = (xv[k][j] * rstd2[k]) * pa[j] + pb[j];
                                u32x2 w; w.x = cvtpk(hv.x, hv.y); w.y = cvtpk(hv.z, hv.w); o8[64 * j] = w; } }
                    }
                }
            }
        }
        { bool again = false;
          if (rep == 0 && PROBE_MASK != 0) { if (ph == 0) again = (PROBE_MASK >> 7) & 1; else if (ph == 1) again = (PROBE_MASK >> 6) & 1; else if (ph >= 2) { const int sub_ = (ph - 2) % 6, l_ = (ph - 2) / 6; again = ((PROBE_MASK >> sub_) & 1) && !(sub_ == 5 && l_ == 1); } }
          if (again) rep = 1; else { rep = 0; ++ph; } }
        if (ph < ph_hi) { if (ph_lo < 0) grid.sync(); else xcd_barrier(xbar); }
    }
}

extern "C" void kernel_launch(void* const* d_in, const int* in_sizes, int n_in, void* d_out, int out_size, void* d_ws, size_t ws_size, hipStream_t stream) {
    static int grid = 0;
    if (grid == 0) {
        if (n_in != 22 || in_sizes[0] != MTOK * DM || out_size != MTOK * DM || ws_size < WS_END) {
            fprintf(stderr, "kernel_launch: unexpected shapes (n_in %d, in0 %d, out %d, ws %zu); nothing launched\n", n_in, n_in > 0 ? in_sizes[0] : -1, out_size, ws_size); grid = -1; return; }
        int dev = 0, cus = 0, per_cu = 0;
        (void)hipGetDevice(&dev); (void)hipDeviceGetAttribute(&cus, hipDeviceAttributeMultiprocessorCount, dev);
        if (hipFuncSetAttribute((const void*)hymba_fwd, hipFuncAttributeMaxDynamicSharedMemorySize, LDS_BYTES) != hipSuccess) { fprintf(stderr, "kernel_launch: hipFuncSetAttribute failed\n"); grid = -1; return; }
        if (hipOccupancyMaxActiveBlocksPerMultiprocessor(&per_cu, (const void*)hymba_fwd, NTHREADS, LDS_BYTES) != hipSuccess || per_cu < 1) { fprintf(stderr, "kernel_launch: occupancy query says %d blocks per CU\n", per_cu); per_cu = 1; }
        (void)hipGetLastError();
        grid = cus > 0 ? cus : 256;
    }
    if (grid < 0) return;
    (void)hipMemsetAsync((char*)d_ws + WS_CTL, 0, CTL_BYTES, stream);
    Args a{};
    for (int i = 0; i < 22; ++i) a.in[i] = d_in[i];
    a.out = (float*)d_out; a.ws = (unsigned char*)d_ws;
#if MK_N_LAUNCHES == 1
    a.ph_lo = 0; a.ph_hi = N_PHASES;
    { void* kargs[] = {&a};
      hipError_t e = hipLaunchCooperativeKernel((const void*)hymba_fwd, dim3(grid), dim3(NTHREADS), kargs, LDS_BYTES, stream);
      if (e != hipSuccess) fprintf(stderr, "cooperative launch failed: %s (grid %d)\n", hipGetErrorString(e), grid); }
#else
    for (int ph = 0; ph < N_PHASES; ++ph) { a.ph_lo = ph; a.ph_hi = ph + 1; void* kargs[] = {&a};
        hipError_t e = hipLaunchCooperativeKernel((const void*)hymba_fwd, dim3(grid), dim3(NTHREADS), kargs, LDS_BYTES, stream);
        if (e != hipSuccess) { fprintf(stderr, "launch %d failed: %s (grid %d)\n", ph, hipGetErrorString(e), grid); break; } }
#endif
}
```

```cpp
#include <hip/hip_runtime.h>
#include <hip/hip_cooperative_groups.h>
#include <cstdio>
#include <cstdint>
namespace cg = cooperative_groups;

#ifndef MK_N_LAUNCHES
#define MK_N_LAUNCHES 1
#endif

#define LAS __attribute__((address_space(3)))
#ifndef ATT_EXP_TOP
#define ATT_EXP_TOP 0
#endif
#ifndef STAGGER_US
#define STAGGER_US 0
#endif
#ifndef PROBE_MASK
#define PROBE_MASK 0
#endif
#ifndef PHMASK
#define PHMASK 0xff
#endif
#define PHEN(k) (((PHMASK) >> (k)) & 1)
typedef unsigned short bf16_t;
typedef short bf16x8 __attribute__((ext_vector_type(8)));
typedef short s16x4 __attribute__((ext_vector_type(4)));
typedef float f32x2 __attribute__((ext_vector_type(2)));
typedef float f32x4 __attribute__((ext_vector_type(4)));
typedef float f32x16 __attribute__((ext_vector_type(16)));
typedef unsigned u32x2 __attribute__((ext_vector_type(2)));
typedef unsigned u32x4 __attribute__((ext_vector_type(4)));

constexpr int DM = 1024, NB = 4, SEQ = 8192, MTOK = NB * SEQ, NLAYER = 2;
constexpr int NH = 4, DNOPE = 128, DROPE = 64, DQK = 192, DV = 128;
constexpr int QLR = 256, KVLR = 128, DIN = 2496, DINP = 2560;
constexpr int CW = 256, CK = 31, SW = 256, SG = 4, SCH = 128;
constexpr float EPS = 1e-6f;
constexpr int ZC_Q = 0, ZC_KV = 256, ZC_KR = 384, ZC_GATT = 512, ZC_CA = 1024, ZC_CB = 1280, ZC_GC = 1536, ZC_SU = 1792, ZC_SV = 2048, ZC_GS = 2304;
constexpr float QSCALE = 0.07216878364870323f * 1.4426950408889634f;

constexpr size_t MiB = 1u << 20;
constexpr size_t WS_CTL = 0, CTL_BYTES = 1 * MiB;
constexpr size_t CTL_BARW = 1024;
constexpr size_t CTL_ADACNT = 8192;
constexpr size_t CTL_MOD = 65536;
constexpr size_t WS_COS = 1 * MiB, WS_SIN = 5 * MiB;
constexpr size_t WS_WIN = 9 * MiB;
constexpr size_t WS_WOUT = 19 * MiB;
constexpr size_t WS_WUQ = 23 * MiB;
constexpr size_t WS_WUKV = 24 * MiB;
constexpr size_t WS_WPW2 = 25 * MiB;
constexpr size_t WS_WSM = 26 * MiB;
constexpr size_t WS_ADAP = 27 * MiB;
constexpr size_t WS_H = 32 * MiB;
constexpr size_t WS_Z = 96 * MiB;
constexpr size_t WS_Y = WS_Z;
constexpr size_t WS_QLN = 256 * MiB;
constexpr size_t WS_KVLN = 272 * MiB;
constexpr size_t WS_CONVH = 288 * MiB;
constexpr size_t WS_SGVT = 304 * MiB;
constexpr size_t WS_Q = 320 * MiB;
constexpr size_t WS_KN = 368 * MiB;
constexpr size_t WS_KR = 400 * MiB;
constexpr size_t WS_V = 408 * MiB;
constexpr size_t WS_YCAT = 440 * MiB;
constexpr size_t WS_END = 504 * MiB;

constexpr int LDS_BYTES = 147456;
constexpr int NTHREADS = 512, NWAVES = 8;

__device__ __forceinline__ float bf2f(unsigned short u) { return __uint_as_float(((unsigned)u) << 16); }
__device__ __forceinline__ unsigned cvtpk(float lo, float hi) { unsigned r; asm("v_cvt_pk_bf16_f32 %0, %1, %2" : "=v"(r) : "v"(lo), "v"(hi)); return r; }
__device__ __forceinline__ float lo_bf(unsigned w) { return __uint_as_float(w << 16); }
__device__ __forceinline__ float hi_bf(unsigned w) { return __uint_as_float(w & 0xffff0000u); }
#define dpp_f(v, ctrl) __int_as_float(__builtin_amdgcn_update_dpp(0, __float_as_int(v), (ctrl), 0xf, 0xf, true))
#define DPP_XOR1 0xB1
#define DPP_XOR2 0x4E
#define DPP_HMIRROR 0x141
#define DPP_MIRROR 0x140
__device__ __forceinline__ float xor1_f(float v) { return dpp_f(v, DPP_XOR1); }
__device__ __forceinline__ float wave_sum(float v) {
    v += dpp_f(v, DPP_XOR1); v += dpp_f(v, DPP_XOR2); v += dpp_f(v, DPP_HMIRROR); v += dpp_f(v, DPP_MIRROR);
    const int iv = __float_as_int(v);
    return (__int_as_float(__builtin_amdgcn_readlane(iv, 0)) + __int_as_float(__builtin_amdgcn_readlane(iv, 16))) +
           (__int_as_float(__builtin_amdgcn_readlane(iv, 32)) + __int_as_float(__builtin_amdgcn_readlane(iv, 48)));
}
__device__ __forceinline__ float sigmoidf_(float x) { return __builtin_amdgcn_rcpf(1.f + __builtin_amdgcn_exp2f(-1.4426950408889634f * x)); }
__device__ __forceinline__ float siluf_(float x) { return x * __builtin_amdgcn_rcpf(1.f + __builtin_amdgcn_exp2f(-1.4426950408889634f * x)); }
__device__ __forceinline__ float geluf_(float v) {
    const float av = __builtin_fabsf(v), t = __builtin_amdgcn_rcpf(av * 0.2316418882f + 1.0f);
    float q = t * 0.5307027145f + (-0.7265760135f); q = q * t + 0.7107068705f; q = q * t + (-0.142248368f); q = q * t + 0.127414796f; q = q * t;
    const float e = __builtin_amdgcn_exp2f((v * v) * (-0.72134752044f));
    const float m = v * (q * e);
    return v < 0.f ? m : v - m;
}

namespace pg8 {
constexpr int BM = 256, BK = 64, HALF = 128, HTB = HALF * BK * 2, STAGE_BYTES = 8 * HTB, NXCD = 8, WGM = 8;
__host__ __device__ __forceinline__ int lds_byte(int r, int c) { const int st = (r >> 4) * 2 + (c >> 5), rr = r & 15, cc = c & 31, ob = rr * 64 + cc * 2; return st * 1024 + (ob ^ (((ob >> 9) & 1) << 5)); }
__host__ __device__ __forceinline__ void stage_rc(int b, int& R, int& C) { const int st = b / 1024, sb = b % 1024, swz = sb ^ (((sb >> 9) & 1) << 5); R = (st >> 1) * 16 + swz / 64; C = (st & 1) * 32 + (swz % 64) / 2; }
__host__ __device__ __forceinline__ int perm32(int rho) { const int n = rho >> 4, i = rho & 15; return 8 * (i >> 2) + 4 * n + (i & 3); }

struct Unit { int pm, pn; };
struct Gemm { const bf16_t* A; const bf16_t* Bt; int M, N, K, lda, ldb; };

struct StaticOrder {
    int nM, nN, nwg, G, c;
    __host__ __device__ void init(int M, int N, int G_, int c_) { nM = M / BM; nN = N / BM; nwg = nM * nN; G = G_; c = c_; }
    __host__ __device__ bool next(int i, Unit& u) const {
        const long L = (long)i * G + c; if (L >= nwg) return false;
        int wgid = (int)L; { const int q = nwg / NXCD, r = nwg % NXCD, xcd = wgid % NXCD, off = wgid / NXCD; wgid = (xcd < r ? xcd * (q + 1) : r * (q + 1) + (xcd - r) * q) + off; }
        const int nig = WGM * nN, gid = wgid / nig, fm = gid * WGM, gsz = (nM - fm) < WGM ? (nM - fm) : WGM;
        u.pm = fm + ((wgid % nig) % gsz); u.pn = (wgid % nig) / gsz; return true;
    }
};

template <class Epi>
__device__ __forceinline__ void gemm_phase(LAS unsigned char* lds, const Gemm g, const StaticOrder& S, const Epi& E, const int tid) {
    const int wid = __builtin_amdgcn_readfirstlane(tid >> 6), lane = tid & 63, wr = wid >> 2, wc = wid & 3, fr = lane & 15, fq = lane >> 4;
    const int K = g.K, nt = K / BK;
    unsigned voffA[2], voffB[2];
#pragma unroll
    for (int i = 0; i < 2; ++i) { int R, C; stage_rc(tid * 16 + i * 8192, R, C); const int Rb = Epi::PERM ? ((R & ~31) + perm32(R & 31)) : R;
        voffA[i] = (unsigned)(R * g.lda + C) * 2u; voffB[i] = (unsigned)(Rb * g.ldb + C) * 2u; }
    const size_t kstep = (size_t)(BK * 2);
    const size_t hstepA = (size_t)HALF * g.lda * 2, hstepB = (size_t)HALF * g.ldb * 2;
    const size_t tstepA = 2 * hstepA, tstepB = 2 * hstepB;
    const unsigned ldsw = (unsigned)wid * 1024u;
    const int aoff = lds_byte(wr * 64 + fr, fq * 8), boff = lds_byte(wc * 32 + fr, fq * 8);
#define PG8_SA(b, h) (((b) * 2 + (h)) * HTB)
#define PG8_SB(b, h) ((4 + (b) * 2 + (h)) * HTB)
#define PG8_STAGE(bufoff, gbase, voff) do { _Pragma("unroll") for (int _i = 0; _i < 2; ++_i) \
        __builtin_amdgcn_global_load_lds((const unsigned*)((const char*)(gbase) + (voff)[_i]), (LAS unsigned*)(lds + (bufoff) + ldsw + _i * 8192), 16, 0, 0); } while (0)
#define PG8_LDA(dst, b, h) do { _Pragma("unroll") for (int m = 0; m < 4; ++m) _Pragma("unroll") for (int k = 0; k < 2; ++k) dst[m][k] = *(const LAS bf16x8*)(lds + PG8_SA(b, h) + aoff + m * 2048 + k * 1024); } while (0)
#define PG8_LDB(dst, b, h) do { _Pragma("unroll") for (int n = 0; n < 2; ++n) _Pragma("unroll") for (int k = 0; k < 2; ++k) dst[n][k] = *(const LAS bf16x8*)(lds + PG8_SB(b, h) + boff + n * 2048 + k * 1024); } while (0)
#define PG8_MMA(ai, bj, At, Bt) do { __builtin_amdgcn_s_setprio(1); _Pragma("unroll") for (int m = 0; m < 4; ++m) _Pragma("unroll") for (int n = 0; n < 2; ++n) _Pragma("unroll") for (int k = 0; k < 2; ++k) \
        acc[ai][bj][m][n] = __builtin_amdgcn_mfma_f32_16x16x32_bf16(Bt[n][k], At[m][k], acc[ai][bj][m][n], 0, 0, 0); __builtin_amdgcn_s_setprio(0); } while (0)
#define PG8_WAIT_V(n) asm volatile("s_waitcnt vmcnt(" #n ")" ::: "memory")
#define PG8_WAIT_L(n) asm volatile("s_waitcnt lgkmcnt(" #n ")" ::: "memory")
#define PG8_BAR __builtin_amdgcn_s_barrier()
#define PG8_SCHED __builtin_amdgcn_sched_barrier(0)
    Unit cur, nxt; int ui = 0;
    if (!S.next(0, cur)) return;
    f32x4 acc[2][2][4][2];
#pragma unroll
    for (int a = 0; a < 2; ++a)
#pragma unroll
        for (int b = 0; b < 2; ++b)
#pragma unroll
            for (int m = 0; m < 4; ++m)
#pragma unroll
                for (int n = 0; n < 2; ++n) acc[a][b][m][n] = (f32x4){0.f, 0.f, 0.f, 0.f};
    bf16x8 At[4][2], B0[2][2], B1[2][2];
    const char* cA = (const char*)g.A + (size_t)cur.pm * tstepA; const char* cB = (const char*)g.Bt + (size_t)cur.pn * tstepB;
    PG8_STAGE(PG8_SB(0, 0), cB, voffB); PG8_STAGE(PG8_SB(0, 1), cB + hstepB, voffB); PG8_STAGE(PG8_SA(0, 0), cA, voffA); PG8_STAGE(PG8_SA(0, 1), cA + hstepA, voffA);
    if (wr == 1) PG8_BAR;
    PG8_WAIT_V(2); PG8_BAR;
    PG8_STAGE(PG8_SB(1, 0), cB + kstep, voffB); PG8_STAGE(PG8_SA(1, 0), cA + kstep, voffA); PG8_STAGE(PG8_SB(1, 1), cB + hstepB + kstep, voffB);
    PG8_WAIT_V(6); PG8_BAR;
    for (;;) {
        const bool has_next = S.next(ui + 1, nxt);
        const char* nA = has_next ? (const char*)g.A + (size_t)nxt.pm * tstepA : cA; const char* nB = has_next ? (const char*)g.Bt + (size_t)nxt.pn * tstepB : cB;
        for (int t = 0; t < nt; t += 2) {
            const bool last = (t == nt - 2);
            const char* a1 = cA + (size_t)(t + 1) * kstep;
            const char* a2 = last ? nA : cA + (size_t)(t + 2) * kstep; const char* b2 = last ? nB : cB + (size_t)(t + 2) * kstep;
            const char* a3 = a2 + kstep; const char* b3 = b2 + kstep;
            PG8_LDB(B0, 0, 0); PG8_LDB(B1, 0, 1); PG8_SCHED; PG8_LDA(At, 0, 0); PG8_STAGE(PG8_SA(1, 1), a1 + hstepA, voffA);
            PG8_WAIT_V(8); PG8_WAIT_L(0); PG8_BAR; PG8_MMA(0, 0, At, B0); PG8_MMA(0, 1, At, B1); PG8_BAR; PG8_SCHED;
            PG8_LDA(At, 0, 1); PG8_STAGE(PG8_SB(0, 0), b2, voffB); PG8_STAGE(PG8_SB(0, 1), b2 + hstepB, voffB); PG8_STAGE(PG8_SA(0, 0), a2, voffA);
            PG8_WAIT_V(8); PG8_WAIT_L(0); PG8_BAR; PG8_MMA(1, 0, At, B0); PG8_MMA(1, 1, At, B1); PG8_BAR; PG8_SCHED;
            PG8_LDB(B0, 1, 0); PG8_LDB(B1, 1, 1); PG8_SCHED; PG8_LDA(At, 1, 0); PG8_STAGE(PG8_SA(0, 1), a2 + hstepA, voffA);
            PG8_WAIT_V(8); PG8_WAIT_L(0); PG8_BAR; PG8_MMA(0, 0, At, B0); PG8_MMA(0, 1, At, B1); PG8_BAR; PG8_SCHED;
            PG8_LDA(At, 1, 1); PG8_STAGE(PG8_SB(1, 0), b3, voffB); PG8_STAGE(PG8_SB(1, 1), b3 + hstepB, voffB); PG8_STAGE(PG8_SA(1, 0), a3, voffA);
            PG8_WAIT_V(8); PG8_WAIT_L(0); PG8_BAR; PG8_MMA(1, 0, At, B0); PG8_MMA(1, 1, At, B1); PG8_BAR; PG8_SCHED;
        }
        if (wr == 0) PG8_BAR;
        { Unit uu = cur; asm volatile("" : "+s"(uu.pm), "+s"(uu.pn)); int t2 = tid; asm volatile("" : "+v"(t2));
          E(acc, uu, wr, wc, t2 & 15, (t2 & 63) >> 4); }
        if (!has_next) break;
#pragma unroll
        for (int a = 0; a < 2; ++a)
#pragma unroll
            for (int b = 0; b < 2; ++b)
#pragma unroll
                for (int m = 0; m < 4; ++m)
#pragma unroll
                    for (int n = 0; n < 2; ++n) acc[a][b][m][n] = (f32x4){0.f, 0.f, 0.f, 0.f};
        cur = nxt; cA = nA; cB = nB; ++ui;
        if (wr == 1) PG8_BAR;
    }
    PG8_WAIT_V(0);
    PG8_BAR;
#undef PG8_SA
#undef PG8_SB
#undef PG8_STAGE
#undef PG8_LDA
#undef PG8_LDB
#undef PG8_MMA
#undef PG8_WAIT_V
#undef PG8_WAIT_L
#undef PG8_BAR
#undef PG8_SCHED
}
}

__host__ __device__ __forceinline__ int v_st(int k, int c) { const int kk = (k & ~0xC) | ((k & 4) << 1) | ((k & 8) >> 1); return ((kk >> 3) * 4 + (c >> 5)) * 512 + ((kk & 7) * 32 + (c & 31)) * 2; }
__device__ __forceinline__ int v_rd_base(int lane) { return ((lane & 3) << 3) | (((lane >> 2) & 3) << 6) | (((lane >> 4) & 1) << 5) | (((lane >> 5) & 1) << 8); }
constexpr int v_rd_off(int d0, int ks, int half) { return d0 * 512 + ks * 4096 + half * 2048; }
__device__ __forceinline__ int crow(int r, int hi) { return (r & 3) + 8 * (r >> 2) + 4 * hi; }

enum { EM_Z = 0, EM_F32 = 1, EM_Q = 2, EM_KV = 3, EM_PW2 = 4, EM_Z1 = 5 };
struct EpiAll {
    static constexpr bool PERM = true;
    int mode; int ldc; void* p0; const void* p1; const void* p2;
    unsigned char* wsb; const float* qng; const float* kvng; LAS unsigned char* ldsp; const float* slg; const float* slb;
    __device__ __forceinline__ void operator()(const f32x4 (&acc)[2][2][4][2], const pg8::Unit& u, int wr, int wc, int fr, int fq) const {
        const int row0 = u.pm * 256 + wr * 64 + fr, col0 = u.pn * 256 + wc * 32 + 8 * fq;
        if (mode == EM_Z) {
            bf16_t* O = (bf16_t*)p0;
#pragma unroll
            for (int ai = 0; ai < 2; ++ai)
#pragma unroll
                for (int m = 0; m < 4; ++m) { bf16_t* rowp = O + (size_t)(row0 + ai * 128 + m * 16) * ldc + col0;
#pragma unroll
                    for (int bj = 0; bj < 2; ++bj) { const f32x4 v0 = acc[ai][bj][m][0], v1 = acc[ai][bj][m][1];
                        u32x4 w; w.x = cvtpk(v0[0], v0[1]); w.y = cvtpk(v0[2], v0[3]); w.z = cvtpk(v1[0], v1[1]); w.w = cvtpk(v1[2], v1[3]);
                        *(u32x4*)(rowp + bj * 128) = w; } }
        } else if (mode == EM_Z1) {
            bf16_t* O = (bf16_t*)p0; const int pn = u.pn;
            if (pn < 2) {
                LAS float* P = (LAS float*)(ldsp + 131072);
                const int nb = (pn == 0) ? 2 : 1;
#pragma unroll
                for (int ai = 0; ai < 2; ++ai)
#pragma unroll
                    for (int m = 0; m < 4; ++m) { float s = 0.f;
#pragma unroll
                        for (int bj = 0; bj < 2; ++bj) if (bj < nb) {
#pragma unroll
                            for (int n = 0; n < 2; ++n) { const f32x4 v = acc[ai][bj][m][n]; s += (v[0] * v[0] + v[1] * v[1]) + (v[2] * v[2] + v[3] * v[3]); } }
                        { auto r_ = __builtin_amdgcn_permlane32_swap(__float_as_uint(s), __float_as_uint(s), false, false); s = __uint_as_float(r_[0]) + __uint_as_float(r_[1]); }
                        { auto r_ = __builtin_amdgcn_permlane16_swap(__float_as_uint(s), __float_as_uint(s), false, false); s = __uint_as_float(r_[0]) + __uint_as_float(r_[1]); }
                        if (fq == 0) P[(ai * 128 + wr * 64 + m * 16 + fr) * 4 + wc] = s; }
                asm volatile("s_waitcnt lgkmcnt(0)" ::: "memory"); __builtin_amdgcn_s_barrier(); asm volatile("" ::: "memory");
                const int c8 = wc * 32 + 8 * fq;
                const float* gn = (pn == 0) ? qng : kvng;
                f32x4 g00 = *(const f32x4*)(gn + c8), g01 = *(const f32x4*)(gn + c8 + 4), g10 = g00, g11 = g01;
                if (pn == 0) { g10 = *(const f32x4*)(gn + 128 + c8); g11 = *(const f32x4*)(gn + 128 + c8 + 4); }
                bf16_t* QLNp = (bf16_t*)(wsb + WS_QLN); bf16_t* KVLNp = (bf16_t*)(wsb + WS_KVLN); unsigned char* KRp = wsb + WS_KR;
                const float* cs = (const float*)p1; const float* sn = (const float*)p2;
                const float inv_n = (pn == 0) ? (1.f / QLR) : (1.f / KVLR);
#pragma unroll
                for (int ai = 0; ai < 2; ++ai)
#pragma unroll
                    for (int m = 0; m < 4; ++m) { const int rl_ = ai * 128 + wr * 64 + m * 16 + fr; const int tok = u.pm * 256 + rl_;
                        const f32x4 pp = *(const LAS f32x4*)(P + rl_ * 4);
                        const float rstd = rsqrtf(((pp[0] + pp[1]) + (pp[2] + pp[3])) * inv_n + EPS);
                        { const f32x4 v0 = acc[ai][0][m][0] * rstd * g00, v1 = acc[ai][0][m][1] * rstd * g01;
                          u32x4 w; w.x = cvtpk(v0[0], v0[1]); w.y = cvtpk(v0[2], v0[3]); w.z = cvtpk(v1[0], v1[1]); w.w = cvtpk(v1[2], v1[3]);
                          if (pn == 0) *(u32x4*)(QLNp + (size_t)tok * QLR + c8) = w; else *(u32x4*)(KVLNp + (size_t)tok * KVLR + c8) = w; }
                        if (pn == 0) { const f32x4 v0 = acc[ai][1][m][0] * rstd * g10, v1 = acc[ai][1][m][1] * rstd * g11;
                          u32x4 w; w.x = cvtpk(v0[0], v0[1]); w.y = cvtpk(v0[2], v0[3]); w.z = cvtpk(v1[0], v1[1]); w.w = cvtpk(v1[2], v1[3]);
                          *(u32x4*)(QLNp + (size_t)tok * QLR + 128 + c8) = w; }
                        else if (wc < 2) { const f32x4 v0 = acc[ai][1][m][0], v1 = acc[ai][1][m][1]; const int i0 = 16 * wc + 4 * fq; const int b = tok >> 13, s_ = tok & 8191;
                          const f32x4 c4 = *(const f32x4*)(cs + (size_t)tok * 32 + i0), s4 = *(const f32x4*)(sn + (size_t)tok * 32 + i0);
                          u32x4 w; w.x = cvtpk(v0[0] * c4[0] - v0[1] * s4[0], v0[1] * c4[0] + v0[0] * s4[0]); w.y = cvtpk(v0[2] * c4[1] - v0[3] * s4[1], v0[3] * c4[1] + v0[2] * s4[1]);
                          w.z = cvtpk(v1[0] * c4[2] - v1[1] * s4[2], v1[1] * c4[2] + v1[0] * s4[2]); w.w = cvtpk(v1[2] * c4[3] - v1[3] * s4[3], v1[3] * c4[3] + v1[2] * s4[3]);
                          *(u32x4*)(KRp + ((size_t)(b * (SEQ / 64) + (s_ >> 6))) * 8192 + (4 * wc + fq) * 1024 + (s_ & 63) * 16) = w; } }
                return;
            }
            if (pn == 8) {
                typedef float f32x2l __attribute__((ext_vector_type(2)));
                LAS f32x2l* P2 = (LAS f32x2l*)(ldsp + 131072);
#pragma unroll
                for (int ai = 0; ai < 2; ++ai)
#pragma unroll
                    for (int m = 0; m < 4; ++m) { float s = 0.f, q = 0.f;
#pragma unroll
                        for (int bj = 0; bj < 2; ++bj)
#pragma unroll
                            for (int n = 0; n < 2; ++n) { const f32x4 v = acc[ai][bj][m][n];
#pragma unroll
                                for (int e = 0; e < 4; ++e) { const float x = geluf_(v[e]); s += x; q += x * x; } }
                        { auto r_ = __builtin_amdgcn_permlane32_swap(__float_as_uint(s), __float_as_uint(s), false, false); s = __uint_as_float(r_[0]) + __uint_as_float(r_[1]); }
                        { auto r_ = __builtin_amdgcn_permlane16_swap(__float_as_uint(s), __float_as_uint(s), false, false); s = __uint_as_float(r_[0]) + __uint_as_float(r_[1]); }
                        { auto r_ = __builtin_amdgcn_permlane32_swap(__float_as_uint(q), __float_as_uint(q), false, false); q = __uint_as_float(r_[0]) + __uint_as_float(r_[1]); }
                        { auto r_ = __builtin_amdgcn_permlane16_swap(__float_as_uint(q), __float_as_uint(q), false, false); q = __uint_as_float(r_[0]) + __uint_as_float(r_[1]); }
                        if (fq == 0) P2[(ai * 128 + wr * 64 + m * 16 + fr) * 4 + wc] = (f32x2l){s, q};
                        __builtin_amdgcn_sched_barrier(0); }
                asm volatile("s_waitcnt lgkmcnt(0)" ::: "memory"); __builtin_amdgcn_s_barrier(); asm volatile("" ::: "memory");
                const int c8 = wc * 32 + 8 * fq;
                f32x4 gg[2][2], bb[2][2];
#pragma unroll
                for (int bj = 0; bj < 2; ++bj)
#pragma unroll
                    for (int n = 0; n < 2; ++n) { gg[bj][n] = *(const f32x4*)(slg + bj * 128 + c8 + 4 * n); bb[bj][n] = *(const f32x4*)(slb + bj * 128 + c8 + 4 * n); }
#pragma unroll
                for (int ai = 0; ai < 2; ++ai)
#pragma unroll
                    for (int m = 0; m < 4; ++m) { const int rl_ = ai * 128 + wr * 64 + m * 16 + fr;
                        const f32x4 pa_ = *(const LAS f32x4*)(P2 + rl_ * 4), pb_ = *(const LAS f32x4*)(P2 + rl_ * 4 + 2);
                        const float mean = ((pa_[0] + pa_[2]) + (pb_[0] + pb_[2])) * (1.f / SW);
                        const float var = ((pa_[1] + pa_[3]) + (pb_[1] + pb_[3])) * (1.f / SW) - mean * mean;
                        const float rstd = rsqrtf(fmaxf(var, 0.f) + EPS);
                        bf16_t* rowb = O + (size_t)(row0 + ai * 128 + m * 16) * ldc + col0;
#pragma unroll
                        for (int bj = 0; bj < 2; ++bj) { f32x4 x0 = acc[ai][bj][m][0], x1 = acc[ai][bj][m][1];
#pragma unroll
                            for (int e = 0; e < 4; ++e) { asm volatile("" : "+v"(x0[e]), "+v"(x1[e])); x0[e] = geluf_(x0[e]); x1[e] = geluf_(x1[e]); }
                            const f32x4 v0 = (x0 - mean) * rstd * gg[bj][0] + bb[bj][0], v1 = (x1 - mean) * rstd * gg[bj][1] + bb[bj][1];
                            u32x4 w; w.x = cvtpk(v0[0], v0[1]); w.y = cvtpk(v0[2], v0[3]); w.z = cvtpk(v1[0], v1[1]); w.w = cvtpk(v1[2], v1[3]);
                            __builtin_nontemporal_store(w, (u32x4*)(rowb + bj * 128)); }
                        __builtin_amdgcn_sched_barrier(0); }
                return;
            }
            const bool paired = (pn == 4) | (pn == 5) | (pn == 7) | (pn == 9), gate = (pn == 2) | (pn == 3) | (pn == 6);
            const int pcol = (pn == 4 ? 1024 : pn == 5 ? 1152 : pn == 7 ? 1792 : 1920) + wc * 32 + 8 * fq;
#pragma unroll
            for (int ai = 0; ai < 2; ++ai)
#pragma unroll
                for (int m = 0; m < 4; ++m) { bf16_t* rowb = O + (size_t)(row0 + ai * 128 + m * 16) * ldc;
                    if (paired) { const f32x4 a0 = acc[ai][0][m][0], a1 = acc[ai][0][m][1], b0 = acc[ai][1][m][0], b1 = acc[ai][1][m][1]; f32x4 r0, r1;
                        if (pn < 6) {
#pragma unroll
                            for (int e = 0; e < 4; ++e) { r0[e] = a0[e] * sigmoidf_(b0[e]); r1[e] = a1[e] * sigmoidf_(b1[e]); } }
                        else {
#pragma unroll
                            for (int e = 0; e < 4; ++e) { r0[e] = geluf_(a0[e]) * siluf_(b0[e]); r1[e] = geluf_(a1[e]) * siluf_(b1[e]); } }
                        u32x4 w; w.x = cvtpk(r0[0], r0[1]); w.y = cvtpk(r0[2], r0[3]); w.z = cvtpk(r1[0], r1[1]); w.w = cvtpk(r1[2], r1[3]);
                        __builtin_nontemporal_store(w, (u32x4*)(rowb + pcol)); }
                    else {
#pragma unroll
                        for (int bj = 0; bj < 2; ++bj) { f32x4 v0 = acc[ai][bj][m][0], v1 = acc[ai][bj][m][1];
                            if (gate) {
#pragma unroll
                                for (int e = 0; e < 4; ++e) { v0[e] = siluf_(v0[e]); v1[e] = siluf_(v1[e]); } }
                            u32x4 w; w.x = cvtpk(v0[0], v0[1]); w.y = cvtpk(v0[2], v0[3]); w.z = cvtpk(v1[0], v1[1]); w.w = cvtpk(v1[2], v1[3]);
                            __builtin_nontemporal_store(w, (u32x4*)(rowb + col0 + bj * 128)); } } }
        } else if (mode == EM_F32) {
            float* C = (float*)p0;
#pragma unroll
            for (int ai = 0; ai < 2; ++ai)
#pragma unroll
                for (int m = 0; m < 4; ++m) { float* rowp = C + (size_t)(row0 + ai * 128 + m * 16) * ldc + col0;
#pragma unroll
                    for (int bj = 0; bj < 2; ++bj)
#pragma unroll
                        for (int n = 0; n < 2; ++n) *(f32x4*)(rowp + bj * 128 + n * 4) = acc[ai][bj][m][n]; }
        } else if (mode == EM_Q) {
            bf16_t* Q = (bf16_t*)p0; const float* cs = (const float*)p1; const float* sn = (const float*)p2;
#pragma unroll
            for (int ai = 0; ai < 2; ++ai)
#pragma unroll
                for (int m = 0; m < 4; ++m) { const int tok = row0 + ai * 128 + m * 16, b = tok >> 13, s = tok & 8191;
#pragma unroll
                    for (int bj = 0; bj < 2; ++bj) { f32x4 v0 = acc[ai][bj][m][0], v1 = acc[ai][bj][m][1]; const int n = col0 + bj * 128;
                        bf16_t* dst;
                        if (u.pn < 2) { const int h = n >> 7, d = n & 127; dst = Q + ((size_t)((b * NH + h) * SEQ + s)) * DQK + d; }
                        else { const int n2 = n - 512, h = n2 >> 6, w = n2 & 63, i0 = w >> 1;
                            const f32x4 c4 = *(const f32x4*)(cs + (size_t)tok * 32 + i0), s4 = *(const f32x4*)(sn + (size_t)tok * 32 + i0);
                            f32x4 a0, a1;
                            a0[0] = v0[0] * c4[0] - v0[1] * s4[0]; a0[1] = v0[1] * c4[0] + v0[0] * s4[0];
                            a0[2] = v0[2] * c4[1] - v0[3] * s4[1]; a0[3] = v0[3] * c4[1] + v0[2] * s4[1];
                            a1[0] = v1[0] * c4[2] - v1[1] * s4[2]; a1[1] = v1[1] * c4[2] + v1[0] * s4[2];
                            a1[2] = v1[2] * c4[3] - v1[3] * s4[3]; a1[3] = v1[3] * c4[3] + v1[2] * s4[3];
                            v0 = a0; v1 = a1; dst = Q + ((size_t)((b * NH + h) * SEQ + s)) * DQK + DNOPE + w; }
                        v0 = v0 * QSCALE; v1 = v1 * QSCALE;
                        u32x4 wv; wv.x = cvtpk(v0[0], v0[1]); wv.y = cvtpk(v0[2], v0[3]); wv.z = cvtpk(v1[0], v1[1]); wv.w = cvtpk(v1[2], v1[3]);
                        *(u32x4*)dst = wv; } }
        } else if (mode == EM_KV) {
            unsigned char* KN = (unsigned char*)p0; unsigned char* VI = (unsigned char*)p1;
#pragma unroll
            for (int ai = 0; ai < 2; ++ai)
#pragma unroll
                for (int m = 0; m < 4; ++m) { const int tok = row0 + ai * 128 + m * 16, b = tok >> 13, s = tok & 8191;
#pragma unroll
                    for (int bj = 0; bj < 2; ++bj) { const f32x4 v0 = acc[ai][bj][m][0], v1 = acc[ai][bj][m][1]; const int n = (col0 + bj * 128) & 511;
                        const int h = n >> 7, d = n & 127;
                        const size_t tbase = ((size_t)((b * NH + h) * (SEQ / 64) + (s >> 6))) * 16384;
                        unsigned char* dst = (u.pn < 2) ? KN + tbase + (d >> 3) * 1024 + (s & 63) * 16 : VI + tbase + v_st(s & 63, d);
                        u32x4 wv; wv.x = cvtpk(v0[0], v0[1]); wv.y = cvtpk(v0[2], v0[3]); wv.z = cvtpk(v1[0], v1[1]); wv.w = cvtpk(v1[2], v1[3]);
                        *(u32x4*)dst = wv; } }
        } else {
            bf16_t* YCAT = (bf16_t*)p0; const bf16_t* Z = (const bf16_t*)p1;
#pragma unroll
            for (int ai = 0; ai < 2; ++ai)
#pragma unroll
                for (int m = 0; m < 4; ++m) { const int tok = row0 + ai * 128 + m * 16;
#pragma unroll
                    for (int bj = 0; bj < 2; ++bj) { const f32x4 v0 = acc[ai][bj][m][0], v1 = acc[ai][bj][m][1]; const int c = col0 + bj * 128;
                        const u32x4 g = *(const u32x4*)(Z + (size_t)tok * DINP + ZC_GC + c);
                        u32x4 wv;
                        wv.x = cvtpk(v0[0] * lo_bf(g.x), v0[1] * hi_bf(g.x)); wv.y = cvtpk(v0[2] * lo_bf(g.y), v0[3] * hi_bf(g.y));
                        wv.z = cvtpk(v1[0] * lo_bf(g.z), v1[1] * hi_bf(g.z)); wv.w = cvtpk(v1[2] * lo_bf(g.w), v1[3] * hi_bf(g.w));
                        *(u32x4*)(YCAT + (size_t)tok * DM + 512 + c) = wv; } }
        }
    }
};

namespace att {
constexpr int SLOT = 40960, NSLOT = 3, VOFF = 24576, LDS_WS = NSLOT * SLOT;
constexpr float THR = 8.f;
#define SBAR() __builtin_amdgcn_sched_barrier(0)
__device__ __forceinline__ void glds16s(const void* sbase, unsigned voff, unsigned lds_dst) { unsigned keep;
    asm volatile("s_mov_b32 %0, m0\n\ts_mov_b32 m0, %3\n\ts_nop 0\n\tglobal_load_lds_dwordx4 %1, %2\n\ts_mov_b32 m0, %0" : "=&s"(keep) : "v"(voff), "s"(sbase), "s"(lds_dst) : "memory"); }
#if ATT_EXP_TOP & 4
#define GLDS_DUP "global_load_lds_dwordx4 %1, off\n\t"
#else
#define GLDS_DUP ""
#endif
__device__ __forceinline__ void glds16(const void* gsrc, unsigned lds_dst) { unsigned keep;
    asm volatile("s_mov_b32 %0, m0\n\ts_mov_b32 m0, %2\n\ts_nop 0\n\tglobal_load_lds_dwordx4 %1, off\n\t" GLDS_DUP "s_mov_b32 m0, %0" : "=&s"(keep) : "v"(gsrc), "s"(lds_dst) : "memory"); }

__device__ __forceinline__ void attn_unit3(int b, int h, int qb, const bf16_t* Q, const unsigned char* KN, const unsigned char* KR, const unsigned char* VI,
                                           const bf16_t* Z, bf16_t* YCAT, char* shm, const int tid) {
    const int lane = tid & 63, r32 = lane & 31, hi = lane >> 5; const int wid = __builtin_amdgcn_readfirstlane(tid >> 6);
    const int q0 = qb * 256, NT = 4 * (qb + 1);
    const int bh = b * NH + h;
    const unsigned lds0 = (unsigned)(uintptr_t)shm;
    LAS float* wsf = (LAS float*)((LAS char*)shm + LDS_WS) + wid * 64;
    LAS float* wsh = wsf + 4 * hi;
    const unsigned char* knb = KN + (size_t)bh * (SEQ / 64) * 16384;
    const unsigned char* krb = KR + (size_t)b * (SEQ / 64) * 8192;
    const unsigned char* vbs = VI + (size_t)bh * (SEQ / 64) * 16384;
    const unsigned dvo = (unsigned)(wid * 1024 + lane * 16);
#define DMA_TILE(t, slot) do { const unsigned d_ = (unsigned)__builtin_amdgcn_readfirstlane(lds0 + (slot) + wid * 1024); \
        glds16s(knb + (size_t)(t) * 16384, dvo, d_); glds16s(knb + (size_t)(t) * 16384 + 8192, dvo, d_ + 8192); glds16s(krb + (size_t)(t) * 8192, dvo, d_ + 16384); \
        glds16s(vbs + (size_t)(t) * 16384, dvo, d_ + VOFF); glds16s(vbs + (size_t)(t) * 16384 + 8192, dvo, d_ + VOFF + 8192); } while (0)
    const bf16_t* Qw = Q + ((size_t)(bh * SEQ + q0 + wid * 32 + r32)) * DQK;
    bf16x8 qr[12];
#pragma unroll
    for (int d0 = 0; d0 < 12; ++d0) qr[d0] = *(const bf16x8*)(Qw + d0 * 16 + hi * 8);
#pragma unroll
    for (int d0 = 0; d0 < 12; ++d0) asm volatile("" : "+v"(qr[d0]));
    asm volatile("s_waitcnt vmcnt(0)" ::: "memory");
    DMA_TILE(0, 0);
    float m_run = 0.f, l_run = 0.f; f32x16 o[4];
#pragma unroll
    for (int d = 0; d < 4; ++d) o[d] = f32x16{};
    const LAS char* shm3 = (const LAS char*)shm;
    const LAS char* kl = shm3 + hi * 1024 + r32 * 16;
    const int vb0 = (int)lds0 + VOFF + v_rd_base(lane);
    const int qabs = q0 + wid * 32 + r32;
    f32x16 sA, sB, negm; bf16x8 pa0, pa1; float pmaxN = 0.f;
    bf16x8 kpa, kpb;

#define MF(acc, a_, b_) acc = __builtin_amdgcn_mfma_f32_32x32x16_bf16(a_, b_, acc, 0, 0, 0)
#define DMAP(on_, i_, t_, slot_) do { if (on_) { const unsigned d_ = (unsigned)__builtin_amdgcn_readfirstlane(lds0 + (slot_) + wid * 1024); \
        if ((i_) == 0) glds16s(knb + (size_t)(t_) * 16384, dvo, d_); else if ((i_) == 1) glds16s(knb + (size_t)(t_) * 16384 + 8192, dvo, d_ + 8192); \
        else if ((i_) == 2) glds16s(krb + (size_t)(t_) * 8192, dvo, d_ + 16384); else if ((i_) == 3) glds16s(vbs + (size_t)(t_) * 16384, dvo, d_ + VOFF); \
        else glds16s(vbs + (size_t)(t_) * 16384 + 8192, dvo, d_ + VOFF + 8192); } } while (0)
#ifndef ATT_EXP
#define ATT_EXP 0
#endif
#if ATT_EXP & 1
#define KLD1(dst, kp_, d0) do { dst = *(const LAS bf16x8*)(kp_ + (d0) * 2048); bf16x8 dmy_; asm volatile("ds_read_b128 %0, %1 offset:%2" : "=v"(dmy_) : "v"((int)(uintptr_t)(kp_)), "i"(((d0) * 2048) & 0xffff) : "memory"); asm volatile("" :: "v"(dmy_)); } while (0)
#else
#define KLD1(dst, kp_, d0) dst = *(const LAS bf16x8*)(kp_ + (d0) * 2048)
#endif
#define MASKH(S, T_, hf_) do { if ((T_) >= NT - 4) { const float NEG = -__builtin_inff(); const int kb_ = 64 * (T_) + 32 * (hf_) + 4 * hi; \
        _Pragma("unroll") for (int r = 0; r < 16; ++r) { const int kv = kb_ + (r & 3) + 8 * (r >> 2); if (kv > qabs) S[r] = NEG; } } } while (0)
#define ROWMAX_FIN(mx0, mx1, out) do { float m_ = fmaxf(mx0, mx1); auto rr_ = __builtin_amdgcn_permlane32_swap(__float_as_uint(m_), __float_as_uint(m_), false, false); \
        out = fmaxf(__uint_as_float(rr_[0]), __uint_as_float(rr_[1])); } while (0)
#define DECIDE(pmax_, SYp) do { if (!__all((pmax_) <= THR)) { const float dl_ = fmaxf((pmax_), 0.f); const float al_ = __builtin_amdgcn_exp2f(-dl_); m_run += dl_; l_run *= al_; \
        _Pragma("unroll") for (int r = 0; r < 16; ++r) { SYp[r] -= dl_; negm[r] = -m_run; } \
        if (hi == 0) wsf[r32] = al_; asm volatile("s_waitcnt lgkmcnt(0)" ::: "memory"); \
        _Pragma("unroll") for (int d_ = 0; d_ < 4; ++d_) _Pragma("unroll") for (int r = 0; r < 16; ++r) o[d_][r] *= wsh[(r & 3) + 8 * (r >> 2)]; \
        asm volatile("s_waitcnt lgkmcnt(0)" ::: "memory"); } } while (0)
#define PK4(P, B_, OUT) do { unsigned a0_ = cvtpk(P[B_ + 0], P[B_ + 1]), a1_ = cvtpk(P[B_ + 2], P[B_ + 3]); \
        unsigned b0_ = cvtpk(P[B_ + 4], P[B_ + 5]), b1_ = cvtpk(P[B_ + 6], P[B_ + 7]); \
        auto r0_ = __builtin_amdgcn_permlane32_swap(a0_, b0_, false, false); auto r1_ = __builtin_amdgcn_permlane32_swap(a1_, b1_, false, false); \
        u32x4 w_ = {r0_[0], r1_[0], r0_[1], r1_[1]}; OUT = *reinterpret_cast<bf16x8*>(&w_); } while (0)
#if ATT_EXP & 2
#define SMC2(S, i) do { const float e0_ = __builtin_amdgcn_exp2f(S[i] - m_run), e1_ = __builtin_amdgcn_exp2f(S[(i) + 1] - m_run); \
        float x0_ = __builtin_amdgcn_exp2f(S[i] - l_run), x1_ = __builtin_amdgcn_exp2f(S[(i) + 1] - l_run); x0_ += x1_; asm volatile("" :: "v"(x0_)); \
        S[i] = e0_; S[(i) + 1] = e1_; ps0 += e0_; ps1 += e1_; } while (0)
#else
#define SMC2(S, i) do { const float e0_ = __builtin_amdgcn_exp2f(S[i]), e1_ = __builtin_amdgcn_exp2f(S[(i) + 1]); S[i] = e0_; S[(i) + 1] = e1_; ps0 += e0_; ps1 += e1_; } while (0)
#endif
#define SMFIN() do { float ps_ = ps0 + ps1; auto rr_ = __builtin_amdgcn_permlane32_swap(__float_as_uint(ps_), __float_as_uint(ps_), false, false); \
        l_run += __uint_as_float(rr_[0]) + __uint_as_float(rr_[1]); } while (0)
#define TRRD(dst, off) asm volatile("ds_read_b64_tr_b16 %0, %1 offset:%2" : "=&v"(dst) : "v"(vb_), "i"(off) : "memory")
#define TRRD4(P_, d0, hf_) do { constexpr int b_ = v_rd_off(d0, 2 * (hf_), 0); TRRD(P_##l0, b_); TRRD(P_##h0, b_ + 2048); TRRD(P_##l1, b_ + 4096); TRRD(P_##h1, b_ + 6144); } while (0)
#define VF(P_, k) (bf16x8){P_##l##k[0], P_##l##k[1], P_##l##k[2], P_##l##k[3], P_##h##k[0], P_##h##k[1], P_##h##k[2], P_##h##k[3]}
#define LGK(n) asm volatile("s_waitcnt lgkmcnt(" #n ")" ::: "memory")
#define RMC2(S, j) do { mx0 = __builtin_fmaxf(__builtin_fmaxf(mx0, S[j]), S[(j) + 1]); } while (0)
#define RMC4(S, j) do { RMC2(S, j); RMC2(S, (j) + 2); } while (0)

#define HSTEP(SX, SY, T_, HF, TN, HFN, has_next_, dma_on_, bar_, pf_, knext_) do { \
        float ps0 = 0.f, ps1 = 0.f; \
        if (has_next_) { \
            const LAS char* kp_ = kl + ((HFN) == 0 ? sl_n1 : sl_cur) + (HFN) * 512; bf16x8 k0 = kpa, k1 = kpb, k2; \
            KLD1(k2, kp_, 2); SBAR(); \
            SY = __builtin_amdgcn_mfma_f32_32x32x16_bf16(k0, qr[0], negm, 0, 0, 0); SMC2(SX, 0); SBAR(); KLD1(k0, kp_, 3); DMAP(dma_on_, 0, (T_) + 2, sl_n2); SBAR(); \
            MF(SY, k1, qr[1]); SMC2(SX, 2); SBAR(); KLD1(k1, kp_, 4); DMAP(dma_on_, 1, (T_) + 2, sl_n2); SBAR(); \
            MF(SY, k2, qr[2]); SMC2(SX, 4); SBAR(); KLD1(k2, kp_, 5); DMAP(dma_on_, 2, (T_) + 2, sl_n2); SBAR(); \
            MF(SY, k0, qr[3]); SMC2(SX, 6); SBAR(); KLD1(k0, kp_, 6); DMAP(dma_on_, 3, (T_) + 2, sl_n2); SBAR(); \
            MF(SY, k1, qr[4]); SMC2(SX, 8); SBAR(); KLD1(k1, kp_, 7); DMAP(dma_on_, 4, (T_) + 2, sl_n2); SBAR(); \
            MF(SY, k2, qr[5]); SMC2(SX, 10); SBAR(); KLD1(k2, kp_, 8); SBAR(); \
            MF(SY, k0, qr[6]); SMC2(SX, 12); SBAR(); KLD1(k0, kp_, 9); SBAR(); \
            MF(SY, k1, qr[7]); SMC2(SX, 14); SBAR(); KLD1(k1, kp_, 10); SBAR(); \
            MF(SY, k2, qr[8]); PK4(SX, 0, pa0); SBAR(); KLD1(k2, kp_, 11); SBAR(); \
            MF(SY, k0, qr[9]); PK4(SX, 8, pa1); SBAR(); \
            MF(SY, k1, qr[10]); SMFIN(); SBAR(); \
            MF(SY, k2, qr[11]); SBAR(); \
        } else { \
            _Pragma("unroll") for (int i_ = 0; i_ < 16; i_ += 2) SMC2(SX, i_); \
            PK4(SX, 0, pa0); PK4(SX, 8, pa1); SMFIN(); SBAR(); \
        } \
        if (bar_) asm volatile("s_waitcnt vmcnt(0) lgkmcnt(0)\n\ts_barrier" ::: "memory");     \
        { const int vb_ = vb0 + sl_cur; s16x4 Al0, Al1, Ah0, Ah1, Bl0, Bl1, Bh0, Bh1; \
          float mx0 = -__builtin_inff(); \
          TRRD4(A, 0, HF); TRRD4(B, 1, HF); SBAR(); \
          if (pf_) { KLD1(kpa, knext_, 0); KLD1(kpb, knext_, 1); } SBAR(); \
          if (has_next_) MASKH(SY, TN, HFN); \
          SBAR(); if (pf_) LGK(6); else LGK(4); SBAR();                   \
          MF(o[0], pa0, VF(A, 0)); if (has_next_) { RMC4(SY, 0); } SBAR(); MF(o[0], pa1, VF(A, 1)); if (has_next_) { RMC4(SY, 4); } SBAR(); \
          TRRD4(A, 2, HF); SBAR(); if (pf_) LGK(6); else LGK(4); SBAR();    \
          MF(o[1], pa0, VF(B, 0)); if (has_next_) { RMC4(SY, 8); } SBAR(); MF(o[1], pa1, VF(B, 1)); if (has_next_) { RMC4(SY, 12); } SBAR(); \
          TRRD4(B, 3, HF); LGK(4); SBAR();                                  \
          MF(o[2], pa0, VF(A, 0)); MF(o[2], pa1, VF(A, 1)); SBAR(); \
          LGK(0); SBAR(); \
          MF(o[3], pa0, VF(B, 0)); MF(o[3], pa1, VF(B, 1)); SBAR(); \
          const float mx1 = mx0; \
          if (has_next_) { ROWMAX_FIN(mx0, mx1, pmaxN); DECIDE(pmaxN, SY); } } \
    } while (0)

    int sl_cur = 0, sl_n1 = SLOT, sl_n2 = 2 * SLOT;
    asm volatile("s_waitcnt vmcnt(0) lgkmcnt(0)\n\ts_barrier" ::: "memory");
    DMA_TILE(1, SLOT);
    { const LAS char* kp_ = shm3 + hi * 1024 + r32 * 16; bf16x8 ka, kb;
      sA = f32x16{};
      KLD1(ka, kp_, 0); KLD1(kb, kp_, 1); SBAR();
#pragma unroll
      for (int d2 = 0; d2 < 12; d2 += 2) {
          MF(sA, ka, qr[d2]); SBAR(); if (d2 + 2 < 12) KLD1(ka, kp_, d2 + 2); SBAR();
          MF(sA, kb, qr[d2 + 1]); SBAR(); if (d2 + 3 < 12) KLD1(kb, kp_, d2 + 3); SBAR(); }
      KLD1(kpa, kp_ + 512, 0); KLD1(kpb, kp_ + 512, 1); SBAR(); }
    MASKH(sA, 0, 0);
    { float mx0 = -__builtin_inff();
#pragma unroll
      for (int j = 0; j < 16; j += 2) RMC2(sA, j);
      ROWMAX_FIN(mx0, mx0, pmaxN); m_run = pmaxN;
#pragma unroll
      for (int r = 0; r < 16; ++r) { sA[r] -= m_run; negm[r] = -m_run; } }
    for (int T = 0; T < NT; ++T) {
        const bool more = T + 1 < NT;
        HSTEP(sA, sB, T, 0, T, 1, true, false, more, more, (kl + sl_n1));
        HSTEP(sB, sA, T, 1, T + 1, 0, more, (T + 2 < NT), false, more, (kl + sl_n1 + 512));
        { const int tmp_ = sl_cur; sl_cur = sl_n1; sl_n1 = sl_n2; sl_n2 = tmp_; }
    }
    if (hi == 0) wsf[32 + r32] = l_run;
    asm volatile("s_waitcnt lgkmcnt(0)" ::: "memory");
    { int r32e = r32, hie = hi; asm volatile("" : "+v"(r32e), "+v"(hie));
      const LAS float* wse = wsf + 32 + 4 * hie;
      const size_t mrow0 = (size_t)b * SEQ + q0 + wid * 32 + 4 * hie;
      const bf16_t* zp = Z + mrow0 * DINP + ZC_GATT + h * DV + r32e; bf16_t* yp = YCAT + mrow0 * DM + h * DV + r32e;
#pragma unroll
      for (int r = 0; r < 16; ++r) { const int cr = (r & 3) + 8 * (r >> 2); const float rl = __builtin_amdgcn_rcpf(wse[cr]);
#pragma unroll
          for (int d0 = 0; d0 < 4; ++d0) {
              const float g = bf2f(zp[(size_t)cr * DINP + d0 * 32]);
              const float v = o[d0][r] * rl * g;
              const float vn = xor1_f(v);
              if ((r32e & 1) == 0) *(unsigned*)(yp + (size_t)cr * DM + d0 * 32) = cvtpk(v, vn); } } }
    asm volatile("s_waitcnt vmcnt(0) lgkmcnt(0)\n\ts_barrier" ::: "memory");
#undef DMA_TILE
#undef DMAP
#undef MF
#undef KLD1
#undef MASKH
#undef ROWMAX_FIN
#undef DECIDE
#undef PK4
#undef SMC2
#undef SMFIN
#undef TRRD
#undef TRRD4
#undef VF
#undef LGK
#undef RMC2
#undef RMC4
#undef HSTEP
}
#undef SBAR
}

#define XB_TMO      128
#define XB_XCNT(j)  (256  + 64 * (j))
#define XB_XSUB(j)  (1280 + 64 * (j))
#define XB_XGEN(j)  (2304 + 64 * (j))
#define XB_TOP      3328
#define XB_TOPGEN   3392
#define XCD_BAR_WORDS 3456
#define XB_SPIN_CAP (1u << 18)
__device__ __forceinline__ unsigned xb_ld(unsigned* p)              { return __hip_atomic_load(p, __ATOMIC_RELAXED, __HIP_MEMORY_SCOPE_AGENT); }
__device__ __forceinline__ unsigned xb_add(unsigned* p, unsigned v) { return __hip_atomic_fetch_add(p, v, __ATOMIC_RELAXED, __HIP_MEMORY_SCOPE_AGENT); }
__device__ __forceinline__ unsigned xb_xcc_id() { return (unsigned)__builtin_amdgcn_s_getreg((3 << 11) | 20) & 0xFu; }
#define XB_SPIN(cond, bar) do { unsigned _sp = 0; while (cond) { __builtin_amdgcn_s_sleep(1); \
    if ((++_sp & 255u) == 0u) { if (xb_ld(&(bar)[XB_TMO])) break; if (_sp > XB_SPIN_CAP) { atomicAdd(&(bar)[XB_TMO], 1u); break; } } } } while (0)
struct XcdBarrier { unsigned* bar; unsigned x; volatile LAS unsigned* st; };
__device__ __forceinline__ XcdBarrier xcd_barrier_post(unsigned* bar, volatile LAS unsigned* st) {
    XcdBarrier b; b.bar = bar; b.x = xb_xcc_id(); b.st = st;
    if (threadIdx.x == 0) (void)xb_add(&bar[XB_XCNT(b.x)], 1u);
    return b;
}
__device__ __forceinline__ void xcd_barrier_complete(unsigned* bar, unsigned x, unsigned& nloc, unsigned& nx) {
    const unsigned G = gridDim.x * gridDim.y * gridDim.z;
    unsigned sum, cnt, mine, sp = 0u;
    for (;;) {
        sum = 0u; cnt = 0u; mine = 0u;
#pragma unroll
        for (unsigned j = 0; j < 16; ++j) { const unsigned c = xb_ld(&bar[XB_XCNT(j)]); sum += c; cnt += (c > 0u) ? 1u : 0u; mine = (j == x) ? c : mine; }
        if (sum == G) break;
        __builtin_amdgcn_s_sleep(1);
        if ((++sp & 255u) == 0u) { if (xb_ld(&bar[XB_TMO])) break; if (sp > XB_SPIN_CAP) { atomicAdd(&bar[XB_TMO], 1u); break; } }
    }
    nloc = mine > 0u ? mine : 1u; nx = cnt > 0u ? cnt : 1u;
}
__device__ __forceinline__ void xcd_barrier(const XcdBarrier& b) {
    asm volatile("s_waitcnt vmcnt(0)" ::: "memory");
    __syncthreads();
    if (threadIdx.x == 0) {
        unsigned* bar = b.bar;
        __builtin_amdgcn_s_waitcnt(0);
        unsigned nloc = b.st[0], nx = b.st[1];
        if (nloc == 0u) { xcd_barrier_complete(bar, b.x, nloc, nx); b.st[0] = nloc; b.st[1] = nx; }
        const unsigned old = xb_add(&bar[XB_XSUB(b.x)], 1u);
        const unsigned gen = old / nloc;
        if (old + 1u == (gen + 1u) * nloc) {
            __builtin_amdgcn_fence(__ATOMIC_RELEASE, "agent");
            asm volatile("s_waitcnt vmcnt(0)" ::: "memory");
            const unsigned og = xb_add(&bar[XB_TOP], 1u);
            const unsigned tg = og / nx;
            if (og + 1u == (tg + 1u) * nx) xb_add(&bar[XB_TOPGEN], 1u);
            else XB_SPIN(xb_ld(&bar[XB_TOPGEN]) == tg, bar);
            __builtin_amdgcn_fence(__ATOMIC_ACQUIRE, "agent");
            xb_add(&bar[XB_XGEN(b.x)], 1u);
            asm volatile("s_waitcnt vmcnt(0)" ::: "memory");
        } else {
            XB_SPIN(xb_ld(&bar[XB_XGEN(b.x)]) == gen, bar);
            __builtin_amdgcn_fence(__ATOMIC_ACQUIRE, "agent");
            asm volatile("s_waitcnt vmcnt(0)" ::: "memory");
        }
    }
    __syncthreads();
}

struct Args { const void* in[22]; float* out; unsigned char* ws; int ph_lo, ph_hi; };
enum { I_X = 0, I_C, I_POS, I_WADA, I_BADA, I_GPRE, I_GPOST, I_WIN, I_QNG, I_WUQ, I_KVNG, I_WUKV, I_CONVW, I_CONVB, I_CLNG, I_CLNB, I_WPW2, I_SLNG, I_SLNB, I_WS, I_BS, I_WOUT };
constexpr int N_PHASES = 2 + 6 * NLAYER;

__device__ __forceinline__ int wmap(int mat, int n) {
    if (mat == 0) {
        if (n < 384) return n; if (n < 448) { const int w = n - 384; return 384 + 32 * (w & 1) + (w >> 1); } if (n < 512) return -1;
        const int t = n >> 8, j = n & 127, second = (n >> 7) & 1;
        if (t == 4 || t == 5) return (second ? 1216 : 960) + (t - 4) * 128 + j;
        if (t == 7 || t == 9) return (second ? 2240 : 1728) + (t == 9 ? 128 : 0) + j;
        return n - 64; }
    if (mat == 2) { if (n < 512) return (n >> 7) * DQK + (n & 127); const int n2 = n - 512, h = n2 >> 6, w = n2 & 63; return h * DQK + DNOPE + 32 * (w & 1) + (w >> 1); }
    if (mat == 3) { const int h = (n & 511) >> 7, d = n & 127; return h * 256 + (n >= 512 ? 128 : 0) + d; }
    return n;
}
__device__ __forceinline__ void transpose_item(const float* W, int Nsrc, bf16_t* WT, int Kd, int mat, LAS float* scr, int kb, int nb, int lane) {
    const int k0 = 64 * kb, n0 = 32 * nb; const int src = wmap(mat, n0 + (lane & 31));
#pragma unroll 8
    for (int i = 0; i < 32; ++i) { const int kk = 2 * i + (lane >> 5); scr[kk * 33 + (lane & 31)] = src >= 0 ? W[(size_t)(k0 + kk) * Nsrc + src] : 0.f; }
    asm volatile("s_waitcnt lgkmcnt(0)" ::: "memory");
    const int c = lane & 7;
#pragma unroll
    for (int j = 0; j < 4; ++j) { const int n = (lane >> 3) + 8 * j; const LAS float* s = scr + (8 * c) * 33 + n;
        u32x4 o; o.x = cvtpk(s[0 * 33], s[1 * 33]); o.y = cvtpk(s[2 * 33], s[3 * 33]); o.z = cvtpk(s[4 * 33], s[5 * 33]); o.w = cvtpk(s[6 * 33], s[7 * 33]);
        *(u32x4*)(WT + (size_t)(n0 + n) * Kd + k0 + 8 * c) = o; }
    asm volatile("s_waitcnt lgkmcnt(0)" ::: "memory");
}

__global__ void __launch_bounds__(NTHREADS, 2) hymba_fwd(Args args) {
    extern __shared__ __attribute__((aligned(16))) unsigned char lds[];
    typedef const __attribute__((address_space(4))) Args* KArgP;
    cg::grid_group grid = cg::this_grid();
    const int ph_lo = args.ph_lo, ph_hi = args.ph_hi;
    const int wave_s = __builtin_amdgcn_readfirstlane(threadIdx.x >> 6);
    volatile LAS unsigned* xbst = (volatile LAS unsigned*)((LAS unsigned char*)lds + LDS_BYTES - 64);
    if (threadIdx.x < 4) xbst[threadIdx.x] = 0u;
    __syncthreads();
    const XcdBarrier xbar = xcd_barrier_post((unsigned*)(args.ws + WS_CTL) + CTL_BARW, xbst);

    int ph = ph_lo, rep = 0;
    while (ph < ph_hi) {
        KArgP ap0 = (KArgP)__builtin_amdgcn_kernarg_segment_ptr();
#define ARG(k) (ap->in[k])
#define TID_HERE() int lane; asm volatile("v_mbcnt_lo_u32_b32 %0, -1, 0\n\tv_mbcnt_hi_u32_b32 %0, -1, %0" : "=v"(lane)); const int tid = wave_s * 64 + lane; (void)tid
        const int wave = wave_s;
#define PHASE_ROOTS() \
        KArgP ap = ap0; asm volatile("" : "+s"(ap)); \
        int G = gridDim.x, bx = blockIdx.x; asm volatile("" : "+s"(G), "+s"(bx)); \
        const int vcu = (G % 8 == 0) ? (bx % 8) * (G / 8) + bx / 8 : bx; \
        const int gw = vcu * NWAVES + wave, NGW = G * NWAVES; (void)gw; (void)NGW; \
        unsigned char* ws = ap->ws; float* outp = ap->out; (void)outp; \
        const float* x_in = (const float*)ARG(I_X); (void)x_in; \
        float* adap = (float*)(ws + WS_ADAP); (void)adap; float* mod = (float*)(ws + WS_CTL + CTL_MOD); (void)mod; \
        float* cs_t = (float*)(ws + WS_COS); float* sn_t = (float*)(ws + WS_SIN); (void)cs_t; (void)sn_t; \
        bf16_t* Hb = (bf16_t*)(ws + WS_H); bf16_t* Zb = (bf16_t*)(ws + WS_Z); bf16_t* Y16 = (bf16_t*)(ws + WS_Y); (void)Hb; (void)Zb; (void)Y16; \
        bf16_t* QLN = (bf16_t*)(ws + WS_QLN); bf16_t* KVLN = (bf16_t*)(ws + WS_KVLN); bf16_t* CONVH = (bf16_t*)(ws + WS_CONVH); bf16_t* SGVT = (bf16_t*)(ws + WS_SGVT); (void)QLN; (void)KVLN; (void)CONVH; (void)SGVT; \
        bf16_t* Qb = (bf16_t*)(ws + WS_Q); unsigned char* KNb = ws + WS_KN; unsigned char* KRb = ws + WS_KR; unsigned char* VIb = ws + WS_V; (void)Qb; (void)KNb; (void)KRb; (void)VIb; \
        bf16_t* YCAT = (bf16_t*)(ws + WS_YCAT); (void)YCAT
        if (ph == 0 && PHEN(0)) {
            TID_HERE(); PHASE_ROOTS();
            LAS float* scr = (LAS float*)(lds + wave * 16384);
            for (int it = gw; it < NLAYER * 16 * 48; it += NGW) { const int l = it / 768, r = it % 768, kc = r / 48, nc = r % 48;
                const float* W = (const float*)ARG(I_WADA) + (size_t)l * DM * 3072 + (size_t)(kc * 64) * 3072 + nc * 64 + lane;
                const float* c = (const float*)ARG(I_C) + kc * 64;
                float a0 = 0.f, a1 = 0.f, a2 = 0.f, a3 = 0.f;
#pragma unroll 8
                for (int k = 0; k < 64; ++k) { const float w = W[(size_t)k * 3072];
                    a0 += siluf_(c[k]) * w; a1 += siluf_(c[DM + k]) * w; a2 += siluf_(c[2 * DM + k]) * w; a3 += siluf_(c[3 * DM + k]) * w; }
                float* dst = adap + ((size_t)(kc * 2 + l) * 4) * 3072 + nc * 64 + lane;
                __hip_atomic_store(dst, a0, __ATOMIC_RELAXED, __HIP_MEMORY_SCOPE_AGENT); __hip_atomic_store(dst + 3072, a1, __ATOMIC_RELAXED, __HIP_MEMORY_SCOPE_AGENT);
                __hip_atomic_store(dst + 2 * 3072, a2, __ATOMIC_RELAXED, __HIP_MEMORY_SCOPE_AGENT); __hip_atomic_store(dst + 3 * 3072, a3, __ATOMIC_RELAXED, __HIP_MEMORY_SCOPE_AGENT);
                asm volatile("s_waitcnt vmcnt(0)" ::: "memory");
                unsigned tk = 0;
                if (lane == 0) tk = __hip_atomic_fetch_add((unsigned*)(ws + WS_CTL) + CTL_ADACNT + (l * 48 + nc) * 16, 1u, __ATOMIC_RELAXED, __HIP_MEMORY_SCOPE_AGENT);
                tk = (unsigned)__builtin_amdgcn_readfirstlane((int)tk);
                if (tk == 15u) {
                    const float* bada = (const float*)ARG(I_BADA) + (size_t)l * 3072;
#pragma unroll
                    for (int b = 0; b < 4; ++b) { float s = 0.f;
#pragma unroll
                        for (int k2 = 0; k2 < 16; ++k2) s += __hip_atomic_load(adap + ((size_t)(k2 * 2 + l) * 4 + b) * 3072 + nc * 64 + lane, __ATOMIC_RELAXED, __HIP_MEMORY_SCOPE_AGENT);
                        mod[((size_t)l * 4 + b) * 3072 + nc * 64 + lane] = s + bada[nc * 64 + lane]; }
                } }
            {
                constexpr int I0 = 16 * 80, I1 = 16 * 32, I2 = 4 * 24, I3 = 2 * 32, I4 = 4 * 8, IL = I0 + I1 + I2 + I3 + I4;
                for (int it = gw; it < NLAYER * IL; it += NGW) {
                    const int l = it / IL; int r = it % IL;
                    if (r < I0) { transpose_item((const float*)ARG(I_WIN) + (size_t)l * DM * DIN, DIN, (bf16_t*)(ws + WS_WIN) + (size_t)l * DINP * DM, DM, 0, scr, r / 80, r % 80, lane); continue; } r -= I0;
                    if (r < I1) { transpose_item((const float*)ARG(I_WOUT) + (size_t)l * DM * DM, DM, (bf16_t*)(ws + WS_WOUT) + (size_t)l * DM * DM, DM, 1, scr, r / 32, r % 32, lane); continue; } r -= I1;
                    if (r < I2) { transpose_item((const float*)ARG(I_WUQ) + (size_t)l * QLR * 768, 768, (bf16_t*)(ws + WS_WUQ) + (size_t)l * 768 * 256, 256, 2, scr, r / 24, r % 24, lane); continue; } r -= I2;
                    if (r < I3) { transpose_item((const float*)ARG(I_WUKV) + (size_t)l * KVLR * 1024, 1024, (bf16_t*)(ws + WS_WUKV) + (size_t)l * 1024 * 128, 128, 3, scr, r / 32, r % 32, lane); continue; } r -= I3;
                    transpose_item((const float*)ARG(I_WPW2) + (size_t)l * CW * CW, CW, (bf16_t*)(ws + WS_WPW2) + (size_t)l * CW * CW, CW, 4, scr, r / 8, r % 8, lane);
                }
            }
            const int gt = vcu * NTHREADS + tid, NGT = G * NTHREADS;
            for (int i = gt; i < NLAYER * SG * SCH * SCH; i += NGT) { const int s = i & 127, t = (i >> 7) & 127;
                const float v = s <= t ? ((const float*)ARG(I_WS))[i] : 0.f; ((bf16_t*)(ws + WS_WSM))[i] = (bf16_t)(cvtpk(v, 0.f) & 0xffffu); }
            const float inv_freq = powf(10000.0f, -(float)(2 * (gt & 31)) / 64.0f);
            for (int i = gt; i < MTOK * 32; i += NGT) { const int tok = i >> 5;
                const float ang = (float)((const int*)ARG(I_POS))[tok] * inv_freq;
                cs_t[i] = cosf(ang); sn_t[i] = sinf(ang); }
        } else if (ph == 1 && PHEN(1)) {
            TID_HERE(); PHASE_ROOTS();
            const float* gp = (const float*)ARG(I_GPRE);
            for (int grp = gw; grp < MTOK / 4; grp += NGW) { const int m0 = grp * 4, b = m0 >> 13;
                f32x4 v[4][4];
#pragma unroll
                for (int k = 0; k < 4; ++k) { const f32x4* xr = (const f32x4*)(x_in + (size_t)(m0 + k) * DM) + lane;
#pragma unroll
                    for (int j = 0; j < 4; ++j) v[k][j] = __builtin_nontemporal_load(&xr[64 * j]); }
                f32x4 pa[4], pb[4];
#pragma unroll
                for (int j = 0; j < 4; ++j) { const int c = 4 * lane + 256 * j;
                    pb[j] = *(const f32x4*)(mod + (size_t)b * 3072 + c);
                    pa[j] = *(const f32x4*)(gp + c) * (*(const f32x4*)(mod + (size_t)b * 3072 + DM + c) + 1.f); }
#pragma unroll
                for (int k = 0; k < 4; ++k) { float ss = 0.f;
#pragma unroll
                    for (int j = 0; j < 4; ++j) ss += (v[k][j].x * v[k][j].x + v[k][j].y * v[k][j].y) + (v[k][j].z * v[k][j].z + v[k][j].w * v[k][j].w);
                    const float rstd = rsqrtf(wave_sum(ss) * (1.f / DM) + EPS);
                    u32x2* o8 = (u32x2*)(Hb + (size_t)(m0 + k) * DM) + lane;
#pragma unroll
                    for (int j = 0; j < 4; ++j) { const f32x4 hv = (v[k][j] * rstd) * pa[j] + pb[j];
                        u32x2 w; w.x = cvtpk(hv.x, hv.y); w.y = cvtpk(hv.z, hv.w); o8[64 * j] = w; } }
            }
        } else {
            const int l = (ph - 2) / 6, sub = (ph - 2) % 6;
            const int ngemm = (sub == 0 || sub == 4) ? 1 : (sub == 2 ? 3 : 0);
#pragma nounroll
            for (int gi_ = 0; gi_ < ngemm * (1 + ((PROBE_MASK >> 8) & 1)) && PHEN(2); ++gi_) {
                const int gi = gi_ % ngemm;
                TID_HERE(); PHASE_ROOTS();
                pg8::Gemm g; EpiAll E; int Nn, cc = bx;
                if (sub == 0) { g = pg8::Gemm{Hb, (const bf16_t*)(ws + WS_WIN) + (size_t)l * DINP * DM, MTOK, DINP, DM, DM, DM}; Nn = DINP; E = EpiAll{EM_Z1, DINP, Zb, cs_t, sn_t, ws, (const float*)ARG(I_QNG) + l * QLR, (const float*)ARG(I_KVNG) + l * KVLR, (LAS unsigned char*)lds, (const float*)ARG(I_SLNG) + l * SW, (const float*)ARG(I_SLNB) + l * SW}; }
                else if (sub == 4) { g = pg8::Gemm{YCAT, (const bf16_t*)(ws + WS_WOUT) + (size_t)l * DM * DM, MTOK, DM, DM, DM, DM}; Nn = DM; E = EpiAll{EM_Z, DM, Y16, nullptr, nullptr, nullptr, nullptr, nullptr, nullptr, nullptr, nullptr}; }
                else if (gi == 0) { g = pg8::Gemm{QLN, (const bf16_t*)(ws + WS_WUQ) + (size_t)l * 768 * 256, MTOK, 768, 256, 256, 256}; Nn = 768; E = EpiAll{EM_Q, 0, Qb, cs_t, sn_t, nullptr, nullptr, nullptr, nullptr, nullptr, nullptr}; }
                else if (gi == 1) { g = pg8::Gemm{CONVH, (const bf16_t*)(ws + WS_WPW2) + (size_t)l * CW * CW, MTOK, CW, CW, CW, CW}; Nn = CW; cc = (bx + G / 2) % G; E = EpiAll{EM_PW2, 0, YCAT, Zb, nullptr, nullptr, nullptr, nullptr, nullptr, nullptr, nullptr}; }
                else { g = pg8::Gemm{KVLN, (const bf16_t*)(ws + WS_WUKV) + (size_t)l * 1024 * 128, MTOK, 1024, 128, 128, 128}; Nn = 1024; E = EpiAll{EM_KV, 0, KNb, VIb, nullptr, nullptr, nullptr, nullptr, nullptr, nullptr, nullptr}; }
                pg8::StaticOrder S; S.init(MTOK, Nn, G, cc);
#if STAGGER_US > 0
                if (sub == 0 && (bx & 8)) { const unsigned long long t0_ = __builtin_amdgcn_s_memrealtime(); while (__builtin_amdgcn_s_memrealtime() - t0_ < (unsigned long long)(STAGGER_US * 100)) __builtin_amdgcn_s_sleep(8); }
#endif
                pg8::gemm_phase<EpiAll>((LAS unsigned char*)lds, g, S, E, tid);
            }
            if (sub == 0) {
            } else if (sub == 1 && PHEN(3)) {
                TID_HERE(); PHASE_ROOTS();
                const float* cw = (const float*)ARG(I_CONVW) + (size_t)l * CK * CW; const float* cb = (const float*)ARG(I_CONVB) + l * CW;
                const float* clg = (const float*)ARG(I_CLNG) + l * CW; const float* clb = (const float*)ARG(I_CLNB) + l * CW;
                LAS float* glu = (LAS float*)lds;
                LAS float* cvo = (LAS float*)(lds + 63488);
                LAS bf16_t* sgv = (LAS bf16_t*)(lds + 63488 + 32768);
                float cwv[CK];
#pragma unroll
                for (int j = 0; j < CK; ++j) cwv[j] = cw[j * CW + (tid & 255)];
                const float cbias = cb[tid & 255];
                const f32x4 clg4 = *(const f32x4*)(clg + 4 * lane), clb4 = *(const f32x4*)(clb + 4 * lane);
                u32x4 ga[4]; u32x2 zsv[4];
#define P2A_LOAD(tt_) do { const int b_ = (tt_) >> 8, s0_ = ((tt_) & 255) * 32; const size_t m0_ = (size_t)b_ * SEQ + s0_; \
                    _Pragma("unroll") for (int pass = 0; pass < 4; ++pass) { const int r = pass * 16 + (tid >> 5), c8 = (tid & 31) * 8; const int s = s0_ - 30 + r; \
                        ga[pass] = *(const u32x4*)(Zb + ((size_t)b_ * SEQ + (s >= 0 ? (r < 62 ? s : s0_) : 0)) * DINP + ZC_CA + c8); \
                        if (r >= 62 || s < 0) ga[pass] = (u32x4){0u, 0u, 0u, 0u}; } \
                    _Pragma("unroll") for (int i = 0; i < 4; ++i) { const size_t m = m0_ + 4 * wave + i; const bf16_t* zr = Zb + m * DINP; \
                        zsv[i] = *(const u32x2*)(zr + ZC_SV + 4 * lane); } } while (0)
                P2A_LOAD(vcu < MTOK / 32 ? vcu : 0);
                for (int tt = vcu; tt < MTOK / 32; tt += G) {
                    const int b = tt >> 8, s0 = (tt & 255) * 32; const size_t m0 = (size_t)b * SEQ + s0;
#pragma unroll
                    for (int pass = 0; pass < 4; ++pass) { const int r = pass * 16 + (tid >> 5), c8 = (tid & 31) * 8;
                        if (r < 62) { const u32x4 a = ga[pass];
                            *(LAS f32x4*)(glu + r * 256 + c8) = (f32x4){lo_bf(a.x), hi_bf(a.x), lo_bf(a.y), hi_bf(a.y)}; *(LAS f32x4*)(glu + r * 256 + c8 + 4) = (f32x4){lo_bf(a.z), hi_bf(a.z), lo_bf(a.w), hi_bf(a.w)}; } }
#pragma unroll
                    for (int i = 0; i < 4; ++i) { const int tl = 4 * wave + i; const size_t m = m0 + tl; const int s = s0 + tl;
                        *(LAS u32x2*)(sgv + tl * 256 + 4 * lane) = zsv[i];
                    }
                    __syncthreads();
                    { const int tn = tt + G; P2A_LOAD(tn < MTOK / 32 ? tn : tt); }
                    { const int c = tid & 255, half = tid >> 8;
                      for (int g4 = 0; g4 < 4; ++g4) { const int tb = 16 * half + 4 * g4; float v[34];
#pragma unroll
                          for (int k = 0; k < 34; ++k) v[k] = glu[(tb + k) * 256 + c];
#pragma unroll
                          for (int i = 0; i < 4; ++i) { float a = cbias;
#pragma unroll
                              for (int j = 0; j < CK; ++j) a += cwv[j] * v[i + j];
                              cvo[(tb + i) * 256 + c] = a; } } }
                    __syncthreads();
                    for (int i = 0; i < 4; ++i) { const int tl = 4 * wave + i; const size_t m = m0 + tl;
                        const f32x4 xv = *(const LAS f32x4*)(cvo + tl * 256 + 4 * lane);
                        const float mean = wave_sum((xv.x + xv.y) + (xv.z + xv.w)) * (1.f / CW);
                        const float d0 = xv.x - mean, d1 = xv.y - mean, d2 = xv.z - mean, d3 = xv.w - mean;
                        const float rstd = rsqrtf(wave_sum((d0 * d0 + d1 * d1) + (d2 * d2 + d3 * d3)) * (1.f / CW) + EPS);
                        const f32x4 g = clg4, bb = clb4;
                        u32x2 w; w.x = cvtpk(siluf_(d0 * rstd * g.x + bb.x), siluf_(d1 * rstd * g.y + bb.y)); w.y = cvtpk(siluf_(d2 * rstd * g.z + bb.z), siluf_(d3 * rstd * g.w + bb.w));
                        *(u32x2*)(CONVH + m * 256 + 4 * lane) = w; }
                    { const int c = tid & 255, half = tid >> 8; unsigned pk[8];
#pragma unroll
                      for (int k = 0; k < 8; ++k) { const unsigned lo = sgv[(16 * half + 2 * k) * 256 + c], hi2 = sgv[(16 * half + 2 * k + 1) * 256 + c]; pk[k] = lo | (hi2 << 16); }
                      bf16_t* dst = SGVT + ((size_t)(m0 >> 7) * 256 + c) * 128 + (s0 & 127) + 16 * half;
                      *(u32x4*)dst = (u32x4){pk[0], pk[1], pk[2], pk[3]}; *(u32x4*)(dst + 8) = (u32x4){pk[4], pk[5], pk[6], pk[7]}; }
                    __syncthreads();
                }
#undef P2A_LOAD
            } else if (sub == 2 && PHEN(4)) {
                TID_HERE(); PHASE_ROOTS();
                { const bf16_t* WsM = (const bf16_t*)(ws + WS_WSM) + (size_t)l * SG * SCH * SCH; const float* bs = (const float*)ARG(I_BS) + l * SG * SCH;
                  const int r32 = lane & 31, hi = lane >> 5, gq = wave >> 1, th = wave & 1;
                  constexpr int UP = 528;
                  LAS unsigned char* ub = (LAS unsigned char*)lds;
                  for (int ck_ = vcu; ck_ < (MTOK / SCH) * (1 + ((PROBE_MASK >> 9) & 1)); ck_ += G) { const int ck = ck_ % (MTOK / SCH);
                      const size_t mc = (size_t)ck * SCH;
                      const bf16_t* Wb = WsM + ((size_t)gq * SCH + 64 * th + r32) * SCH + 8 * hi;
                      const bf16_t* Vb = SGVT + ((size_t)ck * 256 + gq * 64 + r32) * SCH + 8 * hi;
                      bf16x8 wf[2][4], vf[2][4];
#pragma unroll
                      for (int ks = 0; ks < 4; ++ks) { wf[0][ks] = *(const bf16x8*)(Wb + 16 * ks); wf[1][ks] = *(const bf16x8*)(Wb + 32 * SCH + 16 * ks);
                                                       vf[0][ks] = *(const bf16x8*)(Vb + 16 * ks); vf[1][ks] = *(const bf16x8*)(Vb + 32 * SCH + 16 * ks); }
#pragma unroll
                      for (int p = 0; p < 8; ++p) { const int idx = p * NTHREADS + tid, t = idx >> 5, c8 = (idx & 31) * 8;
                          const u32x4 o = *(const u32x4*)(Zb + (mc + t) * DINP + ZC_SU + c8);
                          *(LAS u32x4*)(ub + t * UP + c8 * 2) = o; }
                      f32x16 acc[2][2];
#pragma unroll
                      for (int a = 0; a < 2; ++a)
#pragma unroll
                          for (int bq = 0; bq < 2; ++bq) acc[a][bq] = f32x16{};
#pragma unroll
                      for (int kh = 0; kh < 2; ++kh) {
#pragma unroll
                          for (int ks = 0; ks < 4; ++ks) {
                              acc[0][0] = __builtin_amdgcn_mfma_f32_32x32x16_bf16(vf[0][ks], wf[0][ks], acc[0][0], 0, 0, 0);
                              acc[0][1] = __builtin_amdgcn_mfma_f32_32x32x16_bf16(vf[0][ks], wf[1][ks], acc[0][1], 0, 0, 0);
                              acc[1][0] = __builtin_amdgcn_mfma_f32_32x32x16_bf16(vf[1][ks], wf[0][ks], acc[1][0], 0, 0, 0);
                              acc[1][1] = __builtin_amdgcn_mfma_f32_32x32x16_bf16(vf[1][ks], wf[1][ks], acc[1][1], 0, 0, 0);
                          }
                          if (kh == 0) {
#pragma unroll
                              for (int ks = 0; ks < 4; ++ks) { wf[0][ks] = *(const bf16x8*)(Wb + 64 + 16 * ks); wf[1][ks] = *(const bf16x8*)(Wb + 32 * SCH + 64 + 16 * ks);
                                                               vf[0][ks] = *(const bf16x8*)(Vb + 64 + 16 * ks); vf[1][ks] = *(const bf16x8*)(Vb + 32 * SCH + 64 + 16 * ks); }
                          }
                      }
                      __syncthreads();
#pragma unroll
                      for (int rb = 0; rb < 2; ++rb) { const int t = 64 * th + 32 * rb + r32; const float bt = bs[gq * SCH + t];
#pragma unroll
                          for (int cb = 0; cb < 2; ++cb)
#pragma unroll
                              for (int q4 = 0; q4 < 4; ++q4) { LAS u32x2* p = (LAS u32x2*)(ub + t * UP + (gq * 64 + 32 * cb + 8 * q4 + 4 * hi) * 2);
                                  const u32x2 up = *p; u32x2 w;
                                  w.x = cvtpk((acc[cb][rb][4 * q4 + 0] + bt) * lo_bf(up.x), (acc[cb][rb][4 * q4 + 1] + bt) * hi_bf(up.x));
                                  w.y = cvtpk((acc[cb][rb][4 * q4 + 2] + bt) * lo_bf(up.y), (acc[cb][rb][4 * q4 + 3] + bt) * hi_bf(up.y));
                                  *p = w; } }
                      __syncthreads();
#pragma unroll
                      for (int p = 0; p < 8; ++p) { const int idx = p * NTHREADS + tid, t = idx >> 5, c8 = (idx & 31) * 8;
                          *(u32x4*)(YCAT + (mc + t) * DM + 768 + c8) = *(const LAS u32x4*)(ub + t * UP + c8 * 2); }
                      __syncthreads();
                  } }
            } else if (sub == 3 && PHEN(5)) {
                TID_HERE(); PHASE_ROOTS();
                const int nun = (NB * NH * 32 + G - 1) / G;
#pragma nounroll
                for (int i = 0; i < nun; ++i) {
                    const int u_ = vcu + i * G;
                    int bh = u_ >> 5, qb = 31 - (u_ & 31);
                    if (G == 256) { bh = vcu >> 4; qb = (i == 0) ? 31 - (vcu & 15) : (vcu & 15); }
                    int tid_u = tid; asm volatile("" : "+v"(tid_u));
                    if (bh < NB * NH) att::attn_unit3(bh >> 2, bh & 3, qb, Qb, KNb, KRb, VIb, Zb, YCAT, (char*)lds, tid_u);
                }
            } else if (sub == 5 && PHEN(7)) {
                TID_HERE(); PHASE_ROOTS();
                const float* xsrc = (l == 0) ? x_in : (const float*)outp;
                const float* gpost = (const float*)ARG(I_GPOST) + l * DM;
                const float* modl = mod + (size_t)l * 4 * 3072; const float* mod1 = mod + (size_t)4 * 3072; const float* gp1 = (const float*)ARG(I_GPRE) + DM;
                for (int grp = gw; grp < MTOK / 4; grp += NGW) { const int m0 = grp * 4, b = m0 >> 13;
                    u32x2 yv[4][4]; f32x4 xv[4][4];
#pragma unroll
                    for (int k = 0; k < 4; ++k) { const u32x2* yr = (const u32x2*)(Y16 + (size_t)(m0 + k) * DM) + lane; const f32x4* xr = (const f32x4*)(xsrc + (size_t)(m0 + k) * DM) + lane;
#pragma unroll
                        for (int j = 0; j < 4; ++j) { yv[k][j] = __builtin_nontemporal_load(&yr[64 * j]); xv[k][j] = __builtin_nontemporal_load(&xr[64 * j]); } }
                    f32x4 pg[4];
#pragma unroll
                    for (int j = 0; j < 4; ++j) { const int c = 4 * lane + 256 * j; pg[j] = *(const f32x4*)(modl + (size_t)b * 3072 + 2 * DM + c) * *(const f32x4*)(gpost + c); }
                    float rstd2[4];
#pragma unroll
                    for (int k = 0; k < 4; ++k) { float ss = 0.f; f32x4 y[4];
#pragma unroll
                        for (int j = 0; j < 4; ++j) { y[j] = (f32x4){lo_bf(yv[k][j].x), hi_bf(yv[k][j].x), lo_bf(yv[k][j].y), hi_bf(yv[k][j].y)};
                            ss += (y[j].x * y[j].x + y[j].y * y[j].y) + (y[j].z * y[j].z + y[j].w * y[j].w); }
                        const float rstd = rsqrtf(wave_sum(ss) * (1.f / DM) + EPS);
                        f32x4* orow = (f32x4*)(outp + (size_t)(m0 + k) * DM) + lane; float ss2 = 0.f;
#pragma unroll
                        for (int j = 0; j < 4; ++j) { xv[k][j] = xv[k][j] + (y[j] * rstd) * pg[j]; orow[64 * j] = xv[k][j];
                            ss2 += (xv[k][j].x * xv[k][j].x + xv[k][j].y * xv[k][j].y) + (xv[k][j].z * xv[k][j].z + xv[k][j].w * xv[k][j].w); }
                        rstd2[k] = rsqrtf(wave_sum(ss2) * (1.f / DM) + EPS); }
                    if (l == 0) {
                        f32x4 pa[4], pb[4];
#pragma unroll
                        for (int j = 0; j < 4; ++j) { const int c = 4 * lane + 256 * j;
                            pb[j] = *(const f32x4*)(mod1 + (size_t)b * 3072 + c);
                            pa[j] = *(const f32x4*)(gp1 + c) * (*(const f32x4*)(mod1 + (size_t)b * 3072 + DM + c) + 1.f); }
#pragma unroll
                        for (int k = 0; k < 4; ++k) { u32x2* o8 = (u32x2*)(Hb + (size_t)(m0 + k) * DM) + lane;
#pragma unroll
                            for (int j = 0; j < 4; ++j) { const f32x4 hv = (xv[k][j] * rstd2[k]) * pa[j] + pb[j];
                                u32x2 w; w.x = cvtpk(hv.x, hv.y); w.y = cvtpk(hv.z, hv.w); o8[64 * j] = w; } }
                    }
                }
            }
        }
        { bool again = false;
          if (rep == 0 && PROBE_MASK != 0) { if (ph == 0) again = (PROBE_MASK >> 7) & 1; else if (ph == 1) again = (PROBE_MASK >> 6) & 1; else if (ph >= 2) { const int sub_ = (ph - 2) % 6, l_ = (ph - 2) / 6; again = ((PROBE_MASK >> sub_) & 1) && !(sub_ == 5 && l_ == 1); } }
          if (again) rep = 1; else { rep = 0; ++ph; } }
        if (ph < ph_hi) { if (ph_lo < 0) grid.sync(); else xcd_barrier(xbar); }
    }
}

extern "C" void kernel_launch(void* const* d_in, const int* in_sizes, int n_in, void* d_out, int out_size, void* d_ws, size_t ws_size, hipStream_t stream) {
    static int grid = 0;
    if (grid == 0) {
        if (n_in != 22 || in_sizes[0] != MTOK * DM || out_size != MTOK * DM || ws_size < WS_END) {
            fprintf(stderr, "kernel_launch: unexpected shapes (n_in %d, in0 %d, out %d, ws %zu); nothing launched\n", n_in, n_in > 0 ? in_sizes[0] : -1, out_size, ws_size); grid = -1; return; }
        int dev = 0, cus = 0, per_cu = 0;
        (void)hipGetDevice(&dev); (void)hipDeviceGetAttribute(&cus, hipDeviceAttributeMultiprocessorCount, dev);
        if (hipFuncSetAttribute((const void*)hymba_fwd, hipFuncAttributeMaxDynamicSharedMemorySize, LDS_BYTES) != hipSuccess) { fprintf(stderr, "kernel_launch: hipFuncSetAttribute failed\n"); grid = -1; return; }
        if (hipOccupancyMaxActiveBlocksPerMultiprocessor(&per_cu, (const void*)hymba_fwd, NTHREADS, LDS_BYTES) != hipSuccess || per_cu < 1) { fprintf(stderr, "kernel_launch: occupancy query says %d blocks per CU\n", per_cu); per_cu = 1; }
        (void)hipGetLastError();
        grid = cus > 0 ? cus : 256;
    }
    if (grid < 0) return;
    (void)hipMemsetAsync((char*)d_ws + WS_CTL, 0, CTL_BYTES, stream);
    Args a{};
    for (int i = 0; i < 22; ++i) a.in[i] = d_in[i];
    a.out = (float*)d_out; a.ws = (unsigned char*)d_ws;
#if MK_N_LAUNCHES == 1
    a.ph_lo = 0; a.ph_hi = N_PHASES;
    { void* kargs[] = {&a};
      hipError_t e = hipLaunchCooperativeKernel((const void*)hymba_fwd, dim3(grid), dim3(NTHREADS), kargs, LDS_BYTES, stream);
      if (e != hipSuccess) fprintf(stderr, "cooperative launch failed: %s (grid %d)\n", hipGetErrorString(e), grid); }
#else
    for (int ph = 0; ph < N_PHASES; ++ph) { a.ph_lo = ph; a.ph_hi = ph + 1; void* kargs[] = {&a};
        hipError_t e = hipLaunchCooperativeKernel((const void*)hymba_fwd, dim3(grid), dim3(NTHREADS), kargs, LDS_BYTES, stream);
        if (e != hipSuccess) { fprintf(stderr, "launch %d failed: %s (grid %d)\n", ph, hipGetErrorString(e), grid); break; } }
#endif
}
```

```cpp
#include <hip/hip_runtime.h>
#include <hip/hip_cooperative_groups.h>
#include <cstdio>
#include <cstdint>
namespace cg = cooperative_groups;

#ifndef MK_N_LAUNCHES
#define MK_N_LAUNCHES 1
#endif

#define LAS __attribute__((address_space(3)))
#ifndef ATT_EXP_TOP
#define ATT_EXP_TOP 0
#endif
#ifndef STAGGER_US
#define STAGGER_US 0
#endif
#ifndef PROBE_MASK
#define PROBE_MASK 0
#endif
#ifndef PHMASK
#define PHMASK 0xff
#endif
#define PHEN(k) (((PHMASK) >> (k)) & 1)
typedef unsigned short bf16_t;
typedef short bf16x8 __attribute__((ext_vector_type(8)));
typedef short s16x4 __attribute__((ext_vector_type(4)));
typedef float f32x2 __attribute__((ext_vector_type(2)));
typedef float f32x4 __attribute__((ext_vector_type(4)));
typedef float f32x16 __attribute__((ext_vector_type(16)));
typedef unsigned u32x2 __attribute__((ext_vector_type(2)));
typedef unsigned u32x4 __attribute__((ext_vector_type(4)));

constexpr int DM = 1024, NB = 4, SEQ = 8192, MTOK = NB * SEQ, NLAYER = 2;
constexpr int NH = 4, DNOPE = 128, DROPE = 64, DQK = 192, DV = 128;
constexpr int QLR = 256, KVLR = 128, DIN = 2496, DINP = 2560;
constexpr int CW = 256, CK = 31, SW = 256, SG = 4, SCH = 128;
constexpr float EPS = 1e-6f;
constexpr int ZC_Q = 0, ZC_KV = 256, ZC_KR = 384, ZC_GATT = 512, ZC_CA = 1024, ZC_CB = 1280, ZC_GC = 1536, ZC_SU = 1792, ZC_SV = 2048, ZC_GS = 2304;
constexpr float QSCALE = 0.07216878364870323f * 1.4426950408889634f;

constexpr size_t MiB = 1u << 20;
constexpr size_t WS_CTL = 0, CTL_BYTES = 1 * MiB;
constexpr size_t CTL_BARW = 1024;
constexpr size_t CTL_ADACNT = 8192;
constexpr size_t CTL_MOD = 65536;
constexpr size_t WS_COS = 1 * MiB, WS_SIN = 5 * MiB;
constexpr size_t WS_WIN = 9 * MiB;
constexpr size_t WS_WOUT = 19 * MiB;
constexpr size_t WS_WUQ = 23 * MiB;
constexpr size_t WS_WUKV = 24 * MiB;
constexpr size_t WS_WPW2 = 25 * MiB;
constexpr size_t WS_WSM = 26 * MiB;
constexpr size_t WS_ADAP = 27 * MiB;
constexpr size_t WS_H = 32 * MiB;
constexpr size_t WS_Z = 96 * MiB;
constexpr size_t WS_Y = WS_Z;
constexpr size_t WS_QLN = 256 * MiB;
constexpr size_t WS_KVLN = 272 * MiB;
constexpr size_t WS_CONVH = 288 * MiB;
constexpr size_t WS_SGVT = 304 * MiB;
constexpr size_t WS_Q = 320 * MiB;
constexpr size_t WS_KN = 368 * MiB;
constexpr size_t WS_KR = 400 * MiB;
constexpr size_t WS_V = 408 * MiB;
constexpr size_t WS_YCAT = 440 * MiB;
constexpr size_t WS_END = 504 * MiB;

constexpr int LDS_BYTES = 147456;
constexpr int NTHREADS = 512, NWAVES = 8;

__device__ __forceinline__ float bf2f(unsigned short u) { return __uint_as_float(((unsigned)u) << 16); }
__device__ __forceinline__ unsigned cvtpk(float lo, float hi) { unsigned r; asm("v_cvt_pk_bf16_f32 %0, %1, %2" : "=v"(r) : "v"(lo), "v"(hi)); return r; }
__device__ __forceinline__ float lo_bf(unsigned w) { return __uint_as_float(w << 16); }
__device__ __forceinline__ float hi_bf(unsigned w) { return __uint_as_float(w & 0xffff0000u); }
#define dpp_f(v, ctrl) __int_as_float(__builtin_amdgcn_update_dpp(0, __float_as_int(v), (ctrl), 0xf, 0xf, true))
#define DPP_XOR1 0xB1
#define DPP_XOR2 0x4E
#define DPP_HMIRROR 0x141
#define DPP_MIRROR 0x140
__device__ __forceinline__ float xor1_f(float v) { return dpp_f(v, DPP_XOR1); }
__device__ __forceinline__ float wave_sum(float v) {
    v += dpp_f(v, DPP_XOR1); v += dpp_f(v, DPP_XOR2); v += dpp_f(v, DPP_HMIRROR); v += dpp_f(v, DPP_MIRROR);
    const int iv = __float_as_int(v);
    return (__int_as_float(__builtin_amdgcn_readlane(iv, 0)) + __int_as_float(__builtin_amdgcn_readlane(iv, 16))) +
           (__int_as_float(__builtin_amdgcn_readlane(iv, 32)) + __int_as_float(__builtin_amdgcn_readlane(iv, 48)));
}
__device__ __forceinline__ float sigmoidf_(float x) { return __builtin_amdgcn_rcpf(1.f + __builtin_amdgcn_exp2f(-1.4426950408889634f * x)); }
__device__ __forceinline__ float siluf_(float x) { return x * __builtin_amdgcn_rcpf(1.f + __builtin_amdgcn_exp2f(-1.4426950408889634f * x)); }
__device__ __forceinline__ float geluf_(float v) {
    const float av = __builtin_fabsf(v), t = __builtin_amdgcn_rcpf(av * 0.2316418882f + 1.0f);
    float q = t * 0.5307027145f + (-0.7265760135f); q = q * t + 0.7107068705f; q = q * t + (-0.142248368f); q = q * t + 0.127414796f; q = q * t;
    const float e = __builtin_amdgcn_exp2f((v * v) * (-0.72134752044f));
    const float m = v * (q * e);
    return v < 0.f ? m : v - m;
}

namespace pg8 {
constexpr int BM = 256, BK = 64, HALF = 128, HTB = HALF * BK * 2, STAGE_BYTES = 8 * HTB, NXCD = 8, WGM = 8;
__host__ __device__ __forceinline__ int lds_byte(int r, int c) { const int st = (r >> 4) * 2 + (c >> 5), rr = r & 15, cc = c & 31, ob = rr * 64 + cc * 2; return st * 1024 + (ob ^ (((ob >> 9) & 1) << 5)); }
__host__ __device__ __forceinline__ void stage_rc(int b, int& R, int& C) { const int st = b / 1024, sb = b % 1024, swz = sb ^ (((sb >> 9) & 1) << 5); R = (st >> 1) * 16 + swz / 64; C = (st & 1) * 32 + (swz % 64) / 2; }
__host__ __device__ __forceinline__ int perm32(int rho) { const int n = rho >> 4, i = rho & 15; return 8 * (i >> 2) + 4 * n + (i & 3); }

struct Unit { int pm, pn; };
struct Gemm { const bf16_t* A; const bf16_t* Bt; int M, N, K, lda, ldb; };

struct StaticOrder {
    int nM, nN, nwg, G, c;
    __host__ __device__ void init(int M, int N, int G_, int c_) { nM = M / BM; nN = N / BM; nwg = nM * nN; G = G_; c = c_; }
    __host__ __device__ bool next(int i, Unit& u) const {
        const long L = (long)i * G + c; if (L >= nwg) return false;
        int wgid = (int)L; { const int q = nwg / NXCD, r = nwg % NXCD, xcd = wgid % NXCD, off = wgid / NXCD; wgid = (xcd < r ? xcd * (q + 1) : r * (q + 1) + (xcd - r) * q) + off; }
        const int nig = WGM * nN, gid = wgid / nig, fm = gid * WGM, gsz = (nM - fm) < WGM ? (nM - fm) : WGM;
        u.pm = fm + ((wgid % nig) % gsz); u.pn = (wgid % nig) / gsz; return true;
    }
};

template <class Epi>
__device__ __forceinline__ void gemm_phase(LAS unsigned char* lds, const Gemm g, const StaticOrder& S, const Epi& E, const int tid) {
    const int wid = __builtin_amdgcn_readfirstlane(tid >> 6), lane = tid & 63, wr = wid >> 2, wc = wid & 3, fr = lane & 15, fq = lane >> 4;
    const int K = g.K, nt = K / BK;
    unsigned voffA[2], voffB[2];
#pragma unroll
    for (int i = 0; i < 2; ++i) { int R, C; stage_rc(tid * 16 + i * 8192, R, C); const int Rb = Epi::PERM ? ((R & ~31) + perm32(R & 31)) : R;
        voffA[i] = (unsigned)(R * g.lda + C) * 2u; voffB[i] = (unsigned)(Rb * g.ldb + C) * 2u; }
    const size_t kstep = (size_t)(BK * 2);
    const size_t hstepA = (size_t)HALF * g.lda * 2, hstepB = (size_t)HALF * g.ldb * 2;
    const size_t tstepA = 2 * hstepA, tstepB = 2 * hstepB;
    const unsigned ldsw = (unsigned)wid * 1024u;
    const int aoff = lds_byte(wr * 64 + fr, fq * 8), boff = lds_byte(wc * 32 + fr, fq * 8);
#define PG8_SA(b, h) (((b) * 2 + (h)) * HTB)
#define PG8_SB(b, h) ((4 + (b) * 2 + (h)) * HTB)
#define PG8_STAGE(bufoff, gbase, voff) do { _Pragma("unroll") for (int _i = 0; _i < 2; ++_i) \
        __builtin_amdgcn_global_load_lds((const unsigned*)((const char*)(gbase) + (voff)[_i]), (LAS unsigned*)(lds + (bufoff) + ldsw + _i * 8192), 16, 0, 0); } while (0)
#define PG8_LDA(dst, b, h) do { _Pragma("unroll") for (int m = 0; m < 4; ++m) _Pragma("unroll") for (int k = 0; k < 2; ++k) dst[m][k] = *(const LAS bf16x8*)(lds + PG8_SA(b, h) + aoff + m * 2048 + k * 1024); } while (0)
#define PG8_LDB(dst, b, h) do { _Pragma("unroll") for (int n = 0; n < 2; ++n) _Pragma("unroll") for (int k = 0; k < 2; ++k) dst[n][k] = *(const LAS bf16x8*)(lds + PG8_SB(b, h) + boff + n * 2048 + k * 1024); } while (0)
#define PG8_MMA(ai, bj, At, Bt) do { __builtin_amdgcn_s_setprio(1); _Pragma("unroll") for (int m = 0; m < 4; ++m) _Pragma("unroll") for (int n = 0; n < 2; ++n) _Pragma("unroll") for (int k = 0; k < 2; ++k) \
        acc[ai][bj][m][n] = __builtin_amdgcn_mfma_f32_16x16x32_bf16(Bt[n][k], At[m][k], acc[ai][bj][m][n], 0, 0, 0); __builtin_amdgcn_s_setprio(0); } while (0)
#define PG8_WAIT_V(n) asm volatile("s_waitcnt vmcnt(" #n ")" ::: "memory")
#define PG8_WAIT_L(n) asm volatile("s_waitcnt lgkmcnt(" #n ")" ::: "memory")
#define PG8_BAR __builtin_amdgcn_s_barrier()
#define PG8_SCHED __builtin_amdgcn_sched_barrier(0)
    Unit cur, nxt; int ui = 0;
    if (!S.next(0, cur)) return;
    f32x4 acc[2][2][4][2];
#pragma unroll
    for (int a = 0; a < 2; ++a)
#pragma unroll
        for (int b = 0; b < 2; ++b)
#pragma unroll
            for (int m = 0; m < 4; ++m)
#pragma unroll
                for (int n = 0; n < 2; ++n) acc[a][b][m][n] = (f32x4){0.f, 0.f, 0.f, 0.f};
    bf16x8 At[4][2], B0[2][2], B1[2][2];
    const char* cA = (const char*)g.A + (size_t)cur.pm * tstepA; const char* cB = (const char*)g.Bt + (size_t)cur.pn * tstepB;
    PG8_STAGE(PG8_SB(0, 0), cB, voffB); PG8_STAGE(PG8_SB(0, 1), cB + hstepB, voffB); PG8_STAGE(PG8_SA(0, 0), cA, voffA); PG8_STAGE(PG8_SA(0, 1), cA + hstepA, voffA);
    if (wr == 1) PG8_BAR;
    PG8_WAIT_V(2); PG8_BAR;
    PG8_STAGE(PG8_SB(1, 0), cB + kstep, voffB); PG8_STAGE(PG8_SA(1, 0), cA + kstep, voffA); PG8_STAGE(PG8_SB(1, 1), cB + hstepB + kstep, voffB);
    PG8_WAIT_V(6); PG8_BAR;
    for (;;) {
        const bool has_next = S.next(ui + 1, nxt);
        const char* nA = has_next ? (const char*)g.A + (size_t)nxt.pm * tstepA : cA; const char* nB = has_next ? (const char*)g.Bt + (size_t)nxt.pn * tstepB : cB;
        for (int t = 0; t < nt; t += 2) {
            const bool last = (t == nt - 2);
            const char* a1 = cA + (size_t)(t + 1) * kstep;
            const char* a2 = last ? nA : cA + (size_t)(t + 2) * kstep; const char* b2 = last ? nB : cB + (size_t)(t + 2) * kstep;
            const char* a3 = a2 + kstep; const char* b3 = b2 + kstep;
            PG8_LDB(B0, 0, 0); PG8_LDB(B1, 0, 1); PG8_SCHED; PG8_LDA(At, 0, 0); PG8_STAGE(PG8_SA(1, 1), a1 + hstepA, voffA);
            PG8_WAIT_V(8); PG8_WAIT_L(0); PG8_BAR; PG8_MMA(0, 0, At, B0); PG8_MMA(0, 1, At, B1); PG8_BAR; PG8_SCHED;
            PG8_LDA(At, 0, 1); PG8_STAGE(PG8_SB(0, 0), b2, voffB); PG8_STAGE(PG8_SB(0, 1), b2 + hstepB, voffB); PG8_STAGE(PG8_SA(0, 0), a2, voffA);
            PG8_WAIT_V(8); PG8_WAIT_L(0); PG8_BAR; PG8_MMA(1, 0, At, B0); PG8_MMA(1, 1, At, B1); PG8_BAR; PG8_SCHED;
            PG8_LDB(B0, 1, 0); PG8_LDB(B1, 1, 1); PG8_SCHED; PG8_LDA(At, 1, 0); PG8_STAGE(PG8_SA(0, 1), a2 + hstepA, voffA);
            PG8_WAIT_V(8); PG8_WAIT_L(0); PG8_BAR; PG8_MMA(0, 0, At, B0); PG8_MMA(0, 1, At, B1); PG8_BAR; PG8_SCHED;
            PG8_LDA(At, 1, 1); PG8_STAGE(PG8_SB(1, 0), b3, voffB); PG8_STAGE(PG8_SB(1, 1), b3 + hstepB, voffB); PG8_STAGE(PG8_SA(1, 0), a3, voffA);
            PG8_WAIT_V(8); PG8_WAIT_L(0); PG8_BAR; PG8_MMA(1, 0, At, B0); PG8_MMA(1, 1, At, B1); PG8_BAR; PG8_SCHED;
        }
        if (wr == 0) PG8_BAR;
        { Unit uu = cur; asm volatile("" : "+s"(uu.pm), "+s"(uu.pn)); int t2 = tid; asm volatile("" : "+v"(t2));
          E(acc, uu, wr, wc, t2 & 15, (t2 & 63) >> 4); }
        if (!has_next) break;
#pragma unroll
        for (int a = 0; a < 2; ++a)
#pragma unroll
            for (int b = 0; b < 2; ++b)
#pragma unroll
                for (int m = 0; m < 4; ++m)
#pragma unroll
                    for (int n = 0; n < 2; ++n) acc[a][b][m][n] = (f32x4){0.f, 0.f, 0.f, 0.f};
        cur = nxt; cA = nA; cB = nB; ++ui;
        if (wr == 1) PG8_BAR;
    }
    PG8_WAIT_V(0);
    PG8_BAR;
#undef PG8_SA
#undef PG8_SB
#undef PG8_STAGE
#undef PG8_LDA
#undef PG8_LDB
#undef PG8_MMA
#undef PG8_WAIT_V
#undef PG8_WAIT_L
#undef PG8_BAR
#undef PG8_SCHED
}
}

__host__ __device__ __forceinline__ int v_st(int k, int c) { const int kk = (k & ~0xC) | ((k & 4) << 1) | ((k & 8) >> 1); return ((kk >> 3) * 4 + (c >> 5)) * 512 + ((kk & 7) * 32 + (c & 31)) * 2; }
__device__ __forceinline__ int v_rd_base(int lane) { return ((lane & 3) << 3) | (((lane >> 2) & 3) << 6) | (((lane >> 4) & 1) << 5) | (((lane >> 5) & 1) << 8); }
constexpr int v_rd_off(int d0, int ks, int half) { return d0 * 512 + ks * 4096 + half * 2048; }
__device__ __forceinline__ int crow(int r, int hi) { return (r & 3) + 8 * (r >> 2) + 4 * hi; }

enum { EM_Z = 0, EM_F32 = 1, EM_Q = 2, EM_KV = 3, EM_PW2 = 4, EM_Z1 = 5 };
struct EpiAll {
    static constexpr bool PERM = true;
    int mode; int ldc; void* p0; const void* p1; const void* p2;
    unsigned char* wsb; const float* qng; const float* kvng; LAS unsigned char* ldsp; const float* slg; const float* slb;
    __device__ __forceinline__ void operator()(const f32x4 (&acc)[2][2][4][2], const pg8::Unit& u, int wr, int wc, int fr, int fq) const {
        const int row0 = u.pm * 256 + wr * 64 + fr, col0 = u.pn * 256 + wc * 32 + 8 * fq;
        if (mode == EM_Z) {
            bf16_t* O = (bf16_t*)p0;
#pragma unroll
            for (int ai = 0; ai < 2; ++ai)
#pragma unroll
                for (int m = 0; m < 4; ++m) { bf16_t* rowp = O + (size_t)(row0 + ai * 128 + m * 16) * ldc + col0;
#pragma unroll
                    for (int bj = 0; bj < 2; ++bj) { const f32x4 v0 = acc[ai][bj][m][0], v1 = acc[ai][bj][m][1];
                        u32x4 w; w.x = cvtpk(v0[0], v0[1]); w.y = cvtpk(v0[2], v0[3]); w.z = cvtpk(v1[0], v1[1]); w.w = cvtpk(v1[2], v1[3]);
                        *(u32x4*)(rowp + bj * 128) = w; } }
        } else if (mode == EM_Z1) {
            bf16_t* O = (bf16_t*)p0; const int pn = u.pn;
            if (pn < 2) {
                LAS float* P = (LAS float*)(ldsp + 131072);
                const int nb = (pn == 0) ? 2 : 1;
#pragma unroll
                for (int ai = 0; ai < 2; ++ai)
#pragma unroll
                    for (int m = 0; m < 4; ++m) { float s = 0.f;
#pragma unroll
                        for (int bj = 0; bj < 2; ++bj) if (bj < nb) {
#pragma unroll
                            for (int n = 0; n < 2; ++n) { const f32x4 v = acc[ai][bj][m][n]; s += (v[0] * v[0] + v[1] * v[1]) + (v[2] * v[2] + v[3] * v[3]); } }
                        { auto r_ = __builtin_amdgcn_permlane32_swap(__float_as_uint(s), __float_as_uint(s), false, false); s = __uint_as_float(r_[0]) + __uint_as_float(r_[1]); }
                        { auto r_ = __builtin_amdgcn_permlane16_swap(__float_as_uint(s), __float_as_uint(s), false, false); s = __uint_as_float(r_[0]) + __uint_as_float(r_[1]); }
                        if (fq == 0) P[(ai * 128 + wr * 64 + m * 16 + fr) * 4 + wc] = s; }
                asm volatile("s_waitcnt lgkmcnt(0)" ::: "memory"); __builtin_amdgcn_s_barrier(); asm volatile("" ::: "memory");
                const int c8 = wc * 32 + 8 * fq;
                const float* gn = (pn == 0) ? qng : kvng;
                f32x4 g00 = *(const f32x4*)(gn + c8), g01 = *(const f32x4*)(gn + c8 + 4), g10 = g00, g11 = g01;
                if (pn == 0) { g10 = *(const f32x4*)(gn + 128 + c8); g11 = *(const f32x4*)(gn + 128 + c8 + 4); }
                bf16_t* QLNp = (bf16_t*)(wsb + WS_QLN); bf16_t* KVLNp = (bf16_t*)(wsb + WS_KVLN); unsigned char* KRp = wsb + WS_KR;
                const float* cs = (const float*)p1; const float* sn = (const float*)p2;
                const float inv_n = (pn == 0) ? (1.f / QLR) : (1.f / KVLR);
#pragma unroll
                for (int ai = 0; ai < 2; ++ai)
#pragma unroll
                    for (int m = 0; m < 4; ++m) { const int rl_ = ai * 128 + wr * 64 + m * 16 + fr; const int tok = u.pm * 256 + rl_;
                        const f32x4 pp = *(const LAS f32x4*)(P + rl_ * 4);
                        const float rstd = rsqrtf(((pp[0] + pp[1]) + (pp[2] + pp[3])) * inv_n + EPS);
                        { const f32x4 v0 = acc[ai][0][m][0] * rstd * g00, v1 = acc[ai][0][m][1] * rstd * g01;
                          u32x4 w; w.x = cvtpk(v0[0], v0[1]); w.y = cvtpk(v0[2], v0[3]); w.z = cvtpk(v1[0], v1[1]); w.w = cvtpk(v1[2], v1[3]);
                          if (pn == 0) *(u32x4*)(QLNp + (size_t)tok * QLR + c8) = w; else *(u32x4*)(KVLNp + (size_t)tok * KVLR + c8) = w; }
                        if (pn == 0) { const f32x4 v0 = acc[ai][1][m][0] * rstd * g10, v1 = acc[ai][1][m][1] * rstd * g11;
                          u32x4 w; w.x = cvtpk(v0[0], v0[1]); w.y = cvtpk(v0[2], v0[3]); w.z = cvtpk(v1[0], v1[1]); w.w = cvtpk(v1[2], v1[3]);
                          *(u32x4*)(QLNp + (size_t)tok * QLR + 128 + c8) = w; }
                        else if (wc < 2) { const f32x4 v0 = acc[ai][1][m][0], v1 = acc[ai][1][m][1]; const int i0 = 16 * wc + 4 * fq; const int b = tok >> 13, s_ = tok & 8191;
                          const f32x4 c4 = *(const f32x4*)(cs + (size_t)tok * 32 + i0), s4 = *(const f32x4*)(sn + (size_t)tok * 32 + i0);
                          u32x4 w; w.x = cvtpk(v0[0] * c4[0] - v0[1] * s4[0], v0[1] * c4[0] + v0[0] * s4[0]); w.y = cvtpk(v0[2] * c4[1] - v0[3] * s4[1], v0[3] * c4[1] + v0[2] * s4[1]);
                          w.z = cvtpk(v1[0] * c4[2] - v1[1] * s4[2], v1[1] * c4[2] + v1[0] * s4[2]); w.w = cvtpk(v1[2] * c4[3] - v1[3] * s4[3], v1[3] * c4[3] + v1[2] * s4[3]);
                          *(u32x4*)(KRp + ((size_t)(b * (SEQ / 64) + (s_ >> 6))) * 8192 + (4 * wc + fq) * 1024 + (s_ & 63) * 16) = w; } }
                return;
            }
            if (pn == 8) {
                typedef float f32x2l __attribute__((ext_vector_type(2)));
                LAS f32x2l* P2 = (LAS f32x2l*)(ldsp + 131072);
#pragma unroll
                for (int ai = 0; ai < 2; ++ai)
#pragma unroll
                    for (int m = 0; m < 4; ++m) { float s = 0.f, q = 0.f;
#pragma unroll
                        for (int bj = 0; bj < 2; ++bj)
#pragma unroll
                            for (int n = 0; n < 2; ++n) { const f32x4 v = acc[ai][bj][m][n];
#pragma unroll
                                for (int e = 0; e < 4; ++e) { const float x = geluf_(v[e]); s += x; q += x * x; } }
                        { auto r_ = __builtin_amdgcn_permlane32_swap(__float_as_uint(s), __float_as_uint(s), false, false); s = __uint_as_float(r_[0]) + __uint_as_float(r_[1]); }
                        { auto r_ = __builtin_amdgcn_permlane16_swap(__float_as_uint(s), __float_as_uint(s), false, false); s = __uint_as_float(r_[0]) + __uint_as_float(r_[1]); }
                        { auto r_ = __builtin_amdgcn_permlane32_swap(__float_as_uint(q), __float_as_uint(q), false, false); q = __uint_as_float(r_[0]) + __uint_as_float(r_[1]); }
                        { auto r_ = __builtin_amdgcn_permlane16_swap(__float_as_uint(q), __float_as_uint(q), false, false); q = __uint_as_float(r_[0]) + __uint_as_float(r_[1]); }
                        if (fq == 0) P2[(ai * 128 + wr * 64 + m * 16 + fr) * 4 + wc] = (f32x2l){s, q};
                        __builtin_amdgcn_sched_barrier(0); }
                asm volatile("s_waitcnt lgkmcnt(0)" ::: "memory"); __builtin_amdgcn_s_barrier(); asm volatile("" ::: "memory");
                const int c8 = wc * 32 + 8 * fq;
                f32x4 gg[2][2], bb[2][2];
#pragma unroll
                for (int bj = 0; bj < 2; ++bj)
#pragma unroll
                    for (int n = 0; n < 2; ++n) { gg[bj][n] = *(const f32x4*)(slg + bj * 128 + c8 + 4 * n); bb[bj][n] = *(const f32x4*)(slb + bj * 128 + c8 + 4 * n); }
#pragma unroll
                for (int ai = 0; ai < 2; ++ai)
#pragma unroll
                    for (int m = 0; m < 4; ++m) { const int rl_ = ai * 128 + wr * 64 + m * 16 + fr;
                        const f32x4 pa_ = *(const LAS f32x4*)(P2 + rl_ * 4), pb_ = *(const LAS f32x4*)(P2 + rl_ * 4 + 2);
                        const float mean = ((pa_[0] + pa_[2]) + (pb_[0] + pb_[2])) * (1.f / SW);
                        const float var = ((pa_[1] + pa_[3]) + (pb_[1] + pb_[3])) * (1.f / SW) - mean * mean;
                        const float rstd = rsqrtf(fmaxf(var, 0.f) + EPS);
                        bf16_t* rowb = O + (size_t)(row0 + ai * 128 + m * 16) * ldc + col0;
#pragma unroll
                        for (int bj = 0; bj < 2; ++bj) { f32x4 x0 = acc[ai][bj][m][0], x1 = acc[ai][bj][m][1];
#pragma unroll
                            for (int e = 0; e < 4; ++e) { asm volatile("" : "+v"(x0[e]), "+v"(x1[e])); x0[e] = geluf_(x0[e]); x1[e] = geluf_(x1[e]); }
                            const f32x4 v0 = (x0 - mean) * rstd * gg[bj][0] + bb[bj][0], v1 = (x1 - mean) * rstd * gg[bj][1] + bb[bj][1];
                            u32x4 w; w.x = cvtpk(v0[0], v0[1]); w.y = cvtpk(v0[2], v0[3]); w.z = cvtpk(v1[0], v1[1]); w.w = cvtpk(v1[2], v1[3]);
                            __builtin_nontemporal_store(w, (u32x4*)(rowb + bj * 128)); }
                        __builtin_amdgcn_sched_barrier(0); }
                return;
            }
            const bool paired = (pn == 4) | (pn == 5) | (pn == 7) | (pn == 9), gate = (pn == 2) | (pn == 3) | (pn == 6);
            const int pcol = (pn == 4 ? 1024 : pn == 5 ? 1152 : pn == 7 ? 1792 : 1920) + wc * 32 + 8 * fq;
#pragma unroll
            for (int ai = 0; ai < 2; ++ai)
#pragma unroll
                for (int m = 0; m < 4; ++m) { bf16_t* rowb = O + (size_t)(row0 + ai * 128 + m * 16) * ldc;
                    if (paired) { const f32x4 a0 = acc[ai][0][m][0], a1 = acc[ai][0][m][1], b0 = acc[ai][1][m][0], b1 = acc[ai][1][m][1]; f32x4 r0, r1;
                        if (pn < 6) {
#pragma unroll
                            for (int e = 0; e < 4; ++e) { r0[e] = a0[e] * sigmoidf_(b0[e]); r1[e] = a1[e] * sigmoidf_(b1[e]); } }
                        else {
#pragma unroll
                            for (int e = 0; e < 4; ++e) { r0[e] = geluf_(a0[e]) * siluf_(b0[e]); r1[e] = geluf_(a1[e]) * siluf_(b1[e]); } }
                        u32x4 w; w.x = cvtpk(r0[0], r0[1]); w.y = cvtpk(r0[2], r0[3]); w.z = cvtpk(r1[0], r1[1]); w.w = cvtpk(r1[2], r1[3]);
                        __builtin_nontemporal_store(w, (u32x4*)(rowb + pcol)); }
                    else {
#pragma unroll
                        for (int bj = 0; bj < 2; ++bj) { f32x4 v0 = acc[ai][bj][m][0], v1 = acc[ai][bj][m][1];
                            if (gate) {
#pragma unroll
                                for (int e = 0; e < 4; ++e) { v0[e] = siluf_(v0[e]); v1[e] = siluf_(v1[e]); } }
                            u32x4 w; w.x = cvtpk(v0[0], v0[1]); w.y = cvtpk(v0[2], v0[3]); w.z = cvtpk(v1[0], v1[1]); w.w = cvtpk(v1[2], v1[3]);
                            __builtin_nontemporal_store(w, (u32x4*)(rowb + col0 + bj * 128)); } } }
        } else if (mode == EM_F32) {
            float* C = (float*)p0;
#pragma unroll
            for (int ai = 0; ai < 2; ++ai)
#pragma unroll
                for (int m = 0; m < 4; ++m) { float* rowp = C + (size_t)(row0 + ai * 128 + m * 16) * ldc + col0;
#pragma unroll
                    for (int bj = 0; bj < 2; ++bj)
#pragma unroll
                        for (int n = 0; n < 2; ++n) *(f32x4*)(rowp + bj * 128 + n * 4) = acc[ai][bj][m][n]; }
        } else if (mode == EM_Q) {
            bf16_t* Q = (bf16_t*)p0; const float* cs = (const float*)p1; const float* sn = (const float*)p2;
#pragma unroll
            for (int ai = 0; ai < 2; ++ai)
#pragma unroll
                for (int m = 0; m < 4; ++m) { const int tok = row0 + ai * 128 + m * 16, b = tok >> 13, s = tok & 8191;
#pragma unroll
                    for (int bj = 0; bj < 2; ++bj) { f32x4 v0 = acc[ai][bj][m][0], v1 = acc[ai][bj][m][1]; const int n = col0 + bj * 128;
                        bf16_t* dst;
                        if (u.pn < 2) { const int h = n >> 7, d = n & 127; dst = Q + ((size_t)((b * NH + h) * SEQ + s)) * DQK + d; }
                        else { const int n2 = n - 512, h = n2 >> 6, w = n2 & 63, i0 = w >> 1;
                            const f32x4 c4 = *(const f32x4*)(cs + (size_t)tok * 32 + i0), s4 = *(const f32x4*)(sn + (size_t)tok * 32 + i0);
                            f32x4 a0, a1;
                            a0[0] = v0[0] * c4[0] - v0[1] * s4[0]; a0[1] = v0[1] * c4[0] + v0[0] * s4[0];
                            a0[2] = v0[2] * c4[1] - v0[3] * s4[1]; a0[3] = v0[3] * c4[1] + v0[2] * s4[1];
                            a1[0] = v1[0] * c4[2] - v1[1] * s4[2]; a1[1] = v1[1] * c4[2] + v1[0] * s4[2];
                            a1[2] = v1[2] * c4[3] - v1[3] * s4[3]; a1[3] = v1[3] * c4[3] + v1[2] * s4[3];
                            v0 = a0; v1 = a1; dst = Q + ((size_t)((b * NH + h) * SEQ + s)) * DQK + DNOPE + w; }
                        v0 = v0 * QSCALE; v1 = v1 * QSCALE;
                        u32x4 wv; wv.x = cvtpk(v0[0], v0[1]); wv.y = cvtpk(v0[2], v0[3]); wv.z = cvtpk(v1[0], v1[1]); wv.w = cvtpk(v1[2], v1[3]);
                        *(u32x4*)dst = wv; } }
        } else if (mode == EM_KV) {
            unsigned char* KN = (unsigned char*)p0; unsigned char* VI = (unsigned char*)p1;
#pragma unroll
            for (int ai = 0; ai < 2; ++ai)
#pragma unroll
                for (int m = 0; m < 4; ++m) { const int tok = row0 + ai * 128 + m * 16, b = tok >> 13, s = tok & 8191;
#pragma unroll
                    for (int bj = 0; bj < 2; ++bj) { const f32x4 v0 = acc[ai][bj][m][0], v1 = acc[ai][bj][m][1]; const int n = (col0 + bj * 128) & 511;
                        const int h = n >> 7, d = n & 127;
                        const size_t tbase = ((size_t)((b * NH + h) * (SEQ / 64) + (s >> 6))) * 16384;
                        unsigned char* dst = (u.pn < 2) ? KN + tbase + (d >> 3) * 1024 + (s & 63) * 16 : VI + tbase + v_st(s & 63, d);
                        u32x4 wv; wv.x = cvtpk(v0[0], v0[1]); wv.y = cvtpk(v0[2], v0[3]); wv.z = cvtpk(v1[0], v1[1]); wv.w = cvtpk(v1[2], v1[3]);
                        *(u32x4*)dst = wv; } }
        } else {
            bf16_t* YCAT = (bf16_t*)p0; const bf16_t* Z = (const bf16_t*)p1;
#pragma unroll
            for (int ai = 0; ai < 2; ++ai)
#pragma unroll
                for (int m = 0; m < 4; ++m) { const int tok = row0 + ai * 128 + m * 16;
#pragma unroll
                    for (int bj = 0; bj < 2; ++bj) { const f32x4 v0 = acc[ai][bj][m][0], v1 = acc[ai][bj][m][1]; const int c = col0 + bj * 128;
                        const u32x4 g = *(const u32x4*)(Z + (size_t)tok * DINP + ZC_GC + c);
                        u32x4 wv;
                        wv.x = cvtpk(v0[0] * lo_bf(g.x), v0[1] * hi_bf(g.x)); wv.y = cvtpk(v0[2] * lo_bf(g.y), v0[3] * hi_bf(g.y));
                        wv.z = cvtpk(v1[0] * lo_bf(g.z), v1[1] * hi_bf(g.z)); wv.w = cvtpk(v1[2] * lo_bf(g.w), v1[3] * hi_bf(g.w));
                        *(u32x4*)(YCAT + (size_t)tok * DM + 512 + c) = wv; } }
        }
    }
};

namespace att {
constexpr int SLOT = 40960, NSLOT = 3, VOFF = 24576, LDS_WS = NSLOT * SLOT;
constexpr float THR = 8.f;
#define SBAR() __builtin_amdgcn_sched_barrier(0)
__device__ __forceinline__ void glds16s(const void* sbase, unsigned voff, unsigned lds_dst) { unsigned keep;
    asm volatile("s_mov_b32 %0, m0\n\ts_mov_b32 m0, %3\n\ts_nop 0\n\tglobal_load_lds_dwordx4 %1, %2\n\ts_mov_b32 m0, %0" : "=&s"(keep) : "v"(voff), "s"(sbase), "s"(lds_dst) : "memory"); }
#if ATT_EXP_TOP & 4
#define GLDS_DUP "global_load_lds_dwordx4 %1, off\n\t"
#else
#define GLDS_DUP ""
#endif
__device__ __forceinline__ void glds16(const void* gsrc, unsigned lds_dst) { unsigned keep;
    asm volatile("s_mov_b32 %0, m0\n\ts_mov_b32 m0, %2\n\ts_nop 0\n\tglobal_load_lds_dwordx4 %1, off\n\t" GLDS_DUP "s_mov_b32 m0, %0" : "=&s"(keep) : "v"(gsrc), "s"(lds_dst) : "memory"); }

template <int AX> __device__ __forceinline__ void attn_unit3(int b, int h, int qb, const bf16_t* Q, const unsigned char* KN, const unsigned char* KR, const unsigned char* VI,
                                           const bf16_t* Z, bf16_t* YCAT, char* shm, const int tid) {
    const int lane = tid & 63, r32 = lane & 31, hi = lane >> 5; const int wid = __builtin_amdgcn_readfirstlane(tid >> 6);
    const int q0 = qb * 256, NT = 4 * (qb + 1);
    const int bh = b * NH + h;
    const unsigned lds0 = (unsigned)(uintptr_t)shm;
    const unsigned char* knb = KN + (size_t)bh * (SEQ / 64) * 16384;
    const unsigned char* krb = KR + (size_t)b * (SEQ / 64) * 8192;
    const unsigned char* vbs = VI + (size_t)bh * (SEQ / 64) * 16384;
    const unsigned dvo = (unsigned)(wid * 1024 + lane * 16);
#define DMA_TILE(t, slot) do { const unsigned d_ = (unsigned)__builtin_amdgcn_readfirstlane(lds0 + (slot) + wid * 1024); \
        glds16s(knb + (size_t)(t) * 16384, dvo, d_); glds16s(knb + (size_t)(t) * 16384 + 8192, dvo, d_ + 8192); glds16s(krb + (size_t)(t) * 8192, dvo, d_ + 16384); \
        glds16s(vbs + (size_t)(t) * 16384, dvo, d_ + VOFF); glds16s(vbs + (size_t)(t) * 16384 + 8192, dvo, d_ + VOFF + 8192); } while (0)
    const bf16_t* Qw = Q + ((size_t)(bh * SEQ + q0 + wid * 32 + r32)) * DQK;
    bf16x8 qr[12];
#pragma unroll
    for (int d0 = 0; d0 < 12; ++d0) qr[d0] = *(const bf16x8*)(Qw + d0 * 16 + hi * 8);
#pragma unroll
    for (int d0 = 0; d0 < 12; ++d0) asm volatile("" : "+v"(qr[d0]));
    asm volatile("s_waitcnt vmcnt(0)" ::: "memory");
    DMA_TILE(0, 0);
    float m_run = 0.f, l_run = 0.f; f32x16 o[4];
#pragma unroll
    for (int d = 0; d < 4; ++d) o[d] = f32x16{};
    const LAS char* shm3 = (const LAS char*)shm;
    const LAS char* kl = shm3 + hi * 1024 + r32 * 16;
    const int vb0 = (int)lds0 + VOFF + v_rd_base(lane);
    const int qabs = q0 + wid * 32 + r32;
    f32x16 sA, sB, negm; bf16x8 pa0, pa1; float pmaxN = 0.f;
    bf16x8 kpa, kpb;

#define MF(acc, a_, b_) acc = __builtin_amdgcn_mfma_f32_32x32x16_bf16(a_, b_, acc, 0, 0, 0)
#define MFQ(acc, a_, b_) do { if (AX & 64) { asm volatile("" :: "v"(a_), "v"(b_)); } else MF(acc, a_, b_); } while (0)
#define MFO(acc, a_, b_) do { if (AX & 8) { bf16x8 t0_ = a_, t1_ = b_; asm volatile("" :: "v"(t0_), "v"(t1_)); } else acc = __builtin_amdgcn_mfma_f32_32x32x16_bf16(b_, a_, acc, 0, 0, 0); } while (0)
#define DMAP(on_, i_, t_, slot_) do { if ((on_) && !(AX & 2)) { const unsigned d_ = (unsigned)__builtin_amdgcn_readfirstlane(lds0 + (slot_) + wid * 1024); \
        if ((i_) == 0) glds16s(knb + (size_t)(t_) * 16384, dvo, d_); else if ((i_) == 1) glds16s(knb + (size_t)(t_) * 16384 + 8192, dvo, d_ + 8192); \
        else if ((i_) == 2) glds16s(krb + (size_t)(t_) * 8192, dvo, d_ + 16384); else if ((i_) == 3) glds16s(vbs + (size_t)(t_) * 16384, dvo, d_ + VOFF); \
        else glds16s(vbs + (size_t)(t_) * 16384 + 8192, dvo, d_ + VOFF + 8192); } } while (0)
#ifndef ATT_EXP
#define ATT_EXP 0
#endif
#if ATT_EXP & 1
#define KLD1(dst, kp_, d0) do { dst = *(const LAS bf16x8*)(kp_ + (d0) * 2048); bf16x8 dmy_; asm volatile("ds_read_b128 %0, %1 offset:%2" : "=v"(dmy_) : "v"((int)(uintptr_t)(kp_)), "i"(((d0) * 2048) & 0xffff) : "memory"); asm volatile("" :: "v"(dmy_)); } while (0)
#else
#define KLD1(dst, kp_, d0) do { if (AX & 32) { asm volatile("" : "+v"(dst)); } else dst = *(const LAS bf16x8*)(kp_ + (d0) * 2048); } while (0)
#endif
#define KLD1R(dst, kp_, d0) dst = *(const LAS bf16x8*)(kp_ + (d0) * 2048)
#define MASKH(S, T_, hf_) do { if ((T_) >= NT - 4) { const float NEG = -__builtin_inff(); const int kb_ = 64 * (T_) + 32 * (hf_) + 4 * hi; \
        _Pragma("unroll") for (int r = 0; r < 16; ++r) { const int kv = kb_ + (r & 3) + 8 * (r >> 2); if (kv > qabs) S[r] = NEG; } } } while (0)
#define ROWMAX_FIN(mx0, mx1, out) do { float m_ = fmaxf(mx0, mx1); auto rr_ = __builtin_amdgcn_permlane32_swap(__float_as_uint(m_), __float_as_uint(m_), false, false); \
        out = fmaxf(__uint_as_float(rr_[0]), __uint_as_float(rr_[1])); } while (0)
#define DECIDE(pmax_, SYp) do { if (!__all((pmax_) <= THR)) { const float dl_ = fmaxf((pmax_), 0.f); const float al_ = __builtin_amdgcn_exp2f(-dl_); m_run += dl_; l_run *= al_; \
        _Pragma("unroll") for (int r = 0; r < 16; ++r) { SYp[r] -= dl_; negm[r] = -m_run; } \
        _Pragma("unroll") for (int d_ = 0; d_ < 4; ++d_) _Pragma("unroll") for (int r = 0; r < 16; ++r) o[d_][r] *= al_; } } while (0)
#define PK4(P, B_, OUT) do { if (AX & 128) { asm volatile("" : "=v"(OUT) : "v"(P)); break; } unsigned a0_ = cvtpk(P[B_ + 0], P[B_ + 1]), a1_ = cvtpk(P[B_ + 2], P[B_ + 3]); \
        unsigned b0_ = cvtpk(P[B_ + 4], P[B_ + 5]), b1_ = cvtpk(P[B_ + 6], P[B_ + 7]); \
        auto r0_ = __builtin_amdgcn_permlane32_swap(a0_, b0_, false, false); auto r1_ = __builtin_amdgcn_permlane32_swap(a1_, b1_, false, false); \
        u32x4 w_ = {r0_[0], r1_[0], r0_[1], r1_[1]}; OUT = *reinterpret_cast<bf16x8*>(&w_); } while (0)
#if ATT_EXP & 2
#define SMC2(S, i) do { const float e0_ = __builtin_amdgcn_exp2f(S[i] - m_run), e1_ = __builtin_amdgcn_exp2f(S[(i) + 1] - m_run); \
        float x0_ = __builtin_amdgcn_exp2f(S[i] - l_run), x1_ = __builtin_amdgcn_exp2f(S[(i) + 1] - l_run); x0_ += x1_; asm volatile("" :: "v"(x0_)); \
        S[i] = e0_; S[(i) + 1] = e1_; ps0 += e0_; ps1 += e1_; } while (0)
#else
#define SMC2(S, i) do { if (AX & 128) break; const float e0_ = (AX & 1) ? S[i] : __builtin_amdgcn_exp2f(S[i]), e1_ = (AX & 1) ? S[(i) + 1] : __builtin_amdgcn_exp2f(S[(i) + 1]); S[i] = e0_; S[(i) + 1] = e1_; ps0 += e0_; ps1 += e1_; } while (0)
#endif
#define SMFIN() do { if (AX & 128) break; float ps_ = ps0 + ps1; auto rr_ = __builtin_amdgcn_permlane32_swap(__float_as_uint(ps_), __float_as_uint(ps_), false, false); \
        l_run += __uint_as_float(rr_[0]) + __uint_as_float(rr_[1]); } while (0)
#define TRRD(dst, off) do { if (AX & 16) asm volatile("" : "=v"(dst)); else asm volatile("ds_read_b64_tr_b16 %0, %1 offset:%2" : "=&v"(dst) : "v"(vb_), "i"(off) : "memory"); } while (0)
#define TRRD4(P_, d0, hf_) do { constexpr int b_ = v_rd_off(d0, 2 * (hf_), 0); TRRD(P_##l0, b_); TRRD(P_##h0, b_ + 2048); TRRD(P_##l1, b_ + 4096); TRRD(P_##h1, b_ + 6144); } while (0)
#define VF(P_, k) (bf16x8){P_##l##k[0], P_##l##k[1], P_##l##k[2], P_##l##k[3], P_##h##k[0], P_##h##k[1], P_##h##k[2], P_##h##k[3]}
#define LGK(n) do { if (!(AX & 256)) asm volatile("s_waitcnt lgkmcnt(" #n ")" ::: "memory"); } while (0)
#define RMC2(S, j) do { if (AX & 128) break; mx0 = __builtin_fmaxf(__builtin_fmaxf(mx0, S[j]), S[(j) + 1]); } while (0)
#define RMC4(S, j) do { RMC2(S, j); RMC2(S, (j) + 2); } while (0)

#define HSTEP(SX, SY, T_, HF, TN, HFN, has_next_, dma_on_, bar_, pf_, knext_) do { \
        float ps0 = 0.f, ps1 = 0.f; \
        if (has_next_) { \
            const LAS char* kp_ = kl + ((HFN) == 0 ? sl_n1 : sl_cur) + (HFN) * 512; bf16x8 k0 = kpa, k1 = kpb, k2 = kpa; \
            KLD1(k2, kp_, 2); SBAR(); \
            if (AX & 64) { SY = negm; asm volatile("" :: "v"(k0)); } else SY = __builtin_amdgcn_mfma_f32_32x32x16_bf16(k0, qr[0], negm, 0, 0, 0); SMC2(SX, 0); SBAR(); KLD1(k0, kp_, 3); DMAP(dma_on_, 0, (T_) + 2, sl_n2); SBAR(); \
            MFQ(SY, k1, qr[1]); SMC2(SX, 2); SBAR(); KLD1(k1, kp_, 4); DMAP(dma_on_, 1, (T_) + 2, sl_n2); SBAR(); \
            MFQ(SY, k2, qr[2]); SMC2(SX, 4); SBAR(); KLD1(k2, kp_, 5); DMAP(dma_on_, 2, (T_) + 2, sl_n2); SBAR(); \
            MFQ(SY, k0, qr[3]); SMC2(SX, 6); SBAR(); KLD1(k0, kp_, 6); DMAP(dma_on_, 3, (T_) + 2, sl_n2); SBAR(); \
            MFQ(SY, k1, qr[4]); SMC2(SX, 8); SBAR(); KLD1(k1, kp_, 7); DMAP(dma_on_, 4, (T_) + 2, sl_n2); SBAR(); \
            MFQ(SY, k2, qr[5]); SMC2(SX, 10); SBAR(); KLD1(k2, kp_, 8); SBAR(); \
            MFQ(SY, k0, qr[6]); SMC2(SX, 12); SBAR(); KLD1(k0, kp_, 9); SBAR(); \
            MFQ(SY, k1, qr[7]); SMC2(SX, 14); SBAR(); KLD1(k1, kp_, 10); SBAR(); \
            MFQ(SY, k2, qr[8]); PK4(SX, 0, pa0); SBAR(); KLD1(k2, kp_, 11); SBAR(); \
            MFQ(SY, k0, qr[9]); PK4(SX, 8, pa1); SBAR(); \
            MFQ(SY, k1, qr[10]); SMFIN(); SBAR(); \
            MFQ(SY, k2, qr[11]); SBAR(); \
        } else { \
            _Pragma("unroll") for (int i_ = 0; i_ < 16; i_ += 2) SMC2(SX, i_); \
            PK4(SX, 0, pa0); PK4(SX, 8, pa1); SMFIN(); SBAR(); \
        } \
        if (bar_) { if (AX & 4) asm volatile("s_waitcnt vmcnt(0) lgkmcnt(0)" ::: "memory"); else asm volatile("s_waitcnt vmcnt(0) lgkmcnt(0)\n\ts_barrier" ::: "memory"); }     \
        { const int vb_ = vb0 + sl_cur; s16x4 Al0, Al1, Ah0, Ah1, Bl0, Bl1, Bh0, Bh1; \
          float mx0 = -__builtin_inff(); \
          TRRD4(A, 0, HF); TRRD4(B, 1, HF); SBAR(); \
          if (pf_) { KLD1(kpa, knext_, 0); KLD1(kpb, knext_, 1); } SBAR(); \
          if (has_next_) MASKH(SY, TN, HFN); \
          SBAR(); if (pf_) LGK(6); else LGK(4); SBAR();                   \
          MFO(o[0], pa0, VF(A, 0)); if (has_next_) { RMC4(SY, 0); } SBAR(); MFO(o[0], pa1, VF(A, 1)); if (has_next_) { RMC4(SY, 4); } SBAR(); \
          TRRD4(A, 2, HF); SBAR(); if (pf_) LGK(6); else LGK(4); SBAR();    \
          MFO(o[1], pa0, VF(B, 0)); if (has_next_) { RMC4(SY, 8); } SBAR(); MFO(o[1], pa1, VF(B, 1)); if (has_next_) { RMC4(SY, 12); } SBAR(); \
          TRRD4(B, 3, HF); LGK(4); SBAR();                                  \
          MFO(o[2], pa0, VF(A, 0)); MFO(o[2], pa1, VF(A, 1)); SBAR(); \
          LGK(0); SBAR(); \
          MFO(o[3], pa0, VF(B, 0)); MFO(o[3], pa1, VF(B, 1)); SBAR(); \
          const float mx1 = mx0; \
          if ((has_next_) && !(AX & 128)) { ROWMAX_FIN(mx0, mx1, pmaxN); DECIDE(pmaxN, SY); } } \
    } while (0)

    int sl_cur = 0, sl_n1 = SLOT, sl_n2 = 2 * SLOT;
    asm volatile("s_waitcnt vmcnt(0) lgkmcnt(0)\n\ts_barrier" ::: "memory");
    DMA_TILE(1, SLOT); if (AX & 2) DMA_TILE(2, 2 * SLOT);
    { const LAS char* kp_ = shm3 + hi * 1024 + r32 * 16; bf16x8 ka, kb;
      sA = f32x16{};
      KLD1R(ka, kp_, 0); KLD1R(kb, kp_, 1); SBAR();
#pragma unroll
      for (int d2 = 0; d2 < 12; d2 += 2) {
          MF(sA, ka, qr[d2]); SBAR(); if (d2 + 2 < 12) KLD1R(ka, kp_, d2 + 2); SBAR();
          MF(sA, kb, qr[d2 + 1]); SBAR(); if (d2 + 3 < 12) KLD1R(kb, kp_, d2 + 3); SBAR(); }
      KLD1R(kpa, kp_ + 512, 0); KLD1R(kpb, kp_ + 512, 1); SBAR(); }
    MASKH(sA, 0, 0);
    { float mx0 = -__builtin_inff();
#pragma unroll
      for (int j = 0; j < 16; j += 2) RMC2(sA, j);
      ROWMAX_FIN(mx0, mx0, pmaxN); m_run = pmaxN;
#pragma unroll
      for (int r = 0; r < 16; ++r) { sA[r] -= m_run; negm[r] = -m_run; } }
    for (int T = 0; T < ((AX & 1024) ? 1 : NT); ++T) {
        const bool more = T + 1 < NT;
        HSTEP(sA, sB, T, 0, T, 1, true, false, more, more, (kl + sl_n1));
        HSTEP(sB, sA, T, 1, T + 1, 0, more, (T + 2 < NT), false, more, (kl + sl_n1 + 512));
        { const int tmp_ = sl_cur; sl_cur = sl_n1; sl_n1 = sl_n2; sl_n2 = tmp_; }
    }
    asm volatile("s_waitcnt lgkmcnt(0)\n\ts_barrier" ::: "memory");
    if (AX & 512) { asm volatile("" :: "v"(o[0]), "v"(o[1]), "v"(o[2]), "v"(o[3])); } else
    { int r32e = r32, hie = hi; asm volatile("" : "+v"(r32e), "+v"(hie));
      const size_t mrow = (size_t)b * SEQ + q0 + wid * 32 + r32e;
      const bf16_t* zp = Z + mrow * DINP + ZC_GATT + h * DV + 8 * hie; bf16_t* yp = YCAT + mrow * DM + h * DV + 8 * hie;
      u32x4 gv[8];
#pragma unroll
      for (int j = 0; j < 8; ++j) gv[j] = *(const u32x4*)(zp + 16 * j);
      const float rl = __builtin_amdgcn_rcpf(l_run);
#pragma unroll
      for (int j = 0; j < 8; ++j) { const int d0 = j >> 1, gp = j & 1; float na[4], nb[4];
#pragma unroll
          for (int i = 0; i < 4; ++i) { auto rr_ = __builtin_amdgcn_permlane32_swap(__float_as_uint(o[d0][8 * gp + i] * rl), __float_as_uint(o[d0][8 * gp + 4 + i] * rl), false, false);
              na[i] = __uint_as_float(rr_[0]); nb[i] = __uint_as_float(rr_[1]); }
          const u32x4 g = gv[j]; u32x4 w;
          w.x = cvtpk(na[0] * lo_bf(g.x), na[1] * hi_bf(g.x)); w.y = cvtpk(na[2] * lo_bf(g.y), na[3] * hi_bf(g.y));
          w.z = cvtpk(nb[0] * lo_bf(g.z), nb[1] * hi_bf(g.z)); w.w = cvtpk(nb[2] * lo_bf(g.w), nb[3] * hi_bf(g.w));
          *(u32x4*)(yp + 16 * j) = w; } }
#undef DMA_TILE
#undef DMAP
#undef MF
#undef MFQ
#undef MFO
#undef KLD1R
#undef KLD1
#undef MASKH
#undef ROWMAX_FIN
#undef DECIDE
#undef PK4
#undef SMC2
#undef SMFIN
#undef TRRD
#undef TRRD4
#undef VF
#undef LGK
#undef RMC2
#undef RMC4
#undef HSTEP
}
#undef SBAR
}

#define XB_TMO      128
#define XB_XCNT(j)  (256  + 64 * (j))
#define XB_XSUB(j)  (1280 + 64 * (j))
#define XB_XGEN(j)  (2304 + 64 * (j))
#define XB_TOP      3328
#define XB_TOPGEN   3392
#define XCD_BAR_WORDS 3456
#define XB_SPIN_CAP (1u << 18)
__device__ __forceinline__ unsigned xb_ld(unsigned* p)              { return __hip_atomic_load(p, __ATOMIC_RELAXED, __HIP_MEMORY_SCOPE_AGENT); }
__device__ __forceinline__ unsigned xb_add(unsigned* p, unsigned v) { return __hip_atomic_fetch_add(p, v, __ATOMIC_RELAXED, __HIP_MEMORY_SCOPE_AGENT); }
__device__ __forceinline__ unsigned xb_xcc_id() { return (unsigned)__builtin_amdgcn_s_getreg((3 << 11) | 20) & 0xFu; }
#define XB_SPIN(cond, bar) do { unsigned _sp = 0; while (cond) { __builtin_amdgcn_s_sleep(1); \
    if ((++_sp & 255u) == 0u) { if (xb_ld(&(bar)[XB_TMO])) break; if (_sp > XB_SPIN_CAP) { atomicAdd(&(bar)[XB_TMO], 1u); break; } } } } while (0)
struct XcdBarrier { unsigned* bar; unsigned x; volatile LAS unsigned* st; };
__device__ __forceinline__ XcdBarrier xcd_barrier_post(unsigned* bar, volatile LAS unsigned* st) {
    XcdBarrier b; b.bar = bar; b.x = xb_xcc_id(); b.st = st;
    if (threadIdx.x == 0) (void)xb_add(&bar[XB_XCNT(b.x)], 1u);
    return b;
}
__device__ __forceinline__ void xcd_barrier_complete(unsigned* bar, unsigned x, unsigned& nloc, unsigned& nx) {
    const unsigned G = gridDim.x * gridDim.y * gridDim.z;
    unsigned sum, cnt, mine, sp = 0u;
    for (;;) {
        sum = 0u; cnt = 0u; mine = 0u;
#pragma unroll
        for (unsigned j = 0; j < 16; ++j) { const unsigned c = xb_ld(&bar[XB_XCNT(j)]); sum += c; cnt += (c > 0u) ? 1u : 0u; mine = (j == x) ? c : mine; }
        if (sum == G) break;
        __builtin_amdgcn_s_sleep(1);
        if ((++sp & 255u) == 0u) { if (xb_ld(&bar[XB_TMO])) break; if (sp > XB_SPIN_CAP) { atomicAdd(&bar[XB_TMO], 1u); break; } }
    }
    nloc = mine > 0u ? mine : 1u; nx = cnt > 0u ? cnt : 1u;
}
__device__ __forceinline__ void xcd_barrier(const XcdBarrier& b) {
    asm volatile("s_waitcnt vmcnt(0)" ::: "memory");
    __syncthreads();
    if (threadIdx.x == 0) {
        unsigned* bar = b.bar;
        __builtin_amdgcn_s_waitcnt(0);
        unsigned nloc = b.st[0], nx = b.st[1];
        if (nloc == 0u) { xcd_barrier_complete(bar, b.x, nloc, nx); b.st[0] = nloc; b.st[1] = nx; }
        const unsigned old = xb_add(&bar[XB_XSUB(b.x)], 1u);
        const unsigned gen = old / nloc;
        if (old + 1u == (gen + 1u) * nloc) {
            __builtin_amdgcn_fence(__ATOMIC_RELEASE, "agent");
            asm volatile("s_waitcnt vmcnt(0)" ::: "memory");
            const unsigned og = xb_add(&bar[XB_TOP], 1u);
            const unsigned tg = og / nx;
            if (og + 1u == (tg + 1u) * nx) xb_add(&bar[XB_TOPGEN], 1u);
            else XB_SPIN(xb_ld(&bar[XB_TOPGEN]) == tg, bar);
            __builtin_amdgcn_fence(__ATOMIC_ACQUIRE, "agent");
            xb_add(&bar[XB_XGEN(b.x)], 1u);
            asm volatile("s_waitcnt vmcnt(0)" ::: "memory");
        } else {
            XB_SPIN(xb_ld(&bar[XB_XGEN(b.x)]) == gen, bar);
            __builtin_amdgcn_fence(__ATOMIC_ACQUIRE, "agent");
            asm volatile("s_waitcnt vmcnt(0)" ::: "memory");
        }
    }
    __syncthreads();
}

struct Args { const void* in[22]; float* out; unsigned char* ws; int ph_lo, ph_hi; };
enum { I_X = 0, I_C, I_POS, I_WADA, I_BADA, I_GPRE, I_GPOST, I_WIN, I_QNG, I_WUQ, I_KVNG, I_WUKV, I_CONVW, I_CONVB, I_CLNG, I_CLNB, I_WPW2, I_SLNG, I_SLNB, I_WS, I_BS, I_WOUT };
constexpr int N_PHASES = 2 + 6 * NLAYER;

__device__ __forceinline__ int wmap(int mat, int n) {
    if (mat == 0) {
        if (n < 384) return n; if (n < 448) { const int w = n - 384; return 384 + 32 * (w & 1) + (w >> 1); } if (n < 512) return -1;
        const int t = n >> 8, j = n & 127, second = (n >> 7) & 1;
        if (t == 4 || t == 5) return (second ? 1216 : 960) + (t - 4) * 128 + j;
        if (t == 7 || t == 9) return (second ? 2240 : 1728) + (t == 9 ? 128 : 0) + j;
        return n - 64; }
    if (mat == 2) { if (n < 512) return (n >> 7) * DQK + (n & 127); const int n2 = n - 512, h = n2 >> 6, w = n2 & 63; return h * DQK + DNOPE + 32 * (w & 1) + (w >> 1); }
    if (mat == 3) { const int h = (n & 511) >> 7, d = n & 127; return h * 256 + (n >= 512 ? 128 : 0) + d; }
    return n;
}
__device__ __forceinline__ void transpose_item(const float* W, int Nsrc, bf16_t* WT, int Kd, int mat, LAS float* scr, int kb, int nb, int lane) {
    const int k0 = 64 * kb, n0 = 32 * nb; const int src = wmap(mat, n0 + (lane & 31));
#pragma unroll 8
    for (int i = 0; i < 32; ++i) { const int kk = 2 * i + (lane >> 5); scr[kk * 33 + (lane & 31)] = src >= 0 ? W[(size_t)(k0 + kk) * Nsrc + src] : 0.f; }
    asm volatile("s_waitcnt lgkmcnt(0)" ::: "memory");
    const int c = lane & 7;
#pragma unroll
    for (int j = 0; j < 4; ++j) { const int n = (lane >> 3) + 8 * j; const LAS float* s = scr + (8 * c) * 33 + n;
        u32x4 o; o.x = cvtpk(s[0 * 33], s[1 * 33]); o.y = cvtpk(s[2 * 33], s[3 * 33]); o.z = cvtpk(s[4 * 33], s[5 * 33]); o.w = cvtpk(s[6 * 33], s[7 * 33]);
        *(u32x4*)(WT + (size_t)(n0 + n) * Kd + k0 + 8 * c) = o; }
    asm volatile("s_waitcnt lgkmcnt(0)" ::: "memory");
}

__global__ void __launch_bounds__(NTHREADS, 2) hymba_fwd(Args args) {
    extern __shared__ __attribute__((aligned(16))) unsigned char lds[];
    typedef const __attribute__((address_space(4))) Args* KArgP;
    cg::grid_group grid = cg::this_grid();
    const int ph_lo = args.ph_lo, ph_hi = args.ph_hi;
    const int wave_s = __builtin_amdgcn_readfirstlane(threadIdx.x >> 6);
    volatile LAS unsigned* xbst = (volatile LAS unsigned*)((LAS unsigned char*)lds + LDS_BYTES - 64);
    if (threadIdx.x < 4) xbst[threadIdx.x] = 0u;
    __syncthreads();
    const XcdBarrier xbar = xcd_barrier_post((unsigned*)(args.ws + WS_CTL) + CTL_BARW, xbst);

    int ph = ph_lo, rep = 0;
    while (ph < ph_hi) {
        KArgP ap0 = (KArgP)__builtin_amdgcn_kernarg_segment_ptr();
#define ARG(k) (ap->in[k])
#define TID_HERE() int lane; asm volatile("v_mbcnt_lo_u32_b32 %0, -1, 0\n\tv_mbcnt_hi_u32_b32 %0, -1, %0" : "=v"(lane)); const int tid = wave_s * 64 + lane; (void)tid
        const int wave = wave_s;
#define PHASE_ROOTS() \
        KArgP ap = ap0; asm volatile("" : "+s"(ap)); \
        int G = gridDim.x, bx = blockIdx.x; asm volatile("" : "+s"(G), "+s"(bx)); \
        const int vcu = (G % 8 == 0) ? (bx % 8) * (G / 8) + bx / 8 : bx; \
        const int gw = vcu * NWAVES + wave, NGW = G * NWAVES; (void)gw; (void)NGW; \
        unsigned char* ws = ap->ws; float* outp = ap->out; (void)outp; \
        const float* x_in = (const float*)ARG(I_X); (void)x_in; \
        float* adap = (float*)(ws + WS_ADAP); (void)adap; float* mod = (float*)(ws + WS_CTL + CTL_MOD); (void)mod; \
        float* cs_t = (float*)(ws + WS_COS); float* sn_t = (float*)(ws + WS_SIN); (void)cs_t; (void)sn_t; \
        bf16_t* Hb = (bf16_t*)(ws + WS_H); bf16_t* Zb = (bf16_t*)(ws + WS_Z); bf16_t* Y16 = (bf16_t*)(ws + WS_Y); (void)Hb; (void)Zb; (void)Y16; \
        bf16_t* QLN = (bf16_t*)(ws + WS_QLN); bf16_t* KVLN = (bf16_t*)(ws + WS_KVLN); bf16_t* CONVH = (bf16_t*)(ws + WS_CONVH); bf16_t* SGVT = (bf16_t*)(ws + WS_SGVT); (void)QLN; (void)KVLN; (void)CONVH; (void)SGVT; \
        bf16_t* Qb = (bf16_t*)(ws + WS_Q); unsigned char* KNb = ws + WS_KN; unsigned char* KRb = ws + WS_KR; unsigned char* VIb = ws + WS_V; (void)Qb; (void)KNb; (void)KRb; (void)VIb; \
        bf16_t* YCAT = (bf16_t*)(ws + WS_YCAT); (void)YCAT
        if (ph == 0 && PHEN(0)) {
            TID_HERE(); PHASE_ROOTS();
            LAS float* scr = (LAS float*)(lds + wave * 16384);
            for (int it = gw; it < NLAYER * 16 * 48; it += NGW) { const int l = it / 768, r = it % 768, kc = r / 48, nc = r % 48;
                const float* W = (const float*)ARG(I_WADA) + (size_t)l * DM * 3072 + (size_t)(kc * 64) * 3072 + nc * 64 + lane;
                const float* c = (const float*)ARG(I_C) + kc * 64;
                float a0 = 0.f, a1 = 0.f, a2 = 0.f, a3 = 0.f;
#pragma unroll 8
                for (int k = 0; k < 64; ++k) { const float w = W[(size_t)k * 3072];
                    a0 += siluf_(c[k]) * w; a1 += siluf_(c[DM + k]) * w; a2 += siluf_(c[2 * DM + k]) * w; a3 += siluf_(c[3 * DM + k]) * w; }
                float* dst = adap + ((size_t)(kc * 2 + l) * 4) * 3072 + nc * 64 + lane;
                __hip_atomic_store(dst, a0, __ATOMIC_RELAXED, __HIP_MEMORY_SCOPE_AGENT); __hip_atomic_store(dst + 3072, a1, __ATOMIC_RELAXED, __HIP_MEMORY_SCOPE_AGENT);
                __hip_atomic_store(dst + 2 * 3072, a2, __ATOMIC_RELAXED, __HIP_MEMORY_SCOPE_AGENT); __hip_atomic_store(dst + 3 * 3072, a3, __ATOMIC_RELAXED, __HIP_MEMORY_SCOPE_AGENT);
                asm volatile("s_waitcnt vmcnt(0)" ::: "memory");
                unsigned tk = 0;
                if (lane == 0) tk = __hip_atomic_fetch_add((unsigned*)(ws + WS_CTL) + CTL_ADACNT + (l * 48 + nc) * 16, 1u, __ATOMIC_RELAXED, __HIP_MEMORY_SCOPE_AGENT);
                tk = (unsigned)__builtin_amdgcn_readfirstlane((int)tk);
                if (tk == 15u) {
                    const float* bada = (const float*)ARG(I_BADA) + (size_t)l * 3072;
#pragma unroll
                    for (int b = 0; b < 4; ++b) { float s = 0.f;
#pragma unroll
                        for (int k2 = 0; k2 < 16; ++k2) s += __hip_atomic_load(adap + ((size_t)(k2 * 2 + l) * 4 + b) * 3072 + nc * 64 + lane, __ATOMIC_RELAXED, __HIP_MEMORY_SCOPE_AGENT);
                        mod[((size_t)l * 4 + b) * 3072 + nc * 64 + lane] = s + bada[nc * 64 + lane]; }
                } }
            {
                constexpr int I0 = 16 * 80, I1 = 16 * 32, I2 = 4 * 24, I3 = 2 * 32, I4 = 4 * 8, IL = I0 + I1 + I2 + I3 + I4;
                for (int it = gw; it < NLAYER * IL; it += NGW) {
                    const int l = it / IL; int r = it % IL;
                    if (r < I0) { transpose_item((const float*)ARG(I_WIN) + (size_t)l * DM * DIN, DIN, (bf16_t*)(ws + WS_WIN) + (size_t)l * DINP * DM, DM, 0, scr, r / 80, r % 80, lane); continue; } r -= I0;
                    if (r < I1) { transpose_item((const float*)ARG(I_WOUT) + (size_t)l * DM * DM, DM, (bf16_t*)(ws + WS_WOUT) + (size_t)l * DM * DM, DM, 1, scr, r / 32, r % 32, lane); continue; } r -= I1;
                    if (r < I2) { transpose_item((const float*)ARG(I_WUQ) + (size_t)l * QLR * 768, 768, (bf16_t*)(ws + WS_WUQ) + (size_t)l * 768 * 256, 256, 2, scr, r / 24, r % 24, lane); continue; } r -= I2;
                    if (r < I3) { transpose_item((const float*)ARG(I_WUKV) + (size_t)l * KVLR * 1024, 1024, (bf16_t*)(ws + WS_WUKV) + (size_t)l * 1024 * 128, 128, 3, scr, r / 32, r % 32, lane); continue; } r -= I3;
                    transpose_item((const float*)ARG(I_WPW2) + (size_t)l * CW * CW, CW, (bf16_t*)(ws + WS_WPW2) + (size_t)l * CW * CW, CW, 4, scr, r / 8, r % 8, lane);
                }
            }
            const int gt = vcu * NTHREADS + tid, NGT = G * NTHREADS;
            for (int i = gt; i < NLAYER * SG * SCH * SCH; i += NGT) { const int s = i & 127, t = (i >> 7) & 127;
                const float v = s <= t ? ((const float*)ARG(I_WS))[i] : 0.f; ((bf16_t*)(ws + WS_WSM))[i] = (bf16_t)(cvtpk(v, 0.f) & 0xffffu); }
            const float inv_freq = powf(10000.0f, -(float)(2 * (gt & 31)) / 64.0f);
            for (int i = gt; i < MTOK * 32; i += NGT) { const int tok = i >> 5;
                const float ang = (float)((const int*)ARG(I_POS))[tok] * inv_freq;
                cs_t[i] = cosf(ang); sn_t[i] = sinf(ang); }
        } else if (ph == 1 && PHEN(1)) {
            TID_HERE(); PHASE_ROOTS();
            const float* gp = (const float*)ARG(I_GPRE);
            for (int grp = gw; grp < MTOK / 4; grp += NGW) { const int m0 = grp * 4, b = m0 >> 13;
                f32x4 v[4][4];
#pragma unroll
                for (int k = 0; k < 4; ++k) { const f32x4* xr = (const f32x4*)(x_in + (size_t)(m0 + k) * DM) + lane;
#pragma unroll
                    for (int j = 0; j < 4; ++j) v[k][j] = __builtin_nontemporal_load(&xr[64 * j]); }
                f32x4 pa[4], pb[4];
#pragma unroll
                for (int j = 0; j < 4; ++j) { const int c = 4 * lane + 256 * j;
                    pb[j] = *(const f32x4*)(mod + (size_t)b * 3072 + c);
                    pa[j] = *(const f32x4*)(gp + c) * (*(const f32x4*)(mod + (size_t)b * 3072 + DM + c) + 1.f); }
#pragma unroll
                for (int k = 0; k < 4; ++k) { float ss = 0.f;
#pragma unroll
                    for (int j = 0; j < 4; ++j) ss += (v[k][j].x * v[k][j].x + v[k][j].y * v[k][j].y) + (v[k][j].z * v[k][j].z + v[k][j].w * v[k][j].w);
                    const float rstd = rsqrtf(wave_sum(ss) * (1.f / DM) + EPS);
                    u32x2* o8 = (u32x2*)(Hb + (size_t)(m0 + k) * DM) + lane;
#pragma unroll
                    for (int j = 0; j < 4; ++j) { const f32x4 hv = (v[k][j] * rstd) * pa[j] + pb[j];
                        u32x2 w; w.x = cvtpk(hv.x, hv.y); w.y = cvtpk(hv.z, hv.w); o8[64 * j] = w; } }
            }
        } else {
            const int l = (ph - 2) / 6, sub = (ph - 2) % 6;
            const int ngemm = (sub == 0 || sub == 4) ? 1 : (sub == 2 ? 3 : 0);
#pragma nounroll
            for (int gi_ = 0; gi_ < ngemm * (1 + ((PROBE_MASK >> 8) & 1)) && PHEN(2); ++gi_) {
                const int gi = gi_ % ngemm;
                TID_HERE(); PHASE_ROOTS();
                pg8::Gemm g; EpiAll E; int Nn, cc = bx;
                if (sub == 0) { g = pg8::Gemm{Hb, (const bf16_t*)(ws + WS_WIN) + (size_t)l * DINP * DM, MTOK, DINP, DM, DM, DM}; Nn = DINP; E = EpiAll{EM_Z1, DINP, Zb, cs_t, sn_t, ws, (const float*)ARG(I_QNG) + l * QLR, (const float*)ARG(I_KVNG) + l * KVLR, (LAS unsigned char*)lds, (const float*)ARG(I_SLNG) + l * SW, (const float*)ARG(I_SLNB) + l * SW}; }
                else if (sub == 4) { g = pg8::Gemm{YCAT, (const bf16_t*)(ws + WS_WOUT) + (size_t)l * DM * DM, MTOK, DM, DM, DM, DM}; Nn = DM; E = EpiAll{EM_Z, DM, Y16, nullptr, nullptr, nullptr, nullptr, nullptr, nullptr, nullptr, nullptr}; }
                else if (gi == 0) { g = pg8::Gemm{QLN, (const bf16_t*)(ws + WS_WUQ) + (size_t)l * 768 * 256, MTOK, 768, 256, 256, 256}; Nn = 768; E = EpiAll{EM_Q, 0, Qb, cs_t, sn_t, nullptr, nullptr, nullptr, nullptr, nullptr, nullptr}; }
                else if (gi == 1) { g = pg8::Gemm{CONVH, (const bf16_t*)(ws + WS_WPW2) + (size_t)l * CW * CW, MTOK, CW, CW, CW, CW}; Nn = CW; cc = (bx + G / 2) % G; E = EpiAll{EM_PW2, 0, YCAT, Zb, nullptr, nullptr, nullptr, nullptr, nullptr, nullptr, nullptr}; }
                else { g = pg8::Gemm{KVLN, (const bf16_t*)(ws + WS_WUKV) + (size_t)l * 1024 * 128, MTOK, 1024, 128, 128, 128}; Nn = 1024; E = EpiAll{EM_KV, 0, KNb, VIb, nullptr, nullptr, nullptr, nullptr, nullptr, nullptr, nullptr}; }
                pg8::StaticOrder S; S.init(MTOK, Nn, G, cc);
#if STAGGER_US > 0
                if (sub == 0 && (bx & 8)) { const unsigned long long t0_ = __builtin_amdgcn_s_memrealtime(); while (__builtin_amdgcn_s_memrealtime() - t0_ < (unsigned long long)(STAGGER_US * 100)) __builtin_amdgcn_s_sleep(8); }
#endif
                pg8::gemm_phase<EpiAll>((LAS unsigned char*)lds, g, S, E, tid);
            }
            if (sub == 0) {
            } else if (sub == 1 && PHEN(3)) {
                TID_HERE(); PHASE_ROOTS();
                const float* cw = (const float*)ARG(I_CONVW) + (size_t)l * CK * CW; const float* cb = (const float*)ARG(I_CONVB) + l * CW;
                const float* clg = (const float*)ARG(I_CLNG) + l * CW; const float* clb = (const float*)ARG(I_CLNB) + l * CW;
                LAS float* glu = (LAS float*)lds;
                LAS float* cvo = (LAS float*)(lds + 63488);
                LAS bf16_t* sgv = (LAS bf16_t*)(lds + 63488 + 32768);
                float cwv[CK];
#pragma unroll
                for (int j = 0; j < CK; ++j) cwv[j] = cw[j * CW + (tid & 255)];
                const float cbias = cb[tid & 255];
                const f32x4 clg4 = *(const f32x4*)(clg + 4 * lane), clb4 = *(const f32x4*)(clb + 4 * lane);
                u32x4 ga[4]; u32x2 zsv[4];
#define P2A_LOAD(tt_) do { const int b_ = (tt_) >> 8, s0_ = ((tt_) & 255) * 32; const size_t m0_ = (size_t)b_ * SEQ + s0_; \
                    _Pragma("unroll") for (int pass = 0; pass < 4; ++pass) { const int r = pass * 16 + (tid >> 5), c8 = (tid & 31) * 8; const int s = s0_ - 30 + r; \
                        ga[pass] = *(const u32x4*)(Zb + ((size_t)b_ * SEQ + (s >= 0 ? (r < 62 ? s : s0_) : 0)) * DINP + ZC_CA + c8); \
                        if (r >= 62 || s < 0) ga[pass] = (u32x4){0u, 0u, 0u, 0u}; } \
                    _Pragma("unroll") for (int i = 0; i < 4; ++i) { const size_t m = m0_ + 4 * wave + i; const bf16_t* zr = Zb + m * DINP; \
                        zsv[i] = *(const u32x2*)(zr + ZC_SV + 4 * lane); } } while (0)
                P2A_LOAD(vcu < MTOK / 32 ? vcu : 0);
                for (int tt = vcu; tt < MTOK / 32; tt += G) {
                    const int b = tt >> 8, s0 = (tt & 255) * 32; const size_t m0 = (size_t)b * SEQ + s0;
#pragma unroll
                    for (int pass = 0; pass < 4; ++pass) { const int r = pass * 16 + (tid >> 5), c8 = (tid & 31) * 8;
                        if (r < 62) { const u32x4 a = ga[pass];
                            *(LAS f32x4*)(glu + r * 256 + c8) = (f32x4){lo_bf(a.x), hi_bf(a.x), lo_bf(a.y), hi_bf(a.y)}; *(LAS f32x4*)(glu + r * 256 + c8 + 4) = (f32x4){lo_bf(a.z), hi_bf(a.z), lo_bf(a.w), hi_bf(a.w)}; } }
#pragma unroll
                    for (int i = 0; i < 4; ++i) { const int tl = 4 * wave + i; const size_t m = m0 + tl; const int s = s0 + tl;
                        *(LAS u32x2*)(sgv + tl * 256 + 4 * lane) = zsv[i];
                    }
                    __syncthreads();
                    { const int tn = tt + G; P2A_LOAD(tn < MTOK / 32 ? tn : tt); }
                    { const int c = tid & 255, half = tid >> 8;
                      for (int g4 = 0; g4 < 4; ++g4) { const int tb = 16 * half + 4 * g4; float v[34];
#pragma unroll
                          for (int k = 0; k < 34; ++k) v[k] = glu[(tb + k) * 256 + c];
#pragma unroll
                          for (int i = 0; i < 4; ++i) { float a = cbias;
#pragma unroll
                              for (int j = 0; j < CK; ++j) a += cwv[j] * v[i + j];
                              cvo[(tb + i) * 256 + c] = a; } } }
                    __syncthreads();
                    for (int i = 0; i < 4; ++i) { const int tl = 4 * wave + i; const size_t m = m0 + tl;
                        const f32x4 xv = *(const LAS f32x4*)(cvo + tl * 256 + 4 * lane);
                        const float mean = wave_sum((xv.x + xv.y) + (xv.z + xv.w)) * (1.f / CW);
                        const float d0 = xv.x - mean, d1 = xv.y - mean, d2 = xv.z - mean, d3 = xv.w - mean;
                        const float rstd = rsqrtf(wave_sum((d0 * d0 + d1 * d1) + (d2 * d2 + d3 * d3)) * (1.f / CW) + EPS);
                        const f32x4 g = clg4, bb = clb4;
                        u32x2 w; w.x = cvtpk(siluf_(d0 * rstd * g.x + bb.x), siluf_(d1 * rstd * g.y + bb.y)); w.y = cvtpk(siluf_(d2 * rstd * g.z + bb.z), siluf_(d3 * rstd * g.w + bb.w));
                        *(u32x2*)(CONVH + m * 256 + 4 * lane) = w; }
                    { const int c = tid & 255, half = tid >> 8; unsigned pk[8];
#pragma unroll
                      for (int k = 0; k < 8; ++k) { const unsigned lo = sgv[(16 * half + 2 * k) * 256 + c], hi2 = sgv[(16 * half + 2 * k + 1) * 256 + c]; pk[k] = lo | (hi2 << 16); }
                      bf16_t* dst = SGVT + ((size_t)(m0 >> 7) * 256 + c) * 128 + (s0 & 127) + 16 * half;
                      *(u32x4*)dst = (u32x4){pk[0], pk[1], pk[2], pk[3]}; *(u32x4*)(dst + 8) = (u32x4){pk[4], pk[5], pk[6], pk[7]}; }
                    __syncthreads();
                }
#undef P2A_LOAD
            } else if (sub == 2 && PHEN(4)) {
                TID_HERE(); PHASE_ROOTS();
                { const bf16_t* WsM = (const bf16_t*)(ws + WS_WSM) + (size_t)l * SG * SCH * SCH; const float* bs = (const float*)ARG(I_BS) + l * SG * SCH;
                  const int r32 = lane & 31, hi = lane >> 5, gq = wave >> 1, th = wave & 1;
                  constexpr int UP = 528;
                  LAS unsigned char* ub = (LAS unsigned char*)lds;
                  for (int ck_ = vcu; ck_ < (MTOK / SCH) * (1 + ((PROBE_MASK >> 9) & 1)); ck_ += G) { const int ck = ck_ % (MTOK / SCH);
                      const size_t mc = (size_t)ck * SCH;
                      const bf16_t* Wb = WsM + ((size_t)gq * SCH + 64 * th + r32) * SCH + 8 * hi;
                      const bf16_t* Vb = SGVT + ((size_t)ck * 256 + gq * 64 + r32) * SCH + 8 * hi;
                      bf16x8 wf[2][4], vf[2][4];
#pragma unroll
                      for (int ks = 0; ks < 4; ++ks) { wf[0][ks] = *(const bf16x8*)(Wb + 16 * ks); wf[1][ks] = *(const bf16x8*)(Wb + 32 * SCH + 16 * ks);
                                                       vf[0][ks] = *(const bf16x8*)(Vb + 16 * ks); vf[1][ks] = *(const bf16x8*)(Vb + 32 * SCH + 16 * ks); }
#pragma unroll
                      for (int p = 0; p < 8; ++p) { const int idx = p * NTHREADS + tid, t = idx >> 5, c8 = (idx & 31) * 8;
                          const u32x4 o = *(const u32x4*)(Zb + (mc + t) * DINP + ZC_SU + c8);
                          *(LAS u32x4*)(ub + t * UP + c8 * 2) = o; }
                      f32x16 acc[2][2];
#pragma unroll
                      for (int a = 0; a < 2; ++a)
#pragma unroll
                          for (int bq = 0; bq < 2; ++bq) acc[a][bq] = f32x16{};
#pragma unroll
                      for (int kh = 0; kh < 2; ++kh) {
#pragma unroll
                          for (int ks = 0; ks < 4; ++ks) {
                              acc[0][0] = __builtin_amdgcn_mfma_f32_32x32x16_bf16(vf[0][ks], wf[0][ks], acc[0][0], 0, 0, 0);
                              acc[0][1] = __builtin_amdgcn_mfma_f32_32x32x16_bf16(vf[0][ks], wf[1][ks], acc[0][1], 0, 0, 0);
                              acc[1][0] = __builtin_amdgcn_mfma_f32_32x32x16_bf16(vf[1][ks], wf[0][ks], acc[1][0], 0, 0, 0);
                              acc[1][1] = __builtin_amdgcn_mfma_f32_32x32x16_bf16(vf[1][ks], wf[1][ks], acc[1][1], 0, 0, 0);
                          }
                          if (kh == 0) {
#pragma unroll
                              for (int ks = 0; ks < 4; ++ks) { wf[0][ks] = *(const bf16x8*)(Wb + 64 + 16 * ks); wf[1][ks] = *(const bf16x8*)(Wb + 32 * SCH + 64 + 16 * ks);
                                                               vf[0][ks] = *(const bf16x8*)(Vb + 64 + 16 * ks); vf[1][ks] = *(const bf16x8*)(Vb + 32 * SCH + 64 + 16 * ks); }
                          }
                      }
                      __syncthreads();
#pragma unroll
                      for (int rb = 0; rb < 2; ++rb) { const int t = 64 * th + 32 * rb + r32; const float bt = bs[gq * SCH + t];
#pragma unroll
                          for (int cb = 0; cb < 2; ++cb)
#pragma unroll
                              for (int q4 = 0; q4 < 4; ++q4) { LAS u32x2* p = (LAS u32x2*)(ub + t * UP + (gq * 64 + 32 * cb + 8 * q4 + 4 * hi) * 2);
                                  const u32x2 up = *p; u32x2 w;
                                  w.x = cvtpk((acc[cb][rb][4 * q4 + 0] + bt) * lo_bf(up.x), (acc[cb][rb][4 * q4 + 1] + bt) * hi_bf(up.x));
                                  w.y = cvtpk((acc[cb][rb][4 * q4 + 2] + bt) * lo_bf(up.y), (acc[cb][rb][4 * q4 + 3] + bt) * hi_bf(up.y));
                                  *p = w; } }
                      __syncthreads();
#pragma unroll
                      for (int p = 0; p < 8; ++p) { const int idx = p * NTHREADS + tid, t = idx >> 5, c8 = (idx & 31) * 8;
                          *(u32x4*)(YCAT + (mc + t) * DM + 768 + c8) = *(const LAS u32x4*)(ub + t * UP + c8 * 2); }
                      __syncthreads();
                  } }
            } else if (sub == 3 && PHEN(5)) {
                TID_HERE(); PHASE_ROOTS();
                const int nun = (NB * NH * 32 + G - 1) / G;
#pragma nounroll
                for (int i = 0; i < nun; ++i) {
                    const int u_ = vcu + i * G;
                    int bh = u_ >> 5, qb = 31 - (u_ & 31);
                    if (G == 256) { bh = vcu >> 4; qb = (i == 0) ? 31 - (vcu & 15) : (vcu & 15); }
                    int tid_u = tid; asm volatile("" : "+v"(tid_u));
                    if (bh < NB * NH) att::attn_unit3<0>(bh >> 2, bh & 3, qb, Qb, KNb, KRb, VIb, Zb, YCAT, (char*)lds, tid_u);
                }
            } else if (sub == 5 && PHEN(7)) {
                TID_HERE(); PHASE_ROOTS();
                const float* xsrc = (l == 0) ? x_in : (const float*)outp;
                const float* gpost = (const float*)ARG(I_GPOST) + l * DM;
                const float* modl = mod + (size_t)l * 4 * 3072; const float* mod1 = mod + (size_t)4 * 3072; const float* gp1 = (const float*)ARG(I_GPRE) + DM;
                for (int grp = gw; grp < MTOK / 4; grp += NGW) { const int m0 = grp * 4, b = m0 >> 13;
                    u32x2 yv[4][4]; f32x4 xv[4][4];
#pragma unroll
                    for (int k = 0; k < 4; ++k) { const u32x2* yr = (const u32x2*)(Y16 + (size_t)(m0 + k) * DM) + lane; const f32x4* xr = (const f32x4*)(xsrc + (size_t)(m0 + k) * DM) + lane;
#pragma unroll
                        for (int j = 0; j < 4; ++j) { yv[k][j] = __builtin_nontemporal_load(&yr[64 * j]); xv[k][j] = __builtin_nontemporal_load(&xr[64 * j]); } }
                    f32x4 pg[4];
#pragma unroll
                    for (int j = 0; j < 4; ++j) { const int c = 4 * lane + 256 * j; pg[j] = *(const f32x4*)(modl + (size_t)b * 3072 + 2 * DM + c) * *(const f32x4*)(gpost + c); }
                    float rstd2[4];
#pragma unroll
                    for (int k = 0; k < 4; ++k) { float ss = 0.f; f32x4 y[4];
#pragma unroll
                        for (int j = 0; j < 4; ++j) { y[j] = (f32x4){lo_bf(yv[k][j].x), hi_bf(yv[k][j].x), lo_bf(yv[k][j].y), hi_bf(yv[k][j].y)};
                            ss += (y[j].x * y[j].x + y[j].y * y[j].y) + (y[j].z * y[j].z + y[j].w * y[j].w); }
                        const float rstd = rsqrtf(wave_sum(ss) * (1.f / DM) + EPS);
                        f32x4* orow = (f32x4*)(outp + (size_t)(m0 + k) * DM) + lane; float ss2 = 0.f;
#pragma unroll
                        for (int j = 0; j < 4; ++j) { xv[k][j] = xv[k][j] + (y[j] * rstd) * pg[j]; orow[64 * j] = xv[k][j];
                            ss2 += (xv[k][j].x * xv[k][j].x + xv[k][j].y * xv[k][j].y) + (xv[k][j].z * xv[k][j].z + xv[k][j].w * xv[k][j].w); }
                        rstd2[k] = rsqrtf(wave_sum(ss2) * (1.f / DM) + EPS); }
                    if (l == 0) {
                        f32x4 pa[4], pb[4];
#pragma unroll
                        for (int j = 0; j < 4; ++j) { const int c = 4 * lane + 256 * j;
                            pb[j] = *(const f32x4*)(mod1 + (size_t)b * 3072 + c);
                            pa[j] = *(const f32x4*)(gp1 + c) * (*(const f32x4*)(mod1 + (size_t)b * 3072 + DM + c) + 1.f); }
#pragma unroll
                        for (int k = 0; k < 4; ++k) { u32x2* o8 = (u32x2*)(Hb + (size_t)(m0 + k) * DM) + lane;
#pragma unroll
                            for (int j = 0; j < 4; ++j) { const f32x4 hv = (xv[k][j] * rstd2[k]) * pa[j] + pb[j];
                                u32x2 w; w.x = cvtpk(hv.x, hv.y); w.y = cvtpk(hv.z, hv.w); o8[64 * j] = w; } }
                    }
                }
            }
        }
        { bool again = false;
          if (rep == 0 && PROBE_MASK != 0) { if (ph == 0) again = (PROBE_MASK >> 7) & 1; else if (ph == 1) again = (PROBE_MASK >> 6) & 1; else if (ph >= 2) { const int sub_ = (ph - 2) % 6, l_ = (ph - 2) / 6; again = ((PROBE_MASK >> sub_) & 1) && !(sub_ == 5 && l_ == 1); } }
          if (again) rep = 1; else { rep = 0; ++ph; } }
        if (ph < ph_hi) { if (ph_lo < 0) grid.sync(); else xcd_barrier(xbar); }
    }
}

#ifndef APROBE
#define APROBE 0
#endif
#ifndef APROBE_AX
#define APROBE_AX 0
#endif
#ifndef APROBE_REP
#define APROBE_REP 2
#endif
#if APROBE
__global__ void __launch_bounds__(NTHREADS, 2) attn_probe(Args args) {
    extern __shared__ __attribute__((aligned(16))) unsigned char lds[];
    const int G = gridDim.x, bx = blockIdx.x; const int vcu = (bx % 8) * (G / 8) + bx / 8;
    unsigned char* ws = args.ws;
#pragma nounroll
    for (int i = 0; i < 2 * APROBE_REP; ++i) {
        const int bh = vcu >> 4, qb = ((i & 1) == 0) ? 31 - (vcu & 15) : (vcu & 15);
        int tid_u = threadIdx.x; asm volatile("" : "+v"(tid_u));
        att::attn_unit3<APROBE_AX>(bh >> 2, bh & 3, qb, (const bf16_t*)(ws + WS_Q), ws + WS_KN, ws + WS_KR, ws + WS_V, (const bf16_t*)(ws + WS_Z), (bf16_t*)(ws + WS_YCAT), (char*)lds, tid_u);
    }
}
#endif

extern "C" void kernel_launch(void* const* d_in, const int* in_sizes, int n_in, void* d_out, int out_size, void* d_ws, size_t ws_size, hipStream_t stream) {
    static int grid = 0;
    if (grid == 0) {
        if (n_in != 22 || in_sizes[0] != MTOK * DM || out_size != MTOK * DM || ws_size < WS_END) {
            fprintf(stderr, "kernel_launch: unexpected shapes (n_in %d, in0 %d, out %d, ws %zu); nothing launched\n", n_in, n_in > 0 ? in_sizes[0] : -1, out_size, ws_size); grid = -1; return; }
        int dev = 0, cus = 0, per_cu = 0;
        (void)hipGetDevice(&dev); (void)hipDeviceGetAttribute(&cus, hipDeviceAttributeMultiprocessorCount, dev);
        if (hipFuncSetAttribute((const void*)hymba_fwd, hipFuncAttributeMaxDynamicSharedMemorySize, LDS_BYTES) != hipSuccess) { fprintf(stderr, "kernel_launch: hipFuncSetAttribute failed\n"); grid = -1; return; }
        if (hipOccupancyMaxActiveBlocksPerMultiprocessor(&per_cu, (const void*)hymba_fwd, NTHREADS, LDS_BYTES) != hipSuccess || per_cu < 1) { fprintf(stderr, "kernel_launch: occupancy query says %d blocks per CU\n", per_cu); per_cu = 1; }
        (void)hipGetLastError();
        grid = cus > 0 ? cus : 256;
    }
    if (grid < 0) return;
    (void)hipMemsetAsync((char*)d_ws + WS_CTL, 0, CTL_BYTES, stream);
    Args a{};
    for (int i = 0; i < 22; ++i) a.in[i] = d_in[i];
    a.out = (float*)d_out; a.ws = (unsigned char*)d_ws;
#if MK_N_LAUNCHES == 1
    a.ph_lo = 0; a.ph_hi = N_PHASES;
    { void* kargs[] = {&a};
      hipError_t e = hipLaunchCooperativeKernel((const void*)hymba_fwd, dim3(grid), dim3(NTHREADS), kargs, LDS_BYTES, stream);
      if (e != hipSuccess) fprintf(stderr, "cooperative launch failed: %s (grid %d)\n", hipGetErrorString(e), grid); }
#if APROBE
    { (void)hipFuncSetAttribute((const void*)attn_probe, hipFuncAttributeMaxDynamicSharedMemorySize, LDS_BYTES);
      hipLaunchKernelGGL(attn_probe, dim3(256), dim3(NTHREADS), LDS_BYTES, stream, a); }
#endif
#else
    for (int ph = 0; ph < N_PHASES; ++ph) { a.ph_lo = ph; a.ph_hi = ph + 1; void* kargs[] = {&a};
        hipError_t e = hipLaunchCooperativeKernel((const void*)hymba_fwd, dim3(grid), dim3(NTHREADS), kargs, LDS_BYTES, stream);
        if (e != hipSuccess) { fprintf(stderr, "launch %d failed: %s (grid %d)\n", ph, hipGetErrorString(e), grid); break; } }
#endif
}
```

```cpp
#include <hip/hip_runtime.h>
#include <hip/hip_cooperative_groups.h>
#include <cstdio>
#include <cstdint>
namespace cg = cooperative_groups;

#ifndef MK_N_LAUNCHES
#define MK_N_LAUNCHES 1
#endif

#define LAS __attribute__((address_space(3)))
#ifndef ATT_EXP_TOP
#define ATT_EXP_TOP 0
#endif
#ifndef STAGGER_US
#define STAGGER_US 0
#endif
#ifndef PROBE_MASK
#define PROBE_MASK 0
#endif
#ifndef PHMASK
#define PHMASK 0xff
#endif
#define PHEN(k) (((PHMASK) >> (k)) & 1)
typedef unsigned short bf16_t;
typedef short bf16x8 __attribute__((ext_vector_type(8)));
typedef short s16x4 __attribute__((ext_vector_type(4)));
typedef float f32x2 __attribute__((ext_vector_type(2)));
typedef float f32x4 __attribute__((ext_vector_type(4)));
typedef float f32x16 __attribute__((ext_vector_type(16)));
typedef unsigned u32x2 __attribute__((ext_vector_type(2)));
typedef unsigned u32x4 __attribute__((ext_vector_type(4)));

constexpr int DM = 1024, NB = 4, SEQ = 8192, MTOK = NB * SEQ, NLAYER = 2;
constexpr int NH = 4, DNOPE = 128, DROPE = 64, DQK = 192, DV = 128;
constexpr int QLR = 256, KVLR = 128, DIN = 2496, DINP = 2560;
constexpr int CW = 256, CK = 31, SW = 256, SG = 4, SCH = 128;
constexpr float EPS = 1e-6f;
constexpr int ZC_Q = 0, ZC_KV = 256, ZC_KR = 384, ZC_GATT = 512, ZC_CA = 1024, ZC_CB = 1280, ZC_GC = 1536, ZC_SU = 1792, ZC_SV = 2048, ZC_GS = 2304;
constexpr float QSCALE = 0.07216878364870323f * 1.4426950408889634f;

constexpr size_t MiB = 1u << 20;
constexpr size_t WS_CTL = 0, CTL_BYTES = 1 * MiB;
constexpr size_t CTL_BARW = 1024;
constexpr size_t CTL_ADACNT = 8192;
constexpr size_t CTL_MOD = 65536;
constexpr size_t WS_COS = 1 * MiB, WS_SIN = 5 * MiB;
constexpr size_t WS_WIN = 9 * MiB;
constexpr size_t WS_WOUT = 19 * MiB;
constexpr size_t WS_WUQ = 23 * MiB;
constexpr size_t WS_WUKV = 24 * MiB;
constexpr size_t WS_WPW2 = 25 * MiB;
constexpr size_t WS_WSM = 26 * MiB;
constexpr size_t WS_ADAP = 27 * MiB;
constexpr size_t WS_H = 32 * MiB;
constexpr size_t WS_Z = 96 * MiB;
constexpr size_t WS_Y = WS_Z;
constexpr size_t WS_QLN = 256 * MiB;
constexpr size_t WS_KVLN = 272 * MiB;
constexpr size_t WS_CONVH = 288 * MiB;
constexpr size_t WS_SGVT = 304 * MiB;
constexpr size_t WS_Q = 320 * MiB;
constexpr size_t WS_KN = 368 * MiB;
constexpr size_t WS_KR = 400 * MiB;
constexpr size_t WS_V = 408 * MiB;
constexpr size_t WS_YCAT = 440 * MiB;
constexpr size_t WS_END = 504 * MiB;

constexpr int LDS_BYTES = 147456;
constexpr int NTHREADS = 512, NWAVES = 8;

__device__ __forceinline__ float bf2f(unsigned short u) { return __uint_as_float(((unsigned)u) << 16); }
__device__ __forceinline__ unsigned cvtpk(float lo, float hi) { unsigned r; asm("v_cvt_pk_bf16_f32 %0, %1, %2" : "=v"(r) : "v"(lo), "v"(hi)); return r; }
__device__ __forceinline__ float lo_bf(unsigned w) { return __uint_as_float(w << 16); }
__device__ __forceinline__ float hi_bf(unsigned w) { return __uint_as_float(w & 0xffff0000u); }
#define dpp_f(v, ctrl) __int_as_float(__builtin_amdgcn_update_dpp(0, __float_as_int(v), (ctrl), 0xf, 0xf, true))
#define DPP_XOR1 0xB1
#define DPP_XOR2 0x4E
#define DPP_HMIRROR 0x141
#define DPP_MIRROR 0x140
__device__ __forceinline__ float xor1_f(float v) { return dpp_f(v, DPP_XOR1); }
__device__ __forceinline__ float wave_sum(float v) {
    v += dpp_f(v, DPP_XOR1); v += dpp_f(v, DPP_XOR2); v += dpp_f(v, DPP_HMIRROR); v += dpp_f(v, DPP_MIRROR);
    const int iv = __float_as_int(v);
    return (__int_as_float(__builtin_amdgcn_readlane(iv, 0)) + __int_as_float(__builtin_amdgcn_readlane(iv, 16))) +
           (__int_as_float(__builtin_amdgcn_readlane(iv, 32)) + __int_as_float(__builtin_amdgcn_readlane(iv, 48)));
}
__device__ __forceinline__ float sigmoidf_(float x) { return __builtin_amdgcn_rcpf(1.f + __builtin_amdgcn_exp2f(-1.4426950408889634f * x)); }
__device__ __forceinline__ float siluf_(float x) { return x * __builtin_amdgcn_rcpf(1.f + __builtin_amdgcn_exp2f(-1.4426950408889634f * x)); }
__device__ __forceinline__ float geluf_(float v) {
    const float av = __builtin_fabsf(v), t = __builtin_amdgcn_rcpf(av * 0.2316418882f + 1.0f);
    float q = t * 0.5307027145f + (-0.7265760135f); q = q * t + 0.7107068705f; q = q * t + (-0.142248368f); q = q * t + 0.127414796f; q = q * t;
    const float e = __builtin_amdgcn_exp2f((v * v) * (-0.72134752044f));
    const float m = v * (q * e);
    return v < 0.f ? m : v - m;
}

namespace pg8 {
constexpr int BM = 256, BK = 64, HALF = 128, HTB = HALF * BK * 2, STAGE_BYTES = 8 * HTB, NXCD = 8, WGM = 8;
__host__ __device__ __forceinline__ int lds_byte(int r, int c) { const int st = (r >> 4) * 2 + (c >> 5), rr = r & 15, cc = c & 31, ob = rr * 64 + cc * 2; return st * 1024 + (ob ^ (((ob >> 9) & 1) << 5)); }
__host__ __device__ __forceinline__ void stage_rc(int b, int& R, int& C) { const int st = b / 1024, sb = b % 1024, swz = sb ^ (((sb >> 9) & 1) << 5); R = (st >> 1) * 16 + swz / 64; C = (st & 1) * 32 + (swz % 64) / 2; }
__host__ __device__ __forceinline__ int perm32(int rho) { const int n = rho >> 4, i = rho & 15; return 8 * (i >> 2) + 4 * n + (i & 3); }

struct Unit { int pm, pn; };
struct Gemm { const bf16_t* A; const bf16_t* Bt; int M, N, K, lda, ldb; };

struct StaticOrder {
    int nM, nN, nwg, G, c;
    __host__ __device__ void init(int M, int N, int G_, int c_) { nM = M / BM; nN = N / BM; nwg = nM * nN; G = G_; c = c_; }
    __host__ __device__ bool next(int i, Unit& u) const {
        const long L = (long)i * G + c; if (L >= nwg) return false;
        int wgid = (int)L; { const int q = nwg / NXCD, r = nwg % NXCD, xcd = wgid % NXCD, off = wgid / NXCD; wgid = (xcd < r ? xcd * (q + 1) : r * (q + 1) + (xcd - r) * q) + off; }
        const int nig = WGM * nN, gid = wgid / nig, fm = gid * WGM, gsz = (nM - fm) < WGM ? (nM - fm) : WGM;
        u.pm = fm + ((wgid % nig) % gsz); u.pn = (wgid % nig) / gsz; return true;
    }
};

template <class Epi>
__device__ __forceinline__ void gemm_phase(LAS unsigned char* lds, const Gemm g, const StaticOrder& S, const Epi& E, const int tid) {
    const int wid = __builtin_amdgcn_readfirstlane(tid >> 6), lane = tid & 63, wr = wid >> 2, wc = wid & 3, fr = lane & 15, fq = lane >> 4;
    const int K = g.K, nt = K / BK;
    unsigned voffA[2], voffB[2];
#pragma unroll
    for (int i = 0; i < 2; ++i) { int R, C; stage_rc(tid * 16 + i * 8192, R, C); const int Rb = Epi::PERM ? ((R & ~31) + perm32(R & 31)) : R;
        voffA[i] = (unsigned)(R * g.lda + C) * 2u; voffB[i] = (unsigned)(Rb * g.ldb + C) * 2u; }
    const size_t kstep = (size_t)(BK * 2);
    const size_t hstepA = (size_t)HALF * g.lda * 2, hstepB = (size_t)HALF * g.ldb * 2;
    const size_t tstepA = 2 * hstepA, tstepB = 2 * hstepB;
    const unsigned ldsw = (unsigned)wid * 1024u;
    const int aoff = lds_byte(wr * 64 + fr, fq * 8), boff = lds_byte(wc * 32 + fr, fq * 8);
#define PG8_SA(b, h) (((b) * 2 + (h)) * HTB)
#define PG8_SB(b, h) ((4 + (b) * 2 + (h)) * HTB)
#define PG8_STAGE(bufoff, gbase, voff) do { _Pragma("unroll") for (int _i = 0; _i < 2; ++_i) \
        __builtin_amdgcn_global_load_lds((const unsigned*)((const char*)(gbase) + (voff)[_i]), (LAS unsigned*)(lds + (bufoff) + ldsw + _i * 8192), 16, 0, 0); } while (0)
#define PG8_LDA(dst, b, h) do { _Pragma("unroll") for (int m = 0; m < 4; ++m) _Pragma("unroll") for (int k = 0; k < 2; ++k) dst[m][k] = *(const LAS bf16x8*)(lds + PG8_SA(b, h) + aoff + m * 2048 + k * 1024); } while (0)
#define PG8_LDB(dst, b, h) do { _Pragma("unroll") for (int n = 0; n < 2; ++n) _Pragma("unroll") for (int k = 0; k < 2; ++k) dst[n][k] = *(const LAS bf16x8*)(lds + PG8_SB(b, h) + boff + n * 2048 + k * 1024); } while (0)
#define PG8_MMA(ai, bj, At, Bt) do { __builtin_amdgcn_s_setprio(1); _Pragma("unroll") for (int m = 0; m < 4; ++m) _Pragma("unroll") for (int n = 0; n < 2; ++n) _Pragma("unroll") for (int k = 0; k < 2; ++k) \
        acc[ai][bj][m][n] = __builtin_amdgcn_mfma_f32_16x16x32_bf16(Bt[n][k], At[m][k], acc[ai][bj][m][n], 0, 0, 0); __builtin_amdgcn_s_setprio(0); } while (0)
#define PG8_WAIT_V(n) asm volatile("s_waitcnt vmcnt(" #n ")" ::: "memory")
#define PG8_WAIT_L(n) asm volatile("s_waitcnt lgkmcnt(" #n ")" ::: "memory")
#define PG8_BAR __builtin_amdgcn_s_barrier()
#define PG8_SCHED __builtin_amdgcn_sched_barrier(0)
    Unit cur, nxt; int ui = 0;
    if (!S.next(0, cur)) return;
    f32x4 acc[2][2][4][2];
#pragma unroll
    for (int a = 0; a < 2; ++a)
#pragma unroll
        for (int b = 0; b < 2; ++b)
#pragma unroll
            for (int m = 0; m < 4; ++m)
#pragma unroll
                for (int n = 0; n < 2; ++n) acc[a][b][m][n] = (f32x4){0.f, 0.f, 0.f, 0.f};
    bf16x8 At[4][2], B0[2][2], B1[2][2];
    const char* cA = (const char*)g.A + (size_t)cur.pm * tstepA; const char* cB = (const char*)g.Bt + (size_t)cur.pn * tstepB;
    PG8_STAGE(PG8_SB(0, 0), cB, voffB); PG8_STAGE(PG8_SB(0, 1), cB + hstepB, voffB); PG8_STAGE(PG8_SA(0, 0), cA, voffA); PG8_STAGE(PG8_SA(0, 1), cA + hstepA, voffA);
    if (wr == 1) PG8_BAR;
    PG8_WAIT_V(2); PG8_BAR;
    PG8_STAGE(PG8_SB(1, 0), cB + kstep, voffB); PG8_STAGE(PG8_SA(1, 0), cA + kstep, voffA); PG8_STAGE(PG8_SB(1, 1), cB + hstepB + kstep, voffB);
    PG8_WAIT_V(6); PG8_BAR;
    for (;;) {
        const bool has_next = S.next(ui + 1, nxt);
        const char* nA = has_next ? (const char*)g.A + (size_t)nxt.pm * tstepA : cA; const char* nB = has_next ? (const char*)g.Bt + (size_t)nxt.pn * tstepB : cB;
        for (int t = 0; t < nt; t += 2) {
            const bool last = (t == nt - 2);
            const char* a1 = cA + (size_t)(t + 1) * kstep;
            const char* a2 = last ? nA : cA + (size_t)(t + 2) * kstep; const char* b2 = last ? nB : cB + (size_t)(t + 2) * kstep;
            const char* a3 = a2 + kstep; const char* b3 = b2 + kstep;
            PG8_LDB(B0, 0, 0); PG8_LDB(B1, 0, 1); PG8_SCHED; PG8_LDA(At, 0, 0); PG8_STAGE(PG8_SA(1, 1), a1 + hstepA, voffA);
            PG8_WAIT_V(8); PG8_WAIT_L(0); PG8_BAR; PG8_MMA(0, 0, At, B0); PG8_MMA(0, 1, At, B1); PG8_BAR; PG8_SCHED;
            PG8_LDA(At, 0, 1); PG8_STAGE(PG8_SB(0, 0), b2, voffB); PG8_STAGE(PG8_SB(0, 1), b2 + hstepB, voffB); PG8_STAGE(PG8_SA(0, 0), a2, voffA);
            PG8_WAIT_V(8); PG8_WAIT_L(0); PG8_BAR; PG8_MMA(1, 0, At, B0); PG8_MMA(1, 1, At, B1); PG8_BAR; PG8_SCHED;
            PG8_LDB(B0, 1, 0); PG8_LDB(B1, 1, 1); PG8_SCHED; PG8_LDA(At, 1, 0); PG8_STAGE(PG8_SA(0, 1), a2 + hstepA, voffA);
            PG8_WAIT_V(8); PG8_WAIT_L(0); PG8_BAR; PG8_MMA(0, 0, At, B0); PG8_MMA(0, 1, At, B1); PG8_BAR; PG8_SCHED;
            PG8_LDA(At, 1, 1); PG8_STAGE(PG8_SB(1, 0), b3, voffB); PG8_STAGE(PG8_SB(1, 1), b3 + hstepB, voffB); PG8_STAGE(PG8_SA(1, 0), a3, voffA);
            PG8_WAIT_V(8); PG8_WAIT_L(0); PG8_BAR; PG8_MMA(1, 0, At, B0); PG8_MMA(1, 1, At, B1); PG8_BAR; PG8_SCHED;
        }
        if (wr == 0) PG8_BAR;
        { Unit uu = cur; asm volatile("" : "+s"(uu.pm), "+s"(uu.pn)); int t2 = tid; asm volatile("" : "+v"(t2));
          E(acc, uu, wr, wc, t2 & 15, (t2 & 63) >> 4); }
        if (!has_next) break;
#pragma unroll
        for (int a = 0; a < 2; ++a)
#pragma unroll
            for (int b = 0; b < 2; ++b)
#pragma unroll
                for (int m = 0; m < 4; ++m)
#pragma unroll
                    for (int n = 0; n < 2; ++n) acc[a][b][m][n] = (f32x4){0.f, 0.f, 0.f, 0.f};
        cur = nxt; cA = nA; cB = nB; ++ui;
        if (wr == 1) PG8_BAR;
    }
    PG8_WAIT_V(0);
    PG8_BAR;
#undef PG8_SA
#undef PG8_SB
#undef PG8_STAGE
#undef PG8_LDA
#undef PG8_LDB
#undef PG8_MMA
#undef PG8_WAIT_V
#undef PG8_WAIT_L
#undef PG8_BAR
#undef PG8_SCHED
}
}

__host__ __device__ __forceinline__ int v_st(int k, int c) { const int kk = (k & ~0xC) | ((k & 4) << 1) | ((k & 8) >> 1); return ((kk >> 3) * 4 + (c >> 5)) * 512 + ((kk & 7) * 32 + (c & 31)) * 2; }
__device__ __forceinline__ int v_rd_base(int lane) { return ((lane & 3) << 3) | (((lane >> 2) & 3) << 6) | (((lane >> 4) & 1) << 5) | (((lane >> 5) & 1) << 8); }
constexpr int v_rd_off(int d0, int ks, int half) { return d0 * 512 + ks * 4096 + half * 2048; }
__device__ __forceinline__ int crow(int r, int hi) { return (r & 3) + 8 * (r >> 2) + 4 * hi; }

enum { EM_Z = 0, EM_F32 = 1, EM_Q = 2, EM_KV = 3, EM_PW2 = 4, EM_Z1 = 5 };
struct EpiAll {
    static constexpr bool PERM = true;
    int mode; int ldc; void* p0; const void* p1; const void* p2;
    unsigned char* wsb; const float* qng; const float* kvng; LAS unsigned char* ldsp; const float* slg; const float* slb;
    __device__ __forceinline__ void operator()(const f32x4 (&acc)[2][2][4][2], const pg8::Unit& u, int wr, int wc, int fr, int fq) const {
        const int row0 = u.pm * 256 + wr * 64 + fr, col0 = u.pn * 256 + wc * 32 + 8 * fq;
        if (mode == EM_Z) {
            bf16_t* O = (bf16_t*)p0;
#pragma unroll
            for (int ai = 0; ai < 2; ++ai)
#pragma unroll
                for (int m = 0; m < 4; ++m) { bf16_t* rowp = O + (size_t)(row0 + ai * 128 + m * 16) * ldc + col0;
#pragma unroll
                    for (int bj = 0; bj < 2; ++bj) { const f32x4 v0 = acc[ai][bj][m][0], v1 = acc[ai][bj][m][1];
                        u32x4 w; w.x = cvtpk(v0[0], v0[1]); w.y = cvtpk(v0[2], v0[3]); w.z = cvtpk(v1[0], v1[1]); w.w = cvtpk(v1[2], v1[3]);
                        *(u32x4*)(rowp + bj * 128) = w; } }
        } else if (mode == EM_Z1) {
            bf16_t* O = (bf16_t*)p0; const int pn = u.pn;
            if (pn < 2) {
                LAS float* P = (LAS float*)(ldsp + 131072);
                const int nb = (pn == 0) ? 2 : 1;
#pragma unroll
                for (int ai = 0; ai < 2; ++ai)
#pragma unroll
                    for (int m = 0; m < 4; ++m) { float s = 0.f;
#pragma unroll
                        for (int bj = 0; bj < 2; ++bj) if (bj < nb) {
#pragma unroll
                            for (int n = 0; n < 2; ++n) { const f32x4 v = acc[ai][bj][m][n]; s += (v[0] * v[0] + v[1] * v[1]) + (v[2] * v[2] + v[3] * v[3]); } }
                        { auto r_ = __builtin_amdgcn_permlane32_swap(__float_as_uint(s), __float_as_uint(s), false, false); s = __uint_as_float(r_[0]) + __uint_as_float(r_[1]); }
                        { auto r_ = __builtin_amdgcn_permlane16_swap(__float_as_uint(s), __float_as_uint(s), false, false); s = __uint_as_float(r_[0]) + __uint_as_float(r_[1]); }
                        if (fq == 0) P[(ai * 128 + wr * 64 + m * 16 + fr) * 4 + wc] = s; }
                asm volatile("s_waitcnt lgkmcnt(0)" ::: "memory"); __builtin_amdgcn_s_barrier(); asm volatile("" ::: "memory");
                const int c8 = wc * 32 + 8 * fq;
                const float* gn = (pn == 0) ? qng : kvng;
                f32x4 g00 = *(const f32x4*)(gn + c8), g01 = *(const f32x4*)(gn + c8 + 4), g10 = g00, g11 = g01;
                if (pn == 0) { g10 = *(const f32x4*)(gn + 128 + c8); g11 = *(const f32x4*)(gn + 128 + c8 + 4); }
                bf16_t* QLNp = (bf16_t*)(wsb + WS_QLN); bf16_t* KVLNp = (bf16_t*)(wsb + WS_KVLN); unsigned char* KRp = wsb + WS_KR;
                const float* cs = (const float*)p1; const float* sn = (const float*)p2;
                const float inv_n = (pn == 0) ? (1.f / QLR) : (1.f / KVLR);
#pragma unroll
                for (int ai = 0; ai < 2; ++ai)
#pragma unroll
                    for (int m = 0; m < 4; ++m) { const int rl_ = ai * 128 + wr * 64 + m * 16 + fr; const int tok = u.pm * 256 + rl_;
                        const f32x4 pp = *(const LAS f32x4*)(P + rl_ * 4);
                        const float rstd = rsqrtf(((pp[0] + pp[1]) + (pp[2] + pp[3])) * inv_n + EPS);
                        { const f32x4 v0 = acc[ai][0][m][0] * rstd * g00, v1 = acc[ai][0][m][1] * rstd * g01;
                          u32x4 w; w.x = cvtpk(v0[0], v0[1]); w.y = cvtpk(v0[2], v0[3]); w.z = cvtpk(v1[0], v1[1]); w.w = cvtpk(v1[2], v1[3]);
                          if (pn == 0) *(u32x4*)(QLNp + (size_t)tok * QLR + c8) = w; else *(u32x4*)(KVLNp + (size_t)tok * KVLR + c8) = w; }
                        if (pn == 0) { const f32x4 v0 = acc[ai][1][m][0] * rstd * g10, v1 = acc[ai][1][m][1] * rstd * g11;
                          u32x4 w; w.x = cvtpk(v0[0], v0[1]); w.y = cvtpk(v0[2], v0[3]); w.z = cvtpk(v1[0], v1[1]); w.w = cvtpk(v1[2], v1[3]);
                          *(u32x4*)(QLNp + (size_t)tok * QLR + 128 + c8) = w; }
                        else if (wc < 2) { const f32x4 v0 = acc[ai][1][m][0], v1 = acc[ai][1][m][1]; const int i0 = 16 * wc + 4 * fq; const int b = tok >> 13, s_ = tok & 8191;
                          const f32x4 c4 = *(const f32x4*)(cs + (size_t)tok * 32 + i0), s4 = *(const f32x4*)(sn + (size_t)tok * 32 + i0);
                          u32x4 w; w.x = cvtpk(v0[0] * c4[0] - v0[1] * s4[0], v0[1] * c4[0] + v0[0] * s4[0]); w.y = cvtpk(v0[2] * c4[1] - v0[3] * s4[1], v0[3] * c4[1] + v0[2] * s4[1]);
                          w.z = cvtpk(v1[0] * c4[2] - v1[1] * s4[2], v1[1] * c4[2] + v1[0] * s4[2]); w.w = cvtpk(v1[2] * c4[3] - v1[3] * s4[3], v1[3] * c4[3] + v1[2] * s4[3]);
                          *(u32x4*)(KRp + ((size_t)(b * (SEQ / 64) + (s_ >> 6))) * 8192 + (4 * wc + fq) * 1024 + (s_ & 63) * 16) = w; } }
                return;
            }
            if (pn == 8) {
                typedef float f32x2l __attribute__((ext_vector_type(2)));
                LAS f32x2l* P2 = (LAS f32x2l*)(ldsp + 131072);
#pragma unroll
                for (int ai = 0; ai < 2; ++ai)
#pragma unroll
                    for (int m = 0; m < 4; ++m) { float s = 0.f, q = 0.f;
#pragma unroll
                        for (int bj = 0; bj < 2; ++bj)
#pragma unroll
                            for (int n = 0; n < 2; ++n) { const f32x4 v = acc[ai][bj][m][n];
#pragma unroll
                                for (int e = 0; e < 4; ++e) { const float x = geluf_(v[e]); s += x; q += x * x; } }
                        { auto r_ = __builtin_amdgcn_permlane32_swap(__float_as_uint(s), __float_as_uint(s), false, false); s = __uint_as_float(r_[0]) + __uint_as_float(r_[1]); }
                        { auto r_ = __builtin_amdgcn_permlane16_swap(__float_as_uint(s), __float_as_uint(s), false, false); s = __uint_as_float(r_[0]) + __uint_as_float(r_[1]); }
                        { auto r_ = __builtin_amdgcn_permlane32_swap(__float_as_uint(q), __float_as_uint(q), false, false); q = __uint_as_float(r_[0]) + __uint_as_float(r_[1]); }
                        { auto r_ = __builtin_amdgcn_permlane16_swap(__float_as_uint(q), __float_as_uint(q), false, false); q = __uint_as_float(r_[0]) + __uint_as_float(r_[1]); }
                        if (fq == 0) P2[(ai * 128 + wr * 64 + m * 16 + fr) * 4 + wc] = (f32x2l){s, q};
                        __builtin_amdgcn_sched_barrier(0); }
                asm volatile("s_waitcnt lgkmcnt(0)" ::: "memory"); __builtin_amdgcn_s_barrier(); asm volatile("" ::: "memory");
                const int c8 = wc * 32 + 8 * fq;
                f32x4 gg[2][2], bb[2][2];
#pragma unroll
                for (int bj = 0; bj < 2; ++bj)
#pragma unroll
                    for (int n = 0; n < 2; ++n) { gg[bj][n] = *(const f32x4*)(slg + bj * 128 + c8 + 4 * n); bb[bj][n] = *(const f32x4*)(slb + bj * 128 + c8 + 4 * n); }
#pragma unroll
                for (int ai = 0; ai < 2; ++ai)
#pragma unroll
                    for (int m = 0; m < 4; ++m) { const int rl_ = ai * 128 + wr * 64 + m * 16 + fr;
                        const f32x4 pa_ = *(const LAS f32x4*)(P2 + rl_ * 4), pb_ = *(const LAS f32x4*)(P2 + rl_ * 4 + 2);
                        const float mean = ((pa_[0] + pa_[2]) + (pb_[0] + pb_[2])) * (1.f / SW);
                        const float var = ((pa_[1] + pa_[3]) + (pb_[1] + pb_[3])) * (1.f / SW) - mean * mean;
                        const float rstd = rsqrtf(fmaxf(var, 0.f) + EPS);
                        bf16_t* rowb = O + (size_t)(row0 + ai * 128 + m * 16) * ldc + col0;
#pragma unroll
                        for (int bj = 0; bj < 2; ++bj) { f32x4 x0 = acc[ai][bj][m][0], x1 = acc[ai][bj][m][1];
#pragma unroll
                            for (int e = 0; e < 4; ++e) { asm volatile("" : "+v"(x0[e]), "+v"(x1[e])); x0[e] = geluf_(x0[e]); x1[e] = geluf_(x1[e]); }
                            const f32x4 v0 = (x0 - mean) * rstd * gg[bj][0] + bb[bj][0], v1 = (x1 - mean) * rstd * gg[bj][1] + bb[bj][1];
                            u32x4 w; w.x = cvtpk(v0[0], v0[1]); w.y = cvtpk(v0[2], v0[3]); w.z = cvtpk(v1[0], v1[1]); w.w = cvtpk(v1[2], v1[3]);
                            __builtin_nontemporal_store(w, (u32x4*)(rowb + bj * 128)); }
                        __builtin_amdgcn_sched_barrier(0); }
                return;
            }
            const bool paired = (pn == 4) | (pn == 5) | (pn == 7) | (pn == 9), gate = (pn == 2) | (pn == 3) | (pn == 6);
            const int pcol = (pn == 4 ? 1024 : pn == 5 ? 1152 : pn == 7 ? 1792 : 1920) + wc * 32 + 8 * fq;
#pragma unroll
            for (int ai = 0; ai < 2; ++ai)
#pragma unroll
                for (int m = 0; m < 4; ++m) { bf16_t* rowb = O + (size_t)(row0 + ai * 128 + m * 16) * ldc;
                    if (paired) { const f32x4 a0 = acc[ai][0][m][0], a1 = acc[ai][0][m][1], b0 = acc[ai][1][m][0], b1 = acc[ai][1][m][1]; f32x4 r0, r1;
                        if (pn < 6) {
#pragma unroll
                            for (int e = 0; e < 4; ++e) { r0[e] = a0[e] * sigmoidf_(b0[e]); r1[e] = a1[e] * sigmoidf_(b1[e]); } }
                        else {
#pragma unroll
                            for (int e = 0; e < 4; ++e) { r0[e] = geluf_(a0[e]) * siluf_(b0[e]); r1[e] = geluf_(a1[e]) * siluf_(b1[e]); } }
                        u32x4 w; w.x = cvtpk(r0[0], r0[1]); w.y = cvtpk(r0[2], r0[3]); w.z = cvtpk(r1[0], r1[1]); w.w = cvtpk(r1[2], r1[3]);
                        __builtin_nontemporal_store(w, (u32x4*)(rowb + pcol)); }
                    else {
#pragma unroll
                        for (int bj = 0; bj < 2; ++bj) { f32x4 v0 = acc[ai][bj][m][0], v1 = acc[ai][bj][m][1];
                            if (gate) {
#pragma unroll
                                for (int e = 0; e < 4; ++e) { v0[e] = siluf_(v0[e]); v1[e] = siluf_(v1[e]); } }
                            u32x4 w; w.x = cvtpk(v0[0], v0[1]); w.y = cvtpk(v0[2], v0[3]); w.z = cvtpk(v1[0], v1[1]); w.w = cvtpk(v1[2], v1[3]);
                            __builtin_nontemporal_store(w, (u32x4*)(rowb + col0 + bj * 128)); } } }
        } else if (mode == EM_F32) {
            float* C = (float*)p0;
#pragma unroll
            for (int ai = 0; ai < 2; ++ai)
#pragma unroll
                for (int m = 0; m < 4; ++m) { float* rowp = C + (size_t)(row0 + ai * 128 + m * 16) * ldc + col0;
#pragma unroll
                    for (int bj = 0; bj < 2; ++bj)
#pragma unroll
                        for (int n = 0; n < 2; ++n) *(f32x4*)(rowp + bj * 128 + n * 4) = acc[ai][bj][m][n]; }
        } else if (mode == EM_Q) {
            bf16_t* Q = (bf16_t*)p0; const float* cs = (const float*)p1; const float* sn = (const float*)p2;
#pragma unroll
            for (int ai = 0; ai < 2; ++ai)
#pragma unroll
                for (int m = 0; m < 4; ++m) { const int tok = row0 + ai * 128 + m * 16, b = tok >> 13, s = tok & 8191;
#pragma unroll
                    for (int bj = 0; bj < 2; ++bj) { f32x4 v0 = acc[ai][bj][m][0], v1 = acc[ai][bj][m][1]; const int n = col0 + bj * 128;
                        bf16_t* dst;
                        if (u.pn < 2) { const int h = n >> 7, d = n & 127; dst = Q + ((size_t)((b * NH + h) * SEQ + s)) * DQK + d; }
                        else { const int n2 = n - 512, h = n2 >> 6, w = n2 & 63, i0 = w >> 1;
                            const f32x4 c4 = *(const f32x4*)(cs + (size_t)tok * 32 + i0), s4 = *(const f32x4*)(sn + (size_t)tok * 32 + i0);
                            f32x4 a0, a1;
                            a0[0] = v0[0] * c4[0] - v0[1] * s4[0]; a0[1] = v0[1] * c4[0] + v0[0] * s4[0];
                            a0[2] = v0[2] * c4[1] - v0[3] * s4[1]; a0[3] = v0[3] * c4[1] + v0[2] * s4[1];
                            a1[0] = v1[0] * c4[2] - v1[1] * s4[2]; a1[1] = v1[1] * c4[2] + v1[0] * s4[2];
                            a1[2] = v1[2] * c4[3] - v1[3] * s4[3]; a1[3] = v1[3] * c4[3] + v1[2] * s4[3];
                            v0 = a0; v1 = a1; dst = Q + ((size_t)((b * NH + h) * SEQ + s)) * DQK + DNOPE + w; }
                        v0 = v0 * QSCALE; v1 = v1 * QSCALE;
                        u32x4 wv; wv.x = cvtpk(v0[0], v0[1]); wv.y = cvtpk(v0[2], v0[3]); wv.z = cvtpk(v1[0], v1[1]); wv.w = cvtpk(v1[2], v1[3]);
                        *(u32x4*)dst = wv; } }
        } else if (mode == EM_KV) {
            unsigned char* KN = (unsigned char*)p0; unsigned char* VI = (unsigned char*)p1;
#pragma unroll
            for (int ai = 0; ai < 2; ++ai)
#pragma unroll
                for (int m = 0; m < 4; ++m) { const int tok = row0 + ai * 128 + m * 16, b = tok >> 13, s = tok & 8191;
#pragma unroll
                    for (int bj = 0; bj < 2; ++bj) { const f32x4 v0 = acc[ai][bj][m][0], v1 = acc[ai][bj][m][1]; const int n = (col0 + bj * 128) & 511;
                        const int h = n >> 7, d = n & 127;
                        const size_t tbase = ((size_t)((b * NH + h) * (SEQ / 64) + (s >> 6))) * 16384;
                        unsigned char* dst = (u.pn < 2) ? KN + tbase + (d >> 3) * 1024 + (s & 63) * 16 : VI + tbase + v_st(s & 63, d);
                        u32x4 wv; wv.x = cvtpk(v0[0], v0[1]); wv.y = cvtpk(v0[2], v0[3]); wv.z = cvtpk(v1[0], v1[1]); wv.w = cvtpk(v1[2], v1[3]);
                        *(u32x4*)dst = wv; } }
        } else {
            bf16_t* YCAT = (bf16_t*)p0; const bf16_t* Z = (const bf16_t*)p1;
#pragma unroll
            for (int ai = 0; ai < 2; ++ai)
#pragma unroll
                for (int m = 0; m < 4; ++m) { const int tok = row0 + ai * 128 + m * 16;
#pragma unroll
                    for (int bj = 0; bj < 2; ++bj) { const f32x4 v0 = acc[ai][bj][m][0], v1 = acc[ai][bj][m][1]; const int c = col0 + bj * 128;
                        const u32x4 g = *(const u32x4*)(Z + (size_t)tok * DINP + ZC_GC + c);
                        u32x4 wv;
                        wv.x = cvtpk(v0[0] * lo_bf(g.x), v0[1] * hi_bf(g.x)); wv.y = cvtpk(v0[2] * lo_bf(g.y), v0[3] * hi_bf(g.y));
                        wv.z = cvtpk(v1[0] * lo_bf(g.z), v1[1] * hi_bf(g.z)); wv.w = cvtpk(v1[2] * lo_bf(g.w), v1[3] * hi_bf(g.w));
                        *(u32x4*)(YCAT + (size_t)tok * DM + 512 + c) = wv; } }
        }
    }
};

namespace att {
constexpr int SLOT = 40960, NSLOT = 3, VOFF = 24576, LDS_WS = NSLOT * SLOT;
constexpr float THR = 8.f;
#define SBAR() __builtin_amdgcn_sched_barrier(0)
__device__ __forceinline__ void glds16s(const void* sbase, unsigned voff, unsigned lds_dst) { unsigned keep;
    asm volatile("s_mov_b32 %0, m0\n\ts_mov_b32 m0, %3\n\ts_nop 0\n\tglobal_load_lds_dwordx4 %1, %2\n\ts_mov_b32 m0, %0" : "=&s"(keep) : "v"(voff), "s"(sbase), "s"(lds_dst) : "memory"); }
#if ATT_EXP_TOP & 4
#define GLDS_DUP "global_load_lds_dwordx4 %1, off\n\t"
#else
#define GLDS_DUP ""
#endif
__device__ __forceinline__ void glds16(const void* gsrc, unsigned lds_dst) { unsigned keep;
    asm volatile("s_mov_b32 %0, m0\n\ts_mov_b32 m0, %2\n\ts_nop 0\n\tglobal_load_lds_dwordx4 %1, off\n\t" GLDS_DUP "s_mov_b32 m0, %0" : "=&s"(keep) : "v"(gsrc), "s"(lds_dst) : "memory"); }

template <int AX> __device__ __forceinline__ void attn_unit3(int b, int h, int qb, const bf16_t* Q, const unsigned char* KN, const unsigned char* KR, const unsigned char* VI,
                                           const bf16_t* Z, bf16_t* YCAT, char* shm, const int tid) {
    const int lane = tid & 63, r32 = lane & 31, hi = lane >> 5; const int wid = __builtin_amdgcn_readfirstlane(tid >> 6);
    const int q0 = qb * 256, NT = 4 * (qb + 1);
    const int bh = b * NH + h;
    const unsigned lds0 = (unsigned)(uintptr_t)shm;
    const unsigned char* knb = KN + (size_t)bh * (SEQ / 64) * 16384;
    const unsigned char* krb = KR + (size_t)b * (SEQ / 64) * 8192;
    const unsigned char* vbs = VI + (size_t)bh * (SEQ / 64) * 16384;
    const unsigned dvo = (unsigned)(wid * 1024 + lane * 16);
#define DMA_TILE(t, slot) do { const unsigned d_ = (unsigned)__builtin_amdgcn_readfirstlane(lds0 + (slot) + wid * 1024); \
        glds16s(knb + (size_t)(t) * 16384, dvo, d_); glds16s(knb + (size_t)(t) * 16384 + 8192, dvo, d_ + 8192); glds16s(krb + (size_t)(t) * 8192, dvo, d_ + 16384); \
        glds16s(vbs + (size_t)(t) * 16384, dvo, d_ + VOFF); glds16s(vbs + (size_t)(t) * 16384 + 8192, dvo, d_ + VOFF + 8192); } while (0)
    const bf16_t* Qw = Q + ((size_t)(bh * SEQ + q0 + wid * 32 + r32)) * DQK;
    bf16x8 qr[12];
#pragma unroll
    for (int d0 = 0; d0 < 12; ++d0) qr[d0] = *(const bf16x8*)(Qw + d0 * 16 + hi * 8);
#pragma unroll
    for (int d0 = 0; d0 < 12; ++d0) asm volatile("" : "+v"(qr[d0]));
    asm volatile("s_waitcnt vmcnt(0)" ::: "memory");
    DMA_TILE(0, 0);
    float m_run = 0.f, l_run = 0.f; f32x16 o[4];
#pragma unroll
    for (int d = 0; d < 4; ++d) o[d] = f32x16{};
    const LAS char* shm3 = (const LAS char*)shm;
    const LAS char* kl = shm3 + hi * 1024 + r32 * 16;
    const int vb0 = (int)lds0 + VOFF + v_rd_base(lane);
    const int qabs = q0 + wid * 32 + r32;
    f32x16 sA, sB, negm; bf16x8 pa0, pa1; float pmaxN = 0.f;
    bf16x8 kpa, kpb;

#define MF(acc, a_, b_) acc = __builtin_amdgcn_mfma_f32_32x32x16_bf16(a_, b_, acc, 0, 0, 0)
#define MFQ(acc, a_, b_) do { if (AX & 64) { asm volatile("" :: "v"(a_), "v"(b_)); } else MF(acc, a_, b_); } while (0)
#define MFO(acc, a_, b_) do { if (AX & 8) { bf16x8 t0_ = a_, t1_ = b_; asm volatile("" :: "v"(t0_), "v"(t1_)); } else acc = __builtin_amdgcn_mfma_f32_32x32x16_bf16(b_, a_, acc, 0, 0, 0); } while (0)
#define DMAP(on_, i_, t_, slot_) do { if ((on_) && !(AX & 2)) { const unsigned d_ = (unsigned)__builtin_amdgcn_readfirstlane(lds0 + (slot_) + wid * 1024); \
        if ((i_) == 0) glds16s(knb + (size_t)(t_) * 16384, dvo, d_); else if ((i_) == 1) glds16s(knb + (size_t)(t_) * 16384 + 8192, dvo, d_ + 8192); \
        else if ((i_) == 2) glds16s(krb + (size_t)(t_) * 8192, dvo, d_ + 16384); else if ((i_) == 3) glds16s(vbs + (size_t)(t_) * 16384, dvo, d_ + VOFF); \
        else glds16s(vbs + (size_t)(t_) * 16384 + 8192, dvo, d_ + VOFF + 8192); } } while (0)
#ifndef ATT_EXP
#define ATT_EXP 0
#endif
#if ATT_EXP & 1
#define KLD1(dst, kp_, d0) do { dst = *(const LAS bf16x8*)(kp_ + (d0) * 2048); bf16x8 dmy_; asm volatile("ds_read_b128 %0, %1 offset:%2" : "=v"(dmy_) : "v"((int)(uintptr_t)(kp_)), "i"(((d0) * 2048) & 0xffff) : "memory"); asm volatile("" :: "v"(dmy_)); } while (0)
#else
#define KLD1(dst, kp_, d0) do { if (AX & 32) { asm volatile("" : "+v"(dst)); } else dst = *(const LAS bf16x8*)(kp_ + (d0) * 2048); } while (0)
#endif
#define KLD1R(dst, kp_, d0) dst = *(const LAS bf16x8*)(kp_ + (d0) * 2048)
#define MASKH(S, T_, hf_) do { if ((T_) >= NT - 4) { const float NEG = -__builtin_inff(); const int kb_ = 64 * (T_) + 32 * (hf_) + 4 * hi; \
        _Pragma("unroll") for (int r = 0; r < 16; ++r) { const int kv = kb_ + (r & 3) + 8 * (r >> 2); if (kv > qabs) S[r] = NEG; } } } while (0)
#define ROWMAX_FIN(mx0, mx1, out) do { float m_ = fmaxf(mx0, mx1); auto rr_ = __builtin_amdgcn_permlane32_swap(__float_as_uint(m_), __float_as_uint(m_), false, false); \
        out = fmaxf(__uint_as_float(rr_[0]), __uint_as_float(rr_[1])); } while (0)
#define DECIDE(pmax_, SYp) do { if (!__all((pmax_) <= THR)) { const float dl_ = fmaxf((pmax_), 0.f); const float al_ = __builtin_amdgcn_exp2f(-dl_); m_run += dl_; l_run *= al_; \
        _Pragma("unroll") for (int r = 0; r < 16; ++r) { SYp[r] -= dl_; negm[r] = -m_run; } \
        _Pragma("unroll") for (int d_ = 0; d_ < 4; ++d_) _Pragma("unroll") for (int r = 0; r < 16; ++r) o[d_][r] *= al_; } } while (0)
#define PK4(P, B_, OUT) do { if (AX & (128 | 4096)) { asm volatile("" : "=v"(OUT) : "v"(P)); break; } unsigned a0_ = cvtpk(P[B_ + 0], P[B_ + 1]), a1_ = cvtpk(P[B_ + 2], P[B_ + 3]); \
        unsigned b0_ = cvtpk(P[B_ + 4], P[B_ + 5]), b1_ = cvtpk(P[B_ + 6], P[B_ + 7]); \
        auto r0_ = __builtin_amdgcn_permlane32_swap(a0_, b0_, false, false); auto r1_ = __builtin_amdgcn_permlane32_swap(a1_, b1_, false, false); \
        u32x4 w_ = {r0_[0], r1_[0], r0_[1], r1_[1]}; OUT = *reinterpret_cast<bf16x8*>(&w_); } while (0)
#if ATT_EXP & 2
#define SMC2(S, i) do { const float e0_ = __builtin_amdgcn_exp2f(S[i] - m_run), e1_ = __builtin_amdgcn_exp2f(S[(i) + 1] - m_run); \
        float x0_ = __builtin_amdgcn_exp2f(S[i] - l_run), x1_ = __builtin_amdgcn_exp2f(S[(i) + 1] - l_run); x0_ += x1_; asm volatile("" :: "v"(x0_)); \
        S[i] = e0_; S[(i) + 1] = e1_; ps0 += e0_; ps1 += e1_; } while (0)
#else
#define SMC2(S, i) do { if (AX & (128 | 2048)) break; const float e0_ = (AX & 1) ? S[i] : __builtin_amdgcn_exp2f(S[i]), e1_ = (AX & 1) ? S[(i) + 1] : __builtin_amdgcn_exp2f(S[(i) + 1]); S[i] = e0_; S[(i) + 1] = e1_; ps0 += e0_; ps1 += e1_; } while (0)
#endif
#define SMFIN() do { if (AX & (128 | 16384)) break; float ps_ = ps0 + ps1; auto rr_ = __builtin_amdgcn_permlane32_swap(__float_as_uint(ps_), __float_as_uint(ps_), false, false); \
        l_run += __uint_as_float(rr_[0]) + __uint_as_float(rr_[1]); } while (0)
#define TRRD(dst, off) do { if (AX & 16) asm volatile("" : "=v"(dst)); else asm volatile("ds_read_b64_tr_b16 %0, %1 offset:%2" : "=&v"(dst) : "v"(vb_), "i"(off) : "memory"); } while (0)
#define TRRD4(P_, d0, hf_) do { constexpr int b_ = v_rd_off(d0, 2 * (hf_), 0); TRRD(P_##l0, b_); TRRD(P_##h0, b_ + 2048); TRRD(P_##l1, b_ + 4096); TRRD(P_##h1, b_ + 6144); } while (0)
#define VF(P_, k) (bf16x8){P_##l##k[0], P_##l##k[1], P_##l##k[2], P_##l##k[3], P_##h##k[0], P_##h##k[1], P_##h##k[2], P_##h##k[3]}
#define LGK(n) do { if (!(AX & 256)) asm volatile("s_waitcnt lgkmcnt(" #n ")" ::: "memory"); } while (0)
#define RMC2(S, j) do { if (AX & (128 | 8192)) break; mx0 = __builtin_fmaxf(__builtin_fmaxf(mx0, S[j]), S[(j) + 1]); } while (0)
#define RMC4(S, j) do { RMC2(S, j); RMC2(S, (j) + 2); } while (0)

#define HSTEP(SX, SY, T_, HF, TN, HFN, has_next_, dma_on_, bar_, pf_, knext_, td_) do { \
        float ps0 = 0.f, ps1 = 0.f; \
        if (has_next_) { \
            const LAS char* kp_ = kl + ((HFN) == 0 ? sl_n1 : sl_cur) + (HFN) * 512; bf16x8 k0 = kpa, k1 = kpb, k2 = kpa; \
            KLD1(k2, kp_, 2); SBAR(); \
            if (AX & 64) { SY = negm; asm volatile("" :: "v"(k0)); } else SY = __builtin_amdgcn_mfma_f32_32x32x16_bf16(k0, qr[0], negm, 0, 0, 0); SMC2(SX, 0); SBAR(); KLD1(k0, kp_, 3); DMAP(dma_on_, 0, td_, sl_n2); SBAR(); \
            MFQ(SY, k1, qr[1]); SMC2(SX, 2); SBAR(); KLD1(k1, kp_, 4); DMAP(dma_on_, 1, td_, sl_n2); SBAR(); \
            MFQ(SY, k2, qr[2]); SMC2(SX, 4); SBAR(); KLD1(k2, kp_, 5); DMAP(dma_on_, 2, td_, sl_n2); SBAR(); \
            MFQ(SY, k0, qr[3]); SMC2(SX, 6); SBAR(); KLD1(k0, kp_, 6); DMAP(dma_on_, 3, td_, sl_n2); SBAR(); \
            MFQ(SY, k1, qr[4]); SMC2(SX, 8); SBAR(); KLD1(k1, kp_, 7); DMAP(dma_on_, 4, td_, sl_n2); SBAR(); \
            MFQ(SY, k2, qr[5]); SMC2(SX, 10); SBAR(); KLD1(k2, kp_, 8); SBAR(); \
            MFQ(SY, k0, qr[6]); SMC2(SX, 12); SBAR(); KLD1(k0, kp_, 9); SBAR(); \
            MFQ(SY, k1, qr[7]); SMC2(SX, 14); SBAR(); KLD1(k1, kp_, 10); SBAR(); \
            MFQ(SY, k2, qr[8]); PK4(SX, 0, pa0); SBAR(); KLD1(k2, kp_, 11); SBAR(); \
            MFQ(SY, k0, qr[9]); PK4(SX, 8, pa1); SBAR(); \
            MFQ(SY, k1, qr[10]); SMFIN(); SBAR(); \
            MFQ(SY, k2, qr[11]); SBAR(); \
        } else { \
            _Pragma("unroll") for (int i_ = 0; i_ < 16; i_ += 2) SMC2(SX, i_); \
            PK4(SX, 0, pa0); PK4(SX, 8, pa1); SMFIN(); SBAR(); \
        } \
        if (bar_) { if (AX & 4) asm volatile("s_waitcnt vmcnt(0) lgkmcnt(0)" ::: "memory"); else asm volatile("s_waitcnt vmcnt(0) lgkmcnt(0)\n\ts_barrier" ::: "memory"); }     \
        { const int vb_ = vb0 + sl_cur; s16x4 Al0, Al1, Ah0, Ah1, Bl0, Bl1, Bh0, Bh1; \
          float mx0 = -__builtin_inff(); \
          TRRD4(A, 0, HF); TRRD4(B, 1, HF); SBAR(); \
          if (pf_) { KLD1(kpa, knext_, 0); KLD1(kpb, knext_, 1); } SBAR(); \
          if (has_next_) MASKH(SY, TN, HFN); \
          SBAR(); if (pf_) LGK(6); else LGK(4); SBAR();                   \
          MFO(o[0], pa0, VF(A, 0)); if (has_next_) { RMC4(SY, 0); } SBAR(); MFO(o[0], pa1, VF(A, 1)); if (has_next_) { RMC4(SY, 4); } SBAR(); \
          TRRD4(A, 2, HF); SBAR(); if (pf_) LGK(6); else LGK(4); SBAR();    \
          MFO(o[1], pa0, VF(B, 0)); if (has_next_) { RMC4(SY, 8); } SBAR(); MFO(o[1], pa1, VF(B, 1)); if (has_next_) { RMC4(SY, 12); } SBAR(); \
          TRRD4(B, 3, HF); LGK(4); SBAR();                                  \
          MFO(o[2], pa0, VF(A, 0)); MFO(o[2], pa1, VF(A, 1)); SBAR(); \
          LGK(0); SBAR(); \
          MFO(o[3], pa0, VF(B, 0)); MFO(o[3], pa1, VF(B, 1)); SBAR(); \
          const float mx1 = mx0; \
          if ((has_next_) && !(AX & (128 | 8192))) { ROWMAX_FIN(mx0, mx1, pmaxN); DECIDE(pmaxN, SY); } } \
    } while (0)

    int sl_cur = 0, sl_n1 = SLOT, sl_n2 = 2 * SLOT;
    asm volatile("s_waitcnt vmcnt(0) lgkmcnt(0)\n\ts_barrier" ::: "memory");
    DMA_TILE(1, SLOT); if (AX & 2) DMA_TILE(2, 2 * SLOT);
    { const LAS char* kp_ = shm3 + hi * 1024 + r32 * 16; bf16x8 ka, kb;
      sA = f32x16{};
      KLD1R(ka, kp_, 0); KLD1R(kb, kp_, 1); SBAR();
#pragma unroll
      for (int d2 = 0; d2 < 12; d2 += 2) {
          MF(sA, ka, qr[d2]); SBAR(); if (d2 + 2 < 12) KLD1R(ka, kp_, d2 + 2); SBAR();
          MF(sA, kb, qr[d2 + 1]); SBAR(); if (d2 + 3 < 12) KLD1R(kb, kp_, d2 + 3); SBAR(); }
      KLD1R(kpa, kp_ + 512, 0); KLD1R(kpb, kp_ + 512, 1); SBAR(); }
    MASKH(sA, 0, 0);
    { float mx0 = -__builtin_inff();
#pragma unroll
      for (int j = 0; j < 16; j += 2) RMC2(sA, j);
      ROWMAX_FIN(mx0, mx0, pmaxN); m_run = pmaxN;
#pragma unroll
      for (int r = 0; r < 16; ++r) { sA[r] -= m_run; negm[r] = -m_run; } }
    for (int T = 0; T < ((AX & 1024) ? 1 : NT); ++T) {
        const int tdma = (T + 2 < NT) ? T + 2 : NT - 1;
        HSTEP(sA, sB, T, 0, T, 1, true, false, true, true, (kl + sl_n1), 0);
        HSTEP(sB, sA, T, 1, T + 1, 0, true, true, false, true, (kl + sl_n1 + 512), tdma);
        { const int tmp_ = sl_cur; sl_cur = sl_n1; sl_n1 = sl_n2; sl_n2 = tmp_; }
    }
    asm volatile("s_waitcnt lgkmcnt(0)\n\ts_barrier" ::: "memory");
    if (AX & 512) { asm volatile("" :: "v"(o[0]), "v"(o[1]), "v"(o[2]), "v"(o[3])); } else
    { int r32e = r32, hie = hi; asm volatile("" : "+v"(r32e), "+v"(hie));
      const size_t mrow = (size_t)b * SEQ + q0 + wid * 32 + r32e;
      const bf16_t* zp = Z + mrow * DINP + ZC_GATT + h * DV + 8 * hie; bf16_t* yp = YCAT + mrow * DM + h * DV + 8 * hie;
      u32x4 gv[8];
#pragma unroll
      for (int j = 0; j < 8; ++j) gv[j] = *(const u32x4*)(zp + 16 * j);
      const float rl = __builtin_amdgcn_rcpf(l_run);
#pragma unroll
      for (int j = 0; j < 8; ++j) { const int d0 = j >> 1, gp = j & 1; float na[4], nb[4];
#pragma unroll
          for (int i = 0; i < 4; ++i) { auto rr_ = __builtin_amdgcn_permlane32_swap(__float_as_uint(o[d0][8 * gp + i] * rl), __float_as_uint(o[d0][8 * gp + 4 + i] * rl), false, false);
              na[i] = __uint_as_float(rr_[0]); nb[i] = __uint_as_float(rr_[1]); }
          const u32x4 g = gv[j]; u32x4 w;
          w.x = cvtpk(na[0] * lo_bf(g.x), na[1] * hi_bf(g.x)); w.y = cvtpk(na[2] * lo_bf(g.y), na[3] * hi_bf(g.y));
          w.z = cvtpk(nb[0] * lo_bf(g.z), nb[1] * hi_bf(g.z)); w.w = cvtpk(nb[2] * lo_bf(g.w), nb[3] * hi_bf(g.w));
          *(u32x4*)(yp + 16 * j) = w; } }
#undef DMA_TILE
#undef DMAP
#undef MF
#undef MFQ
#undef MFO
#undef KLD1R
#undef KLD1
#undef MASKH
#undef ROWMAX_FIN
#undef DECIDE
#undef PK4
#undef SMC2
#undef SMFIN
#undef TRRD
#undef TRRD4
#undef VF
#undef LGK
#undef RMC2
#undef RMC4
#undef HSTEP
}
#undef SBAR
}

#define XB_TMO      128
#define XB_XCNT(j)  (256  + 64 * (j))
#define XB_XSUB(j)  (1280 + 64 * (j))
#define XB_XGEN(j)  (2304 + 64 * (j))
#define XB_TOP      3328
#define XB_TOPGEN   3392
#define XCD_BAR_WORDS 3456
#define XB_SPIN_CAP (1u << 18)
__device__ __forceinline__ unsigned xb_ld(unsigned* p)              { return __hip_atomic_load(p, __ATOMIC_RELAXED, __HIP_MEMORY_SCOPE_AGENT); }
__device__ __forceinline__ unsigned xb_add(unsigned* p, unsigned v) { return __hip_atomic_fetch_add(p, v, __ATOMIC_RELAXED, __HIP_MEMORY_SCOPE_AGENT); }
__device__ __forceinline__ unsigned xb_xcc_id() { return (unsigned)__builtin_amdgcn_s_getreg((3 << 11) | 20) & 0xFu; }
#define XB_SPIN(cond, bar) do { unsigned _sp = 0; while (cond) { __builtin_amdgcn_s_sleep(1); \
    if ((++_sp & 255u) == 0u) { if (xb_ld(&(bar)[XB_TMO])) break; if (_sp > XB_SPIN_CAP) { atomicAdd(&(bar)[XB_TMO], 1u); break; } } } } while (0)
struct XcdBarrier { unsigned* bar; unsigned x; volatile LAS unsigned* st; };
__device__ __forceinline__ XcdBarrier xcd_barrier_post(unsigned* bar, volatile LAS unsigned* st) {
    XcdBarrier b; b.bar = bar; b.x = xb_xcc_id(); b.st = st;
    if (threadIdx.x == 0) (void)xb_add(&bar[XB_XCNT(b.x)], 1u);
    return b;
}
__device__ __forceinline__ void xcd_barrier_complete(unsigned* bar, unsigned x, unsigned& nloc, unsigned& nx) {
    const unsigned G = gridDim.x * gridDim.y * gridDim.z;
    unsigned sum, cnt, mine, sp = 0u;
    for (;;) {
        sum = 0u; cnt = 0u; mine = 0u;
#pragma unroll
        for (unsigned j = 0; j < 16; ++j) { const unsigned c = xb_ld(&bar[XB_XCNT(j)]); sum += c; cnt += (c > 0u) ? 1u : 0u; mine = (j == x) ? c : mine; }
        if (sum == G) break;
        __builtin_amdgcn_s_sleep(1);
        if ((++sp & 255u) == 0u) { if (xb_ld(&bar[XB_TMO])) break; if (sp > XB_SPIN_CAP) { atomicAdd(&bar[XB_TMO], 1u); break; } }
    }
    nloc = mine > 0u ? mine : 1u; nx = cnt > 0u ? cnt : 1u;
}
__device__ __forceinline__ void xcd_barrier(const XcdBarrier& b) {
    asm volatile("s_waitcnt vmcnt(0)" ::: "memory");
    __syncthreads();
    if (threadIdx.x == 0) {
        unsigned* bar = b.bar;
        __builtin_amdgcn_s_waitcnt(0);
        unsigned nloc = b.st[0], nx = b.st[1];
        if (nloc == 0u) { xcd_barrier_complete(bar, b.x, nloc, nx); b.st[0] = nloc; b.st[1] = nx; }
        const unsigned old = xb_add(&bar[XB_XSUB(b.x)], 1u);
        const unsigned gen = old / nloc;
        if (old + 1u == (gen + 1u) * nloc) {
            __builtin_amdgcn_fence(__ATOMIC_RELEASE, "agent");
            asm volatile("s_waitcnt vmcnt(0)" ::: "memory");
            const unsigned og = xb_add(&bar[XB_TOP], 1u);
            const unsigned tg = og / nx;
            if (og + 1u == (tg + 1u) * nx) xb_add(&bar[XB_TOPGEN], 1u);
            else XB_SPIN(xb_ld(&bar[XB_TOPGEN]) == tg, bar);
            __builtin_amdgcn_fence(__ATOMIC_ACQUIRE, "agent");
            xb_add(&bar[XB_XGEN(b.x)], 1u);
            asm volatile("s_waitcnt vmcnt(0)" ::: "memory");
        } else {
            XB_SPIN(xb_ld(&bar[XB_XGEN(b.x)]) == gen, bar);
            __builtin_amdgcn_fence(__ATOMIC_ACQUIRE, "agent");
            asm volatile("s_waitcnt vmcnt(0)" ::: "memory");
        }
    }
    __syncthreads();
}

struct Args { const void* in[22]; float* out; unsigned char* ws; int ph_lo, ph_hi; };
enum { I_X = 0, I_C, I_POS, I_WADA, I_BADA, I_GPRE, I_GPOST, I_WIN, I_QNG, I_WUQ, I_KVNG, I_WUKV, I_CONVW, I_CONVB, I_CLNG, I_CLNB, I_WPW2, I_SLNG, I_SLNB, I_WS, I_BS, I_WOUT };
constexpr int N_PHASES = 2 + 6 * NLAYER;

__device__ __forceinline__ int wmap(int mat, int n) {
    if (mat == 0) {
        if (n < 384) return n; if (n < 448) { const int w = n - 384; return 384 + 32 * (w & 1) + (w >> 1); } if (n < 512) return -1;
        const int t = n >> 8, j = n & 127, second = (n >> 7) & 1;
        if (t == 4 || t == 5) return (second ? 1216 : 960) + (t - 4) * 128 + j;
        if (t == 7 || t == 9) return (second ? 2240 : 1728) + (t == 9 ? 128 : 0) + j;
        return n - 64; }
    if (mat == 2) { if (n < 512) return (n >> 7) * DQK + (n & 127); const int n2 = n - 512, h = n2 >> 6, w = n2 & 63; return h * DQK + DNOPE + 32 * (w & 1) + (w >> 1); }
    if (mat == 3) { const int h = (n & 511) >> 7, d = n & 127; return h * 256 + (n >= 512 ? 128 : 0) + d; }
    return n;
}
__device__ __forceinline__ void transpose_item(const float* W, int Nsrc, bf16_t* WT, int Kd, int mat, LAS float* scr, int kb, int nb, int lane) {
    const int k0 = 64 * kb, n0 = 32 * nb; const int src = wmap(mat, n0 + (lane & 31));
#pragma unroll 8
    for (int i = 0; i < 32; ++i) { const int kk = 2 * i + (lane >> 5); scr[kk * 33 + (lane & 31)] = src >= 0 ? W[(size_t)(k0 + kk) * Nsrc + src] : 0.f; }
    asm volatile("s_waitcnt lgkmcnt(0)" ::: "memory");
    const int c = lane & 7;
#pragma unroll
    for (int j = 0; j < 4; ++j) { const int n = (lane >> 3) + 8 * j; const LAS float* s = scr + (8 * c) * 33 + n;
        u32x4 o; o.x = cvtpk(s[0 * 33], s[1 * 33]); o.y = cvtpk(s[2 * 33], s[3 * 33]); o.z = cvtpk(s[4 * 33], s[5 * 33]); o.w = cvtpk(s[6 * 33], s[7 * 33]);
        *(u32x4*)(WT + (size_t)(n0 + n) * Kd + k0 + 8 * c) = o; }
    asm volatile("s_waitcnt lgkmcnt(0)" ::: "memory");
}

__global__ void __launch_bounds__(NTHREADS, 2) hymba_fwd(Args args) {
    extern __shared__ __attribute__((aligned(16))) unsigned char lds[];
    typedef const __attribute__((address_space(4))) Args* KArgP;
    cg::grid_group grid = cg::this_grid();
    const int ph_lo = args.ph_lo, ph_hi = args.ph_hi;
    const int wave_s = __builtin_amdgcn_readfirstlane(threadIdx.x >> 6);
    volatile LAS unsigned* xbst = (volatile LAS unsigned*)((LAS unsigned char*)lds + LDS_BYTES - 64);
    if (threadIdx.x < 4) xbst[threadIdx.x] = 0u;
    __syncthreads();
    const XcdBarrier xbar = xcd_barrier_post((unsigned*)(args.ws + WS_CTL) + CTL_BARW, xbst);

    int ph = ph_lo, rep = 0;
    while (ph < ph_hi) {
        KArgP ap0 = (KArgP)__builtin_amdgcn_kernarg_segment_ptr();
#define ARG(k) (ap->in[k])
#define TID_HERE() int lane; asm volatile("v_mbcnt_lo_u32_b32 %0, -1, 0\n\tv_mbcnt_hi_u32_b32 %0, -1, %0" : "=v"(lane)); const int tid = wave_s * 64 + lane; (void)tid
        const int wave = wave_s;
#define PHASE_ROOTS() \
        KArgP ap = ap0; asm volatile("" : "+s"(ap)); \
        int G = gridDim.x, bx = blockIdx.x; asm volatile("" : "+s"(G), "+s"(bx)); \
        const int vcu = (G % 8 == 0) ? (bx % 8) * (G / 8) + bx / 8 : bx; \
        const int gw = vcu * NWAVES + wave, NGW = G * NWAVES; (void)gw; (void)NGW; \
        unsigned char* ws = ap->ws; float* outp = ap->out; (void)outp; \
        const float* x_in = (const float*)ARG(I_X); (void)x_in; \
        float* adap = (float*)(ws + WS_ADAP); (void)adap; float* mod = (float*)(ws + WS_CTL + CTL_MOD); (void)mod; \
        float* cs_t = (float*)(ws + WS_COS); float* sn_t = (float*)(ws + WS_SIN); (void)cs_t; (void)sn_t; \
        bf16_t* Hb = (bf16_t*)(ws + WS_H); bf16_t* Zb = (bf16_t*)(ws + WS_Z); bf16_t* Y16 = (bf16_t*)(ws + WS_Y); (void)Hb; (void)Zb; (void)Y16; \
        bf16_t* QLN = (bf16_t*)(ws + WS_QLN); bf16_t* KVLN = (bf16_t*)(ws + WS_KVLN); bf16_t* CONVH = (bf16_t*)(ws + WS_CONVH); bf16_t* SGVT = (bf16_t*)(ws + WS_SGVT); (void)QLN; (void)KVLN; (void)CONVH; (void)SGVT; \
        bf16_t* Qb = (bf16_t*)(ws + WS_Q); unsigned char* KNb = ws + WS_KN; unsigned char* KRb = ws + WS_KR; unsigned char* VIb = ws + WS_V; (void)Qb; (void)KNb; (void)KRb; (void)VIb; \
        bf16_t* YCAT = (bf16_t*)(ws + WS_YCAT); (void)YCAT
        if (ph == 0 && PHEN(0)) {
            TID_HERE(); PHASE_ROOTS();
            LAS float* scr = (LAS float*)(lds + wave * 16384);
            for (int it = gw; it < NLAYER * 16 * 48; it += NGW) { const int l = it / 768, r = it % 768, kc = r / 48, nc = r % 48;
                const float* W = (const float*)ARG(I_WADA) + (size_t)l * DM * 3072 + (size_t)(kc * 64) * 3072 + nc * 64 + lane;
                const float* c = (const float*)ARG(I_C) + kc * 64;
                float a0 = 0.f, a1 = 0.f, a2 = 0.f, a3 = 0.f;
#pragma unroll 8
                for (int k = 0; k < 64; ++k) { const float w = W[(size_t)k * 3072];
                    a0 += siluf_(c[k]) * w; a1 += siluf_(c[DM + k]) * w; a2 += siluf_(c[2 * DM + k]) * w; a3 += siluf_(c[3 * DM + k]) * w; }
                float* dst = adap + ((size_t)(kc * 2 + l) * 4) * 3072 + nc * 64 + lane;
                __hip_atomic_store(dst, a0, __ATOMIC_RELAXED, __HIP_MEMORY_SCOPE_AGENT); __hip_atomic_store(dst + 3072, a1, __ATOMIC_RELAXED, __HIP_MEMORY_SCOPE_AGENT);
                __hip_atomic_store(dst + 2 * 3072, a2, __ATOMIC_RELAXED, __HIP_MEMORY_SCOPE_AGENT); __hip_atomic_store(dst + 3 * 3072, a3, __ATOMIC_RELAXED, __HIP_MEMORY_SCOPE_AGENT);
                asm volatile("s_waitcnt vmcnt(0)" ::: "memory");
                unsigned tk = 0;
                if (lane == 0) tk = __hip_atomic_fetch_add((unsigned*)(ws + WS_CTL) + CTL_ADACNT + (l * 48 + nc) * 16, 1u, __ATOMIC_RELAXED, __HIP_MEMORY_SCOPE_AGENT);
                tk = (unsigned)__builtin_amdgcn_readfirstlane((int)tk);
                if (tk == 15u) {
                    const float* bada = (const float*)ARG(I_BADA) + (size_t)l * 3072;
#pragma unroll
                    for (int b = 0; b < 4; ++b) { float s = 0.f;
#pragma unroll
                        for (int k2 = 0; k2 < 16; ++k2) s += __hip_atomic_load(adap + ((size_t)(k2 * 2 + l) * 4 + b) * 3072 + nc * 64 + lane, __ATOMIC_RELAXED, __HIP_MEMORY_SCOPE_AGENT);
                        mod[((size_t)l * 4 + b) * 3072 + nc * 64 + lane] = s + bada[nc * 64 + lane]; }
                } }
            {
                constexpr int I0 = 16 * 80, I1 = 16 * 32, I2 = 4 * 24, I3 = 2 * 32, I4 = 4 * 8, IL = I0 + I1 + I2 + I3 + I4;
                for (int it = gw; it < NLAYER * IL; it += NGW) {
                    const int l = it / IL; int r = it % IL;
                    if (r < I0) { transpose_item((const float*)ARG(I_WIN) + (size_t)l * DM * DIN, DIN, (bf16_t*)(ws + WS_WIN) + (size_t)l * DINP * DM, DM, 0, scr, r / 80, r % 80, lane); continue; } r -= I0;
                    if (r < I1) { transpose_item((const float*)ARG(I_WOUT) + (size_t)l * DM * DM, DM, (bf16_t*)(ws + WS_WOUT) + (size_t)l * DM * DM, DM, 1, scr, r / 32, r % 32, lane); continue; } r -= I1;
                    if (r < I2) { transpose_item((const float*)ARG(I_WUQ) + (size_t)l * QLR * 768, 768, (bf16_t*)(ws + WS_WUQ) + (size_t)l * 768 * 256, 256, 2, scr, r / 24, r % 24, lane); continue; } r -= I2;
                    if (r < I3) { transpose_item((const float*)ARG(I_WUKV) + (size_t)l * KVLR * 1024, 1024, (bf16_t*)(ws + WS_WUKV) + (size_t)l * 1024 * 128, 128, 3, scr, r / 32, r % 32, lane); continue; } r -= I3;
                    transpose_item((const float*)ARG(I_WPW2) + (size_t)l * CW * CW, CW, (bf16_t*)(ws + WS_WPW2) + (size_t)l * CW * CW, CW, 4, scr, r / 8, r % 8, lane);
                }
            }
            const int gt = vcu * NTHREADS + tid, NGT = G * NTHREADS;
            for (int i = gt; i < NLAYER * SG * SCH * SCH; i += NGT) { const int s = i & 127, t = (i >> 7) & 127;
                const float v = s <= t ? ((const float*)ARG(I_WS))[i] : 0.f; ((bf16_t*)(ws + WS_WSM))[i] = (bf16_t)(cvtpk(v, 0.f) & 0xffffu); }
            const float inv_freq = powf(10000.0f, -(float)(2 * (gt & 31)) / 64.0f);
            for (int i = gt; i < MTOK * 32; i += NGT) { const int tok = i >> 5;
                const float ang = (float)((const int*)ARG(I_POS))[tok] * inv_freq;
                cs_t[i] = cosf(ang); sn_t[i] = sinf(ang); }
        } else if (ph == 1 && PHEN(1)) {
            TID_HERE(); PHASE_ROOTS();
            const float* gp = (const float*)ARG(I_GPRE);
            for (int grp = gw; grp < MTOK / 4; grp += NGW) { const int m0 = grp * 4, b = m0 >> 13;
                f32x4 v[4][4];
#pragma unroll
                for (int k = 0; k < 4; ++k) { const f32x4* xr = (const f32x4*)(x_in + (size_t)(m0 + k) * DM) + lane;
#pragma unroll
                    for (int j = 0; j < 4; ++j) v[k][j] = __builtin_nontemporal_load(&xr[64 * j]); }
                f32x4 pa[4], pb[4];
#pragma unroll
                for (int j = 0; j < 4; ++j) { const int c = 4 * lane + 256 * j;
                    pb[j] = *(const f32x4*)(mod + (size_t)b * 3072 + c);
                    pa[j] = *(const f32x4*)(gp + c) * (*(const f32x4*)(mod + (size_t)b * 3072 + DM + c) + 1.f); }
#pragma unroll
                for (int k = 0; k < 4; ++k) { float ss = 0.f;
#pragma unroll
                    for (int j = 0; j < 4; ++j) ss += (v[k][j].x * v[k][j].x + v[k][j].y * v[k][j].y) + (v[k][j].z * v[k][j].z + v[k][j].w * v[k][j].w);
                    const float rstd = rsqrtf(wave_sum(ss) * (1.f / DM) + EPS);
                    u32x2* o8 = (u32x2*)(Hb + (size_t)(m0 + k) * DM) + lane;
#pragma unroll
                    for (int j = 0; j < 4; ++j) { const f32x4 hv = (v[k][j] * rstd) * pa[j] + pb[j];
                        u32x2 w; w.x = cvtpk(hv.x, hv.y); w.y = cvtpk(hv.z, hv.w); o8[64 * j] = w; } }
            }
        } else {
            const int l = (ph - 2) / 6, sub = (ph - 2) % 6;
            const int ngemm = (sub == 0 || sub == 4) ? 1 : (sub == 2 ? 3 : 0);
#pragma nounroll
            for (int gi_ = 0; gi_ < ngemm * (1 + ((PROBE_MASK >> 8) & 1)) && PHEN(2); ++gi_) {
                const int gi = gi_ % ngemm;
                TID_HERE(); PHASE_ROOTS();
                pg8::Gemm g; EpiAll E; int Nn, cc = bx;
                if (sub == 0) { g = pg8::Gemm{Hb, (const bf16_t*)(ws + WS_WIN) + (size_t)l * DINP * DM, MTOK, DINP, DM, DM, DM}; Nn = DINP; E = EpiAll{EM_Z1, DINP, Zb, cs_t, sn_t, ws, (const float*)ARG(I_QNG) + l * QLR, (const float*)ARG(I_KVNG) + l * KVLR, (LAS unsigned char*)lds, (const float*)ARG(I_SLNG) + l * SW, (const float*)ARG(I_SLNB) + l * SW}; }
                else if (sub == 4) { g = pg8::Gemm{YCAT, (const bf16_t*)(ws + WS_WOUT) + (size_t)l * DM * DM, MTOK, DM, DM, DM, DM}; Nn = DM; E = EpiAll{EM_Z, DM, Y16, nullptr, nullptr, nullptr, nullptr, nullptr, nullptr, nullptr, nullptr}; }
                else if (gi == 0) { g = pg8::Gemm{QLN, (const bf16_t*)(ws + WS_WUQ) + (size_t)l * 768 * 256, MTOK, 768, 256, 256, 256}; Nn = 768; E = EpiAll{EM_Q, 0, Qb, cs_t, sn_t, nullptr, nullptr, nullptr, nullptr, nullptr, nullptr}; }
                else if (gi == 1) { g = pg8::Gemm{CONVH, (const bf16_t*)(ws + WS_WPW2) + (size_t)l * CW * CW, MTOK, CW, CW, CW, CW}; Nn = CW; cc = (bx + G / 2) % G; E = EpiAll{EM_PW2, 0, YCAT, Zb, nullptr, nullptr, nullptr, nullptr, nullptr, nullptr, nullptr}; }
                else { g = pg8::Gemm{KVLN, (const bf16_t*)(ws + WS_WUKV) + (size_t)l * 1024 * 128, MTOK, 1024, 128, 128, 128}; Nn = 1024; E = EpiAll{EM_KV, 0, KNb, VIb, nullptr, nullptr, nullptr, nullptr, nullptr, nullptr, nullptr}; }
                pg8::StaticOrder S; S.init(MTOK, Nn, G, cc);
#if STAGGER_US > 0
                if (sub == 0 && (bx & 8)) { const unsigned long long t0_ = __builtin_amdgcn_s_memrealtime(); while (__builtin_amdgcn_s_memrealtime() - t0_ < (unsigned long long)(STAGGER_US * 100)) __builtin_amdgcn_s_sleep(8); }
#endif
                pg8::gemm_phase<EpiAll>((LAS unsigned char*)lds, g, S, E, tid);
            }
            if (sub == 0) {
            } else if (sub == 1 && PHEN(3)) {
                TID_HERE(); PHASE_ROOTS();
                const float* cw = (const float*)ARG(I_CONVW) + (size_t)l * CK * CW; const float* cb = (const float*)ARG(I_CONVB) + l * CW;
                const float* clg = (const float*)ARG(I_CLNG) + l * CW; const float* clb = (const float*)ARG(I_CLNB) + l * CW;
                LAS float* glu = (LAS float*)lds;
                LAS float* cvo = (LAS float*)(lds + 63488);
                LAS bf16_t* sgv = (LAS bf16_t*)(lds + 63488 + 32768);
                float cwv[CK];
#pragma unroll
                for (int j = 0; j < CK; ++j) cwv[j] = cw[j * CW + (tid & 255)];
                const float cbias = cb[tid & 255];
                const f32x4 clg4 = *(const f32x4*)(clg + 4 * lane), clb4 = *(const f32x4*)(clb + 4 * lane);
                u32x4 ga[4]; u32x2 zsv[4];
#define P2A_LOAD(tt_) do { const int b_ = (tt_) >> 8, s0_ = ((tt_) & 255) * 32; const size_t m0_ = (size_t)b_ * SEQ + s0_; \
                    _Pragma("unroll") for (int pass = 0; pass < 4; ++pass) { const int r = pass * 16 + (tid >> 5), c8 = (tid & 31) * 8; const int s = s0_ - 30 + r; \
                        ga[pass] = *(const u32x4*)(Zb + ((size_t)b_ * SEQ + (s >= 0 ? (r < 62 ? s : s0_) : 0)) * DINP + ZC_CA + c8); \
                        if (r >= 62 || s < 0) ga[pass] = (u32x4){0u, 0u, 0u, 0u}; } \
                    _Pragma("unroll") for (int i = 0; i < 4; ++i) { const size_t m = m0_ + 4 * wave + i; const bf16_t* zr = Zb + m * DINP; \
                        zsv[i] = *(const u32x2*)(zr + ZC_SV + 4 * lane); } } while (0)
                P2A_LOAD(vcu < MTOK / 32 ? vcu : 0);
                for (int tt = vcu; tt < MTOK / 32; tt += G) {
                    const int b = tt >> 8, s0 = (tt & 255) * 32; const size_t m0 = (size_t)b * SEQ + s0;
#pragma unroll
                    for (int pass = 0; pass < 4; ++pass) { const int r = pass * 16 + (tid >> 5), c8 = (tid & 31) * 8;
                        if (r < 62) { const u32x4 a = ga[pass];
                            *(LAS f32x4*)(glu + r * 256 + c8) = (f32x4){lo_bf(a.x), hi_bf(a.x), lo_bf(a.y), hi_bf(a.y)}; *(LAS f32x4*)(glu + r * 256 + c8 + 4) = (f32x4){lo_bf(a.z), hi_bf(a.z), lo_bf(a.w), hi_bf(a.w)}; } }
#pragma unroll
                    for (int i = 0; i < 4; ++i) { const int tl = 4 * wave + i; const size_t m = m0 + tl; const int s = s0 + tl;
                        *(LAS u32x2*)(sgv + tl * 256 + 4 * lane) = zsv[i];
                    }
                    __syncthreads();
                    { const int tn = tt + G; P2A_LOAD(tn < MTOK / 32 ? tn : tt); }
                    { const int c = tid & 255, half = tid >> 8;
                      for (int g4 = 0; g4 < 4; ++g4) { const int tb = 16 * half + 4 * g4; float v[34];
#pragma unroll
                          for (int k = 0; k < 34; ++k) v[k] = glu[(tb + k) * 256 + c];
#pragma unroll
                          for (int i = 0; i < 4; ++i) { float a = cbias;
#pragma unroll
                              for (int j = 0; j < CK; ++j) a += cwv[j] * v[i + j];
                              cvo[(tb + i) * 256 + c] = a; } } }
                    __syncthreads();
                    for (int i = 0; i < 4; ++i) { const int tl = 4 * wave + i; const size_t m = m0 + tl;
                        const f32x4 xv = *(const LAS f32x4*)(cvo + tl * 256 + 4 * lane);
                        const float mean = wave_sum((xv.x + xv.y) + (xv.z + xv.w)) * (1.f / CW);
                        const float d0 = xv.x - mean, d1 = xv.y - mean, d2 = xv.z - mean, d3 = xv.w - mean;
                        const float rstd = rsqrtf(wave_sum((d0 * d0 + d1 * d1) + (d2 * d2 + d3 * d3)) * (1.f / CW) + EPS);
                        const f32x4 g = clg4, bb = clb4;
                        u32x2 w; w.x = cvtpk(siluf_(d0 * rstd * g.x + bb.x), siluf_(d1 * rstd * g.y + bb.y)); w.y = cvtpk(siluf_(d2 * rstd * g.z + bb.z), siluf_(d3 * rstd * g.w + bb.w));
                        *(u32x2*)(CONVH + m * 256 + 4 * lane) = w; }
                    { const int c = tid & 255, half = tid >> 8; unsigned pk[8];
#pragma unroll
                      for (int k = 0; k < 8; ++k) { const unsigned lo = sgv[(16 * half + 2 * k) * 256 + c], hi2 = sgv[(16 * half + 2 * k + 1) * 256 + c]; pk[k] = lo | (hi2 << 16); }
                      bf16_t* dst = SGVT + ((size_t)(m0 >> 7) * 256 + c) * 128 + (s0 & 127) + 16 * half;
                      *(u32x4*)dst = (u32x4){pk[0], pk[1], pk[2], pk[3]}; *(u32x4*)(dst + 8) = (u32x4){pk[4], pk[5], pk[6], pk[7]}; }
                    __syncthreads();
                }
#undef P2A_LOAD
            } else if (sub == 2 && PHEN(4)) {
                TID_HERE(); PHASE_ROOTS();
                { const bf16_t* WsM = (const bf16_t*)(ws + WS_WSM) + (size_t)l * SG * SCH * SCH; const float* bs = (const float*)ARG(I_BS) + l * SG * SCH;
                  const int r32 = lane & 31, hi = lane >> 5, gq = wave >> 1, th = wave & 1;
                  constexpr int UP = 528;
                  LAS unsigned char* ub = (LAS unsigned char*)lds;
                  for (int ck_ = vcu; ck_ < (MTOK / SCH) * (1 + ((PROBE_MASK >> 9) & 1)); ck_ += G) { const int ck = ck_ % (MTOK / SCH);
                      const size_t mc = (size_t)ck * SCH;
                      const bf16_t* Wb = WsM + ((size_t)gq * SCH + 64 * th + r32) * SCH + 8 * hi;
                      const bf16_t* Vb = SGVT + ((size_t)ck * 256 + gq * 64 + r32) * SCH + 8 * hi;
                      bf16x8 wf[2][4], vf[2][4];
#pragma unroll
                      for (int ks = 0; ks < 4; ++ks) { wf[0][ks] = *(const bf16x8*)(Wb + 16 * ks); wf[1][ks] = *(const bf16x8*)(Wb + 32 * SCH + 16 * ks);
                                                       vf[0][ks] = *(const bf16x8*)(Vb + 16 * ks); vf[1][ks] = *(const bf16x8*)(Vb + 32 * SCH + 16 * ks); }
#pragma unroll
                      for (int p = 0; p < 8; ++p) { const int idx = p * NTHREADS + tid, t = idx >> 5, c8 = (idx & 31) * 8;
                          const u32x4 o = *(const u32x4*)(Zb + (mc + t) * DINP + ZC_SU + c8);
                          *(LAS u32x4*)(ub + t * UP + c8 * 2) = o; }
                      f32x16 acc[2][2];
#pragma unroll
                      for (int a = 0; a < 2; ++a)
#pragma unroll
                          for (int bq = 0; bq < 2; ++bq) acc[a][bq] = f32x16{};
#pragma unroll
                      for (int kh = 0; kh < 2; ++kh) {
#pragma unroll
                          for (int ks = 0; ks < 4; ++ks) {
                              acc[0][0] = __builtin_amdgcn_mfma_f32_32x32x16_bf16(vf[0][ks], wf[0][ks], acc[0][0], 0, 0, 0);
                              acc[0][1] = __builtin_amdgcn_mfma_f32_32x32x16_bf16(vf[0][ks], wf[1][ks], acc[0][1], 0, 0, 0);
                              acc[1][0] = __builtin_amdgcn_mfma_f32_32x32x16_bf16(vf[1][ks], wf[0][ks], acc[1][0], 0, 0, 0);
                              acc[1][1] = __builtin_amdgcn_mfma_f32_32x32x16_bf16(vf[1][ks], wf[1][ks], acc[1][1], 0, 0, 0);
                          }
                          if (kh == 0) {
#pragma unroll
                              for (int ks = 0; ks < 4; ++ks) { wf[0][ks] = *(const bf16x8*)(Wb + 64 + 16 * ks); wf[1][ks] = *(const bf16x8*)(Wb + 32 * SCH + 64 + 16 * ks);
                                                               vf[0][ks] = *(const bf16x8*)(Vb + 64 + 16 * ks); vf[1][ks] = *(const bf16x8*)(Vb + 32 * SCH + 64 + 16 * ks); }
                          }
                      }
                      __syncthreads();
#pragma unroll
                      for (int rb = 0; rb < 2; ++rb) { const int t = 64 * th + 32 * rb + r32; const float bt = bs[gq * SCH + t];
#pragma unroll
                          for (int cb = 0; cb < 2; ++cb)
#pragma unroll
                              for (int q4 = 0; q4 < 4; ++q4) { LAS u32x2* p = (LAS u32x2*)(ub + t * UP + (gq * 64 + 32 * cb + 8 * q4 + 4 * hi) * 2);
                                  const u32x2 up = *p; u32x2 w;
                                  w.x = cvtpk((acc[cb][rb][4 * q4 + 0] + bt) * lo_bf(up.x), (acc[cb][rb][4 * q4 + 1] + bt) * hi_bf(up.x));
                                  w.y = cvtpk((acc[cb][rb][4 * q4 + 2] + bt) * lo_bf(up.y), (acc[cb][rb][4 * q4 + 3] + bt) * hi_bf(up.y));
                                  *p = w; } }
                      __syncthreads();
#pragma unroll
                      for (int p = 0; p < 8; ++p) { const int idx = p * NTHREADS + tid, t = idx >> 5, c8 = (idx & 31) * 8;
                          *(u32x4*)(YCAT + (mc + t) * DM + 768 + c8) = *(const LAS u32x4*)(ub + t * UP + c8 * 2); }
                      __syncthreads();
                  } }
            } else if (sub == 3 && PHEN(5)) {
                TID_HERE(); PHASE_ROOTS();
                const int nun = (NB * NH * 32 + G - 1) / G;
#pragma nounroll
                for (int i = 0; i < nun; ++i) {
                    const int u_ = vcu + i * G;
                    int bh = u_ >> 5, qb = 31 - (u_ & 31);
                    if (G == 256) { bh = vcu >> 4; qb = (i == 0) ? 31 - (vcu & 15) : (vcu & 15); }
                    int tid_u = tid; asm volatile("" : "+v"(tid_u));
                    if (bh < NB * NH) att::attn_unit3<0>(bh >> 2, bh & 3, qb, Qb, KNb, KRb, VIb, Zb, YCAT, (char*)lds, tid_u);
                }
            } else if (sub == 5 && PHEN(7)) {
                TID_HERE(); PHASE_ROOTS();
                const float* xsrc = (l == 0) ? x_in : (const float*)outp;
                const float* gpost = (const float*)ARG(I_GPOST) + l * DM;
                const float* modl = mod + (size_t)l * 4 * 3072; const float* mod1 = mod + (size_t)4 * 3072; const float* gp1 = (const float*)ARG(I_GPRE) + DM;
                for (int grp = gw; grp < MTOK / 4; grp += NGW) { const int m0 = grp * 4, b = m0 >> 13;
                    u32x2 yv[4][4]; f32x4 xv[4][4];
#pragma unroll
                    for (int k = 0; k < 4; ++k) { const u32x2* yr = (const u32x2*)(Y16 + (size_t)(m0 + k) * DM) + lane; const f32x4* xr = (const f32x4*)(xsrc + (size_t)(m0 + k) * DM) + lane;
#pragma unroll
                        for (int j = 0; j < 4; ++j) { yv[k][j] = __builtin_nontemporal_load(&yr[64 * j]); xv[k][j] = __builtin_nontemporal_load(&xr[64 * j]); } }
                    f32x4 pg[4];
#pragma unroll
                    for (int j = 0; j < 4; ++j) { const int c = 4 * lane + 256 * j; pg[j] = *(const f32x4*)(modl + (size_t)b * 3072 + 2 * DM + c) * *(const f32x4*)(gpost + c); }
                    float rstd2[4];
#pragma unroll
                    for (int k = 0; k < 4; ++k) { float ss = 0.f; f32x4 y[4];
#pragma unroll
                        for (int j = 0; j < 4; ++j) { y[j] = (f32x4){lo_bf(yv[k][j].x), hi_bf(yv[k][j].x), lo_bf(yv[k][j].y), hi_bf(yv[k][j].y)};
                            ss += (y[j].x * y[j].x + y[j].y * y[j].y) + (y[j].z * y[j].z + y[j].w * y[j].w); }
                        const float rstd = rsqrtf(wave_sum(ss) * (1.f / DM) + EPS);
                        f32x4* orow = (f32x4*)(outp + (size_t)(m0 + k) * DM) + lane; float ss2 = 0.f;
#pragma unroll
                        for (int j = 0; j < 4; ++j) { xv[k][j] = xv[k][j] + (y[j] * rstd) * pg[j]; orow[64 * j] = xv[k][j];
                            ss2 += (xv[k][j].x * xv[k][j].x + xv[k][j].y * xv[k][j].y) + (xv[k][j].z * xv[k][j].z + xv[k][j].w * xv[k][j].w); }
                        rstd2[k] = rsqrtf(wave_sum(ss2) * (1.f / DM) + EPS); }
                    if (l == 0) {
                        f32x4 pa[4], pb[4];
#pragma unroll
                        for (int j = 0; j < 4; ++j) { const int c = 4 * lane + 256 * j;
                            pb[j] = *(const f32x4*)(mod1 + (size_t)b * 3072 + c);
                            pa[j] = *(const f32x4*)(gp1 + c) * (*(const f32x4*)(mod1 + (size_t)b * 3072 + DM + c) + 1.f); }
#pragma unroll
                        for (int k = 0; k < 4; ++k) { u32x2* o8 = (u32x2*)(Hb + (size_t)(m0 + k) * DM) + lane;
#pragma unroll
                            for (int j = 0; j < 4; ++j) { const f32x4 hv = (xv[k][j] * rstd2[k]) * pa[j] + pb[j];
                                u32x2 w; w.x = cvtpk(hv.x, hv.y); w.y = cvtpk(hv.z, hv.w); o8[64 * j] = w; } }
                    }
                }
            }
        }
        { bool again = false;
          if (rep == 0 && PROBE_MASK != 0) { if (ph == 0) again = (PROBE_MASK >> 7) & 1; else if (ph == 1) again = (PROBE_MASK >> 6) & 1; else if (ph >= 2) { const int sub_ = (ph - 2) % 6, l_ = (ph - 2) / 6; again = ((PROBE_MASK >> sub_) & 1) && !(sub_ == 5 && l_ == 1); } }
          if (again) rep = 1; else { rep = 0; ++ph; } }
        if (ph < ph_hi) { if (ph_lo < 0) grid.sync(); else xcd_barrier(xbar); }
    }
}

#ifndef APROBE
#define APROBE 0
#endif
#ifndef APROBE_AX
#define APROBE_AX 0
#endif
#ifndef APROBE_REP
#define APROBE_REP 2
#endif
#if APROBE
__global__ void __launch_bounds__(NTHREADS, 2) attn_probe(Args args) {
    extern __shared__ __attribute__((aligned(16))) unsigned char lds[];
    const int G = gridDim.x, bx = blockIdx.x; const int vcu = (bx % 8) * (G / 8) + bx / 8;
    unsigned char* ws = args.ws;
#pragma nounroll
    for (int i = 0; i < 2 * APROBE_REP; ++i) {
        const int bh = vcu >> 4, qb = ((i & 1) == 0) ? 31 - (vcu & 15) : (vcu & 15);
        int tid_u = threadIdx.x; asm volatile("" : "+v"(tid_u));
        att::attn_unit3<APROBE_AX>(bh >> 2, bh & 3, qb, (const bf16_t*)(ws + WS_Q), ws + WS_KN, ws + WS_KR, ws + WS_V, (const bf16_t*)(ws + WS_Z), (bf16_t*)(ws + WS_YCAT), (char*)lds, tid_u);
    }
}
#endif

extern "C" void kernel_launch(void* const* d_in, const int* in_sizes, int n_in, void* d_out, int out_size, void* d_ws, size_t ws_size, hipStream_t stream) {
    static int grid = 0;
    if (grid == 0) {
        if (n_in != 22 || in_sizes[0] != MTOK * DM || out_size != MTOK * DM || ws_size < WS_END) {
            fprintf(stderr, "kernel_launch: unexpected shapes (n_in %d, in0 %d, out %d, ws %zu); nothing launched\n", n_in, n_in > 0 ? in_sizes[0] : -1, out_size, ws_size); grid = -1; return; }
        int dev = 0, cus = 0, per_cu = 0;
        (void)hipGetDevice(&dev); (void)hipDeviceGetAttribute(&cus, hipDeviceAttributeMultiprocessorCount, dev);
        if (hipFuncSetAttribute((const void*)hymba_fwd, hipFuncAttributeMaxDynamicSharedMemorySize, LDS_BYTES) != hipSuccess) { fprintf(stderr, "kernel_launch: hipFuncSetAttribute failed\n"); grid = -1; return; }
        if (hipOccupancyMaxActiveBlocksPerMultiprocessor(&per_cu, (const void*)hymba_fwd, NTHREADS, LDS_BYTES) != hipSuccess || per_cu < 1) { fprintf(stderr, "kernel_launch: occupancy query says %d blocks per CU\n", per_cu); per_cu = 1; }
        (void)hipGetLastError();
        grid = cus > 0 ? cus : 256;
    }
    if (grid < 0) return;
    (void)hipMemsetAsync((char*)d_ws + WS_CTL, 0, CTL_BYTES, stream);
    Args a{};
    for (int i = 0; i < 22; ++i) a.in[i] = d_in[i];
    a.out = (float*)d_out; a.ws = (unsigned char*)d_ws;
#if MK_N_LAUNCHES == 1
    a.ph_lo = 0; a.ph_hi = N_PHASES;
    { void* kargs[] = {&a};
      hipError_t e = hipLaunchCooperativeKernel((const void*)hymba_fwd, dim3(grid), dim3(NTHREADS), kargs, LDS_BYTES, stream);
      if (e != hipSuccess) fprintf(stderr, "cooperative launch failed: %s (grid %d)\n", hipGetErrorString(e), grid); }
#if APROBE
    { (void)hipFuncSetAttribute((const void*)attn_probe, hipFuncAttributeMaxDynamicSharedMemorySize, LDS_BYTES);
      hipLaunchKernelGGL(attn_probe, dim3(256), dim3(NTHREADS), LDS_BYTES, stream, a); }
#endif
#else
    for (int ph = 0; ph < N_PHASES; ++ph) { a.ph_lo = ph; a.ph_hi = ph + 1; void* kargs[] = {&a};
        hipError_t e = hipLaunchCooperativeKernel((const void*)hymba_fwd, dim3(grid), dim3(NTHREADS), kargs, LDS_BYTES, stream);
        if (e != hipSuccess) { fprintf(stderr, "launch %d failed: %s (grid %d)\n", ph, hipGetErrorString(e), grid); break; } }
#endif
}
```

```cpp
#include <hip/hip_runtime.h>
#include <hip/hip_cooperative_groups.h>
#include <cstdio>
#include <cstdint>
namespace cg = cooperative_groups;

#ifndef MK_N_LAUNCHES
#define MK_N_LAUNCHES 1
#endif

#define LAS __attribute__((address_space(3)))
#ifndef ATT_EXP_TOP
#define ATT_EXP_TOP 0
#endif
#ifndef STAGGER_US
#define STAGGER_US 0
#endif
#ifndef PROBE_MASK
#define PROBE_MASK 0
#endif
#ifndef PHMASK
#define PHMASK 0xff
#endif
#define PHEN(k) (((PHMASK) >> (k)) & 1)
typedef unsigned short bf16_t;
typedef short bf16x8 __attribute__((ext_vector_type(8)));
typedef short s16x4 __attribute__((ext_vector_type(4)));
typedef float f32x2 __attribute__((ext_vector_type(2)));
typedef float f32x4 __attribute__((ext_vector_type(4)));
typedef float f32x16 __attribute__((ext_vector_type(16)));
typedef unsigned u32x2 __attribute__((ext_vector_type(2)));
typedef unsigned u32x4 __attribute__((ext_vector_type(4)));

constexpr int DM = 1024, NB = 4, SEQ = 8192, MTOK = NB * SEQ, NLAYER = 2;
constexpr int NH = 4, DNOPE = 128, DROPE = 64, DQK = 192, DV = 128;
constexpr int QLR = 256, KVLR = 128, DIN = 2496, DINP = 2560;
constexpr int CW = 256, CK = 31, SW = 256, SG = 4, SCH = 128;
constexpr float EPS = 1e-6f;
constexpr int ZC_Q = 0, ZC_KV = 256, ZC_KR = 384, ZC_GATT = 512, ZC_CA = 1024, ZC_CB = 1280, ZC_GC = 1536, ZC_SU = 1792, ZC_SV = 2048, ZC_GS = 2304;
constexpr float QSCALE = 0.07216878364870323f * 1.4426950408889634f;

constexpr size_t MiB = 1u << 20;
constexpr size_t WS_CTL = 0, CTL_BYTES = 1 * MiB;
constexpr size_t CTL_BARW = 1024;
constexpr size_t CTL_ADACNT = 8192;
constexpr size_t CTL_MOD = 65536;
constexpr size_t WS_COS = 1 * MiB, WS_SIN = 5 * MiB;
constexpr size_t WS_WIN = 9 * MiB;
constexpr size_t WS_WOUT = 19 * MiB;
constexpr size_t WS_WUQ = 23 * MiB;
constexpr size_t WS_WUKV = 24 * MiB;
constexpr size_t WS_WPW2 = 25 * MiB;
constexpr size_t WS_WSM = 26 * MiB;
constexpr size_t WS_ADAP = 27 * MiB;
constexpr size_t WS_H = 32 * MiB;
constexpr size_t WS_Z = 96 * MiB;
constexpr size_t WS_Y = WS_Z;
constexpr size_t WS_QLN = 256 * MiB;
constexpr size_t WS_KVLN = 272 * MiB;
constexpr size_t WS_CONVH = 288 * MiB;
constexpr size_t WS_SGVT = 304 * MiB;
constexpr size_t WS_Q = 320 * MiB;
constexpr size_t WS_KN = 368 * MiB;
constexpr size_t WS_KR = 400 * MiB;
constexpr size_t WS_V = 408 * MiB;
constexpr size_t WS_YCAT = 440 * MiB;
constexpr size_t WS_END = 504 * MiB;

constexpr int LDS_BYTES = 147456;
constexpr int NTHREADS = 512, NWAVES = 8;

__device__ __forceinline__ float bf2f(unsigned short u) { return __uint_as_float(((unsigned)u) << 16); }
__device__ __forceinline__ unsigned cvtpk(float lo, float hi) { unsigned r; asm("v_cvt_pk_bf16_f32 %0, %1, %2" : "=v"(r) : "v"(lo), "v"(hi)); return r; }
__device__ __forceinline__ float lo_bf(unsigned w) { return __uint_as_float(w << 16); }
__device__ __forceinline__ float hi_bf(unsigned w) { return __uint_as_float(w & 0xffff0000u); }
#define dpp_f(v, ctrl) __int_as_float(__builtin_amdgcn_update_dpp(0, __float_as_int(v), (ctrl), 0xf, 0xf, true))
#define DPP_XOR1 0xB1
#define DPP_XOR2 0x4E
#define DPP_HMIRROR 0x141
#define DPP_MIRROR 0x140
__device__ __forceinline__ float xor1_f(float v) { return dpp_f(v, DPP_XOR1); }
__device__ __forceinline__ float wave_sum(float v) {
    v += dpp_f(v, DPP_XOR1); v += dpp_f(v, DPP_XOR2); v += dpp_f(v, DPP_HMIRROR); v += dpp_f(v, DPP_MIRROR);
    const int iv = __float_as_int(v);
    return (__int_as_float(__builtin_amdgcn_readlane(iv, 0)) + __int_as_float(__builtin_amdgcn_readlane(iv, 16))) +
           (__int_as_float(__builtin_amdgcn_readlane(iv, 32)) + __int_as_float(__builtin_amdgcn_readlane(iv, 48)));
}
__device__ __forceinline__ float sigmoidf_(float x) { return __builtin_amdgcn_rcpf(1.f + __builtin_amdgcn_exp2f(-1.4426950408889634f * x)); }
__device__ __forceinline__ float siluf_(float x) { return x * __builtin_amdgcn_rcpf(1.f + __builtin_amdgcn_exp2f(-1.4426950408889634f * x)); }
__device__ __forceinline__ float geluf_(float v) {
    const float av = __builtin_fabsf(v), t = __builtin_amdgcn_rcpf(av * 0.2316418882f + 1.0f);
    float q = t * 0.5307027145f + (-0.7265760135f); q = q * t + 0.7107068705f; q = q * t + (-0.142248368f); q = q * t + 0.127414796f; q = q * t;
    const float e = __builtin_amdgcn_exp2f((v * v) * (-0.72134752044f));
    const float m = v * (q * e);
    return v < 0.f ? m : v - m;
}

namespace pg8 {
constexpr int BM = 256, BK = 64, HALF = 128, HTB = HALF * BK * 2, STAGE_BYTES = 8 * HTB, NXCD = 8, WGM = 8;
__host__ __device__ __forceinline__ int lds_byte(int r, int c) { const int st = (r >> 4) * 2 + (c >> 5), rr = r & 15, cc = c & 31, ob = rr * 64 + cc * 2; return st * 1024 + (ob ^ (((ob >> 9) & 1) << 5)); }
__host__ __device__ __forceinline__ void stage_rc(int b, int& R, int& C) { const int st = b / 1024, sb = b % 1024, swz = sb ^ (((sb >> 9) & 1) << 5); R = (st >> 1) * 16 + swz / 64; C = (st & 1) * 32 + (swz % 64) / 2; }
__host__ __device__ __forceinline__ int perm32(int rho) { const int n = rho >> 4, i = rho & 15; return 8 * (i >> 2) + 4 * n + (i & 3); }

struct Unit { int pm, pn; };
struct Gemm { const bf16_t* A; const bf16_t* Bt; int M, N, K, lda, ldb; };

struct StaticOrder {
    int nM, nN, nwg, G, c;
    __host__ __device__ void init(int M, int N, int G_, int c_) { nM = M / BM; nN = N / BM; nwg = nM * nN; G = G_; c = c_; }
    __host__ __device__ bool next(int i, Unit& u) const {
        const long L = (long)i * G + c; if (L >= nwg) return false;
        int wgid = (int)L; { const int q = nwg / NXCD, r = nwg % NXCD, xcd = wgid % NXCD, off = wgid / NXCD; wgid = (xcd < r ? xcd * (q + 1) : r * (q + 1) + (xcd - r) * q) + off; }
        const int nig = WGM * nN, gid = wgid / nig, fm = gid * WGM, gsz = (nM - fm) < WGM ? (nM - fm) : WGM;
        u.pm = fm + ((wgid % nig) % gsz); u.pn = (wgid % nig) / gsz; return true;
    }
};

template <class Epi>
__device__ __forceinline__ void gemm_phase(LAS unsigned char* lds, const Gemm g, const StaticOrder& S, const Epi& E, const int tid) {
    const int wid = __builtin_amdgcn_readfirstlane(tid >> 6), lane = tid & 63, wr = wid >> 2, wc = wid & 3, fr = lane & 15, fq = lane >> 4;
    const int K = g.K, nt = K / BK;
    unsigned voffA[2], voffB[2];
#pragma unroll
    for (int i = 0; i < 2; ++i) { int R, C; stage_rc(tid * 16 + i * 8192, R, C); const int Rb = Epi::PERM ? ((R & ~31) + perm32(R & 31)) : R;
        voffA[i] = (unsigned)(R * g.lda + C) * 2u; voffB[i] = (unsigned)(Rb * g.ldb + C) * 2u; }
    const size_t kstep = (size_t)(BK * 2);
    const size_t hstepA = (size_t)HALF * g.lda * 2, hstepB = (size_t)HALF * g.ldb * 2;
    const size_t tstepA = 2 * hstepA, tstepB = 2 * hstepB;
    const unsigned ldsw = (unsigned)wid * 1024u;
    const int aoff = lds_byte(wr * 64 + fr, fq * 8), boff = lds_byte(wc * 32 + fr, fq * 8);
#define PG8_SA(b, h) (((b) * 2 + (h)) * HTB)
#define PG8_SB(b, h) ((4 + (b) * 2 + (h)) * HTB)
#define PG8_STAGE(bufoff, gbase, voff) do { _Pragma("unroll") for (int _i = 0; _i < 2; ++_i) \
        __builtin_amdgcn_global_load_lds((const unsigned*)((const char*)(gbase) + (voff)[_i]), (LAS unsigned*)(lds + (bufoff) + ldsw + _i * 8192), 16, 0, 0); } while (0)
#define PG8_LDA(dst, b, h) do { _Pragma("unroll") for (int m = 0; m < 4; ++m) _Pragma("unroll") for (int k = 0; k < 2; ++k) dst[m][k] = *(const LAS bf16x8*)(lds + PG8_SA(b, h) + aoff + m * 2048 + k * 1024); } while (0)
#define PG8_LDB(dst, b, h) do { _Pragma("unroll") for (int n = 0; n < 2; ++n) _Pragma("unroll") for (int k = 0; k < 2; ++k) dst[n][k] = *(const LAS bf16x8*)(lds + PG8_SB(b, h) + boff + n * 2048 + k * 1024); } while (0)
#define PG8_MMA(ai, bj, At, Bt) do { __builtin_amdgcn_s_setprio(1); _Pragma("unroll") for (int m = 0; m < 4; ++m) _Pragma("unroll") for (int n = 0; n < 2; ++n) _Pragma("unroll") for (int k = 0; k < 2; ++k) \
        acc[ai][bj][m][n] = __builtin_amdgcn_mfma_f32_16x16x32_bf16(Bt[n][k], At[m][k], acc[ai][bj][m][n], 0, 0, 0); __builtin_amdgcn_s_setprio(0); } while (0)
#define PG8_WAIT_V(n) asm volatile("s_waitcnt vmcnt(" #n ")" ::: "memory")
#define PG8_WAIT_L(n) asm volatile("s_waitcnt lgkmcnt(" #n ")" ::: "memory")
#define PG8_BAR __builtin_amdgcn_s_barrier()
#define PG8_SCHED __builtin_amdgcn_sched_barrier(0)
    Unit cur, nxt; int ui = 0;
    if (!S.next(0, cur)) return;
    f32x4 acc[2][2][4][2];
#pragma unroll
    for (int a = 0; a < 2; ++a)
#pragma unroll
        for (int b = 0; b < 2; ++b)
#pragma unroll
            for (int m = 0; m < 4; ++m)
#pragma unroll
                for (int n = 0; n < 2; ++n) acc[a][b][m][n] = (f32x4){0.f, 0.f, 0.f, 0.f};
    bf16x8 At[4][2], B0[2][2], B1[2][2];
    const char* cA = (const char*)g.A + (size_t)cur.pm * tstepA; const char* cB = (const char*)g.Bt + (size_t)cur.pn * tstepB;
    PG8_STAGE(PG8_SB(0, 0), cB, voffB); PG8_STAGE(PG8_SB(0, 1), cB + hstepB, voffB); PG8_STAGE(PG8_SA(0, 0), cA, voffA); PG8_STAGE(PG8_SA(0, 1), cA + hstepA, voffA);
    if (wr == 1) PG8_BAR;
    PG8_WAIT_V(2); PG8_BAR;
    PG8_STAGE(PG8_SB(1, 0), cB + kstep, voffB); PG8_STAGE(PG8_SA(1, 0), cA + kstep, voffA); PG8_STAGE(PG8_SB(1, 1), cB + hstepB + kstep, voffB);
    PG8_WAIT_V(6); PG8_BAR;
    for (;;) {
        const bool has_next = S.next(ui + 1, nxt);
        const char* nA = has_next ? (const char*)g.A + (size_t)nxt.pm * tstepA : cA; const char* nB = has_next ? (const char*)g.Bt + (size_t)nxt.pn * tstepB : cB;
        for (int t = 0; t < nt; t += 2) {
            const bool last = (t == nt - 2);
            const char* a1 = cA + (size_t)(t + 1) * kstep;
            const char* a2 = last ? nA : cA + (size_t)(t + 2) * kstep; const char* b2 = last ? nB : cB + (size_t)(t + 2) * kstep;
            const char* a3 = a2 + kstep; const char* b3 = b2 + kstep;
            PG8_LDB(B0, 0, 0); PG8_LDB(B1, 0, 1); PG8_SCHED; PG8_LDA(At, 0, 0); PG8_STAGE(PG8_SA(1, 1), a1 + hstepA, voffA);
            PG8_WAIT_V(8); PG8_WAIT_L(0); PG8_BAR; PG8_MMA(0, 0, At, B0); PG8_MMA(0, 1, At, B1); PG8_BAR; PG8_SCHED;
            PG8_LDA(At, 0, 1); PG8_STAGE(PG8_SB(0, 0), b2, voffB); PG8_STAGE(PG8_SB(0, 1), b2 + hstepB, voffB); PG8_STAGE(PG8_SA(0, 0), a2, voffA);
            PG8_WAIT_V(8); PG8_WAIT_L(0); PG8_BAR; PG8_MMA(1, 0, At, B0); PG8_MMA(1, 1, At, B1); PG8_BAR; PG8_SCHED;
            PG8_LDB(B0, 1, 0); PG8_LDB(B1, 1, 1); PG8_SCHED; PG8_LDA(At, 1, 0); PG8_STAGE(PG8_SA(0, 1), a2 + hstepA, voffA);
            PG8_WAIT_V(8); PG8_WAIT_L(0); PG8_BAR; PG8_MMA(0, 0, At, B0); PG8_MMA(0, 1, At, B1); PG8_BAR; PG8_SCHED;
            PG8_LDA(At, 1, 1); PG8_STAGE(PG8_SB(1, 0), b3, voffB); PG8_STAGE(PG8_SB(1, 1), b3 + hstepB, voffB); PG8_STAGE(PG8_SA(1, 0), a3, voffA);
            PG8_WAIT_V(8); PG8_WAIT_L(0); PG8_BAR; PG8_MMA(1, 0, At, B0); PG8_MMA(1, 1, At, B1); PG8_BAR; PG8_SCHED;
        }
        if (wr == 0) PG8_BAR;
        { Unit uu = cur; asm volatile("" : "+s"(uu.pm), "+s"(uu.pn)); int t2 = tid; asm volatile("" : "+v"(t2));
          E(acc, uu, wr, wc, t2 & 15, (t2 & 63) >> 4); }
        if (!has_next) break;
#pragma unroll
        for (int a = 0; a < 2; ++a)
#pragma unroll
            for (int b = 0; b < 2; ++b)
#pragma unroll
                for (int m = 0; m < 4; ++m)
#pragma unroll
                    for (int n = 0; n < 2; ++n) acc[a][b][m][n] = (f32x4){0.f, 0.f, 0.f, 0.f};
        cur = nxt; cA = nA; cB = nB; ++ui;
        if (wr == 1) PG8_BAR;
    }
    PG8_WAIT_V(0);
    PG8_BAR;
#undef PG8_SA
#undef PG8_SB
#undef PG8_STAGE
#undef PG8_LDA
#undef PG8_LDB
#undef PG8_MMA
#undef PG8_WAIT_V
#undef PG8_WAIT_L
#undef PG8_BAR
#undef PG8_SCHED
}
}

__host__ __device__ __forceinline__ int v_st(int k, int c) { const int kk = (k & ~0xC) | ((k & 4) << 1) | ((k & 8) >> 1); return ((kk >> 3) * 4 + (c >> 5)) * 512 + ((kk & 7) * 32 + (c & 31)) * 2; }
__device__ __forceinline__ int v_rd_base(int lane) { return ((lane & 3) << 3) | (((lane >> 2) & 3) << 6) | (((lane >> 4) & 1) << 5) | (((lane >> 5) & 1) << 8); }
constexpr int v_rd_off(int d0, int ks, int half) { return d0 * 512 + ks * 4096 + half * 2048; }
__device__ __forceinline__ int crow(int r, int hi) { return (r & 3) + 8 * (r >> 2) + 4 * hi; }

enum { EM_Z = 0, EM_F32 = 1, EM_Q = 2, EM_KV = 3, EM_PW2 = 4, EM_Z1 = 5 };
struct EpiAll {
    static constexpr bool PERM = true;
    int mode; int ldc; void* p0; const void* p1; const void* p2;
    unsigned char* wsb; const float* qng; const float* kvng; LAS unsigned char* ldsp; const float* slg; const float* slb;
    __device__ __forceinline__ void operator()(const f32x4 (&acc)[2][2][4][2], const pg8::Unit& u, int wr, int wc, int fr, int fq) const {
        const int row0 = u.pm * 256 + wr * 64 + fr, col0 = u.pn * 256 + wc * 32 + 8 * fq;
        if (mode == EM_Z) {
            bf16_t* O = (bf16_t*)p0;
#pragma unroll
            for (int ai = 0; ai < 2; ++ai)
#pragma unroll
                for (int m = 0; m < 4; ++m) { bf16_t* rowp = O + (size_t)(row0 + ai * 128 + m * 16) * ldc + col0;
#pragma unroll
                    for (int bj = 0; bj < 2; ++bj) { const f32x4 v0 = acc[ai][bj][m][0], v1 = acc[ai][bj][m][1];
                        u32x4 w; w.x = cvtpk(v0[0], v0[1]); w.y = cvtpk(v0[2], v0[3]); w.z = cvtpk(v1[0], v1[1]); w.w = cvtpk(v1[2], v1[3]);
                        *(u32x4*)(rowp + bj * 128) = w; } }
        } else if (mode == EM_Z1) {
            bf16_t* O = (bf16_t*)p0; const int pn = u.pn;
            if (pn < 2) {
                LAS float* P = (LAS float*)(ldsp + 131072);
                const int nb = (pn == 0) ? 2 : 1;
#pragma unroll
                for (int ai = 0; ai < 2; ++ai)
#pragma unroll
                    for (int m = 0; m < 4; ++m) { float s = 0.f;
#pragma unroll
                        for (int bj = 0; bj < 2; ++bj) if (bj < nb) {
#pragma unroll
                            for (int n = 0; n < 2; ++n) { const f32x4 v = acc[ai][bj][m][n]; s += (v[0] * v[0] + v[1] * v[1]) + (v[2] * v[2] + v[3] * v[3]); } }
                        { auto r_ = __builtin_amdgcn_permlane32_swap(__float_as_uint(s), __float_as_uint(s), false, false); s = __uint_as_float(r_[0]) + __uint_as_float(r_[1]); }
                        { auto r_ = __builtin_amdgcn_permlane16_swap(__float_as_uint(s), __float_as_uint(s), false, false); s = __uint_as_float(r_[0]) + __uint_as_float(r_[1]); }
                        if (fq == 0) P[(ai * 128 + wr * 64 + m * 16 + fr) * 4 + wc] = s; }
                asm volatile("s_waitcnt lgkmcnt(0)" ::: "memory"); __builtin_amdgcn_s_barrier(); asm volatile("" ::: "memory");
                const int c8 = wc * 32 + 8 * fq;
                const float* gn = (pn == 0) ? qng : kvng;
                f32x4 g00 = *(const f32x4*)(gn + c8), g01 = *(const f32x4*)(gn + c8 + 4), g10 = g00, g11 = g01;
                if (pn == 0) { g10 = *(const f32x4*)(gn + 128 + c8); g11 = *(const f32x4*)(gn + 128 + c8 + 4); }
                bf16_t* QLNp = (bf16_t*)(wsb + WS_QLN); bf16_t* KVLNp = (bf16_t*)(wsb + WS_KVLN); unsigned char* KRp = wsb + WS_KR;
                const float* cs = (const float*)p1; const float* sn = (const float*)p2;
                const float inv_n = (pn == 0) ? (1.f / QLR) : (1.f / KVLR);
#pragma unroll
                for (int ai = 0; ai < 2; ++ai)
#pragma unroll
                    for (int m = 0; m < 4; ++m) { const int rl_ = ai * 128 + wr * 64 + m * 16 + fr; const int tok = u.pm * 256 + rl_;
                        const f32x4 pp = *(const LAS f32x4*)(P + rl_ * 4);
                        const float rstd = rsqrtf(((pp[0] + pp[1]) + (pp[2] + pp[3])) * inv_n + EPS);
                        { const f32x4 v0 = acc[ai][0][m][0] * rstd * g00, v1 = acc[ai][0][m][1] * rstd * g01;
                          u32x4 w; w.x = cvtpk(v0[0], v0[1]); w.y = cvtpk(v0[2], v0[3]); w.z = cvtpk(v1[0], v1[1]); w.w = cvtpk(v1[2], v1[3]);
                          if (pn == 0) *(u32x4*)(QLNp + (size_t)tok * QLR + c8) = w; else *(u32x4*)(KVLNp + (size_t)tok * KVLR + c8) = w; }
                        if (pn == 0) { const f32x4 v0 = acc[ai][1][m][0] * rstd * g10, v1 = acc[ai][1][m][1] * rstd * g11;
                          u32x4 w; w.x = cvtpk(v0[0], v0[1]); w.y = cvtpk(v0[2], v0[3]); w.z = cvtpk(v1[0], v1[1]); w.w = cvtpk(v1[2], v1[3]);
                          *(u32x4*)(QLNp + (size_t)tok * QLR + 128 + c8) = w; }
                        else if (wc < 2) { const f32x4 v0 = acc[ai][1][m][0], v1 = acc[ai][1][m][1]; const int i0 = 16 * wc + 4 * fq; const int b = tok >> 13, s_ = tok & 8191;
                          const f32x4 c4 = *(const f32x4*)(cs + (size_t)tok * 32 + i0), s4 = *(const f32x4*)(sn + (size_t)tok * 32 + i0);
                          u32x4 w; w.x = cvtpk(v0[0] * c4[0] - v0[1] * s4[0], v0[1] * c4[0] + v0[0] * s4[0]); w.y = cvtpk(v0[2] * c4[1] - v0[3] * s4[1], v0[3] * c4[1] + v0[2] * s4[1]);
                          w.z = cvtpk(v1[0] * c4[2] - v1[1] * s4[2], v1[1] * c4[2] + v1[0] * s4[2]); w.w = cvtpk(v1[2] * c4[3] - v1[3] * s4[3], v1[3] * c4[3] + v1[2] * s4[3]);
                          *(u32x4*)(KRp + ((size_t)(b * (SEQ / 64) + (s_ >> 6))) * 8192 + (4 * wc + fq) * 1024 + (s_ & 63) * 16) = w; } }
                return;
            }
            if (pn == 8) {
                typedef float f32x2l __attribute__((ext_vector_type(2)));
                LAS f32x2l* P2 = (LAS f32x2l*)(ldsp + 131072);
#pragma unroll
                for (int ai = 0; ai < 2; ++ai)
#pragma unroll
                    for (int m = 0; m < 4; ++m) { float s = 0.f, q = 0.f;
#pragma unroll
                        for (int bj = 0; bj < 2; ++bj)
#pragma unroll
                            for (int n = 0; n < 2; ++n) { const f32x4 v = acc[ai][bj][m][n];
#pragma unroll
                                for (int e = 0; e < 4; ++e) { const float x = geluf_(v[e]); s += x; q += x * x; } }
                        { auto r_ = __builtin_amdgcn_permlane32_swap(__float_as_uint(s), __float_as_uint(s), false, false); s = __uint_as_float(r_[0]) + __uint_as_float(r_[1]); }
                        { auto r_ = __builtin_amdgcn_permlane16_swap(__float_as_uint(s), __float_as_uint(s), false, false); s = __uint_as_float(r_[0]) + __uint_as_float(r_[1]); }
                        { auto r_ = __builtin_amdgcn_permlane32_swap(__float_as_uint(q), __float_as_uint(q), false, false); q = __uint_as_float(r_[0]) + __uint_as_float(r_[1]); }
                        { auto r_ = __builtin_amdgcn_permlane16_swap(__float_as_uint(q), __float_as_uint(q), false, false); q = __uint_as_float(r_[0]) + __uint_as_float(r_[1]); }
                        if (fq == 0) P2[(ai * 128 + wr * 64 + m * 16 + fr) * 4 + wc] = (f32x2l){s, q};
                        __builtin_amdgcn_sched_barrier(0); }
                asm volatile("s_waitcnt lgkmcnt(0)" ::: "memory"); __builtin_amdgcn_s_barrier(); asm volatile("" ::: "memory");
                const int c8 = wc * 32 + 8 * fq;
                f32x4 gg[2][2], bb[2][2];
#pragma unroll
                for (int bj = 0; bj < 2; ++bj)
#pragma unroll
                    for (int n = 0; n < 2; ++n) { gg[bj][n] = *(const f32x4*)(slg + bj * 128 + c8 + 4 * n); bb[bj][n] = *(const f32x4*)(slb + bj * 128 + c8 + 4 * n); }
#pragma unroll
                for (int ai = 0; ai < 2; ++ai)
#pragma unroll
                    for (int m = 0; m < 4; ++m) { const int rl_ = ai * 128 + wr * 64 + m * 16 + fr;
                        const f32x4 pa_ = *(const LAS f32x4*)(P2 + rl_ * 4), pb_ = *(const LAS f32x4*)(P2 + rl_ * 4 + 2);
                        const float mean = ((pa_[0] + pa_[2]) + (pb_[0] + pb_[2])) * (1.f / SW);
                        const float var = ((pa_[1] + pa_[3]) + (pb_[1] + pb_[3])) * (1.f / SW) - mean * mean;
                        const float rstd = rsqrtf(fmaxf(var, 0.f) + EPS);
                        bf16_t* rowb = O + (size_t)(row0 + ai * 128 + m * 16) * ldc + col0;
#pragma unroll
                        for (int bj = 0; bj < 2; ++bj) { f32x4 x0 = acc[ai][bj][m][0], x1 = acc[ai][bj][m][1];
#pragma unroll
                            for (int e = 0; e < 4; ++e) { asm volatile("" : "+v"(x0[e]), "+v"(x1[e])); x0[e] = geluf_(x0[e]); x1[e] = geluf_(x1[e]); }
                            const f32x4 v0 = (x0 - mean) * rstd * gg[bj][0] + bb[bj][0], v1 = (x1 - mean) * rstd * gg[bj][1] + bb[bj][1];
                            u32x4 w; w.x = cvtpk(v0[0], v0[1]); w.y = cvtpk(v0[2], v0[3]); w.z = cvtpk(v1[0], v1[1]); w.w = cvtpk(v1[2], v1[3]);
                            __builtin_nontemporal_store(w, (u32x4*)(rowb + bj * 128)); }
                        __builtin_amdgcn_sched_barrier(0); }
                return;
            }
            const bool paired = (pn == 4) | (pn == 5) | (pn == 7) | (pn == 9), gate = (pn == 2) | (pn == 3) | (pn == 6);
            const int pcol = (pn == 4 ? 1024 : pn == 5 ? 1152 : pn == 7 ? 1792 : 1920) + wc * 32 + 8 * fq;
#pragma unroll
            for (int ai = 0; ai < 2; ++ai)
#pragma unroll
                for (int m = 0; m < 4; ++m) { bf16_t* rowb = O + (size_t)(row0 + ai * 128 + m * 16) * ldc;
                    if (paired) { const f32x4 a0 = acc[ai][0][m][0], a1 = acc[ai][0][m][1], b0 = acc[ai][1][m][0], b1 = acc[ai][1][m][1]; f32x4 r0, r1;
                        if (pn < 6) {
#pragma unroll
                            for (int e = 0; e < 4; ++e) { r0[e] = a0[e] * sigmoidf_(b0[e]); r1[e] = a1[e] * sigmoidf_(b1[e]); } }
                        else {
#pragma unroll
                            for (int e = 0; e < 4; ++e) { r0[e] = geluf_(a0[e]) * siluf_(b0[e]); r1[e] = geluf_(a1[e]) * siluf_(b1[e]); } }
                        u32x4 w; w.x = cvtpk(r0[0], r0[1]); w.y = cvtpk(r0[2], r0[3]); w.z = cvtpk(r1[0], r1[1]); w.w = cvtpk(r1[2], r1[3]);
                        __builtin_nontemporal_store(w, (u32x4*)(rowb + pcol)); }
                    else {
#pragma unroll
                        for (int bj = 0; bj < 2; ++bj) { f32x4 v0 = acc[ai][bj][m][0], v1 = acc[ai][bj][m][1];
                            if (gate) {
#pragma unroll
                                for (int e = 0; e < 4; ++e) { v0[e] = siluf_(v0[e]); v1[e] = siluf_(v1[e]); } }
                            u32x4 w; w.x = cvtpk(v0[0], v0[1]); w.y = cvtpk(v0[2], v0[3]); w.z = cvtpk(v1[0], v1[1]); w.w = cvtpk(v1[2], v1[3]);
                            __builtin_nontemporal_store(w, (u32x4*)(rowb + col0 + bj * 128)); } } }
        } else if (mode == EM_F32) {
            float* C = (float*)p0;
#pragma unroll
            for (int ai = 0; ai < 2; ++ai)
#pragma unroll
                for (int m = 0; m < 4; ++m) { float* rowp = C + (size_t)(row0 + ai * 128 + m * 16) * ldc + col0;
#pragma unroll
                    for (int bj = 0; bj < 2; ++bj)
#pragma unroll
                        for (int n = 0; n < 2; ++n) *(f32x4*)(rowp + bj * 128 + n * 4) = acc[ai][bj][m][n]; }
        } else if (mode == EM_Q) {
            bf16_t* Q = (bf16_t*)p0; const float* cs = (const float*)p1; const float* sn = (const float*)p2;
#pragma unroll
            for (int ai = 0; ai < 2; ++ai)
#pragma unroll
                for (int m = 0; m < 4; ++m) { const int tok = row0 + ai * 128 + m * 16, b = tok >> 13, s = tok & 8191;
#pragma unroll
                    for (int bj = 0; bj < 2; ++bj) { f32x4 v0 = acc[ai][bj][m][0], v1 = acc[ai][bj][m][1]; const int n = col0 + bj * 128;
                        bf16_t* dst;
                        if (u.pn < 2) { const int h = n >> 7, d = n & 127; dst = Q + ((size_t)((b * NH + h) * SEQ + s)) * DQK + d; }
                        else { const int n2 = n - 512, h = n2 >> 6, w = n2 & 63, i0 = w >> 1;
                            const f32x4 c4 = *(const f32x4*)(cs + (size_t)tok * 32 + i0), s4 = *(const f32x4*)(sn + (size_t)tok * 32 + i0);
                            f32x4 a0, a1;
                            a0[0] = v0[0] * c4[0] - v0[1] * s4[0]; a0[1] = v0[1] * c4[0] + v0[0] * s4[0];
                            a0[2] = v0[2] * c4[1] - v0[3] * s4[1]; a0[3] = v0[3] * c4[1] + v0[2] * s4[1];
                            a1[0] = v1[0] * c4[2] - v1[1] * s4[2]; a1[1] = v1[1] * c4[2] + v1[0] * s4[2];
                            a1[2] = v1[2] * c4[3] - v1[3] * s4[3]; a1[3] = v1[3] * c4[3] + v1[2] * s4[3];
                            v0 = a0; v1 = a1; dst = Q + ((size_t)((b * NH + h) * SEQ + s)) * DQK + DNOPE + w; }
                        v0 = v0 * QSCALE; v1 = v1 * QSCALE;
                        u32x4 wv; wv.x = cvtpk(v0[0], v0[1]); wv.y = cvtpk(v0[2], v0[3]); wv.z = cvtpk(v1[0], v1[1]); wv.w = cvtpk(v1[2], v1[3]);
                        *(u32x4*)dst = wv; } }
        } else if (mode == EM_KV) {
            unsigned char* KN = (unsigned char*)p0; unsigned char* VI = (unsigned char*)p1;
#pragma unroll
            for (int ai = 0; ai < 2; ++ai)
#pragma unroll
                for (int m = 0; m < 4; ++m) { const int tok = row0 + ai * 128 + m * 16, b = tok >> 13, s = tok & 8191;
#pragma unroll
                    for (int bj = 0; bj < 2; ++bj) { const f32x4 v0 = acc[ai][bj][m][0], v1 = acc[ai][bj][m][1]; const int n = (col0 + bj * 128) & 511;
                        const int h = n >> 7, d = n & 127;
                        const size_t tbase = ((size_t)((b * NH + h) * (SEQ / 64) + (s >> 6))) * 16384;
                        unsigned char* dst = (u.pn < 2) ? KN + tbase + (d >> 3) * 1024 + (s & 63) * 16 : VI + tbase + v_st(s & 63, d);
                        u32x4 wv; wv.x = cvtpk(v0[0], v0[1]); wv.y = cvtpk(v0[2], v0[3]); wv.z = cvtpk(v1[0], v1[1]); wv.w = cvtpk(v1[2], v1[3]);
                        *(u32x4*)dst = wv; } }
        } else {
            bf16_t* YCAT = (bf16_t*)p0; const bf16_t* Z = (const bf16_t*)p1;
#pragma unroll
            for (int ai = 0; ai < 2; ++ai)
#pragma unroll
                for (int m = 0; m < 4; ++m) { const int tok = row0 + ai * 128 + m * 16;
#pragma unroll
                    for (int bj = 0; bj < 2; ++bj) { const f32x4 v0 = acc[ai][bj][m][0], v1 = acc[ai][bj][m][1]; const int c = col0 + bj * 128;
                        const u32x4 g = *(const u32x4*)(Z + (size_t)tok * DINP + ZC_GC + c);
                        u32x4 wv;
                        wv.x = cvtpk(v0[0] * lo_bf(g.x), v0[1] * hi_bf(g.x)); wv.y = cvtpk(v0[2] * lo_bf(g.y), v0[3] * hi_bf(g.y));
                        wv.z = cvtpk(v1[0] * lo_bf(g.z), v1[1] * hi_bf(g.z)); wv.w = cvtpk(v1[2] * lo_bf(g.w), v1[3] * hi_bf(g.w));
                        *(u32x4*)(YCAT + (size_t)tok * DM + 512 + c) = wv; } }
        }
    }
};

namespace att {
constexpr int SLOT = 40960, NSLOT = 3, VOFF = 24576, LDS_WS = NSLOT * SLOT;
constexpr float PLIM = 4096.f;
#define SBAR() __builtin_amdgcn_sched_barrier(0)
__device__ __forceinline__ void glds16s(const void* sbase, unsigned voff, unsigned lds_dst) { unsigned keep;
    asm volatile("s_mov_b32 %0, m0\n\ts_mov_b32 m0, %3\n\ts_nop 0\n\tglobal_load_lds_dwordx4 %1, %2\n\ts_mov_b32 m0, %0" : "=&s"(keep) : "v"(voff), "s"(sbase), "s"(lds_dst) : "memory"); }
#if ATT_EXP_TOP & 4
#define GLDS_DUP "global_load_lds_dwordx4 %1, off\n\t"
#else
#define GLDS_DUP ""
#endif
__device__ __forceinline__ void glds16(const void* gsrc, unsigned lds_dst) { unsigned keep;
    asm volatile("s_mov_b32 %0, m0\n\ts_mov_b32 m0, %2\n\ts_nop 0\n\tglobal_load_lds_dwordx4 %1, off\n\t" GLDS_DUP "s_mov_b32 m0, %0" : "=&s"(keep) : "v"(gsrc), "s"(lds_dst) : "memory"); }

template <int AX> __device__ __forceinline__ void attn_unit3(int b, int h, int qb, const bf16_t* Q, const unsigned char* KN, const unsigned char* KR, const unsigned char* VI,
                                           const bf16_t* Z, bf16_t* YCAT, char* shm, const int tid) {
    const int lane = tid & 63, r32 = lane & 31, hi = lane >> 5; const int wid = __builtin_amdgcn_readfirstlane(tid >> 6);
    const int q0 = qb * 256, NT = 4 * (qb + 1);
    const int bh = b * NH + h;
    const unsigned lds0 = (unsigned)(uintptr_t)shm;
    const unsigned char* knb = KN + (size_t)bh * (SEQ / 64) * 16384;
    const unsigned char* krb = KR + (size_t)b * (SEQ / 64) * 8192;
    const unsigned char* vbs = VI + (size_t)bh * (SEQ / 64) * 16384;
    const unsigned dvo = (unsigned)(wid * 1024 + lane * 16);
#define DMA_TILE(t, slot) do { const unsigned d_ = (unsigned)__builtin_amdgcn_readfirstlane(lds0 + (slot) + wid * 1024); \
        glds16s(knb + (size_t)(t) * 16384, dvo, d_); glds16s(knb + (size_t)(t) * 16384 + 8192, dvo, d_ + 8192); glds16s(krb + (size_t)(t) * 8192, dvo, d_ + 16384); \
        glds16s(vbs + (size_t)(t) * 16384, dvo, d_ + VOFF); glds16s(vbs + (size_t)(t) * 16384 + 8192, dvo, d_ + VOFF + 8192); } while (0)
    const bf16_t* Qw = Q + ((size_t)(bh * SEQ + q0 + wid * 32 + r32)) * DQK;
    bf16x8 qr[12];
#pragma unroll
    for (int d0 = 0; d0 < 12; ++d0) qr[d0] = *(const bf16x8*)(Qw + d0 * 16 + hi * 8);
#pragma unroll
    for (int d0 = 0; d0 < 12; ++d0) asm volatile("" : "+v"(qr[d0]));
    asm volatile("s_waitcnt vmcnt(0)" ::: "memory");
    DMA_TILE(0, 0);
    float m_run = 0.f, l_run = 0.f; f32x16 o[4];
#pragma unroll
    for (int d = 0; d < 4; ++d) o[d] = f32x16{};
    const LAS char* shm3 = (const LAS char*)shm;
    const LAS char* kl = shm3 + hi * 1024 + r32 * 16;
    const int vb0 = (int)lds0 + VOFF + v_rd_base(lane);
    const int qabs = q0 + wid * 32 + r32;
    f32x16 sA, sB, negm; bf16x8 pa0, pa1;
    bf16x8 kpa, kpb;

#define MF(acc, a_, b_) acc = __builtin_amdgcn_mfma_f32_32x32x16_bf16(a_, b_, acc, 0, 0, 0)
#define MFH(SYv, a_, b_, c_) asm("v_mfma_f32_32x32x16_bf16 %0, %1, %2, %3" : "=&v"(SYv) : "v"(a_), "v"(b_), "v"(c_))
#define MFQ(acc, a_, b_) do { if (AX & 64) { asm volatile("" :: "v"(a_), "v"(b_)); } else MF(acc, a_, b_); } while (0)
#define MFO(acc, a_, b_) do { if (AX & 8) { bf16x8 t0_ = a_, t1_ = b_; asm volatile("" :: "v"(t0_), "v"(t1_)); } else acc = __builtin_amdgcn_mfma_f32_32x32x16_bf16(b_, a_, acc, 0, 0, 0); } while (0)
#define DMAP(on_, i_, t_, slot_) do { if ((on_) && !(AX & 2)) { const unsigned d_ = (unsigned)__builtin_amdgcn_readfirstlane(lds0 + (slot_) + wid * 1024); \
        if ((i_) == 0) glds16s(knb + (size_t)(t_) * 16384, dvo, d_); else if ((i_) == 1) glds16s(knb + (size_t)(t_) * 16384 + 8192, dvo, d_ + 8192); \
        else if ((i_) == 2) glds16s(krb + (size_t)(t_) * 8192, dvo, d_ + 16384); else if ((i_) == 3) glds16s(vbs + (size_t)(t_) * 16384, dvo, d_ + VOFF); \
        else glds16s(vbs + (size_t)(t_) * 16384 + 8192, dvo, d_ + VOFF + 8192); } } while (0)
#ifndef ATT_EXP
#define ATT_EXP 0
#endif
#if ATT_EXP & 1
#define KLD1(dst, kp_, d0) do { dst = *(const LAS bf16x8*)(kp_ + (d0) * 2048); bf16x8 dmy_; asm volatile("ds_read_b128 %0, %1 offset:%2" : "=v"(dmy_) : "v"((int)(uintptr_t)(kp_)), "i"(((d0) * 2048) & 0xffff) : "memory"); asm volatile("" :: "v"(dmy_)); } while (0)
#else
#define KLD1(dst, kp_, d0) do { if (AX & 32) { asm volatile("" : "+v"(dst)); } else dst = *(const LAS bf16x8*)(kp_ + (d0) * 2048); } while (0)
#endif
#define KLD1R(dst, kp_, d0) dst = *(const LAS bf16x8*)(kp_ + (d0) * 2048)
#define MASKH(S, T_, hf_) do { if ((T_) >= NT - 4) { const float NEG = -__builtin_inff(); const int kb_ = 64 * (T_) + 32 * (hf_) + 4 * hi; \
        _Pragma("unroll") for (int r = 0; r < 16; ++r) { const int kv = kb_ + (r & 3) + 8 * (r >> 2); if (kv > qabs) S[r] = NEG; } } } while (0)
#define ROWMAX_FIN(mx0, mx1, out) do { float m_ = fmaxf(mx0, mx1); auto rr_ = __builtin_amdgcn_permlane32_swap(__float_as_uint(m_), __float_as_uint(m_), false, false); \
        out = fmaxf(__uint_as_float(rr_[0]), __uint_as_float(rr_[1])); } while (0)
#define DECIDE(tot_, SYp) do { if (!__all((tot_) <= PLIM)) { const float dl_ = (tot_) > PLIM ? __builtin_amdgcn_logf(tot_) : 0.f; const float al_ = __builtin_amdgcn_exp2f(-dl_); m_run += dl_; l_run *= al_; \
        _Pragma("unroll") for (int r = 0; r < 16; ++r) { SYp[r] -= dl_; negm[r] = -m_run; } asm volatile("" : "+v"(negm)); \
        _Pragma("unroll") for (int d_ = 0; d_ < 4; ++d_) _Pragma("unroll") for (int r = 0; r < 16; ++r) o[d_][r] *= al_; } } while (0)
#define PK4(P, B_, OUT) do { if (AX & (128 | 4096)) { asm volatile("" : "=v"(OUT) : "v"(P)); break; } unsigned a0_ = cvtpk(P[B_ + 0], P[B_ + 1]), a1_ = cvtpk(P[B_ + 2], P[B_ + 3]); \
        unsigned b0_ = cvtpk(P[B_ + 4], P[B_ + 5]), b1_ = cvtpk(P[B_ + 6], P[B_ + 7]); \
        auto r0_ = __builtin_amdgcn_permlane32_swap(a0_, b0_, false, false); auto r1_ = __builtin_amdgcn_permlane32_swap(a1_, b1_, false, false); \
        u32x4 w_ = {r0_[0], r1_[0], r0_[1], r1_[1]}; OUT = *reinterpret_cast<bf16x8*>(&w_); } while (0)
#if ATT_EXP & 2
#define SMC2(S, i) do { const float e0_ = __builtin_amdgcn_exp2f(S[i] - m_run), e1_ = __builtin_amdgcn_exp2f(S[(i) + 1] - m_run); \
        float x0_ = __builtin_amdgcn_exp2f(S[i] - l_run), x1_ = __builtin_amdgcn_exp2f(S[(i) + 1] - l_run); x0_ += x1_; asm volatile("" :: "v"(x0_)); \
        S[i] = e0_; S[(i) + 1] = e1_; ps0 += e0_; ps1 += e1_; } while (0)
#else
#define SMC2(S, i) do { if (AX & (128 | 2048)) break; const float e0_ = (AX & 1) ? S[i] : __builtin_amdgcn_exp2f(S[i]), e1_ = (AX & 1) ? S[(i) + 1] : __builtin_amdgcn_exp2f(S[(i) + 1]); S[i] = e0_; S[(i) + 1] = e1_; ps0 += e0_; ps1 += e1_; } while (0)
#endif
#define SMFIN() do { if (AX & (128 | 16384)) break; float ps_ = ps0 + ps1; auto rr_ = __builtin_amdgcn_permlane32_swap(__float_as_uint(ps_), __float_as_uint(ps_), false, false); \
        ptot = __uint_as_float(rr_[0]) + __uint_as_float(rr_[1]); l_run += ptot; } while (0)
#define TRRD(dst, off) do { if (AX & 16) asm volatile("" : "=v"(dst)); else asm volatile("ds_read_b64_tr_b16 %0, %1 offset:%2" : "=&v"(dst) : "v"(vb_), "i"(off) : "memory"); } while (0)
#define TRRD4(P_, d0, hf_) do { constexpr int b_ = v_rd_off(d0, 2 * (hf_), 0); TRRD(P_##l0, b_); TRRD(P_##h0, b_ + 2048); TRRD(P_##l1, b_ + 4096); TRRD(P_##h1, b_ + 6144); } while (0)
#define VF(P_, k) (bf16x8){P_##l##k[0], P_##l##k[1], P_##l##k[2], P_##l##k[3], P_##h##k[0], P_##h##k[1], P_##h##k[2], P_##h##k[3]}
#define LGK(n) do { if (!(AX & 256)) asm volatile("s_waitcnt lgkmcnt(" #n ")" ::: "memory"); } while (0)
#define RMC2(S, j) do { if (AX & (128 | 8192 | 32768)) break; mx0 = __builtin_fmaxf(__builtin_fmaxf(mx0, S[j]), S[(j) + 1]); } while (0)
#define RMC4(S, j) do { RMC2(S, j); RMC2(S, (j) + 2); } while (0)

#define HSTEP(SX, SY, T_, HF, TN, HFN, has_next_, dma_on_, bar_, pf_, knext_, td_) do { \
        float ps0 = 0.f, ps1 = 0.f, ptot = 0.f; \
        if (has_next_) { \
            const LAS char* kp_ = kl + ((HFN) == 0 ? sl_n1 : sl_cur) + (HFN) * 512; bf16x8 k0 = kpa, k1 = kpb, k2 = kpa; \
            KLD1(k2, kp_, 2); SBAR(); \
            if (AX & 64) { SY = negm; asm volatile("" :: "v"(k0)); } else MFH(SY, k0, qr[0], negm); SMC2(SX, 0); SBAR(); KLD1(k0, kp_, 3); DMAP(dma_on_, 0, td_, sl_n2); SBAR(); \
            MFQ(SY, k1, qr[1]); SMC2(SX, 2); SBAR(); KLD1(k1, kp_, 4); DMAP(dma_on_, 1, td_, sl_n2); SBAR(); \
            MFQ(SY, k2, qr[2]); SMC2(SX, 4); SBAR(); KLD1(k2, kp_, 5); DMAP(dma_on_, 2, td_, sl_n2); SBAR(); \
            MFQ(SY, k0, qr[3]); SMC2(SX, 6); SBAR(); KLD1(k0, kp_, 6); DMAP(dma_on_, 3, td_, sl_n2); SBAR(); \
            MFQ(SY, k1, qr[4]); SMC2(SX, 8); SBAR(); KLD1(k1, kp_, 7); DMAP(dma_on_, 4, td_, sl_n2); SBAR(); \
            MFQ(SY, k2, qr[5]); SMC2(SX, 10); SBAR(); KLD1(k2, kp_, 8); SBAR(); \
            MFQ(SY, k0, qr[6]); SMC2(SX, 12); SBAR(); KLD1(k0, kp_, 9); SBAR(); \
            MFQ(SY, k1, qr[7]); SMC2(SX, 14); SBAR(); KLD1(k1, kp_, 10); SBAR(); \
            MFQ(SY, k2, qr[8]); PK4(SX, 0, pa0); SBAR(); KLD1(k2, kp_, 11); SBAR(); \
            MFQ(SY, k0, qr[9]); PK4(SX, 8, pa1); SBAR(); \
            MFQ(SY, k1, qr[10]); SMFIN(); SBAR(); \
            MFQ(SY, k2, qr[11]); SBAR(); \
        } else { \
            _Pragma("unroll") for (int i_ = 0; i_ < 16; i_ += 2) SMC2(SX, i_); \
            PK4(SX, 0, pa0); PK4(SX, 8, pa1); SMFIN(); SBAR(); \
        } \
        if (bar_) { if (AX & 4) asm volatile("s_waitcnt vmcnt(0) lgkmcnt(0)" ::: "memory"); else asm volatile("s_waitcnt vmcnt(0) lgkmcnt(0)\n\ts_barrier" ::: "memory"); }     \
        { const int vb_ = vb0 + sl_cur; s16x4 Al0, Al1, Ah0, Ah1, Bl0, Bl1, Bh0, Bh1; \
          TRRD4(A, 0, HF); TRRD4(B, 1, HF); SBAR(); \
          if (pf_) { KLD1(kpa, knext_, 0); KLD1(kpb, knext_, 1); } SBAR(); \
          if (has_next_) MASKH(SY, TN, HFN); \
          SBAR(); if (pf_) LGK(6); else LGK(4); SBAR();                   \
          MFO(o[0], pa0, VF(A, 0)); SBAR(); MFO(o[0], pa1, VF(A, 1)); SBAR(); \
          TRRD4(A, 2, HF); SBAR(); if (pf_) LGK(6); else LGK(4); SBAR();    \
          MFO(o[1], pa0, VF(B, 0)); SBAR(); MFO(o[1], pa1, VF(B, 1)); SBAR(); \
          TRRD4(B, 3, HF); LGK(4); SBAR();                                  \
          MFO(o[2], pa0, VF(A, 0)); MFO(o[2], pa1, VF(A, 1)); SBAR(); \
          LGK(0); SBAR(); \
          MFO(o[3], pa0, VF(B, 0)); MFO(o[3], pa1, VF(B, 1)); SBAR(); \
          if ((has_next_) && !(AX & (128 | 8192))) { DECIDE(ptot, SY); } } \
    } while (0)

    int sl_cur = 0, sl_n1 = SLOT, sl_n2 = 2 * SLOT;
    asm volatile("s_waitcnt vmcnt(0) lgkmcnt(0)\n\ts_barrier" ::: "memory");
    DMA_TILE(1, SLOT); if (AX & 2) DMA_TILE(2, 2 * SLOT);
    { const LAS char* kp_ = shm3 + hi * 1024 + r32 * 16; bf16x8 ka, kb;
      sA = f32x16{};
      KLD1R(ka, kp_, 0); KLD1R(kb, kp_, 1); SBAR();
#pragma unroll
      for (int d2 = 0; d2 < 12; d2 += 2) {
          MF(sA, ka, qr[d2]); SBAR(); if (d2 + 2 < 12) KLD1R(ka, kp_, d2 + 2); SBAR();
          MF(sA, kb, qr[d2 + 1]); SBAR(); if (d2 + 3 < 12) KLD1R(kb, kp_, d2 + 3); SBAR(); }
      KLD1R(kpa, kp_ + 512, 0); KLD1R(kpb, kp_ + 512, 1); SBAR(); }
    MASKH(sA, 0, 0);
    { float mx0 = -__builtin_inff();
#pragma unroll
      for (int j = 0; j < 16; j += 2) RMC2(sA, j);
      ROWMAX_FIN(mx0, mx0, m_run);
#pragma unroll
      for (int r = 0; r < 16; ++r) { sA[r] -= m_run; negm[r] = -m_run; } asm volatile("" : "+v"(negm)); }
    for (int T = 0; T < ((AX & 1024) ? 1 : NT); ++T) {
        const int tdma = (T + 2 < NT) ? T + 2 : NT - 1;
        HSTEP(sA, sB, T, 0, T, 1, true, false, true, true, (kl + sl_n1), 0);
        HSTEP(sB, sA, T, 1, T + 1, 0, true, true, false, true, (kl + sl_n1 + 512), tdma);
        { const int tmp_ = sl_cur; sl_cur = sl_n1; sl_n1 = sl_n2; sl_n2 = tmp_; }
    }
    asm volatile("s_waitcnt lgkmcnt(0)\n\ts_barrier" ::: "memory");
    if (AX & 512) { asm volatile("" :: "v"(o[0]), "v"(o[1]), "v"(o[2]), "v"(o[3])); } else
    { int r32e = r32, hie = hi; asm volatile("" : "+v"(r32e), "+v"(hie));
      const size_t mrow = (size_t)b * SEQ + q0 + wid * 32 + r32e;
      const bf16_t* zp = Z + mrow * DINP + ZC_GATT + h * DV + 8 * hie; bf16_t* yp = YCAT + mrow * DM + h * DV + 8 * hie;
      u32x4 gv[8];
#pragma unroll
      for (int j = 0; j < 8; ++j) gv[j] = *(const u32x4*)(zp + 16 * j);
      const float rl = __builtin_amdgcn_rcpf(l_run);
#pragma unroll
      for (int j = 0; j < 8; ++j) { const int d0 = j >> 1, gp = j & 1; float na[4], nb[4];
#pragma unroll
          for (int i = 0; i < 4; ++i) { auto rr_ = __builtin_amdgcn_permlane32_swap(__float_as_uint(o[d0][8 * gp + i] * rl), __float_as_uint(o[d0][8 * gp + 4 + i] * rl), false, false);
              na[i] = __uint_as_float(rr_[0]); nb[i] = __uint_as_float(rr_[1]); }
          const u32x4 g = gv[j]; u32x4 w;
          w.x = cvtpk(na[0] * lo_bf(g.x), na[1] * hi_bf(g.x)); w.y = cvtpk(na[2] * lo_bf(g.y), na[3] * hi_bf(g.y));
          w.z = cvtpk(nb[0] * lo_bf(g.z), nb[1] * hi_bf(g.z)); w.w = cvtpk(nb[2] * lo_bf(g.w), nb[3] * hi_bf(g.w));
          *(u32x4*)(yp + 16 * j) = w; } }
#undef DMA_TILE
#undef DMAP
#undef MF
#undef MFQ
#undef MFH
#undef MFO
#undef KLD1R
#undef KLD1
#undef MASKH
#undef ROWMAX_FIN
#undef DECIDE
#undef PK4
#undef SMC2
#undef SMFIN
#undef TRRD
#undef TRRD4
#undef VF
#undef LGK
#undef RMC2
#undef RMC4
#undef HSTEP
}
#undef SBAR
}

#define XB_TMO      128
#define XB_XCNT(j)  (256  + 64 * (j))
#define XB_XSUB(j)  (1280 + 64 * (j))
#define XB_XGEN(j)  (2304 + 64 * (j))
#define XB_TOP      3328
#define XB_TOPGEN   3392
#define XCD_BAR_WORDS 3456
#define XB_SPIN_CAP (1u << 18)
__device__ __forceinline__ unsigned xb_ld(unsigned* p)              { return __hip_atomic_load(p, __ATOMIC_RELAXED, __HIP_MEMORY_SCOPE_AGENT); }
__device__ __forceinline__ unsigned xb_add(unsigned* p, unsigned v) { return __hip_atomic_fetch_add(p, v, __ATOMIC_RELAXED, __HIP_MEMORY_SCOPE_AGENT); }
__device__ __forceinline__ unsigned xb_xcc_id() { return (unsigned)__builtin_amdgcn_s_getreg((3 << 11) | 20) & 0xFu; }
#define XB_SPIN(cond, bar) do { unsigned _sp = 0; while (cond) { __builtin_amdgcn_s_sleep(1); \
    if ((++_sp & 255u) == 0u) { if (xb_ld(&(bar)[XB_TMO])) break; if (_sp > XB_SPIN_CAP) { atomicAdd(&(bar)[XB_TMO], 1u); break; } } } } while (0)
struct XcdBarrier { unsigned* bar; unsigned x; volatile LAS unsigned* st; };
__device__ __forceinline__ XcdBarrier xcd_barrier_post(unsigned* bar, volatile LAS unsigned* st) {
    XcdBarrier b; b.bar = bar; b.x = xb_xcc_id(); b.st = st;
    if (threadIdx.x == 0) (void)xb_add(&bar[XB_XCNT(b.x)], 1u);
    return b;
}
__device__ __forceinline__ void xcd_barrier_complete(unsigned* bar, unsigned x, unsigned& nloc, unsigned& nx) {
    const unsigned G = gridDim.x * gridDim.y * gridDim.z;
    unsigned sum, cnt, mine, sp = 0u;
    for (;;) {
        sum = 0u; cnt = 0u; mine = 0u;
#pragma unroll
        for (unsigned j = 0; j < 16; ++j) { const unsigned c = xb_ld(&bar[XB_XCNT(j)]); sum += c; cnt += (c > 0u) ? 1u : 0u; mine = (j == x) ? c : mine; }
        if (sum == G) break;
        __builtin_amdgcn_s_sleep(1);
        if ((++sp & 255u) == 0u) { if (xb_ld(&bar[XB_TMO])) break; if (sp > XB_SPIN_CAP) { atomicAdd(&bar[XB_TMO], 1u); break; } }
    }
    nloc = mine > 0u ? mine : 1u; nx = cnt > 0u ? cnt : 1u;
}
__device__ __forceinline__ void xcd_barrier(const XcdBarrier& b) {
    asm volatile("s_waitcnt vmcnt(0)" ::: "memory");
    __syncthreads();
    if (threadIdx.x == 0) {
        unsigned* bar = b.bar;
        __builtin_amdgcn_s_waitcnt(0);
        unsigned nloc = b.st[0], nx = b.st[1];
        if (nloc == 0u) { xcd_barrier_complete(bar, b.x, nloc, nx); b.st[0] = nloc; b.st[1] = nx; }
        const unsigned old = xb_add(&bar[XB_XSUB(b.x)], 1u);
        const unsigned gen = old / nloc;
        if (old + 1u == (gen + 1u) * nloc) {
            __builtin_amdgcn_fence(__ATOMIC_RELEASE, "agent");
            asm volatile("s_waitcnt vmcnt(0)" ::: "memory");
            const unsigned og = xb_add(&bar[XB_TOP], 1u);
            const unsigned tg = og / nx;
            if (og + 1u == (tg + 1u) * nx) xb_add(&bar[XB_TOPGEN], 1u);
            else XB_SPIN(xb_ld(&bar[XB_TOPGEN]) == tg, bar);
            __builtin_amdgcn_fence(__ATOMIC_ACQUIRE, "agent");
            xb_add(&bar[XB_XGEN(b.x)], 1u);
            asm volatile("s_waitcnt vmcnt(0)" ::: "memory");
        } else {
            XB_SPIN(xb_ld(&bar[XB_XGEN(b.x)]) == gen, bar);
            __builtin_amdgcn_fence(__ATOMIC_ACQUIRE, "agent");
            asm volatile("s_waitcnt vmcnt(0)" ::: "memory");
        }
    }
    __syncthreads();
}

struct Args { const void* in[22]; float* out; unsigned char* ws; int ph_lo, ph_hi; };
enum { I_X = 0, I_C, I_POS, I_WADA, I_BADA, I_GPRE, I_GPOST, I_WIN, I_QNG, I_WUQ, I_KVNG, I_WUKV, I_CONVW, I_CONVB, I_CLNG, I_CLNB, I_WPW2, I_SLNG, I_SLNB, I_WS, I_BS, I_WOUT };
constexpr int N_PHASES = 2 + 6 * NLAYER;

__device__ __forceinline__ int wmap(int mat, int n) {
    if (mat == 0) {
        if (n < 384) return n; if (n < 448) { const int w = n - 384; return 384 + 32 * (w & 1) + (w >> 1); } if (n < 512) return -1;
        const int t = n >> 8, j = n & 127, second = (n >> 7) & 1;
        if (t == 4 || t == 5) return (second ? 1216 : 960) + (t - 4) * 128 + j;
        if (t == 7 || t == 9) return (second ? 2240 : 1728) + (t == 9 ? 128 : 0) + j;
        return n - 64; }
    if (mat == 2) { if (n < 512) return (n >> 7) * DQK + (n & 127); const int n2 = n - 512, h = n2 >> 6, w = n2 & 63; return h * DQK + DNOPE + 32 * (w & 1) + (w >> 1); }
    if (mat == 3) { const int h = (n & 511) >> 7, d = n & 127; return h * 256 + (n >= 512 ? 128 : 0) + d; }
    return n;
}
__device__ __forceinline__ void transpose_item(const float* W, int Nsrc, bf16_t* WT, int Kd, int mat, LAS float* scr, int kb, int nb, int lane) {
    const int k0 = 64 * kb, n0 = 32 * nb; const int src = wmap(mat, n0 + (lane & 31));
#pragma unroll 8
    for (int i = 0; i < 32; ++i) { const int kk = 2 * i + (lane >> 5); scr[kk * 33 + (lane & 31)] = src >= 0 ? W[(size_t)(k0 + kk) * Nsrc + src] : 0.f; }
    asm volatile("s_waitcnt lgkmcnt(0)" ::: "memory");
    const int c = lane & 7;
#pragma unroll
    for (int j = 0; j < 4; ++j) { const int n = (lane >> 3) + 8 * j; const LAS float* s = scr + (8 * c) * 33 + n;
        u32x4 o; o.x = cvtpk(s[0 * 33], s[1 * 33]); o.y = cvtpk(s[2 * 33], s[3 * 33]); o.z = cvtpk(s[4 * 33], s[5 * 33]); o.w = cvtpk(s[6 * 33], s[7 * 33]);
        *(u32x4*)(WT + (size_t)(n0 + n) * Kd + k0 + 8 * c) = o; }
    asm volatile("s_waitcnt lgkmcnt(0)" ::: "memory");
}

__global__ void __launch_bounds__(NTHREADS, 2) hymba_fwd(Args args) {
    extern __shared__ __attribute__((aligned(16))) unsigned char lds[];
    typedef const __attribute__((address_space(4))) Args* KArgP;
    cg::grid_group grid = cg::this_grid();
    const int ph_lo = args.ph_lo, ph_hi = args.ph_hi;
    const int wave_s = __builtin_amdgcn_readfirstlane(threadIdx.x >> 6);
    volatile LAS unsigned* xbst = (volatile LAS unsigned*)((LAS unsigned char*)lds + LDS_BYTES - 64);
    if (threadIdx.x < 4) xbst[threadIdx.x] = 0u;
    __syncthreads();
    const XcdBarrier xbar = xcd_barrier_post((unsigned*)(args.ws + WS_CTL) + CTL_BARW, xbst);

    int ph = ph_lo, rep = 0;
    while (ph < ph_hi) {
        KArgP ap0 = (KArgP)__builtin_amdgcn_kernarg_segment_ptr();
#define ARG(k) (ap->in[k])
#define TID_HERE() int lane; asm volatile("v_mbcnt_lo_u32_b32 %0, -1, 0\n\tv_mbcnt_hi_u32_b32 %0, -1, %0" : "=v"(lane)); const int tid = wave_s * 64 + lane; (void)tid
        const int wave = wave_s;
#define PHASE_ROOTS() \
        KArgP ap = ap0; asm volatile("" : "+s"(ap)); \
        int G = gridDim.x, bx = blockIdx.x; asm volatile("" : "+s"(G), "+s"(bx)); \
        const int vcu = (G % 8 == 0) ? (bx % 8) * (G / 8) + bx / 8 : bx; \
        const int gw = vcu * NWAVES + wave, NGW = G * NWAVES; (void)gw; (void)NGW; \
        unsigned char* ws = ap->ws; float* outp = ap->out; (void)outp; \
        const float* x_in = (const float*)ARG(I_X); (void)x_in; \
        float* adap = (float*)(ws + WS_ADAP); (void)adap; float* mod = (float*)(ws + WS_CTL + CTL_MOD); (void)mod; \
        float* cs_t = (float*)(ws + WS_COS); float* sn_t = (float*)(ws + WS_SIN); (void)cs_t; (void)sn_t; \
        bf16_t* Hb = (bf16_t*)(ws + WS_H); bf16_t* Zb = (bf16_t*)(ws + WS_Z); bf16_t* Y16 = (bf16_t*)(ws + WS_Y); (void)Hb; (void)Zb; (void)Y16; \
        bf16_t* QLN = (bf16_t*)(ws + WS_QLN); bf16_t* KVLN = (bf16_t*)(ws + WS_KVLN); bf16_t* CONVH = (bf16_t*)(ws + WS_CONVH); bf16_t* SGVT = (bf16_t*)(ws + WS_SGVT); (void)QLN; (void)KVLN; (void)CONVH; (void)SGVT; \
        bf16_t* Qb = (bf16_t*)(ws + WS_Q); unsigned char* KNb = ws + WS_KN; unsigned char* KRb = ws + WS_KR; unsigned char* VIb = ws + WS_V; (void)Qb; (void)KNb; (void)KRb; (void)VIb; \
        bf16_t* YCAT = (bf16_t*)(ws + WS_YCAT); (void)YCAT
        if (ph == 0 && PHEN(0)) {
            TID_HERE(); PHASE_ROOTS();
            LAS float* scr = (LAS float*)(lds + wave * 16384);
            for (int it = gw; it < NLAYER * 16 * 48; it += NGW) { const int l = it / 768, r = it % 768, kc = r / 48, nc = r % 48;
                const float* W = (const float*)ARG(I_WADA) + (size_t)l * DM * 3072 + (size_t)(kc * 64) * 3072 + nc * 64 + lane;
                const float* c = (const float*)ARG(I_C) + kc * 64;
                float a0 = 0.f, a1 = 0.f, a2 = 0.f, a3 = 0.f;
#pragma unroll 8
                for (int k = 0; k < 64; ++k) { const float w = W[(size_t)k * 3072];
                    a0 += siluf_(c[k]) * w; a1 += siluf_(c[DM + k]) * w; a2 += siluf_(c[2 * DM + k]) * w; a3 += siluf_(c[3 * DM + k]) * w; }
                float* dst = adap + ((size_t)(kc * 2 + l) * 4) * 3072 + nc * 64 + lane;
                __hip_atomic_store(dst, a0, __ATOMIC_RELAXED, __HIP_MEMORY_SCOPE_AGENT); __hip_atomic_store(dst + 3072, a1, __ATOMIC_RELAXED, __HIP_MEMORY_SCOPE_AGENT);
                __hip_atomic_store(dst + 2 * 3072, a2, __ATOMIC_RELAXED, __HIP_MEMORY_SCOPE_AGENT); __hip_atomic_store(dst + 3 * 3072, a3, __ATOMIC_RELAXED, __HIP_MEMORY_SCOPE_AGENT);
                asm volatile("s_waitcnt vmcnt(0)" ::: "memory");
                unsigned tk = 0;
                if (lane == 0) tk = __hip_atomic_fetch_add((unsigned*)(ws + WS_CTL) + CTL_ADACNT + (l * 48 + nc) * 16, 1u, __ATOMIC_RELAXED, __HIP_MEMORY_SCOPE_AGENT);
                tk = (unsigned)__builtin_amdgcn_readfirstlane((int)tk);
                if (tk == 15u) {
                    const float* bada = (const float*)ARG(I_BADA) + (size_t)l * 3072;
#pragma unroll
                    for (int b = 0; b < 4; ++b) { float s = 0.f;
#pragma unroll
                        for (int k2 = 0; k2 < 16; ++k2) s += __hip_atomic_load(adap + ((size_t)(k2 * 2 + l) * 4 + b) * 3072 + nc * 64 + lane, __ATOMIC_RELAXED, __HIP_MEMORY_SCOPE_AGENT);
                        mod[((size_t)l * 4 + b) * 3072 + nc * 64 + lane] = s + bada[nc * 64 + lane]; }
                } }
            {
                constexpr int I0 = 16 * 80, I1 = 16 * 32, I2 = 4 * 24, I3 = 2 * 32, I4 = 4 * 8, IL = I0 + I1 + I2 + I3 + I4;
                for (int it = gw; it < NLAYER * IL; it += NGW) {
                    const int l = it / IL; int r = it % IL;
                    if (r < I0) { transpose_item((const float*)ARG(I_WIN) + (size_t)l * DM * DIN, DIN, (bf16_t*)(ws + WS_WIN) + (size_t)l * DINP * DM, DM, 0, scr, r / 80, r % 80, lane); continue; } r -= I0;
                    if (r < I1) { transpose_item((const float*)ARG(I_WOUT) + (size_t)l * DM * DM, DM, (bf16_t*)(ws + WS_WOUT) + (size_t)l * DM * DM, DM, 1, scr, r / 32, r % 32, lane); continue; } r -= I1;
                    if (r < I2) { transpose_item((const float*)ARG(I_WUQ) + (size_t)l * QLR * 768, 768, (bf16_t*)(ws + WS_WUQ) + (size_t)l * 768 * 256, 256, 2, scr, r / 24, r % 24, lane); continue; } r -= I2;
                    if (r < I3) { transpose_item((const float*)ARG(I_WUKV) + (size_t)l * KVLR * 1024, 1024, (bf16_t*)(ws + WS_WUKV) + (size_t)l * 1024 * 128, 128, 3, scr, r / 32, r % 32, lane); continue; } r -= I3;
                    transpose_item((const float*)ARG(I_WPW2) + (size_t)l * CW * CW, CW, (bf16_t*)(ws + WS_WPW2) + (size_t)l * CW * CW, CW, 4, scr, r / 8, r % 8, lane);
                }
            }
            const int gt = vcu * NTHREADS + tid, NGT = G * NTHREADS;
            for (int i = gt; i < NLAYER * SG * SCH * SCH; i += NGT) { const int s = i & 127, t = (i >> 7) & 127;
                const float v = s <= t ? ((const float*)ARG(I_WS))[i] : 0.f; ((bf16_t*)(ws + WS_WSM))[i] = (bf16_t)(cvtpk(v, 0.f) & 0xffffu); }
            const float inv_freq = powf(10000.0f, -(float)(2 * (gt & 31)) / 64.0f);
            for (int i = gt; i < MTOK * 32; i += NGT) { const int tok = i >> 5;
                const float ang = (float)((const int*)ARG(I_POS))[tok] * inv_freq;
                cs_t[i] = cosf(ang); sn_t[i] = sinf(ang); }
        } else if (ph == 1 && PHEN(1)) {
            TID_HERE(); PHASE_ROOTS();
            const float* gp = (const float*)ARG(I_GPRE);
            for (int grp = gw; grp < MTOK / 4; grp += NGW) { const int m0 = grp * 4, b = m0 >> 13;
                f32x4 v[4][4];
#pragma unroll
                for (int k = 0; k < 4; ++k) { const f32x4* xr = (const f32x4*)(x_in + (size_t)(m0 + k) * DM) + lane;
#pragma unroll
                    for (int j = 0; j < 4; ++j) v[k][j] = __builtin_nontemporal_load(&xr[64 * j]); }
                f32x4 pa[4], pb[4];
#pragma unroll
                for (int j = 0; j < 4; ++j) { const int c = 4 * lane + 256 * j;
                    pb[j] = *(const f32x4*)(mod + (size_t)b * 3072 + c);
                    pa[j] = *(const f32x4*)(gp + c) * (*(const f32x4*)(mod + (size_t)b * 3072 + DM + c) + 1.f); }
#pragma unroll
                for (int k = 0; k < 4; ++k) { float ss = 0.f;
#pragma unroll
                    for (int j = 0; j < 4; ++j) ss += (v[k][j].x * v[k][j].x + v[k][j].y * v[k][j].y) + (v[k][j].z * v[k][j].z + v[k][j].w * v[k][j].w);
                    const float rstd = rsqrtf(wave_sum(ss) * (1.f / DM) + EPS);
                    u32x2* o8 = (u32x2*)(Hb + (size_t)(m0 + k) * DM) + lane;
#pragma unroll
                    for (int j = 0; j < 4; ++j) { const f32x4 hv = (v[k][j] * rstd) * pa[j] + pb[j];
                        u32x2 w; w.x = cvtpk(hv.x, hv.y); w.y = cvtpk(hv.z, hv.w); o8[64 * j] = w; } }
            }
        } else {
            const int l = (ph - 2) / 6, sub = (ph - 2) % 6;
            const int ngemm = (sub == 0 || sub == 4) ? 1 : (sub == 2 ? 3 : 0);
#pragma nounroll
            for (int gi_ = 0; gi_ < ngemm * (1 + ((PROBE_MASK >> 8) & 1)) && PHEN(2); ++gi_) {
                const int gi = gi_ % ngemm;
                TID_HERE(); PHASE_ROOTS();
                pg8::Gemm g; EpiAll E; int Nn, cc = bx;
                if (sub == 0) { g = pg8::Gemm{Hb, (const bf16_t*)(ws + WS_WIN) + (size_t)l * DINP * DM, MTOK, DINP, DM, DM, DM}; Nn = DINP; E = EpiAll{EM_Z1, DINP, Zb, cs_t, sn_t, ws, (const float*)ARG(I_QNG) + l * QLR, (const float*)ARG(I_KVNG) + l * KVLR, (LAS unsigned char*)lds, (const float*)ARG(I_SLNG) + l * SW, (const float*)ARG(I_SLNB) + l * SW}; }
                else if (sub == 4) { g = pg8::Gemm{YCAT, (const bf16_t*)(ws + WS_WOUT) + (size_t)l * DM * DM, MTOK, DM, DM, DM, DM}; Nn = DM; E = EpiAll{EM_Z, DM, Y16, nullptr, nullptr, nullptr, nullptr, nullptr, nullptr, nullptr, nullptr}; }
                else if (gi == 0) { g = pg8::Gemm{QLN, (const bf16_t*)(ws + WS_WUQ) + (size_t)l * 768 * 256, MTOK, 768, 256, 256, 256}; Nn = 768; E = EpiAll{EM_Q, 0, Qb, cs_t, sn_t, nullptr, nullptr, nullptr, nullptr, nullptr, nullptr}; }
                else if (gi == 1) { g = pg8::Gemm{CONVH, (const bf16_t*)(ws + WS_WPW2) + (size_t)l * CW * CW, MTOK, CW, CW, CW, CW}; Nn = CW; cc = (bx + G / 2) % G; E = EpiAll{EM_PW2, 0, YCAT, Zb, nullptr, nullptr, nullptr, nullptr, nullptr, nullptr, nullptr}; }
                else { g = pg8::Gemm{KVLN, (const bf16_t*)(ws + WS_WUKV) + (size_t)l * 1024 * 128, MTOK, 1024, 128, 128, 128}; Nn = 1024; E = EpiAll{EM_KV, 0, KNb, VIb, nullptr, nullptr, nullptr, nullptr, nullptr, nullptr, nullptr}; }
                pg8::StaticOrder S; S.init(MTOK, Nn, G, cc);
#if STAGGER_US > 0
                if (sub == 0 && (bx & 8)) { const unsigned long long t0_ = __builtin_amdgcn_s_memrealtime(); while (__builtin_amdgcn_s_memrealtime() - t0_ < (unsigned long long)(STAGGER_US * 100)) __builtin_amdgcn_s_sleep(8); }
#endif
                pg8::gemm_phase<EpiAll>((LAS unsigned char*)lds, g, S, E, tid);
            }
            if (sub == 0) {
            } else if (sub == 1 && PHEN(3)) {
                TID_HERE(); PHASE_ROOTS();
                const float* cw = (const float*)ARG(I_CONVW) + (size_t)l * CK * CW; const float* cb = (const float*)ARG(I_CONVB) + l * CW;
                const float* clg = (const float*)ARG(I_CLNG) + l * CW; const float* clb = (const float*)ARG(I_CLNB) + l * CW;
                LAS float* glu = (LAS float*)lds;
                LAS float* cvo = (LAS float*)(lds + 63488);
                LAS bf16_t* sgv = (LAS bf16_t*)(lds + 63488 + 32768);
                float cwv[CK];
#pragma unroll
                for (int j = 0; j < CK; ++j) cwv[j] = cw[j * CW + (tid & 255)];
                const float cbias = cb[tid & 255];
                const f32x4 clg4 = *(const f32x4*)(clg + 4 * lane), clb4 = *(const f32x4*)(clb + 4 * lane);
                u32x4 ga[4]; u32x2 zsv[4];
#define P2A_LOAD(tt_) do { const int b_ = (tt_) >> 8, s0_ = ((tt_) & 255) * 32; const size_t m0_ = (size_t)b_ * SEQ + s0_; \
                    _Pragma("unroll") for (int pass = 0; pass < 4; ++pass) { const int r = pass * 16 + (tid >> 5), c8 = (tid & 31) * 8; const int s = s0_ - 30 + r; \
                        ga[pass] = *(const u32x4*)(Zb + ((size_t)b_ * SEQ + (s >= 0 ? (r < 62 ? s : s0_) : 0)) * DINP + ZC_CA + c8); \
                        if (r >= 62 || s < 0) ga[pass] = (u32x4){0u, 0u, 0u, 0u}; } \
                    _Pragma("unroll") for (int i = 0; i < 4; ++i) { const size_t m = m0_ + 4 * wave + i; const bf16_t* zr = Zb + m * DINP; \
                        zsv[i] = *(const u32x2*)(zr + ZC_SV + 4 * lane); } } while (0)
                P2A_LOAD(vcu < MTOK / 32 ? vcu : 0);
                for (int tt = vcu; tt < MTOK / 32; tt += G) {
                    const int b = tt >> 8, s0 = (tt & 255) * 32; const size_t m0 = (size_t)b * SEQ + s0;
#pragma unroll
                    for (int pass = 0; pass < 4; ++pass) { const int r = pass * 16 + (tid >> 5), c8 = (tid & 31) * 8;
                        if (r < 62) { const u32x4 a = ga[pass];
                            *(LAS f32x4*)(glu + r * 256 + c8) = (f32x4){lo_bf(a.x), hi_bf(a.x), lo_bf(a.y), hi_bf(a.y)}; *(LAS f32x4*)(glu + r * 256 + c8 + 4) = (f32x4){lo_bf(a.z), hi_bf(a.z), lo_bf(a.w), hi_bf(a.w)}; } }
#pragma unroll
                    for (int i = 0; i < 4; ++i) { const int tl = 4 * wave + i; const size_t m = m0 + tl; const int s = s0 + tl;
                        *(LAS u32x2*)(sgv + tl * 256 + 4 * lane) = zsv[i];
                    }
                    __syncthreads();
                    { const int tn = tt + G; P2A_LOAD(tn < MTOK / 32 ? tn : tt); }
                    { const int c = tid & 255, half = tid >> 8;
                      for (int g4 = 0; g4 < 4; ++g4) { const int tb = 16 * half + 4 * g4; float v[34];
#pragma unroll
                          for (int k = 0; k < 34; ++k) v[k] = glu[(tb + k) * 256 + c];
#pragma unroll
                          for (int i = 0; i < 4; ++i) { float a = cbias;
#pragma unroll
                              for (int j = 0; j < CK; ++j) a += cwv[j] * v[i + j];
                              cvo[(tb + i) * 256 + c] = a; } } }
                    __syncthreads();
                    for (int i = 0; i < 4; ++i) { const int tl = 4 * wave + i; const size_t m = m0 + tl;
                        const f32x4 xv = *(const LAS f32x4*)(cvo + tl * 256 + 4 * lane);
                        const float mean = wave_sum((xv.x + xv.y) + (xv.z + xv.w)) * (1.f / CW);
                        const float d0 = xv.x - mean, d1 = xv.y - mean, d2 = xv.z - mean, d3 = xv.w - mean;
                        const float rstd = rsqrtf(wave_sum((d0 * d0 + d1 * d1) + (d2 * d2 + d3 * d3)) * (1.f / CW) + EPS);
                        const f32x4 g = clg4, bb = clb4;
                        u32x2 w; w.x = cvtpk(siluf_(d0 * rstd * g.x + bb.x), siluf_(d1 * rstd * g.y + bb.y)); w.y = cvtpk(siluf_(d2 * rstd * g.z + bb.z), siluf_(d3 * rstd * g.w + bb.w));
                        *(u32x2*)(CONVH + m * 256 + 4 * lane) = w; }
                    { const int c = tid & 255, half = tid >> 8; unsigned pk[8];
#pragma unroll
                      for (int k = 0; k < 8; ++k) { const unsigned lo = sgv[(16 * half + 2 * k) * 256 + c], hi2 = sgv[(16 * half + 2 * k + 1) * 256 + c]; pk[k] = lo | (hi2 << 16); }
                      bf16_t* dst = SGVT + ((size_t)(m0 >> 7) * 256 + c) * 128 + (s0 & 127) + 16 * half;
                      *(u32x4*)dst = (u32x4){pk[0], pk[1], pk[2], pk[3]}; *(u32x4*)(dst + 8) = (u32x4){pk[4], pk[5], pk[6], pk[7]}; }
                    __syncthreads();
                }
#undef P2A_LOAD
            } else if (sub == 2 && PHEN(4)) {
                TID_HERE(); PHASE_ROOTS();
                { const bf16_t* WsM = (const bf16_t*)(ws + WS_WSM) + (size_t)l * SG * SCH * SCH; const float* bs = (const float*)ARG(I_BS) + l * SG * SCH;
                  const int r32 = lane & 31, hi = lane >> 5, gq = wave >> 1, th = wave & 1;
                  constexpr int UP = 528;
                  LAS unsigned char* ub = (LAS unsigned char*)lds;
                  for (int ck_ = vcu; ck_ < (MTOK / SCH) * (1 + ((PROBE_MASK >> 9) & 1)); ck_ += G) { const int ck = ck_ % (MTOK / SCH);
                      const size_t mc = (size_t)ck * SCH;
                      const bf16_t* Wb = WsM + ((size_t)gq * SCH + 64 * th + r32) * SCH + 8 * hi;
                      const bf16_t* Vb = SGVT + ((size_t)ck * 256 + gq * 64 + r32) * SCH + 8 * hi;
                      bf16x8 wf[2][4], vf[2][4];
#pragma unroll
                      for (int ks = 0; ks < 4; ++ks) { wf[0][ks] = *(const bf16x8*)(Wb + 16 * ks); wf[1][ks] = *(const bf16x8*)(Wb + 32 * SCH + 16 * ks);
                                                       vf[0][ks] = *(const bf16x8*)(Vb + 16 * ks); vf[1][ks] = *(const bf16x8*)(Vb + 32 * SCH + 16 * ks); }
#pragma unroll
                      for (int p = 0; p < 8; ++p) { const int idx = p * NTHREADS + tid, t = idx >> 5, c8 = (idx & 31) * 8;
                          const u32x4 o = *(const u32x4*)(Zb + (mc + t) * DINP + ZC_SU + c8);
                          *(LAS u32x4*)(ub + t * UP + c8 * 2) = o; }
                      f32x16 acc[2][2];
#pragma unroll
                      for (int a = 0; a < 2; ++a)
#pragma unroll
                          for (int bq = 0; bq < 2; ++bq) acc[a][bq] = f32x16{};
#pragma unroll
                      for (int kh = 0; kh < 2; ++kh) {
#pragma unroll
                          for (int ks = 0; ks < 4; ++ks) {
                              acc[0][0] = __builtin_amdgcn_mfma_f32_32x32x16_bf16(vf[0][ks], wf[0][ks], acc[0][0], 0, 0, 0);
                              acc[0][1] = __builtin_amdgcn_mfma_f32_32x32x16_bf16(vf[0][ks], wf[1][ks], acc[0][1], 0, 0, 0);
                              acc[1][0] = __builtin_amdgcn_mfma_f32_32x32x16_bf16(vf[1][ks], wf[0][ks], acc[1][0], 0, 0, 0);
                              acc[1][1] = __builtin_amdgcn_mfma_f32_32x32x16_bf16(vf[1][ks], wf[1][ks], acc[1][1], 0, 0, 0);
                          }
                          if (kh == 0) {
#pragma unroll
                              for (int ks = 0; ks < 4; ++ks) { wf[0][ks] = *(const bf16x8*)(Wb + 64 + 16 * ks); wf[1][ks] = *(const bf16x8*)(Wb + 32 * SCH + 64 + 16 * ks);
                                                               vf[0][ks] = *(const bf16x8*)(Vb + 64 + 16 * ks); vf[1][ks] = *(const bf16x8*)(Vb + 32 * SCH + 64 + 16 * ks); }
                          }
                      }
                      __syncthreads();
#pragma unroll
                      for (int rb = 0; rb < 2; ++rb) { const int t = 64 * th + 32 * rb + r32; const float bt = bs[gq * SCH + t];
#pragma unroll
                          for (int cb = 0; cb < 2; ++cb)
#pragma unroll
                              for (int q4 = 0; q4 < 4; ++q4) { LAS u32x2* p = (LAS u32x2*)(ub + t * UP + (gq * 64 + 32 * cb + 8 * q4 + 4 * hi) * 2);
                                  const u32x2 up = *p; u32x2 w;
                                  w.x = cvtpk((acc[cb][rb][4 * q4 + 0] + bt) * lo_bf(up.x), (acc[cb][rb][4 * q4 + 1] + bt) * hi_bf(up.x));
                                  w.y = cvtpk((acc[cb][rb][4 * q4 + 2] + bt) * lo_bf(up.y), (acc[cb][rb][4 * q4 + 3] + bt) * hi_bf(up.y));
                                  *p = w; } }
                      __syncthreads();
#pragma unroll
                      for (int p = 0; p < 8; ++p) { const int idx = p * NTHREADS + tid, t = idx >> 5, c8 = (idx & 31) * 8;
                          *(u32x4*)(YCAT + (mc + t) * DM + 768 + c8) = *(const LAS u32x4*)(ub + t * UP + c8 * 2); }
                      __syncthreads();
                  } }
            } else if (sub == 3 && PHEN(5)) {
                TID_HERE(); PHASE_ROOTS();
                const int nun = (NB * NH * 32 + G - 1) / G;
#pragma nounroll
                for (int i = 0; i < nun; ++i) {
                    const int u_ = vcu + i * G;
                    int bh = u_ >> 5, qb = 31 - (u_ & 31);
                    if (G == 256) { bh = vcu >> 4; qb = (i == 0) ? 31 - (vcu & 15) : (vcu & 15); }
                    int tid_u = tid; asm volatile("" : "+v"(tid_u));
                    if (bh < NB * NH) att::attn_unit3<0>(bh >> 2, bh & 3, qb, Qb, KNb, KRb, VIb, Zb, YCAT, (char*)lds, tid_u);
                }
            } else if (sub == 5 && PHEN(7)) {
                TID_HERE(); PHASE_ROOTS();
                const float* xsrc = (l == 0) ? x_in : (const float*)outp;
                const float* gpost = (const float*)ARG(I_GPOST) + l * DM;
                const float* modl = mod + (size_t)l * 4 * 3072; const float* mod1 = mod + (size_t)4 * 3072; const float* gp1 = (const float*)ARG(I_GPRE) + DM;
                for (int grp = gw; grp < MTOK / 4; grp += NGW) { const int m0 = grp * 4, b = m0 >> 13;
                    u32x2 yv[4][4]; f32x4 xv[4][4];
#pragma unroll
                    for (int k = 0; k < 4; ++k) { const u32x2* yr = (const u32x2*)(Y16 + (size_t)(m0 + k) * DM) + lane; const f32x4* xr = (const f32x4*)(xsrc + (size_t)(m0 + k) * DM) + lane;
#pragma unroll
                        for (int j = 0; j < 4; ++j) { yv[k][j] = __builtin_nontemporal_load(&yr[64 * j]); xv[k][j] = __builtin_nontemporal_load(&xr[64 * j]); } }
                    f32x4 pg[4];
#pragma unroll
                    for (int j = 0; j < 4; ++j) { const int c = 4 * lane + 256 * j; pg[j] = *(const f32x4*)(modl + (size_t)b * 3072 + 2 * DM + c) * *(const f32x4*)(gpost + c); }
                    float rstd2[4];
#pragma unroll
                    for (int k = 0; k < 4; ++k) { float ss = 0.f; f32x4 y[4];
#pragma unroll
                        for (int j = 0; j < 4; ++j) { y[j] = (f32x4){lo_bf(yv[k][j].x), hi_bf(yv[k][j].x), lo_bf(yv[k][j].y), hi_bf(yv[k][j].y)};
                            ss += (y[j].x * y[j].x + y[j].y * y[j].y) + (y[j].z * y[j].z + y[j].w * y[j].w); }
                        const float rstd = rsqrtf(wave_sum(ss) * (1.f / DM) + EPS);
                        f32x4* orow = (f32x4*)(outp + (size_t)(m0 + k) * DM) + lane; float ss2 = 0.f;
#pragma unroll
                        for (int j = 0; j < 4; ++j) { xv[k][j] = xv[k][j] + (y[j] * rstd) * pg[j]; orow[64 * j] = xv[k][j];
                            ss2 += (xv[k][j].x * xv[k][j].x + xv[k][j].y * xv[k][j].y) + (xv[k][j].z * xv[k][j].z + xv[k][j].w * xv[k][j].w); }
                        rstd2[k] = rsqrtf(wave_sum(ss2) * (1.f / DM) + EPS); }
                    if (l == 0) {
                        f32x4 pa[4], pb[4];
#pragma unroll
                        for (int j = 0; j < 4; ++j) { const int c = 4 * lane + 256 * j;
                            pb[j] = *(const f32x4*)(mod1 + (size_t)b * 3072 + c);
                            pa[j] = *(const f32x4*)(gp1 + c) * (*(const f32x4*)(mod1 + (size_t)b * 3072 + DM + c) + 1.f); }
#pragma unroll
                        for (int k = 0; k < 4; ++k) { u32x2* o8 = (u32x2*)(Hb + (size_t)(m0 + k) * DM) + lane;
#pragma unroll
                            for (int j = 0; j < 4; ++j) { const f32x4 hv = (xv[k][j] * rstd2[k]) * pa[j] + pb[j];
                                u32x2 w; w.x = cvtpk(hv.x, hv.y); w.y = cvtpk(hv.z, hv.w); o8[64 * j] = w; } }
                    }
                }
            }
        }
        { bool again = false;
          if (rep == 0 && PROBE_MASK != 0) { if (ph == 0) again = (PROBE_MASK >> 7) & 1; else if (ph == 1) again = (PROBE_MASK >> 6) & 1; else if (ph >= 2) { const int sub_ = (ph - 2) % 6, l_ = (ph - 2) / 6; again = ((PROBE_MASK >> sub_) & 1) && !(sub_ == 5 && l_ == 1); } }
          if (again) rep = 1; else { rep = 0; ++ph; } }
        if (ph < ph_hi) { if (ph_lo < 0) grid.sync(); else xcd_barrier(xbar); }
    }
}

#ifndef APROBE
#define APROBE 0
#endif
#ifndef APROBE_AX
#define APROBE_AX 0
#endif
#ifndef APROBE_REP
#define APROBE_REP 2
#endif
#if APROBE
__global__ void __launch_bounds__(NTHREADS, 2) attn_probe(Args args) {
    extern __shared__ __attribute__((aligned(16))) unsigned char lds[];
    const int G = gridDim.x, bx = blockIdx.x; const int vcu = (bx % 8) * (G / 8) + bx / 8;
    unsigned char* ws = args.ws;
#pragma nounroll
    for (int i = 0; i < 2 * APROBE_REP; ++i) {
        const int bh = vcu >> 4, qb = ((i & 1) == 0) ? 31 - (vcu & 15) : (vcu & 15);
        int tid_u = threadIdx.x; asm volatile("" : "+v"(tid_u));
        att::attn_unit3<APROBE_AX>(bh >> 2, bh & 3, qb, (const bf16_t*)(ws + WS_Q), ws + WS_KN, ws + WS_KR, ws + WS_V, (const bf16_t*)(ws + WS_Z), (bf16_t*)(ws + WS_YCAT), (char*)lds, tid_u);
    }
}
#endif

extern "C" void kernel_launch(void* const* d_in, const int* in_sizes, int n_in, void* d_out, int out_size, void* d_ws, size_t ws_size, hipStream_t stream) {
    static int grid = 0;
    if (grid == 0) {
        if (n_in != 22 || in_sizes[0] != MTOK * DM || out_size != MTOK * DM || ws_size < WS_END) {
            fprintf(stderr, "kernel_launch: unexpected shapes (n_in %d, in0 %d, out %d, ws %zu); nothing launched\n", n_in, n_in > 0 ? in_sizes[0] : -1, out_size, ws_size); grid = -1; return; }
        int dev = 0, cus = 0, per_cu = 0;
        (void)hipGetDevice(&dev); (void)hipDeviceGetAttribute(&cus, hipDeviceAttributeMultiprocessorCount, dev);
        if (hipFuncSetAttribute((const void*)hymba_fwd, hipFuncAttributeMaxDynamicSharedMemorySize, LDS_BYTES) != hipSuccess) { fprintf(stderr, "kernel_launch: hipFuncSetAttribute failed\n"); grid = -1; return; }
        if (hipOccupancyMaxActiveBlocksPerMultiprocessor(&per_cu, (const void*)hymba_fwd, NTHREADS, LDS_BYTES) != hipSuccess || per_cu < 1) { fprintf(stderr, "kernel_launch: occupancy query says %d blocks per CU\n", per_cu); per_cu = 1; }
        (void)hipGetLastError();
        grid = cus > 0 ? cus : 256;
    }
    if (grid < 0) return;
    (void)hipMemsetAsync((char*)d_ws + WS_CTL, 0, CTL_BYTES, stream);
    Args a{};
    for (int i = 0; i < 22; ++i) a.in[i] = d_in[i];
    a.out = (float*)d_out; a.ws = (unsigned char*)d_ws;
#if MK_N_LAUNCHES == 1
    a.ph_lo = 0; a.ph_hi = N_PHASES;
    { void* kargs[] = {&a};
      hipError_t e = hipLaunchCooperativeKernel((const void*)hymba_fwd, dim3(grid), dim3(NTHREADS), kargs, LDS_BYTES, stream);
      if (e != hipSuccess) fprintf(stderr, "cooperative launch failed: %s (grid %d)\n", hipGetErrorString(e), grid); }
#if APROBE
    { (void)hipFuncSetAttribute((const void*)attn_probe, hipFuncAttributeMaxDynamicSharedMemorySize, LDS_BYTES);
      hipLaunchKernelGGL(attn_probe, dim3(256), dim3(NTHREADS), LDS_BYTES, stream, a); }
#endif
#else
    for (int ph = 0; ph < N_PHASES; ++ph) { a.ph_lo = ph; a.ph_hi = ph + 1; void* kargs[] = {&a};
        hipError_t e = hipLaunchCooperativeKernel((const void*)hymba_fwd, dim3(grid), dim3(NTHREADS), kargs, LDS_BYTES, stream);
        if (e != hipSuccess) { fprintf(stderr, "launch %d failed: %s (grid %d)\n", ph, hipGetErrorString(e), grid); break; } }
#endif
}
```

```cpp
#include <hip/hip_runtime.h>
#include <hip/hip_cooperative_groups.h>
#include <cstdio>
#include <cstdint>
namespace cg = cooperative_groups;

#ifndef MK_N_LAUNCHES
#define MK_N_LAUNCHES 1
#endif

#define LAS __attribute__((address_space(3)))
#ifndef ATT_EXP_TOP
#define ATT_EXP_TOP 0
#endif
#ifndef STAGGER_US
#define STAGGER_US 0
#endif
#ifndef PROBE_MASK
#define PROBE_MASK 0
#endif
#ifndef PHMASK
#define PHMASK 0xff
#endif
#define PHEN(k) (((PHMASK) >> (k)) & 1)
typedef unsigned short bf16_t;
typedef short bf16x8 __attribute__((ext_vector_type(8)));
typedef short s16x4 __attribute__((ext_vector_type(4)));
typedef float f32x2 __attribute__((ext_vector_type(2)));
typedef float f32x4 __attribute__((ext_vector_type(4)));
typedef float f32x16 __attribute__((ext_vector_type(16)));
typedef unsigned u32x2 __attribute__((ext_vector_type(2)));
typedef unsigned u32x4 __attribute__((ext_vector_type(4)));

constexpr int DM = 1024, NB = 4, SEQ = 8192, MTOK = NB * SEQ, NLAYER = 2;
constexpr int NH = 4, DNOPE = 128, DROPE = 64, DQK = 192, DV = 128;
constexpr int QLR = 256, KVLR = 128, DIN = 2496, DINP = 2560;
constexpr int CW = 256, CK = 31, SW = 256, SG = 4, SCH = 128;
constexpr float EPS = 1e-6f;
constexpr int ZC_Q = 0, ZC_KV = 256, ZC_KR = 384, ZC_GATT = 512, ZC_CA = 1024, ZC_CB = 1280, ZC_GC = 1536, ZC_SU = 1792, ZC_SV = 2048, ZC_GS = 2304;
constexpr float QSCALE = 0.07216878364870323f * 1.4426950408889634f;

constexpr size_t MiB = 1u << 20;
constexpr size_t WS_CTL = 0, CTL_BYTES = 1 * MiB;
constexpr size_t CTL_BARW = 1024;
constexpr size_t CTL_ADACNT = 8192;
constexpr size_t CTL_MOD = 65536;
constexpr size_t WS_COS = 1 * MiB, WS_SIN = 5 * MiB;
constexpr size_t WS_WIN = 9 * MiB;
constexpr size_t WS_WOUT = 19 * MiB;
constexpr size_t WS_WUQ = 23 * MiB;
constexpr size_t WS_WUKV = 24 * MiB;
constexpr size_t WS_WPW2 = 25 * MiB;
constexpr size_t WS_WSM = 26 * MiB;
constexpr size_t WS_ADAP = 27 * MiB;
constexpr size_t WS_H = 32 * MiB;
constexpr size_t WS_Z = 96 * MiB;
constexpr size_t WS_Y = WS_Z;
constexpr size_t WS_QLN = 256 * MiB;
constexpr size_t WS_KVLN = 272 * MiB;
constexpr size_t WS_CONVH = 288 * MiB;
constexpr size_t WS_SGVT = 304 * MiB;
constexpr size_t WS_Q = 320 * MiB;
constexpr size_t WS_KN = 368 * MiB;
constexpr size_t WS_KR = 400 * MiB;
constexpr size_t WS_V = 408 * MiB;
constexpr size_t WS_YCAT = 440 * MiB;
constexpr size_t WS_END = 504 * MiB;

constexpr int LDS_BYTES = 147456;
constexpr int NTHREADS = 512, NWAVES = 8;

__device__ __forceinline__ float bf2f(unsigned short u) { return __uint_as_float(((unsigned)u) << 16); }
__device__ __forceinline__ unsigned cvtpk(float lo, float hi) { unsigned r; asm("v_cvt_pk_bf16_f32 %0, %1, %2" : "=v"(r) : "v"(lo), "v"(hi)); return r; }
__device__ __forceinline__ float lo_bf(unsigned w) { return __uint_as_float(w << 16); }
__device__ __forceinline__ float hi_bf(unsigned w) { return __uint_as_float(w & 0xffff0000u); }
#define dpp_f(v, ctrl) __int_as_float(__builtin_amdgcn_update_dpp(0, __float_as_int(v), (ctrl), 0xf, 0xf, true))
#define DPP_XOR1 0xB1
#define DPP_XOR2 0x4E
#define DPP_HMIRROR 0x141
#define DPP_MIRROR 0x140
__device__ __forceinline__ float xor1_f(float v) { return dpp_f(v, DPP_XOR1); }
__device__ __forceinline__ float wave_sum(float v) {
    v += dpp_f(v, DPP_XOR1); v += dpp_f(v, DPP_XOR2); v += dpp_f(v, DPP_HMIRROR); v += dpp_f(v, DPP_MIRROR);
    const int iv = __float_as_int(v);
    return (__int_as_float(__builtin_amdgcn_readlane(iv, 0)) + __int_as_float(__builtin_amdgcn_readlane(iv, 16))) +
           (__int_as_float(__builtin_amdgcn_readlane(iv, 32)) + __int_as_float(__builtin_amdgcn_readlane(iv, 48)));
}
__device__ __forceinline__ float sigmoidf_(float x) { return __builtin_amdgcn_rcpf(1.f + __builtin_amdgcn_exp2f(-1.4426950408889634f * x)); }
__device__ __forceinline__ float siluf_(float x) { return x * __builtin_amdgcn_rcpf(1.f + __builtin_amdgcn_exp2f(-1.4426950408889634f * x)); }
__device__ __forceinline__ float geluf_(float v) {
    const float av = __builtin_fabsf(v), t = __builtin_amdgcn_rcpf(av * 0.2316418882f + 1.0f);
    float q = t * 0.5307027145f + (-0.7265760135f); q = q * t + 0.7107068705f; q = q * t + (-0.142248368f); q = q * t + 0.127414796f; q = q * t;
    const float e = __builtin_amdgcn_exp2f((v * v) * (-0.72134752044f));
    const float m = v * (q * e);
    return v < 0.f ? m : v - m;
}

namespace pg8 {
constexpr int BM = 256, BK = 64, HALF = 128, HTB = HALF * BK * 2, STAGE_BYTES = 8 * HTB, NXCD = 8, WGM = 8;
__host__ __device__ __forceinline__ int lds_byte(int r, int c) { const int st = (r >> 4) * 2 + (c >> 5), rr = r & 15, cc = c & 31, ob = rr * 64 + cc * 2; return st * 1024 + (ob ^ (((ob >> 9) & 1) << 5)); }
__host__ __device__ __forceinline__ void stage_rc(int b, int& R, int& C) { const int st = b / 1024, sb = b % 1024, swz = sb ^ (((sb >> 9) & 1) << 5); R = (st >> 1) * 16 + swz / 64; C = (st & 1) * 32 + (swz % 64) / 2; }
__host__ __device__ __forceinline__ int perm32(int rho) { const int n = rho >> 4, i = rho & 15; return 8 * (i >> 2) + 4 * n + (i & 3); }

struct Unit { int pm, pn; };
struct Gemm { const bf16_t* A; const bf16_t* Bt; int M, N, K, lda, ldb; };

struct StaticOrder {
    int nM, nN, nwg, G, c;
    __host__ __device__ void init(int M, int N, int G_, int c_) { nM = M / BM; nN = N / BM; nwg = nM * nN; G = G_; c = c_; }
    __host__ __device__ bool next(int i, Unit& u) const {
        const long L = (long)i * G + c; if (L >= nwg) return false;
        int wgid = (int)L; { const int q = nwg / NXCD, r = nwg % NXCD, xcd = wgid % NXCD, off = wgid / NXCD; wgid = (xcd < r ? xcd * (q + 1) : r * (q + 1) + (xcd - r) * q) + off; }
        const int nig = WGM * nN, gid = wgid / nig, fm = gid * WGM, gsz = (nM - fm) < WGM ? (nM - fm) : WGM;
        u.pm = fm + ((wgid % nig) % gsz); u.pn = (wgid % nig) / gsz; return true;
    }
};

template <class Epi>
__device__ __forceinline__ void gemm_phase(LAS unsigned char* lds, const Gemm g, const StaticOrder& S, const Epi& E, const int tid) {
    const int wid = __builtin_amdgcn_readfirstlane(tid >> 6), lane = tid & 63, wr = wid >> 2, wc = wid & 3, fr = lane & 15, fq = lane >> 4;
    const int K = g.K, nt = K / BK;
    unsigned voffA[2], voffB[2];
#pragma unroll
    for (int i = 0; i < 2; ++i) { int R, C; stage_rc(tid * 16 + i * 8192, R, C); const int Rb = Epi::PERM ? ((R & ~31) + perm32(R & 31)) : R;
        voffA[i] = (unsigned)(R * g.lda + C) * 2u; voffB[i] = (unsigned)(Rb * g.ldb + C) * 2u; }
    const size_t kstep = (size_t)(BK * 2);
    const size_t hstepA = (size_t)HALF * g.lda * 2, hstepB = (size_t)HALF * g.ldb * 2;
    const size_t tstepA = 2 * hstepA, tstepB = 2 * hstepB;
    const unsigned ldsw = (unsigned)wid * 1024u;
    const int aoff = lds_byte(wr * 64 + fr, fq * 8), boff = lds_byte(wc * 32 + fr, fq * 8);
#define PG8_SA(b, h) (((b) * 2 + (h)) * HTB)
#define PG8_SB(b, h) ((4 + (b) * 2 + (h)) * HTB)
#define PG8_STAGE(bufoff, gbase, voff) do { _Pragma("unroll") for (int _i = 0; _i < 2; ++_i) \
        __builtin_amdgcn_global_load_lds((const unsigned*)((const char*)(gbase) + (voff)[_i]), (LAS unsigned*)(lds + (bufoff) + ldsw + _i * 8192), 16, 0, 0); } while (0)
#define PG8_LDA(dst, b, h) do { _Pragma("unroll") for (int m = 0; m < 4; ++m) _Pragma("unroll") for (int k = 0; k < 2; ++k) dst[m][k] = *(const LAS bf16x8*)(lds + PG8_SA(b, h) + aoff + m * 2048 + k * 1024); } while (0)
#define PG8_LDB(dst, b, h) do { _Pragma("unroll") for (int n = 0; n < 2; ++n) _Pragma("unroll") for (int k = 0; k < 2; ++k) dst[n][k] = *(const LAS bf16x8*)(lds + PG8_SB(b, h) + boff + n * 2048 + k * 1024); } while (0)
#define PG8_MMA(ai, bj, At, Bt) do { __builtin_amdgcn_s_setprio(1); _Pragma("unroll") for (int m = 0; m < 4; ++m) _Pragma("unroll") for (int n = 0; n < 2; ++n) _Pragma("unroll") for (int k = 0; k < 2; ++k) \
        acc[ai][bj][m][n] = __builtin_amdgcn_mfma_f32_16x16x32_bf16(Bt[n][k], At[m][k], acc[ai][bj][m][n], 0, 0, 0); __builtin_amdgcn_s_setprio(0); } while (0)
#define PG8_WAIT_V(n) asm volatile("s_waitcnt vmcnt(" #n ")" ::: "memory")
#define PG8_WAIT_L(n) asm volatile("s_waitcnt lgkmcnt(" #n ")" ::: "memory")
#define PG8_BAR __builtin_amdgcn_s_barrier()
#define PG8_SCHED __builtin_amdgcn_sched_barrier(0)
    Unit cur, nxt; int ui = 0;
    if (!S.next(0, cur)) return;
    f32x4 acc[2][2][4][2];
#pragma unroll
    for (int a = 0; a < 2; ++a)
#pragma unroll
        for (int b = 0; b < 2; ++b)
#pragma unroll
            for (int m = 0; m < 4; ++m)
#pragma unroll
                for (int n = 0; n < 2; ++n) acc[a][b][m][n] = (f32x4){0.f, 0.f, 0.f, 0.f};
    bf16x8 At[4][2], B0[2][2], B1[2][2];
    const char* cA = (const char*)g.A + (size_t)cur.pm * tstepA; const char* cB = (const char*)g.Bt + (size_t)cur.pn * tstepB;
    PG8_STAGE(PG8_SB(0, 0), cB, voffB); PG8_STAGE(PG8_SB(0, 1), cB + hstepB, voffB); PG8_STAGE(PG8_SA(0, 0), cA, voffA); PG8_STAGE(PG8_SA(0, 1), cA + hstepA, voffA);
    if (wr == 1) PG8_BAR;
    PG8_WAIT_V(2); PG8_BAR;
    PG8_STAGE(PG8_SB(1, 0), cB + kstep, voffB); PG8_STAGE(PG8_SA(1, 0), cA + kstep, voffA); PG8_STAGE(PG8_SB(1, 1), cB + hstepB + kstep, voffB);
    PG8_WAIT_V(6); PG8_BAR;
    for (;;) {
        const bool has_next = S.next(ui + 1, nxt);
        const char* nA = has_next ? (const char*)g.A + (size_t)nxt.pm * tstepA : cA; const char* nB = has_next ? (const char*)g.Bt + (size_t)nxt.pn * tstepB : cB;
        for (int t = 0; t < nt; t += 2) {
            const bool last = (t == nt - 2);
            const char* a1 = cA + (size_t)(t + 1) * kstep;
            const char* a2 = last ? nA : cA + (size_t)(t + 2) * kstep; const char* b2 = last ? nB : cB + (size_t)(t + 2) * kstep;
            const char* a3 = a2 + kstep; const char* b3 = b2 + kstep;
            PG8_LDB(B0, 0, 0); PG8_LDB(B1, 0, 1); PG8_SCHED; PG8_LDA(At, 0, 0); PG8_STAGE(PG8_SA(1, 1), a1 + hstepA, voffA);
            PG8_WAIT_V(8); PG8_WAIT_L(0); PG8_BAR; PG8_MMA(0, 0, At, B0); PG8_MMA(0, 1, At, B1); PG8_BAR; PG8_SCHED;
            PG8_LDA(At, 0, 1); PG8_STAGE(PG8_SB(0, 0), b2, voffB); PG8_STAGE(PG8_SB(0, 1), b2 + hstepB, voffB); PG8_STAGE(PG8_SA(0, 0), a2, voffA);
            PG8_WAIT_V(8); PG8_WAIT_L(0); PG8_BAR; PG8_MMA(1, 0, At, B0); PG8_MMA(1, 1, At, B1); PG8_BAR; PG8_SCHED;
            PG8_LDB(B0, 1, 0); PG8_LDB(B1, 1, 1); PG8_SCHED; PG8_LDA(At, 1, 0); PG8_STAGE(PG8_SA(0, 1), a2 + hstepA, voffA);
            PG8_WAIT_V(8); PG8_WAIT_L(0); PG8_BAR; PG8_MMA(0, 0, At, B0); PG8_MMA(0, 1, At, B1); PG8_BAR; PG8_SCHED;
            PG8_LDA(At, 1, 1); PG8_STAGE(PG8_SB(1, 0), b3, voffB); PG8_STAGE(PG8_SB(1, 1), b3 + hstepB, voffB); PG8_STAGE(PG8_SA(1, 0), a3, voffA);
            PG8_WAIT_V(8); PG8_WAIT_L(0); PG8_BAR; PG8_MMA(1, 0, At, B0); PG8_MMA(1, 1, At, B1); PG8_BAR; PG8_SCHED;
        }
        if (wr == 0) PG8_BAR;
        { Unit uu = cur; asm volatile("" : "+s"(uu.pm), "+s"(uu.pn)); int t2 = tid; asm volatile("" : "+v"(t2));
          E(acc, uu, wr, wc, t2 & 15, (t2 & 63) >> 4); }
        if (!has_next) break;
#pragma unroll
        for (int a = 0; a < 2; ++a)
#pragma unroll
            for (int b = 0; b < 2; ++b)
#pragma unroll
                for (int m = 0; m < 4; ++m)
#pragma unroll
                    for (int n = 0; n < 2; ++n) acc[a][b][m][n] = (f32x4){0.f, 0.f, 0.f, 0.f};
        cur = nxt; cA = nA; cB = nB; ++ui;
        if (wr == 1) PG8_BAR;
    }
    PG8_WAIT_V(0);
    PG8_BAR;
#undef PG8_SA
#undef PG8_SB
#undef PG8_STAGE
#undef PG8_LDA
#undef PG8_LDB
#undef PG8_MMA
#undef PG8_WAIT_V
#undef PG8_WAIT_L
#undef PG8_BAR
#undef PG8_SCHED
}
}

__host__ __device__ __forceinline__ int v_st(int k, int c) { const int kk = k; return ((kk >> 3) * 4 + (c >> 5)) * 512 + ((kk & 7) * 32 + (c & 31)) * 2; }
__device__ __forceinline__ int v_rd_base(int lane) { return ((lane & 3) << 3) | (((lane >> 2) & 3) << 6) | (((lane >> 4) & 1) << 5) | (((lane >> 5) & 1) << 8); }
constexpr int v_rd_off(int d0, int ks, int half) { return d0 * 512 + ks * 4096 + half * 2048; }
__device__ __forceinline__ int crow(int r, int hi) { return (r & 3) + 8 * (r >> 2) + 4 * hi; }

enum { EM_Z = 0, EM_F32 = 1, EM_Q = 2, EM_KV = 3, EM_PW2 = 4, EM_Z1 = 5 };
struct EpiAll {
    static constexpr bool PERM = true;
    int mode; int ldc; void* p0; const void* p1; const void* p2;
    unsigned char* wsb; const float* qng; const float* kvng; LAS unsigned char* ldsp; const float* slg; const float* slb;
    __device__ __forceinline__ void operator()(const f32x4 (&acc)[2][2][4][2], const pg8::Unit& u, int wr, int wc, int fr, int fq) const {
        const int row0 = u.pm * 256 + wr * 64 + fr, col0 = u.pn * 256 + wc * 32 + 8 * fq;
        if (mode == EM_Z) {
            bf16_t* O = (bf16_t*)p0;
#pragma unroll
            for (int ai = 0; ai < 2; ++ai)
#pragma unroll
                for (int m = 0; m < 4; ++m) { bf16_t* rowp = O + (size_t)(row0 + ai * 128 + m * 16) * ldc + col0;
#pragma unroll
                    for (int bj = 0; bj < 2; ++bj) { const f32x4 v0 = acc[ai][bj][m][0], v1 = acc[ai][bj][m][1];
                        u32x4 w; w.x = cvtpk(v0[0], v0[1]); w.y = cvtpk(v0[2], v0[3]); w.z = cvtpk(v1[0], v1[1]); w.w = cvtpk(v1[2], v1[3]);
                        *(u32x4*)(rowp + bj * 128) = w; } }
        } else if (mode == EM_Z1) {
            bf16_t* O = (bf16_t*)p0; const int pn = u.pn;
            if (pn < 2) {
                LAS float* P = (LAS float*)(ldsp + 131072);
                const int nb = (pn == 0) ? 2 : 1;
#pragma unroll
                for (int ai = 0; ai < 2; ++ai)
#pragma unroll
                    for (int m = 0; m < 4; ++m) { float s = 0.f;
#pragma unroll
                        for (int bj = 0; bj < 2; ++bj) if (bj < nb) {
#pragma unroll
                            for (int n = 0; n < 2; ++n) { const f32x4 v = acc[ai][bj][m][n]; s += (v[0] * v[0] + v[1] * v[1]) + (v[2] * v[2] + v[3] * v[3]); } }
                        { auto r_ = __builtin_amdgcn_permlane32_swap(__float_as_uint(s), __float_as_uint(s), false, false); s = __uint_as_float(r_[0]) + __uint_as_float(r_[1]); }
                        { auto r_ = __builtin_amdgcn_permlane16_swap(__float_as_uint(s), __float_as_uint(s), false, false); s = __uint_as_float(r_[0]) + __uint_as_float(r_[1]); }
                        if (fq == 0) P[(ai * 128 + wr * 64 + m * 16 + fr) * 4 + wc] = s; }
                asm volatile("s_waitcnt lgkmcnt(0)" ::: "memory"); __builtin_amdgcn_s_barrier(); asm volatile("" ::: "memory");
                const int c8 = wc * 32 + 8 * fq;
                const float* gn = (pn == 0) ? qng : kvng;
                f32x4 g00 = *(const f32x4*)(gn + c8), g01 = *(const f32x4*)(gn + c8 + 4), g10 = g00, g11 = g01;
                if (pn == 0) { g10 = *(const f32x4*)(gn + 128 + c8); g11 = *(const f32x4*)(gn + 128 + c8 + 4); }
                bf16_t* QLNp = (bf16_t*)(wsb + WS_QLN); bf16_t* KVLNp = (bf16_t*)(wsb + WS_KVLN); unsigned char* KRp = wsb + WS_KR;
                const float* cs = (const float*)p1; const float* sn = (const float*)p2;
                const float inv_n = (pn == 0) ? (1.f / QLR) : (1.f / KVLR);
#pragma unroll
                for (int ai = 0; ai < 2; ++ai)
#pragma unroll
                    for (int m = 0; m < 4; ++m) { const int rl_ = ai * 128 + wr * 64 + m * 16 + fr; const int tok = u.pm * 256 + rl_;
                        const f32x4 pp = *(const LAS f32x4*)(P + rl_ * 4);
                        const float rstd = rsqrtf(((pp[0] + pp[1]) + (pp[2] + pp[3])) * inv_n + EPS);
                        { const f32x4 v0 = acc[ai][0][m][0] * rstd * g00, v1 = acc[ai][0][m][1] * rstd * g01;
                          u32x4 w; w.x = cvtpk(v0[0], v0[1]); w.y = cvtpk(v0[2], v0[3]); w.z = cvtpk(v1[0], v1[1]); w.w = cvtpk(v1[2], v1[3]);
                          if (pn == 0) *(u32x4*)(QLNp + (size_t)tok * QLR + c8) = w; else *(u32x4*)(KVLNp + (size_t)tok * KVLR + c8) = w; }
                        if (pn == 0) { const f32x4 v0 = acc[ai][1][m][0] * rstd * g10, v1 = acc[ai][1][m][1] * rstd * g11;
                          u32x4 w; w.x = cvtpk(v0[0], v0[1]); w.y = cvtpk(v0[2], v0[3]); w.z = cvtpk(v1[0], v1[1]); w.w = cvtpk(v1[2], v1[3]);
                          *(u32x4*)(QLNp + (size_t)tok * QLR + 128 + c8) = w; }
                        else if (wc < 2) { const f32x4 v0 = acc[ai][1][m][0], v1 = acc[ai][1][m][1]; const int i0 = 16 * wc + 4 * fq; const int b = tok >> 13, s_ = tok & 8191;
                          const f32x4 c4 = *(const f32x4*)(cs + (size_t)tok * 32 + i0), s4 = *(const f32x4*)(sn + (size_t)tok * 32 + i0);
                          u32x4 w; w.x = cvtpk(v0[0] * c4[0] - v0[1] * s4[0], v0[1] * c4[0] + v0[0] * s4[0]); w.y = cvtpk(v0[2] * c4[1] - v0[3] * s4[1], v0[3] * c4[1] + v0[2] * s4[1]);
                          w.z = cvtpk(v1[0] * c4[2] - v1[1] * s4[2], v1[1] * c4[2] + v1[0] * s4[2]); w.w = cvtpk(v1[2] * c4[3] - v1[3] * s4[3], v1[3] * c4[3] + v1[2] * s4[3]);
                          *(u32x4*)(KRp + ((size_t)(b * (SEQ / 64) + (s_ >> 6))) * 8192 + (4 * wc + fq) * 1024 + (s_ & 63) * 16) = w; } }
                return;
            }
            if (pn == 8) {
                typedef float f32x2l __attribute__((ext_vector_type(2)));
                LAS f32x2l* P2 = (LAS f32x2l*)(ldsp + 131072);
#pragma unroll
                for (int ai = 0; ai < 2; ++ai)
#pragma unroll
                    for (int m = 0; m < 4; ++m) { float s = 0.f, q = 0.f;
#pragma unroll
                        for (int bj = 0; bj < 2; ++bj)
#pragma unroll
                            for (int n = 0; n < 2; ++n) { const f32x4 v = acc[ai][bj][m][n];
#pragma unroll
                                for (int e = 0; e < 4; ++e) { const float x = geluf_(v[e]); s += x; q += x * x; } }
                        { auto r_ = __builtin_amdgcn_permlane32_swap(__float_as_uint(s), __float_as_uint(s), false, false); s = __uint_as_float(r_[0]) + __uint_as_float(r_[1]); }
                        { auto r_ = __builtin_amdgcn_permlane16_swap(__float_as_uint(s), __float_as_uint(s), false, false); s = __uint_as_float(r_[0]) + __uint_as_float(r_[1]); }
                        { auto r_ = __builtin_amdgcn_permlane32_swap(__float_as_uint(q), __float_as_uint(q), false, false); q = __uint_as_float(r_[0]) + __uint_as_float(r_[1]); }
                        { auto r_ = __builtin_amdgcn_permlane16_swap(__float_as_uint(q), __float_as_uint(q), false, false); q = __uint_as_float(r_[0]) + __uint_as_float(r_[1]); }
                        if (fq == 0) P2[(ai * 128 + wr * 64 + m * 16 + fr) * 4 + wc] = (f32x2l){s, q};
                        __builtin_amdgcn_sched_barrier(0); }
                asm volatile("s_waitcnt lgkmcnt(0)" ::: "memory"); __builtin_amdgcn_s_barrier(); asm volatile("" ::: "memory");
                const int c8 = wc * 32 + 8 * fq;
                f32x4 gg[2][2], bb[2][2];
#pragma unroll
                for (int bj = 0; bj < 2; ++bj)
#pragma unroll
                    for (int n = 0; n < 2; ++n) { gg[bj][n] = *(const f32x4*)(slg + bj * 128 + c8 + 4 * n); bb[bj][n] = *(const f32x4*)(slb + bj * 128 + c8 + 4 * n); }
#pragma unroll
                for (int ai = 0; ai < 2; ++ai)
#pragma unroll
                    for (int m = 0; m < 4; ++m) { const int rl_ = ai * 128 + wr * 64 + m * 16 + fr;
                        const f32x4 pa_ = *(const LAS f32x4*)(P2 + rl_ * 4), pb_ = *(const LAS f32x4*)(P2 + rl_ * 4 + 2);
                        const float mean = ((pa_[0] + pa_[2]) + (pb_[0] + pb_[2])) * (1.f / SW);
                        const float var = ((pa_[1] + pa_[3]) + (pb_[1] + pb_[3])) * (1.f / SW) - mean * mean;
                        const float rstd = rsqrtf(fmaxf(var, 0.f) + EPS);
                        bf16_t* rowb = O + (size_t)(row0 + ai * 128 + m * 16) * ldc + col0;
#pragma unroll
                        for (int bj = 0; bj < 2; ++bj) { f32x4 x0 = acc[ai][bj][m][0], x1 = acc[ai][bj][m][1];
#pragma unroll
                            for (int e = 0; e < 4; ++e) { asm volatile("" : "+v"(x0[e]), "+v"(x1[e])); x0[e] = geluf_(x0[e]); x1[e] = geluf_(x1[e]); }
                            const f32x4 v0 = (x0 - mean) * rstd * gg[bj][0] + bb[bj][0], v1 = (x1 - mean) * rstd * gg[bj][1] + bb[bj][1];
                            u32x4 w; w.x = cvtpk(v0[0], v0[1]); w.y = cvtpk(v0[2], v0[3]); w.z = cvtpk(v1[0], v1[1]); w.w = cvtpk(v1[2], v1[3]);
                            __builtin_nontemporal_store(w, (u32x4*)(rowb + bj * 128)); }
                        __builtin_amdgcn_sched_barrier(0); }
                return;
            }
            const bool paired = (pn == 4) | (pn == 5) | (pn == 7) | (pn == 9), gate = (pn == 2) | (pn == 3) | (pn == 6);
            const int pcol = (pn == 4 ? 1024 : pn == 5 ? 1152 : pn == 7 ? 1792 : 1920) + wc * 32 + 8 * fq;
#pragma unroll
            for (int ai = 0; ai < 2; ++ai)
#pragma unroll
                for (int m = 0; m < 4; ++m) { bf16_t* rowb = O + (size_t)(row0 + ai * 128 + m * 16) * ldc;
                    if (paired) { const f32x4 a0 = acc[ai][0][m][0], a1 = acc[ai][0][m][1], b0 = acc[ai][1][m][0], b1 = acc[ai][1][m][1]; f32x4 r0, r1;
                        if (pn < 6) {
#pragma unroll
                            for (int e = 0; e < 4; ++e) { r0[e] = a0[e] * sigmoidf_(b0[e]); r1[e] = a1[e] * sigmoidf_(b1[e]); } }
                        else {
#pragma unroll
                            for (int e = 0; e < 4; ++e) { r0[e] = geluf_(a0[e]) * siluf_(b0[e]); r1[e] = geluf_(a1[e]) * siluf_(b1[e]); } }
                        u32x4 w; w.x = cvtpk(r0[0], r0[1]); w.y = cvtpk(r0[2], r0[3]); w.z = cvtpk(r1[0], r1[1]); w.w = cvtpk(r1[2], r1[3]);
                        __builtin_nontemporal_store(w, (u32x4*)(rowb + pcol)); }
                    else {
#pragma unroll
                        for (int bj = 0; bj < 2; ++bj) { f32x4 v0 = acc[ai][bj][m][0], v1 = acc[ai][bj][m][1];
                            if (gate) {
#pragma unroll
                                for (int e = 0; e < 4; ++e) { v0[e] = siluf_(v0[e]); v1[e] = siluf_(v1[e]); } }
                            u32x4 w; w.x = cvtpk(v0[0], v0[1]); w.y = cvtpk(v0[2], v0[3]); w.z = cvtpk(v1[0], v1[1]); w.w = cvtpk(v1[2], v1[3]);
                            __builtin_nontemporal_store(w, (u32x4*)(rowb + col0 + bj * 128)); } } }
        } else if (mode == EM_F32) {
            float* C = (float*)p0;
#pragma unroll
            for (int ai = 0; ai < 2; ++ai)
#pragma unroll
                for (int m = 0; m < 4; ++m) { float* rowp = C + (size_t)(row0 + ai * 128 + m * 16) * ldc + col0;
#pragma unroll
                    for (int bj = 0; bj < 2; ++bj)
#pragma unroll
                        for (int n = 0; n < 2; ++n) *(f32x4*)(rowp + bj * 128 + n * 4) = acc[ai][bj][m][n]; }
        } else if (mode == EM_Q) {
            bf16_t* Q = (bf16_t*)p0; const float* cs = (const float*)p1; const float* sn = (const float*)p2;
#pragma unroll
            for (int ai = 0; ai < 2; ++ai)
#pragma unroll
                for (int m = 0; m < 4; ++m) { const int tok = row0 + ai * 128 + m * 16, b = tok >> 13, s = tok & 8191;
#pragma unroll
                    for (int bj = 0; bj < 2; ++bj) { f32x4 v0 = acc[ai][bj][m][0], v1 = acc[ai][bj][m][1]; const int n = col0 + bj * 128;
                        bf16_t* dst;
                        if (u.pn < 2) { const int h = n >> 7, d = n & 127; dst = Q + ((size_t)((b * NH + h) * SEQ + s)) * DQK + d; }
                        else { const int n2 = n - 512, h = n2 >> 6, w = n2 & 63, i0 = w >> 1;
                            const f32x4 c4 = *(const f32x4*)(cs + (size_t)tok * 32 + i0), s4 = *(const f32x4*)(sn + (size_t)tok * 32 + i0);
                            f32x4 a0, a1;
                            a0[0] = v0[0] * c4[0] - v0[1] * s4[0]; a0[1] = v0[1] * c4[0] + v0[0] * s4[0];
                            a0[2] = v0[2] * c4[1] - v0[3] * s4[1]; a0[3] = v0[3] * c4[1] + v0[2] * s4[1];
                            a1[0] = v1[0] * c4[2] - v1[1] * s4[2]; a1[1] = v1[1] * c4[2] + v1[0] * s4[2];
                            a1[2] = v1[2] * c4[3] - v1[3] * s4[3]; a1[3] = v1[3] * c4[3] + v1[2] * s4[3];
                            v0 = a0; v1 = a1; dst = Q + ((size_t)((b * NH + h) * SEQ + s)) * DQK + DNOPE + w; }
                        v0 = v0 * QSCALE; v1 = v1 * QSCALE;
                        u32x4 wv; wv.x = cvtpk(v0[0], v0[1]); wv.y = cvtpk(v0[2], v0[3]); wv.z = cvtpk(v1[0], v1[1]); wv.w = cvtpk(v1[2], v1[3]);
                        *(u32x4*)dst = wv; } }
        } else if (mode == EM_KV) {
            unsigned char* KN = (unsigned char*)p0; unsigned char* VI = (unsigned char*)p1;
#pragma unroll
            for (int ai = 0; ai < 2; ++ai)
#pragma unroll
                for (int m = 0; m < 4; ++m) { const int tok = row0 + ai * 128 + m * 16, b = tok >> 13, s = tok & 8191;
#pragma unroll
                    for (int bj = 0; bj < 2; ++bj) { const f32x4 v0 = acc[ai][bj][m][0], v1 = acc[ai][bj][m][1]; const int n = (col0 + bj * 128) & 511;
                        const int h = n >> 7, d = n & 127;
                        const size_t tbase = ((size_t)((b * NH + h) * (SEQ / 64) + (s >> 6))) * 16384;
                        unsigned char* dst = (u.pn < 2) ? KN + tbase + (d >> 3) * 1024 + (s & 63) * 16 : VI + tbase + v_st(s & 63, d);
                        u32x4 wv; wv.x = cvtpk(v0[0], v0[1]); wv.y = cvtpk(v0[2], v0[3]); wv.z = cvtpk(v1[0], v1[1]); wv.w = cvtpk(v1[2], v1[3]);
                        *(u32x4*)dst = wv; } }
        } else {
            bf16_t* YCAT = (bf16_t*)p0; const bf16_t* Z = (const bf16_t*)p1;
#pragma unroll
            for (int ai = 0; ai < 2; ++ai)
#pragma unroll
                for (int m = 0; m < 4; ++m) { const int tok = row0 + ai * 128 + m * 16;
#pragma unroll
                    for (int bj = 0; bj < 2; ++bj) { const f32x4 v0 = acc[ai][bj][m][0], v1 = acc[ai][bj][m][1]; const int c = col0 + bj * 128;
                        const u32x4 g = *(const u32x4*)(Z + (size_t)tok * DINP + ZC_GC + c);
                        u32x4 wv;
                        wv.x = cvtpk(v0[0] * lo_bf(g.x), v0[1] * hi_bf(g.x)); wv.y = cvtpk(v0[2] * lo_bf(g.y), v0[3] * hi_bf(g.y));
                        wv.z = cvtpk(v1[0] * lo_bf(g.z), v1[1] * hi_bf(g.z)); wv.w = cvtpk(v1[2] * lo_bf(g.w), v1[3] * hi_bf(g.w));
                        *(u32x4*)(YCAT + (size_t)tok * DM + 512 + c) = wv; } }
        }
    }
};

namespace att {
constexpr int SLOT = 40960, NSLOT = 3, VOFF = 24576, LDS_WS = NSLOT * SLOT;
constexpr float PLIM = 4096.f;
#define SBAR() __builtin_amdgcn_sched_barrier(0)
__device__ __forceinline__ void glds16s(const void* sbase, unsigned voff, unsigned lds_dst) { unsigned keep;
    asm volatile("s_mov_b32 %0, m0\n\ts_mov_b32 m0, %3\n\ts_nop 0\n\tglobal_load_lds_dwordx4 %1, %2\n\ts_mov_b32 m0, %0" : "=&s"(keep) : "v"(voff), "s"(sbase), "s"(lds_dst) : "memory"); }
#if ATT_EXP_TOP & 4
#define GLDS_DUP "global_load_lds_dwordx4 %1, off\n\t"
#else
#define GLDS_DUP ""
#endif
__device__ __forceinline__ void glds16(const void* gsrc, unsigned lds_dst) { unsigned keep;
    asm volatile("s_mov_b32 %0, m0\n\ts_mov_b32 m0, %2\n\ts_nop 0\n\tglobal_load_lds_dwordx4 %1, off\n\t" GLDS_DUP "s_mov_b32 m0, %0" : "=&s"(keep) : "v"(gsrc), "s"(lds_dst) : "memory"); }

template <int AX> __device__ __forceinline__ void attn_unit3(int b, int h, int qb, const bf16_t* Q, const unsigned char* KN, const unsigned char* KR, const unsigned char* VI,
                                           const bf16_t* Z, bf16_t* YCAT, char* shm, const int tid) {
    const int lane = tid & 63, r32 = lane & 31, hi = lane >> 5; const int wid = __builtin_amdgcn_readfirstlane(tid >> 6);
    const int q0 = qb * 256, NT = 4 * (qb + 1);
    const int bh = b * NH + h;
    const unsigned lds0 = (unsigned)(uintptr_t)shm;
    const unsigned char* knb = KN + (size_t)bh * (SEQ / 64) * 16384;
    const unsigned char* krb = KR + (size_t)b * (SEQ / 64) * 8192;
    const unsigned char* vbs = VI + (size_t)bh * (SEQ / 64) * 16384;
    const unsigned dvo = (unsigned)(wid * 1024 + lane * 16);
#define DMA_TILE(t, slot) do { const unsigned d_ = (unsigned)__builtin_amdgcn_readfirstlane(lds0 + (slot) + wid * 1024); \
        glds16s(knb + (size_t)(t) * 16384, dvo, d_); glds16s(knb + (size_t)(t) * 16384 + 8192, dvo, d_ + 8192); glds16s(krb + (size_t)(t) * 8192, dvo, d_ + 16384); \
        glds16s(vbs + (size_t)(t) * 16384, dvo, d_ + VOFF); glds16s(vbs + (size_t)(t) * 16384 + 8192, dvo, d_ + VOFF + 8192); } while (0)
    const bf16_t* Qw = Q + ((size_t)(bh * SEQ + q0 + wid * 32 + r32)) * DQK;
    bf16x8 qr[12];
#pragma unroll
    for (int d0 = 0; d0 < 12; ++d0) qr[d0] = *(const bf16x8*)(Qw + d0 * 16 + hi * 8);
    u32x4 gv[8];
    { const bf16_t* zp0 = Z + ((size_t)b * SEQ + q0 + wid * 32 + r32) * DINP + ZC_GATT + h * DV + 8 * hi;
#pragma unroll
      for (int j = 0; j < 8; ++j) gv[j] = *(const u32x4*)(zp0 + 16 * j); }
#pragma unroll
    for (int d0 = 0; d0 < 12; ++d0) asm volatile("" : "+v"(qr[d0]));
#pragma unroll
    for (int j = 0; j < 8; ++j) asm volatile("" : "+v"(gv[j]));
    asm volatile("s_waitcnt vmcnt(0)" ::: "memory");
    DMA_TILE(0, 0);
    float m_run = 0.f, l_run = 0.f; f32x16 o[4];
#pragma unroll
    for (int d = 0; d < 4; ++d) o[d] = f32x16{};
    const LAS char* shm3 = (const LAS char*)shm;
    const LAS char* kl = shm3 + hi * 1024 + r32 * 16;
    const int vb0 = (int)lds0 + VOFF + v_rd_base(lane);
    const int qabs = q0 + wid * 32 + r32;
    f32x16 sA, sB, negm; bf16x8 pa0, pa1;
    bf16x8 kpa, kpb;

#define MF(acc, a_, b_) acc = __builtin_amdgcn_mfma_f32_32x32x16_bf16(a_, b_, acc, 0, 0, 0)
#define MFH(SYv, a_, b_, c_) asm("v_mfma_f32_32x32x16_bf16 %0, %1, %2, %3" : "=&v"(SYv) : "v"(a_), "v"(b_), "v"(c_))
#define MFQ(acc, a_, b_) do { if (AX & 64) { asm volatile("" :: "v"(a_), "v"(b_)); } else MF(acc, a_, b_); } while (0)
#define MFO(acc, a_, b_) do { if (AX & 8) { bf16x8 t0_ = a_, t1_ = b_; asm volatile("" :: "v"(t0_), "v"(t1_)); } else acc = __builtin_amdgcn_mfma_f32_32x32x16_bf16(b_, a_, acc, 0, 0, 0); } while (0)
#define DMAP(on_, i_, t_, slot_) do { if ((on_) && !(AX & 2)) { const unsigned d_ = (unsigned)__builtin_amdgcn_readfirstlane(lds0 + (slot_) + wid * 1024); \
        if ((i_) == 0) glds16s(knb + (size_t)(t_) * 16384, dvo, d_); else if ((i_) == 1) glds16s(knb + (size_t)(t_) * 16384 + 8192, dvo, d_ + 8192); \
        else if ((i_) == 2) glds16s(krb + (size_t)(t_) * 8192, dvo, d_ + 16384); else if ((i_) == 3) glds16s(vbs + (size_t)(t_) * 16384, dvo, d_ + VOFF); \
        else glds16s(vbs + (size_t)(t_) * 16384 + 8192, dvo, d_ + VOFF + 8192); } } while (0)
#define KLD1(dst, kp_, d0) do { if (AX & 32) { asm volatile("" : "+v"(dst)); } else dst = *(const LAS bf16x8*)(kp_ + (d0) * 2048); } while (0)
#define KLD1R(dst, kp_, d0) dst = *(const LAS bf16x8*)(kp_ + (d0) * 2048)
#define MASKH(S, T_, hf_) do { if ((T_) >= NT - 4) { const float NEG = -__builtin_inff(); const int kb_ = 64 * (T_) + 32 * (hf_) + 4 * hi; \
        _Pragma("unroll") for (int r = 0; r < 16; ++r) { const int kv = kb_ + (r & 3) + 8 * (r >> 2); if (kv > qabs) S[r] = NEG; } } } while (0)
#define ROWMAX_FIN(mx0, mx1, out) do { float m_ = fmaxf(mx0, mx1); auto rr_ = __builtin_amdgcn_permlane32_swap(__float_as_uint(m_), __float_as_uint(m_), false, false); \
        out = fmaxf(__uint_as_float(rr_[0]), __uint_as_float(rr_[1])); } while (0)
#define DECIDE(part_, SYp) do { if (!__all((part_) <= 0.5f * PLIM)) { auto rt_ = __builtin_amdgcn_permlane32_swap(__float_as_uint(part_), __float_as_uint(part_), false, false); \
        const float tot_ = __uint_as_float(rt_[0]) + __uint_as_float(rt_[1]); const float dl_ = (tot_) > PLIM ? __builtin_amdgcn_logf(tot_) : 0.f; const float al_ = __builtin_amdgcn_exp2f(-dl_); m_run += dl_; l_run *= al_; \
        _Pragma("unroll") for (int r = 0; r < 16; ++r) { SYp[r] -= dl_; negm[r] = -m_run; } asm volatile("" : "+v"(negm)); \
        _Pragma("unroll") for (int d_ = 0; d_ < 4; ++d_) _Pragma("unroll") for (int r = 0; r < 16; ++r) o[d_][r] *= al_; } } while (0)
#define PK4(P, B_, OUT) do { if (AX & (128 | 4096)) { asm volatile("" : "=v"(OUT) : "v"(P)); break; } unsigned a0_ = cvtpk(P[B_ + 0], P[B_ + 1]), a1_ = cvtpk(P[B_ + 2], P[B_ + 3]); \
        unsigned b0_ = cvtpk(P[B_ + 4], P[B_ + 5]), b1_ = cvtpk(P[B_ + 6], P[B_ + 7]); \
        u32x4 w_ = {a0_, a1_, b0_, b1_}; OUT = *reinterpret_cast<bf16x8*>(&w_); } while (0)
#define SMC2(S, i) do { if (AX & (128 | 2048)) break; const float e0_ = (AX & 1) ? S[i] : __builtin_amdgcn_exp2f(S[i]), e1_ = (AX & 1) ? S[(i) + 1] : __builtin_amdgcn_exp2f(S[(i) + 1]); S[i] = e0_; S[(i) + 1] = e1_; if ((i) == 0) { ps0 = e0_; ps1 = e1_; } else { ps0 += e0_; ps1 += e1_; asm volatile("" : "+v"(ps0), "+v"(ps1)); } } while (0)
#define SMFIN() do { if (AX & (128 | 16384)) break; ptot = ps0 + ps1; l_run += ptot; } while (0)
#define TRRD(dst, off) do { if (AX & 16) asm volatile("" : "=v"(dst)); else asm volatile("ds_read_b64_tr_b16 %0, %1 offset:%2" : "=&v"(dst) : "v"(vb_), "i"(off) : "memory"); } while (0)
#define TRRD4(P_, d0, hf_) do { constexpr int b_ = v_rd_off(d0, 2 * (hf_), 0); TRRD(P_##l0, b_); TRRD(P_##h0, b_ + 2048); TRRD(P_##l1, b_ + 4096); TRRD(P_##h1, b_ + 6144); } while (0)
#define VF(P_, k) (bf16x8){P_##l##k[0], P_##l##k[1], P_##l##k[2], P_##l##k[3], P_##h##k[0], P_##h##k[1], P_##h##k[2], P_##h##k[3]}
#define LGK(n) do { if (!(AX & 256)) asm volatile("s_waitcnt lgkmcnt(" #n ")" ::: "memory"); } while (0)
#define RMC2(S, j) do { if (AX & (128 | 8192 | 32768)) break; mx0 = __builtin_fmaxf(__builtin_fmaxf(mx0, S[j]), S[(j) + 1]); } while (0)
#define RMC4(S, j) do { RMC2(S, j); RMC2(S, (j) + 2); } while (0)

#define HSTEP(SX, SY, T_, HF, TN, HFN, has_next_, dma_on_, bar_, pf_, knext_, td_) do { \
        float ps0 = 0.f, ps1 = 0.f, ptot = 0.f; \
        if (has_next_) { \
            const LAS char* kp_ = kl + ((HFN) == 0 ? sl_n1 : sl_cur) + (HFN) * 512; bf16x8 k0 = kpa, k1 = kpb, k2 = kpa; \
            KLD1(k2, kp_, 2); SBAR(); \
            if (AX & 64) { SY = negm; asm volatile("" :: "v"(k0)); } else MFH(SY, k0, qr[0], negm); SMC2(SX, 0); SBAR(); KLD1(k0, kp_, 3); DMAP(dma_on_, 0, td_, sl_n2); SBAR(); \
            MFQ(SY, k1, qr[1]); SMC2(SX, 2); SBAR(); KLD1(k1, kp_, 4); DMAP(dma_on_, 1, td_, sl_n2); SBAR(); \
            MFQ(SY, k2, qr[2]); SMC2(SX, 4); SBAR(); KLD1(k2, kp_, 5); DMAP(dma_on_, 2, td_, sl_n2); SBAR(); \
            MFQ(SY, k0, qr[3]); SMC2(SX, 6); SBAR(); KLD1(k0, kp_, 6); DMAP(dma_on_, 3, td_, sl_n2); SBAR(); \
            MFQ(SY, k1, qr[4]); SMC2(SX, 8); SBAR(); KLD1(k1, kp_, 7); DMAP(dma_on_, 4, td_, sl_n2); SBAR(); \
            MFQ(SY, k2, qr[5]); SMC2(SX, 10); SBAR(); KLD1(k2, kp_, 8); SBAR(); \
            MFQ(SY, k0, qr[6]); SMC2(SX, 12); SBAR(); KLD1(k0, kp_, 9); SBAR(); \
            MFQ(SY, k1, qr[7]); SMC2(SX, 14); SBAR(); KLD1(k1, kp_, 10); SBAR(); \
            MFQ(SY, k2, qr[8]); PK4(SX, 0, pa0); SBAR(); KLD1(k2, kp_, 11); SBAR(); \
            MFQ(SY, k0, qr[9]); PK4(SX, 8, pa1); SBAR(); \
            MFQ(SY, k1, qr[10]); SMFIN(); SBAR(); \
            MFQ(SY, k2, qr[11]); SBAR(); \
        } else { \
            _Pragma("unroll") for (int i_ = 0; i_ < 16; i_ += 2) SMC2(SX, i_); \
            PK4(SX, 0, pa0); PK4(SX, 8, pa1); SMFIN(); SBAR(); \
        } \
        if (bar_) { if (AX & 4) asm volatile("s_waitcnt vmcnt(0) lgkmcnt(0)" ::: "memory"); else asm volatile("s_waitcnt vmcnt(0) lgkmcnt(0)\n\ts_barrier" ::: "memory"); }     \
        { const int vb_ = vb0 + sl_cur; s16x4 Al0, Al1, Ah0, Ah1, Bl0, Bl1, Bh0, Bh1; \
          TRRD4(A, 0, HF); TRRD4(B, 1, HF); SBAR(); \
          if (pf_) { KLD1(kpa, knext_, 0); KLD1(kpb, knext_, 1); } SBAR(); \
          if (has_next_) MASKH(SY, TN, HFN); \
          SBAR(); if (pf_) LGK(6); else LGK(4); SBAR();                   \
          MFO(o[0], pa0, VF(A, 0)); SBAR(); MFO(o[0], pa1, VF(A, 1)); SBAR(); \
          TRRD4(A, 2, HF); SBAR(); if (pf_) LGK(6); else LGK(4); SBAR();    \
          MFO(o[1], pa0, VF(B, 0)); SBAR(); MFO(o[1], pa1, VF(B, 1)); SBAR(); \
          TRRD4(B, 3, HF); LGK(4); SBAR();                                  \
          MFO(o[2], pa0, VF(A, 0)); MFO(o[2], pa1, VF(A, 1)); SBAR(); \
          LGK(0); SBAR(); \
          MFO(o[3], pa0, VF(B, 0)); MFO(o[3], pa1, VF(B, 1)); SBAR(); \
          if ((has_next_) && !(AX & (128 | 8192))) { DECIDE(ptot, SY); } } \
    } while (0)

    int sl_cur = 0, sl_n1 = SLOT, sl_n2 = 2 * SLOT;
    asm volatile("s_waitcnt vmcnt(0) lgkmcnt(0)\n\ts_barrier" ::: "memory");
    DMA_TILE(1, SLOT); if (AX & 2) DMA_TILE(2, 2 * SLOT);
    { const LAS char* kp_ = shm3 + hi * 1024 + r32 * 16; bf16x8 ka, kb;
      sA = f32x16{};
      KLD1R(ka, kp_, 0); KLD1R(kb, kp_, 1); SBAR();
#pragma unroll
      for (int d2 = 0; d2 < 12; d2 += 2) {
          MF(sA, ka, qr[d2]); SBAR(); if (d2 + 2 < 12) KLD1R(ka, kp_, d2 + 2); SBAR();
          MF(sA, kb, qr[d2 + 1]); SBAR(); if (d2 + 3 < 12) KLD1R(kb, kp_, d2 + 3); SBAR(); }
      KLD1R(kpa, kp_ + 512, 0); KLD1R(kpb, kp_ + 512, 1); SBAR(); }
    MASKH(sA, 0, 0);
    { float mx0 = -__builtin_inff();
#pragma unroll
      for (int j = 0; j < 16; j += 2) RMC2(sA, j);
      ROWMAX_FIN(mx0, mx0, m_run);
#pragma unroll
      for (int r = 0; r < 16; ++r) { sA[r] -= m_run; negm[r] = -m_run; } asm volatile("" : "+v"(negm)); }
    for (int T = 0; T < ((AX & 1024) ? 1 : NT); ++T) {
        const int tdma = (T + 2 < NT) ? T + 2 : NT - 1;
        HSTEP(sA, sB, T, 0, T, 1, true, false, true, true, (kl + sl_n1), 0);
        HSTEP(sB, sA, T, 1, T + 1, 0, true, true, false, true, (kl + sl_n1 + 512), tdma);
        { const int tmp_ = sl_cur; sl_cur = sl_n1; sl_n1 = sl_n2; sl_n2 = tmp_; }
    }
    asm volatile("s_waitcnt lgkmcnt(0)\n\ts_barrier" ::: "memory");
    if (AX & 512) { asm volatile("" :: "v"(o[0]), "v"(o[1]), "v"(o[2]), "v"(o[3])); } else
    { int r32e = r32, hie = hi; asm volatile("" : "+v"(r32e), "+v"(hie));
      const size_t mrow = (size_t)b * SEQ + q0 + wid * 32 + r32e;
      bf16_t* yp = YCAT + mrow * DM + h * DV + 8 * hie;
      auto rl_ = __builtin_amdgcn_permlane32_swap(__float_as_uint(l_run), __float_as_uint(l_run), false, false);
      const float rl = __builtin_amdgcn_rcpf(__uint_as_float(rl_[0]) + __uint_as_float(rl_[1]));
#pragma unroll
      for (int j = 0; j < 8; ++j) { const int d0 = j >> 1, gp = j & 1; float na[4], nb[4];
#pragma unroll
          for (int i = 0; i < 4; ++i) { auto rr_ = __builtin_amdgcn_permlane32_swap(__float_as_uint(o[d0][8 * gp + i] * rl), __float_as_uint(o[d0][8 * gp + 4 + i] * rl), false, false);
              na[i] = __uint_as_float(rr_[0]); nb[i] = __uint_as_float(rr_[1]); }
          const u32x4 g = gv[j]; u32x4 w;
          w.x = cvtpk(na[0] * lo_bf(g.x), na[1] * hi_bf(g.x)); w.y = cvtpk(na[2] * lo_bf(g.y), na[3] * hi_bf(g.y));
          w.z = cvtpk(nb[0] * lo_bf(g.z), nb[1] * hi_bf(g.z)); w.w = cvtpk(nb[2] * lo_bf(g.w), nb[3] * hi_bf(g.w));
          *(u32x4*)(yp + 16 * j) = w; } }
#undef DMA_TILE
#undef DMAP
#undef MF
#undef MFQ
#undef MFH
#undef MFO
#undef KLD1R
#undef KLD1
#undef MASKH
#undef ROWMAX_FIN
#undef DECIDE
#undef PK4
#undef SMC2
#undef SMFIN
#undef TRRD
#undef TRRD4
#undef VF
#undef LGK
#undef RMC2
#undef RMC4
#undef HSTEP
}
#undef SBAR
}

#define XB_TMO      128
#define XB_XCNT(j)  (256  + 64 * (j))
#define XB_XSUB(j)  (1280 + 64 * (j))
#define XB_XGEN(j)  (2304 + 64 * (j))
#define XB_TOP      3328
#define XB_TOPGEN   3392
#define XCD_BAR_WORDS 3456
#define XB_SPIN_CAP (1u << 18)
__device__ __forceinline__ unsigned xb_ld(unsigned* p)              { return __hip_atomic_load(p, __ATOMIC_RELAXED, __HIP_MEMORY_SCOPE_AGENT); }
__device__ __forceinline__ unsigned xb_add(unsigned* p, unsigned v) { return __hip_atomic_fetch_add(p, v, __ATOMIC_RELAXED, __HIP_MEMORY_SCOPE_AGENT); }
__device__ __forceinline__ unsigned xb_xcc_id() { return (unsigned)__builtin_amdgcn_s_getreg((3 << 11) | 20) & 0xFu; }
#define XB_SPIN(cond, bar) do { unsigned _sp = 0; while (cond) { __builtin_amdgcn_s_sleep(1); \
    if ((++_sp & 255u) == 0u) { if (xb_ld(&(bar)[XB_TMO])) break; if (_sp > XB_SPIN_CAP) { atomicAdd(&(bar)[XB_TMO], 1u); break; } } } } while (0)
struct XcdBarrier { unsigned* bar; unsigned x; volatile LAS unsigned* st; };
__device__ __forceinline__ XcdBarrier xcd_barrier_post(unsigned* bar, volatile LAS unsigned* st) {
    XcdBarrier b; b.bar = bar; b.x = xb_xcc_id(); b.st = st;
    if (threadIdx.x == 0) (void)xb_add(&bar[XB_XCNT(b.x)], 1u);
    return b;
}
__device__ __forceinline__ void xcd_barrier_complete(unsigned* bar, unsigned x, unsigned& nloc, unsigned& nx) {
    const unsigned G = gridDim.x * gridDim.y * gridDim.z;
    unsigned sum, cnt, mine, sp = 0u;
    for (;;) {
        sum = 0u; cnt = 0u; mine = 0u;
#pragma unroll
        for (unsigned j = 0; j < 16; ++j) { const unsigned c = xb_ld(&bar[XB_XCNT(j)]); sum += c; cnt += (c > 0u) ? 1u : 0u; mine = (j == x) ? c : mine; }
        if (sum == G) break;
        __builtin_amdgcn_s_sleep(1);
        if ((++sp & 255u) == 0u) { if (xb_ld(&bar[XB_TMO])) break; if (sp > XB_SPIN_CAP) { atomicAdd(&bar[XB_TMO], 1u); break; } }
    }
    nloc = mine > 0u ? mine : 1u; nx = cnt > 0u ? cnt : 1u;
}
__device__ __forceinline__ void xcd_barrier(const XcdBarrier& b) {
    asm volatile("s_waitcnt vmcnt(0)" ::: "memory");
    __syncthreads();
    if (threadIdx.x == 0) {
        unsigned* bar = b.bar;
        __builtin_amdgcn_s_waitcnt(0);
        unsigned nloc = b.st[0], nx = b.st[1];
        if (nloc == 0u) { xcd_barrier_complete(bar, b.x, nloc, nx); b.st[0] = nloc; b.st[1] = nx; }
        const unsigned old = xb_add(&bar[XB_XSUB(b.x)], 1u);
        const unsigned gen = old / nloc;
        if (old + 1u == (gen + 1u) * nloc) {
            __builtin_amdgcn_fence(__ATOMIC_RELEASE, "agent");
            asm volatile("s_waitcnt vmcnt(0)" ::: "memory");
            const unsigned og = xb_add(&bar[XB_TOP], 1u);
            const unsigned tg = og / nx;
            if (og + 1u == (tg + 1u) * nx) xb_add(&bar[XB_TOPGEN], 1u);
            else XB_SPIN(xb_ld(&bar[XB_TOPGEN]) == tg, bar);
            __builtin_amdgcn_fence(__ATOMIC_ACQUIRE, "agent");
            xb_add(&bar[XB_XGEN(b.x)], 1u);
            asm volatile("s_waitcnt vmcnt(0)" ::: "memory");
        } else {
            XB_SPIN(xb_ld(&bar[XB_XGEN(b.x)]) == gen, bar);
            __builtin_amdgcn_fence(__ATOMIC_ACQUIRE, "agent");
            asm volatile("s_waitcnt vmcnt(0)" ::: "memory");
        }
    }
    __syncthreads();
}

struct Args { const void* in[22]; float* out; unsigned char* ws; int ph_lo, ph_hi; };
enum { I_X = 0, I_C, I_POS, I_WADA, I_BADA, I_GPRE, I_GPOST, I_WIN, I_QNG, I_WUQ, I_KVNG, I_WUKV, I_CONVW, I_CONVB, I_CLNG, I_CLNB, I_WPW2, I_SLNG, I_SLNB, I_WS, I_BS, I_WOUT };
constexpr int N_PHASES = 2 + 6 * NLAYER;

__device__ __forceinline__ int wmap(int mat, int n) {
    if (mat == 0) {
        if (n < 384) return n; if (n < 448) { const int w = n - 384; return 384 + 32 * (w & 1) + (w >> 1); } if (n < 512) return -1;
        const int t = n >> 8, j = n & 127, second = (n >> 7) & 1;
        if (t == 4 || t == 5) return (second ? 1216 : 960) + (t - 4) * 128 + j;
        if (t == 7 || t == 9) return (second ? 2240 : 1728) + (t == 9 ? 128 : 0) + j;
        return n - 64; }
    if (mat == 2) { if (n < 512) return (n >> 7) * DQK + (n & 127); const int n2 = n - 512, h = n2 >> 6, w = n2 & 63; return h * DQK + DNOPE + 32 * (w & 1) + (w >> 1); }
    if (mat == 3) { const int h = (n & 511) >> 7, d = n & 127; return h * 256 + (n >= 512 ? 128 : 0) + d; }
    return n;
}
__device__ __forceinline__ void transpose_item(const float* W, int Nsrc, bf16_t* WT, int Kd, int mat, LAS float* scr, int kb, int nb, int lane) {
    const int k0 = 64 * kb, n0 = 32 * nb; const int src = wmap(mat, n0 + (lane & 31));
#pragma unroll 8
    for (int i = 0; i < 32; ++i) { const int kk = 2 * i + (lane >> 5); scr[kk * 33 + (lane & 31)] = src >= 0 ? W[(size_t)(k0 + kk) * Nsrc + src] : 0.f; }
    asm volatile("s_waitcnt lgkmcnt(0)" ::: "memory");
    const int c = lane & 7;
#pragma unroll
    for (int j = 0; j < 4; ++j) { const int n = (lane >> 3) + 8 * j; const LAS float* s = scr + (8 * c) * 33 + n;
        u32x4 o; o.x = cvtpk(s[0 * 33], s[1 * 33]); o.y = cvtpk(s[2 * 33], s[3 * 33]); o.z = cvtpk(s[4 * 33], s[5 * 33]); o.w = cvtpk(s[6 * 33], s[7 * 33]);
        *(u32x4*)(WT + (size_t)(n0 + n) * Kd + k0 + 8 * c) = o; }
    asm volatile("s_waitcnt lgkmcnt(0)" ::: "memory");
}

__global__ void __launch_bounds__(NTHREADS, 2) hymba_fwd(Args args) {
    extern __shared__ __attribute__((aligned(16))) unsigned char lds[];
    typedef const __attribute__((address_space(4))) Args* KArgP;
    cg::grid_group grid = cg::this_grid();
    const int ph_lo = args.ph_lo, ph_hi = args.ph_hi;
    const int wave_s = __builtin_amdgcn_readfirstlane(threadIdx.x >> 6);
    volatile LAS unsigned* xbst = (volatile LAS unsigned*)((LAS unsigned char*)lds + LDS_BYTES - 64);
    if (threadIdx.x < 4) xbst[threadIdx.x] = 0u;
    __syncthreads();
    const XcdBarrier xbar = xcd_barrier_post((unsigned*)(args.ws + WS_CTL) + CTL_BARW, xbst);

    int ph = ph_lo, rep = 0;
    while (ph < ph_hi) {
        KArgP ap0 = (KArgP)__builtin_amdgcn_kernarg_segment_ptr();
#define ARG(k) (ap->in[k])
#define TID_HERE() int lane; asm volatile("v_mbcnt_lo_u32_b32 %0, -1, 0\n\tv_mbcnt_hi_u32_b32 %0, -1, %0" : "=v"(lane)); const int tid = wave_s * 64 + lane; (void)tid
        const int wave = wave_s;
#define PHASE_ROOTS() \
        KArgP ap = ap0; asm volatile("" : "+s"(ap)); \
        int G = gridDim.x, bx = blockIdx.x; asm volatile("" : "+s"(G), "+s"(bx)); \
        const int vcu = (G % 8 == 0) ? (bx % 8) * (G / 8) + bx / 8 : bx; \
        const int gw = vcu * NWAVES + wave, NGW = G * NWAVES; (void)gw; (void)NGW; \
        unsigned char* ws = ap->ws; float* outp = ap->out; (void)outp; \
        const float* x_in = (const float*)ARG(I_X); (void)x_in; \
        float* adap = (float*)(ws + WS_ADAP); (void)adap; float* mod = (float*)(ws + WS_CTL + CTL_MOD); (void)mod; \
        float* cs_t = (float*)(ws + WS_COS); float* sn_t = (float*)(ws + WS_SIN); (void)cs_t; (void)sn_t; \
        bf16_t* Hb = (bf16_t*)(ws + WS_H); bf16_t* Zb = (bf16_t*)(ws + WS_Z); bf16_t* Y16 = (bf16_t*)(ws + WS_Y); (void)Hb; (void)Zb; (void)Y16; \
        bf16_t* QLN = (bf16_t*)(ws + WS_QLN); bf16_t* KVLN = (bf16_t*)(ws + WS_KVLN); bf16_t* CONVH = (bf16_t*)(ws + WS_CONVH); bf16_t* SGVT = (bf16_t*)(ws + WS_SGVT); (void)QLN; (void)KVLN; (void)CONVH; (void)SGVT; \
        bf16_t* Qb = (bf16_t*)(ws + WS_Q); unsigned char* KNb = ws + WS_KN; unsigned char* KRb = ws + WS_KR; unsigned char* VIb = ws + WS_V; (void)Qb; (void)KNb; (void)KRb; (void)VIb; \
        bf16_t* YCAT = (bf16_t*)(ws + WS_YCAT); (void)YCAT
        if (ph == 0 && PHEN(0)) {
            TID_HERE(); PHASE_ROOTS();
            LAS float* scr = (LAS float*)(lds + wave * 16384);
            for (int it = gw; it < NLAYER * 16 * 48; it += NGW) { const int l = it / 768, r = it % 768, kc = r / 48, nc = r % 48;
                const float* W = (const float*)ARG(I_WADA) + (size_t)l * DM * 3072 + (size_t)(kc * 64) * 3072 + nc * 64 + lane;
                const float* c = (const float*)ARG(I_C) + kc * 64;
                float a0 = 0.f, a1 = 0.f, a2 = 0.f, a3 = 0.f;
#pragma unroll 8
                for (int k = 0; k < 64; ++k) { const float w = W[(size_t)k * 3072];
                    a0 += siluf_(c[k]) * w; a1 += siluf_(c[DM + k]) * w; a2 += siluf_(c[2 * DM + k]) * w; a3 += siluf_(c[3 * DM + k]) * w; }
                float* dst = adap + ((size_t)(kc * 2 + l) * 4) * 3072 + nc * 64 + lane;
                __hip_atomic_store(dst, a0, __ATOMIC_RELAXED, __HIP_MEMORY_SCOPE_AGENT); __hip_atomic_store(dst + 3072, a1, __ATOMIC_RELAXED, __HIP_MEMORY_SCOPE_AGENT);
                __hip_atomic_store(dst + 2 * 3072, a2, __ATOMIC_RELAXED, __HIP_MEMORY_SCOPE_AGENT); __hip_atomic_store(dst + 3 * 3072, a3, __ATOMIC_RELAXED, __HIP_MEMORY_SCOPE_AGENT);
                asm volatile("s_waitcnt vmcnt(0)" ::: "memory");
                unsigned tk = 0;
                if (lane == 0) tk = __hip_atomic_fetch_add((unsigned*)(ws + WS_CTL) + CTL_ADACNT + (l * 48 + nc) * 16, 1u, __ATOMIC_RELAXED, __HIP_MEMORY_SCOPE_AGENT);
                tk = (unsigned)__builtin_amdgcn_readfirstlane((int)tk);
                if (tk == 15u) {
                    const float* bada = (const float*)ARG(I_BADA) + (size_t)l * 3072;
#pragma unroll
                    for (int b = 0; b < 4; ++b) { float s = 0.f;
#pragma unroll
                        for (int k2 = 0; k2 < 16; ++k2) s += __hip_atomic_load(adap + ((size_t)(k2 * 2 + l) * 4 + b) * 3072 + nc * 64 + lane, __ATOMIC_RELAXED, __HIP_MEMORY_SCOPE_AGENT);
                        mod[((size_t)l * 4 + b) * 3072 + nc * 64 + lane] = s + bada[nc * 64 + lane]; }
                } }
            {
                constexpr int I0 = 16 * 80, I1 = 16 * 32, I2 = 4 * 24, I3 = 2 * 32, I4 = 4 * 8, IL = I0 + I1 + I2 + I3 + I4;
                for (int it = gw; it < NLAYER * IL; it += NGW) {
                    const int l = it / IL; int r = it % IL;
                    if (r < I0) { transpose_item((const float*)ARG(I_WIN) + (size_t)l * DM * DIN, DIN, (bf16_t*)(ws + WS_WIN) + (size_t)l * DINP * DM, DM, 0, scr, r / 80, r % 80, lane); continue; } r -= I0;
                    if (r < I1) { transpose_item((const float*)ARG(I_WOUT) + (size_t)l * DM * DM, DM, (bf16_t*)(ws + WS_WOUT) + (size_t)l * DM * DM, DM, 1, scr, r / 32, r % 32, lane); continue; } r -= I1;
                    if (r < I2) { transpose_item((const float*)ARG(I_WUQ) + (size_t)l * QLR * 768, 768, (bf16_t*)(ws + WS_WUQ) + (size_t)l * 768 * 256, 256, 2, scr, r / 24, r % 24, lane); continue; } r -= I2;
                    if (r < I3) { transpose_item((const float*)ARG(I_WUKV) + (size_t)l * KVLR * 1024, 1024, (bf16_t*)(ws + WS_WUKV) + (size_t)l * 1024 * 128, 128, 3, scr, r / 32, r % 32, lane); continue; } r -= I3;
                    transpose_item((const float*)ARG(I_WPW2) + (size_t)l * CW * CW, CW, (bf16_t*)(ws + WS_WPW2) + (size_t)l * CW * CW, CW, 4, scr, r / 8, r % 8, lane);
                }
            }
            const int gt = vcu * NTHREADS + tid, NGT = G * NTHREADS;
            for (int i = gt; i < NLAYER * SG * SCH * SCH; i += NGT) { const int s = i & 127, t = (i >> 7) & 127;
                const float v = s <= t ? ((const float*)ARG(I_WS))[i] : 0.f; ((bf16_t*)(ws + WS_WSM))[i] = (bf16_t)(cvtpk(v, 0.f) & 0xffffu); }
            const float inv_freq = powf(10000.0f, -(float)(2 * (gt & 31)) / 64.0f);
            for (int i = gt; i < MTOK * 32; i += NGT) { const int tok = i >> 5;
                const float ang = (float)((const int*)ARG(I_POS))[tok] * inv_freq;
                cs_t[i] = cosf(ang); sn_t[i] = sinf(ang); }
        } else if (ph == 1 && PHEN(1)) {
            TID_HERE(); PHASE_ROOTS();
            const float* gp = (const float*)ARG(I_GPRE);
            for (int grp = gw; grp < MTOK / 4; grp += NGW) { const int m0 = grp * 4, b = m0 >> 13;
                f32x4 v[4][4];
#pragma unroll
                for (int k = 0; k < 4; ++k) { const f32x4* xr = (const f32x4*)(x_in + (size_t)(m0 + k) * DM) + lane;
#pragma unroll
                    for (int j = 0; j < 4; ++j) v[k][j] = __builtin_nontemporal_load(&xr[64 * j]); }
                f32x4 pa[4], pb[4];
#pragma unroll
                for (int j = 0; j < 4; ++j) { const int c = 4 * lane + 256 * j;
                    pb[j] = *(const f32x4*)(mod + (size_t)b * 3072 + c);
                    pa[j] = *(const f32x4*)(gp + c) * (*(const f32x4*)(mod + (size_t)b * 3072 + DM + c) + 1.f); }
#pragma unroll
                for (int k = 0; k < 4; ++k) { float ss = 0.f;
#pragma unroll
                    for (int j = 0; j < 4; ++j) ss += (v[k][j].x * v[k][j].x + v[k][j].y * v[k][j].y) + (v[k][j].z * v[k][j].z + v[k][j].w * v[k][j].w);
                    const float rstd = rsqrtf(wave_sum(ss) * (1.f / DM) + EPS);
                    u32x2* o8 = (u32x2*)(Hb + (size_t)(m0 + k) * DM) + lane;
#pragma unroll
                    for (int j = 0; j < 4; ++j) { const f32x4 hv = (v[k][j] * rstd) * pa[j] + pb[j];
                        u32x2 w; w.x = cvtpk(hv.x, hv.y); w.y = cvtpk(hv.z, hv.w); o8[64 * j] = w; } }
            }
        } else {
            const int l = (ph - 2) / 6, sub = (ph - 2) % 6;
            const int ngemm = (sub == 0 || sub == 4) ? 1 : (sub == 2 ? 3 : 0);
#pragma nounroll
            for (int gi_ = 0; gi_ < ngemm * (1 + ((PROBE_MASK >> 8) & 1)) && PHEN(2); ++gi_) {
                const int gi = gi_ % ngemm;
                TID_HERE(); PHASE_ROOTS();
                pg8::Gemm g; EpiAll E; int Nn, cc = bx;
                if (sub == 0) { g = pg8::Gemm{Hb, (const bf16_t*)(ws + WS_WIN) + (size_t)l * DINP * DM, MTOK, DINP, DM, DM, DM}; Nn = DINP; E = EpiAll{EM_Z1, DINP, Zb, cs_t, sn_t, ws, (const float*)ARG(I_QNG) + l * QLR, (const float*)ARG(I_KVNG) + l * KVLR, (LAS unsigned char*)lds, (const float*)ARG(I_SLNG) + l * SW, (const float*)ARG(I_SLNB) + l * SW}; }
                else if (sub == 4) { g = pg8::Gemm{YCAT, (const bf16_t*)(ws + WS_WOUT) + (size_t)l * DM * DM, MTOK, DM, DM, DM, DM}; Nn = DM; E = EpiAll{EM_Z, DM, Y16, nullptr, nullptr, nullptr, nullptr, nullptr, nullptr, nullptr, nullptr}; }
                else if (gi == 0) { g = pg8::Gemm{QLN, (const bf16_t*)(ws + WS_WUQ) + (size_t)l * 768 * 256, MTOK, 768, 256, 256, 256}; Nn = 768; E = EpiAll{EM_Q, 0, Qb, cs_t, sn_t, nullptr, nullptr, nullptr, nullptr, nullptr, nullptr}; }
                else if (gi == 1) { g = pg8::Gemm{CONVH, (const bf16_t*)(ws + WS_WPW2) + (size_t)l * CW * CW, MTOK, CW, CW, CW, CW}; Nn = CW; cc = (bx + G / 2) % G; E = EpiAll{EM_PW2, 0, YCAT, Zb, nullptr, nullptr, nullptr, nullptr, nullptr, nullptr, nullptr}; }
                else { g = pg8::Gemm{KVLN, (const bf16_t*)(ws + WS_WUKV) + (size_t)l * 1024 * 128, MTOK, 1024, 128, 128, 128}; Nn = 1024; E = EpiAll{EM_KV, 0, KNb, VIb, nullptr, nullptr, nullptr, nullptr, nullptr, nullptr, nullptr}; }
                pg8::StaticOrder S; S.init(MTOK, Nn, G, cc);
#if STAGGER_US > 0
                if (sub == 0 && (bx & 8)) { const unsigned long long t0_ = __builtin_amdgcn_s_memrealtime(); while (__builtin_amdgcn_s_memrealtime() - t0_ < (unsigned long long)(STAGGER_US * 100)) __builtin_amdgcn_s_sleep(8); }
#endif
                pg8::gemm_phase<EpiAll>((LAS unsigned char*)lds, g, S, E, tid);
            }
            if (sub == 0) {
            } else if (sub == 1 && PHEN(3)) {
                TID_HERE(); PHASE_ROOTS();
                const float* cw = (const float*)ARG(I_CONVW) + (size_t)l * CK * CW; const float* cb = (const float*)ARG(I_CONVB) + l * CW;
                const float* clg = (const float*)ARG(I_CLNG) + l * CW; const float* clb = (const float*)ARG(I_CLNB) + l * CW;
                LAS float* glu = (LAS float*)lds;
                LAS float* cvo = (LAS float*)(lds + 63488);
                LAS bf16_t* sgv = (LAS bf16_t*)(lds + 63488 + 32768);
                float cwv[CK];
#pragma unroll
                for (int j = 0; j < CK; ++j) cwv[j] = cw[j * CW + (tid & 255)];
                const float cbias = cb[tid & 255];
                const f32x4 clg4 = *(const f32x4*)(clg + 4 * lane), clb4 = *(const f32x4*)(clb + 4 * lane);
                u32x4 ga[4]; u32x2 zsv[4];
#define P2A_LOAD(tt_) do { const int b_ = (tt_) >> 8, s0_ = ((tt_) & 255) * 32; const size_t m0_ = (size_t)b_ * SEQ + s0_; \
                    _Pragma("unroll") for (int pass = 0; pass < 4; ++pass) { const int r = pass * 16 + (tid >> 5), c8 = (tid & 31) * 8; const int s = s0_ - 30 + r; \
                        ga[pass] = *(const u32x4*)(Zb + ((size_t)b_ * SEQ + (s >= 0 ? (r < 62 ? s : s0_) : 0)) * DINP + ZC_CA + c8); \
                        if (r >= 62 || s < 0) ga[pass] = (u32x4){0u, 0u, 0u, 0u}; } \
                    _Pragma("unroll") for (int i = 0; i < 4; ++i) { const size_t m = m0_ + 4 * wave + i; const bf16_t* zr = Zb + m * DINP; \
                        zsv[i] = *(const u32x2*)(zr + ZC_SV + 4 * lane); } } while (0)
                P2A_LOAD(vcu < MTOK / 32 ? vcu : 0);
                for (int tt = vcu; tt < MTOK / 32; tt += G) {
                    const int b = tt >> 8, s0 = (tt & 255) * 32; const size_t m0 = (size_t)b * SEQ + s0;
#pragma unroll
                    for (int pass = 0; pass < 4; ++pass) { const int r = pass * 16 + (tid >> 5), c8 = (tid & 31) * 8;
                        if (r < 62) { const u32x4 a = ga[pass];
                            *(LAS f32x4*)(glu + r * 256 + c8) = (f32x4){lo_bf(a.x), hi_bf(a.x), lo_bf(a.y), hi_bf(a.y)}; *(LAS f32x4*)(glu + r * 256 + c8 + 4) = (f32x4){lo_bf(a.z), hi_bf(a.z), lo_bf(a.w), hi_bf(a.w)}; } }
#pragma unroll
                    for (int i = 0; i < 4; ++i) { const int tl = 4 * wave + i; const size_t m = m0 + tl; const int s = s0 + tl;
                        *(LAS u32x2*)(sgv + tl * 256 + 4 * lane) = zsv[i];
                    }
                    __syncthreads();
                    { const int tn = tt + G; P2A_LOAD(tn < MTOK / 32 ? tn : tt); }
                    { const int c = tid & 255, half = tid >> 8;
                      for (int g4 = 0; g4 < 4; ++g4) { const int tb = 16 * half + 4 * g4; float v[34];
#pragma unroll
                          for (int k = 0; k < 34; ++k) v[k] = glu[(tb + k) * 256 + c];
#pragma unroll
                          for (int i = 0; i < 4; ++i) { float a = cbias;
#pragma unroll
                              for (int j = 0; j < CK; ++j) a += cwv[j] * v[i + j];
                              cvo[(tb + i) * 256 + c] = a; } } }
                    __syncthreads();
                    for (int i = 0; i < 4; ++i) { const int tl = 4 * wave + i; const size_t m = m0 + tl;
                        const f32x4 xv = *(const LAS f32x4*)(cvo + tl * 256 + 4 * lane);
                        const float mean = wave_sum((xv.x + xv.y) + (xv.z + xv.w)) * (1.f / CW);
                        const float d0 = xv.x - mean, d1 = xv.y - mean, d2 = xv.z - mean, d3 = xv.w - mean;
                        const float rstd = rsqrtf(wave_sum((d0 * d0 + d1 * d1) + (d2 * d2 + d3 * d3)) * (1.f / CW) + EPS);
                        const f32x4 g = clg4, bb = clb4;
                        u32x2 w; w.x = cvtpk(siluf_(d0 * rstd * g.x + bb.x), siluf_(d1 * rstd * g.y + bb.y)); w.y = cvtpk(siluf_(d2 * rstd * g.z + bb.z), siluf_(d3 * rstd * g.w + bb.w));
                        *(u32x2*)(CONVH + m * 256 + 4 * lane) = w; }
                    { const int c = tid & 255, half = tid >> 8; unsigned pk[8];
#pragma unroll
                      for (int k = 0; k < 8; ++k) { const unsigned lo = sgv[(16 * half + 2 * k) * 256 + c], hi2 = sgv[(16 * half + 2 * k + 1) * 256 + c]; pk[k] = lo | (hi2 << 16); }
                      bf16_t* dst = SGVT + ((size_t)(m0 >> 7) * 256 + c) * 128 + (s0 & 127) + 16 * half;
                      *(u32x4*)dst = (u32x4){pk[0], pk[1], pk[2], pk[3]}; *(u32x4*)(dst + 8) = (u32x4){pk[4], pk[5], pk[6], pk[7]}; }
                    __syncthreads();
                }
#undef P2A_LOAD
            } else if (sub == 2 && PHEN(4)) {
                TID_HERE(); PHASE_ROOTS();
                { const bf16_t* WsM = (const bf16_t*)(ws + WS_WSM) + (size_t)l * SG * SCH * SCH; const float* bs = (const float*)ARG(I_BS) + l * SG * SCH;
                  const int r32 = lane & 31, hi = lane >> 5, gq = wave >> 1, th = wave & 1;
                  constexpr int UP = 528;
                  LAS unsigned char* ub = (LAS unsigned char*)lds;
                  for (int ck_ = vcu; ck_ < (MTOK / SCH) * (1 + ((PROBE_MASK >> 9) & 1)); ck_ += G) { const int ck = ck_ % (MTOK / SCH);
                      const size_t mc = (size_t)ck * SCH;
                      const bf16_t* Wb = WsM + ((size_t)gq * SCH + 64 * th + r32) * SCH + 8 * hi;
                      const bf16_t* Vb = SGVT + ((size_t)ck * 256 + gq * 64 + r32) * SCH + 8 * hi;
                      bf16x8 wf[2][4], vf[2][4];
#pragma unroll
                      for (int ks = 0; ks < 4; ++ks) { wf[0][ks] = *(const bf16x8*)(Wb + 16 * ks); wf[1][ks] = *(const bf16x8*)(Wb + 32 * SCH + 16 * ks);
                                                       vf[0][ks] = *(const bf16x8*)(Vb + 16 * ks); vf[1][ks] = *(const bf16x8*)(Vb + 32 * SCH + 16 * ks); }
#pragma unroll
                      for (int p = 0; p < 8; ++p) { const int idx = p * NTHREADS + tid, t = idx >> 5, c8 = (idx & 31) * 8;
                          const u32x4 o = *(const u32x4*)(Zb + (mc + t) * DINP + ZC_SU + c8);
                          *(LAS u32x4*)(ub + t * UP + c8 * 2) = o; }
                      f32x16 acc[2][2];
#pragma unroll
                      for (int a = 0; a < 2; ++a)
#pragma unroll
                          for (int bq = 0; bq < 2; ++bq) acc[a][bq] = f32x16{};
#pragma unroll
                      for (int kh = 0; kh < 2; ++kh) {
#pragma unroll
                          for (int ks = 0; ks < 4; ++ks) {
                              acc[0][0] = __builtin_amdgcn_mfma_f32_32x32x16_bf16(vf[0][ks], wf[0][ks], acc[0][0], 0, 0, 0);
                              acc[0][1] = __builtin_amdgcn_mfma_f32_32x32x16_bf16(vf[0][ks], wf[1][ks], acc[0][1], 0, 0, 0);
                              acc[1][0] = __builtin_amdgcn_mfma_f32_32x32x16_bf16(vf[1][ks], wf[0][ks], acc[1][0], 0, 0, 0);
                              acc[1][1] = __builtin_amdgcn_mfma_f32_32x32x16_bf16(vf[1][ks], wf[1][ks], acc[1][1], 0, 0, 0);
                          }
                          if (kh == 0) {
#pragma unroll
                              for (int ks = 0; ks < 4; ++ks) { wf[0][ks] = *(const bf16x8*)(Wb + 64 + 16 * ks); wf[1][ks] = *(const bf16x8*)(Wb + 32 * SCH + 64 + 16 * ks);
                                                               vf[0][ks] = *(const bf16x8*)(Vb + 64 + 16 * ks); vf[1][ks] = *(const bf16x8*)(Vb + 32 * SCH + 64 + 16 * ks); }
                          }
                      }
                      __syncthreads();
#pragma unroll
                      for (int rb = 0; rb < 2; ++rb) { const int t = 64 * th + 32 * rb + r32; const float bt = bs[gq * SCH + t];
#pragma unroll
                          for (int cb = 0; cb < 2; ++cb)
#pragma unroll
                              for (int q4 = 0; q4 < 4; ++q4) { LAS u32x2* p = (LAS u32x2*)(ub + t * UP + (gq * 64 + 32 * cb + 8 * q4 + 4 * hi) * 2);
                                  const u32x2 up = *p; u32x2 w;
                                  w.x = cvtpk((acc[cb][rb][4 * q4 + 0] + bt) * lo_bf(up.x), (acc[cb][rb][4 * q4 + 1] + bt) * hi_bf(up.x));
                                  w.y = cvtpk((acc[cb][rb][4 * q4 + 2] + bt) * lo_bf(up.y), (acc[cb][rb][4 * q4 + 3] + bt) * hi_bf(up.y));
                                  *p = w; } }
                      __syncthreads();
#pragma unroll
                      for (int p = 0; p < 8; ++p) { const int idx = p * NTHREADS + tid, t = idx >> 5, c8 = (idx & 31) * 8;
                          *(u32x4*)(YCAT + (mc + t) * DM + 768 + c8) = *(const LAS u32x4*)(ub + t * UP + c8 * 2); }
                      __syncthreads();
                  } }
            } else if (sub == 3 && PHEN(5)) {
                TID_HERE(); PHASE_ROOTS();
                const int nun = (NB * NH * 32 + G - 1) / G;
#pragma nounroll
                for (int i = 0; i < nun; ++i) {
                    const int u_ = vcu + i * G;
                    int bh = u_ >> 5, qb = 31 - (u_ & 31);
                    if (G == 256) { bh = vcu >> 4; qb = (i == 0) ? 31 - (vcu & 15) : (vcu & 15); }
                    int tid_u = tid; asm volatile("" : "+v"(tid_u));
                    if (bh < NB * NH) att::attn_unit3<0>(bh >> 2, bh & 3, qb, Qb, KNb, KRb, VIb, Zb, YCAT, (char*)lds, tid_u);
                }
            } else if (sub == 5 && PHEN(7)) {
                TID_HERE(); PHASE_ROOTS();
                const float* xsrc = (l == 0) ? x_in : (const float*)outp;
                const float* gpost = (const float*)ARG(I_GPOST) + l * DM;
                const float* modl = mod + (size_t)l * 4 * 3072; const float* mod1 = mod + (size_t)4 * 3072; const float* gp1 = (const float*)ARG(I_GPRE) + DM;
                for (int grp = gw; grp < MTOK / 4; grp += NGW) { const int m0 = grp * 4, b = m0 >> 13;
                    u32x2 yv[4][4]; f32x4 xv[4][4];
#pragma unroll
                    for (int k = 0; k < 4; ++k) { const u32x2* yr = (const u32x2*)(Y16 + (size_t)(m0 + k) * DM) + lane; const f32x4* xr = (const f32x4*)(xsrc + (size_t)(m0 + k) * DM) + lane;
#pragma unroll
                        for (int j = 0; j < 4; ++j) { yv[k][j] = __builtin_nontemporal_load(&yr[64 * j]); xv[k][j] = __builtin_nontemporal_load(&xr[64 * j]); } }
                    f32x4 pg[4];
#pragma unroll
                    for (int j = 0; j < 4; ++j) { const int c = 4 * lane + 256 * j; pg[j] = *(const f32x4*)(modl + (size_t)b * 3072 + 2 * DM + c) * *(const f32x4*)(gpost + c); }
                    float rstd2[4];
#pragma unroll
                    for (int k = 0; k < 4; ++k) { float ss = 0.f; f32x4 y[4];
#pragma unroll
                        for (int j = 0; j < 4; ++j) { y[j] = (f32x4){lo_bf(yv[k][j].x), hi_bf(yv[k][j].x), lo_bf(yv[k][j].y), hi_bf(yv[k][j].y)};
                            ss += (y[j].x * y[j].x + y[j].y * y[j].y) + (y[j].z * y[j].z + y[j].w * y[j].w); }
                        const float rstd = rsqrtf(wave_sum(ss) * (1.f / DM) + EPS);
                        f32x4* orow = (f32x4*)(outp + (size_t)(m0 + k) * DM) + lane; float ss2 = 0.f;
#pragma unroll
                        for (int j = 0; j < 4; ++j) { xv[k][j] = xv[k][j] + (y[j] * rstd) * pg[j]; orow[64 * j] = xv[k][j];
                            ss2 += (xv[k][j].x * xv[k][j].x + xv[k][j].y * xv[k][j].y) + (xv[k][j].z * xv[k][j].z + xv[k][j].w * xv[k][j].w); }
                        rstd2[k] = rsqrtf(wave_sum(ss2) * (1.f / DM) + EPS); }
                    if (l == 0) {
                        f32x4 pa[4], pb[4];
#pragma unroll
                        for (int j = 0; j < 4; ++j) { const int c = 4 * lane + 256 * j;
                            pb[j] = *(const f32x4*)(mod1 + (size_t)b * 3072 + c);
                            pa[j] = *(const f32x4*)(gp1 + c) * (*(const f32x4*)(mod1 + (size_t)b * 3072 + DM + c) + 1.f); }
#pragma unroll
                        for (int k = 0; k < 4; ++k) { u32x2* o8 = (u32x2*)(Hb + (size_t)(m0 + k) * DM) + lane;
#pragma unroll
                            for (int j = 0; j < 4; ++j) { const f32x4 hv = (xv[k][j] * rstd2[k]) * pa[j] + pb[j];
                                u32x2 w; w.x = cvtpk(hv.x, hv.y); w.y = cvtpk(hv.z, hv.w); o8[64 * j] = w; } }
                    }
                }
            }
        }
        { bool again = false;
          if (rep == 0 && PROBE_MASK != 0) { if (ph == 0) again = (PROBE_MASK >> 7) & 1; else if (ph == 1) again = (PROBE_MASK >> 6) & 1; else if (ph >= 2) { const int sub_ = (ph - 2) % 6, l_ = (ph - 2) / 6; again = ((PROBE_MASK >> sub_) & 1) && !(sub_ == 5 && l_ == 1); } }
          if (again) rep = 1; else { rep = 0; ++ph; } }
        if (ph < ph_hi) { if (ph_lo < 0) grid.sync(); else xcd_barrier(xbar); }
    }
}

#ifndef APROBE
#define APROBE 0
#endif
#ifndef APROBE_AX
#define APROBE_AX 0
#endif
#ifndef APROBE_REP
#define APROBE_REP 2
#endif
#if APROBE
__global__ void __launch_bounds__(NTHREADS, 2) attn_probe(Args args) {
    extern __shared__ __attribute__((aligned(16))) unsigned char lds[];
    const int G = gridDim.x, bx = blockIdx.x; const int vcu = (bx % 8) * (G / 8) + bx / 8;
    unsigned char* ws = args.ws;
#pragma nounroll
    for (int i = 0; i < 2 * APROBE_REP; ++i) {
        const int bh = vcu >> 4, qb = ((i & 1) == 0) ? 31 - (vcu & 15) : (vcu & 15);
        int tid_u = threadIdx.x; asm volatile("" : "+v"(tid_u));
        att::attn_unit3<APROBE_AX>(bh >> 2, bh & 3, qb, (const bf16_t*)(ws + WS_Q), ws + WS_KN, ws + WS_KR, ws + WS_V, (const bf16_t*)(ws + WS_Z), (bf16_t*)(ws + WS_YCAT), (char*)lds, tid_u);
    }
}
#endif

extern "C" void kernel_launch(void* const* d_in, const int* in_sizes, int n_in, void* d_out, int out_size, void* d_ws, size_t ws_size, hipStream_t stream) {
    static int grid = 0;
    if (grid == 0) {
        if (n_in != 22 || in_sizes[0] != MTOK * DM || out_size != MTOK * DM || ws_size < WS_END) {
            fprintf(stderr, "kernel_launch: unexpected shapes (n_in %d, in0 %d, out %d, ws %zu); nothing launched\n", n_in, n_in > 0 ? in_sizes[0] : -1, out_size, ws_size); grid = -1; return; }
        int dev = 0, cus = 0, per_cu = 0;
        (void)hipGetDevice(&dev); (void)hipDeviceGetAttribute(&cus, hipDeviceAttributeMultiprocessorCount, dev);
        if (hipFuncSetAttribute((const void*)hymba_fwd, hipFuncAttributeMaxDynamicSharedMemorySize, LDS_BYTES) != hipSuccess) { fprintf(stderr, "kernel_launch: hipFuncSetAttribute failed\n"); grid = -1; return; }
        if (hipOccupancyMaxActiveBlocksPerMultiprocessor(&per_cu, (const void*)hymba_fwd, NTHREADS, LDS_BYTES) != hipSuccess || per_cu < 1) { fprintf(stderr, "kernel_launch: occupancy query says %d blocks per CU\n", per_cu); per_cu = 1; }
        (void)hipGetLastError();
        grid = cus > 0 ? cus : 256;
    }
    if (grid < 0) return;
    (void)hipMemsetAsync((char*)d_ws + WS_CTL, 0, CTL_BYTES, stream);
    Args a{};
    for (int i = 0; i < 22; ++i) a.in[i] = d_in[i];
    a.out = (float*)d_out; a.ws = (unsigned char*)d_ws;
#if MK_N_LAUNCHES == 1
    a.ph_lo = 0; a.ph_hi = N_PHASES;
    { void* kargs[] = {&a};
      hipError_t e = hipLaunchCooperativeKernel((const void*)hymba_fwd, dim3(grid), dim3(NTHREADS), kargs, LDS_BYTES, stream);
      if (e != hipSuccess) fprintf(stderr, "cooperative launch failed: %s (grid %d)\n", hipGetErrorString(e), grid); }
#if APROBE
    { (void)hipFuncSetAttribute((const void*)attn_probe, hipFuncAttributeMaxDynamicSharedMemorySize, LDS_BYTES);
      hipLaunchKernelGGL(attn_probe, dim3(256), dim3(NTHREADS), LDS_BYTES, stream, a); }
#endif
#else
    for (int ph = 0; ph < N_PHASES; ++ph) { a.ph_lo = ph; a.ph_hi = ph + 1; void* kargs[] = {&a};
        hipError_t e = hipLaunchCooperativeKernel((const void*)hymba_fwd, dim3(grid), dim3(NTHREADS), kargs, LDS_BYTES, stream);
        if (e != hipSuccess) { fprintf(stderr, "launch %d failed: %s (grid %d)\n", ph, hipGetErrorString(e), grid); break; } }
#endif
}
```
